# Optimizing an MI355X kernel written in HIP

```python
import jax, jax.numpy as jnp
from jax import lax
import numpy as np

D_MODEL = 2048
BATCH = 1
SEQ = 8192
DEPTH = 2

GRID_W = 64
CTX_LEN = 256
HEAD_DIM = 128
N_HEADS = D_MODEL // HEAD_DIM
A_HEADS = 6
A_KV_HEADS = 2
A_GROUP = A_HEADS // A_KV_HEADS
A_WINDOW = 128
A_BLOCK = 128
B_HEADS = 6
NA_ROWS = 8
NA_COLS = 16
C_GROUPS = N_HEADS - A_HEADS - B_HEADS
C_GROUP_W = HEAD_DIM
C_W = C_GROUPS * C_GROUP_W
CHUNK = 128
N_EXPERTS = 32
N_EXPERT_GROUPS = 4
EXPERTS_PER_GROUP = N_EXPERTS // N_EXPERT_GROUPS
TOP_K = 2
EXPERT_FF = 512
ROPE_BASE = 10000.0
LN_EPS = 1e-5
NEG_INF = -1e30
DEEPNORM_ALPHA = (2 * DEPTH) ** 0.25
DEEPNORM_BETA = (8 * DEPTH) ** -0.25

A_Q_W = A_HEADS * HEAD_DIM
A_KV_W = A_KV_HEADS * HEAD_DIM
B_W = B_HEADS * HEAD_DIM
OFF_AK = A_Q_W
OFF_AV = OFF_AK + A_KV_W
OFF_BQ = OFF_AV + A_KV_W
OFF_BK = OFF_BQ + B_W
OFF_BV = OFF_BK + B_W
OFF_C = OFF_BV + B_W
IN_COLS = OFF_C + 2 * C_W
MIX_W = A_Q_W + B_W + C_W

kernel_name = 'hybrid_dit_window_natten_sgu_moe'


def layer_norm(x, g, b):
    xf = x.astype(jnp.float32)
    mu = jnp.mean(xf, axis=-1, keepdims=True)
    var = jnp.mean(jnp.square(xf - mu), axis=-1, keepdims=True)
    return ((xf - mu) * lax.rsqrt(var + LN_EPS)).astype(x.dtype) * g + b


def heads(p, lo, hi, n):
    return p[..., lo:hi].reshape(p.shape[:-1] + (n, HEAD_DIM))


def axial_rope(n):
    t = jnp.arange(n)
    row = (t // GRID_W).astype(jnp.float32)
    col = (t % GRID_W).astype(jnp.float32)
    n_freq = HEAD_DIM // 4
    inv_freq = ROPE_BASE ** (-jnp.arange(n_freq, dtype=jnp.float32) / n_freq)
    ang = jnp.concatenate([row[:, None] * inv_freq, col[:, None] * inv_freq], axis=-1)
    return jnp.cos(ang), jnp.sin(ang)


def apply_rope(x, cos, sin):
    half = HEAD_DIM // 2
    c = cos[None, :, None, :].astype(x.dtype)
    s = sin[None, :, None, :].astype(x.dtype)
    x1, x2 = x[..., :half], x[..., half:]
    return jnp.concatenate([x1 * c - x2 * s, x2 * c + x1 * s], axis=-1)


def window_attention(q, k, v, kc, vc, sink):
    B, n, H, dh = q.shape
    L = kc.shape[1]
    nb = n // A_BLOCK
    scale = dh ** -0.5
    qb = q.reshape(B, nb, A_BLOCK, A_KV_HEADS, A_GROUP, dh)

    def band(t):
        tp = jnp.pad(t, ((0, 0), (A_BLOCK, A_BLOCK), (0, 0), (0, 0)))
        tp = tp.reshape(B, nb + 2, A_BLOCK, A_KV_HEADS, dh)
        return jnp.concatenate([tp[:, :-2], tp[:, 1:-1], tp[:, 2:]], axis=2)

    k_band, v_band = band(k), band(v)
    blk = np.arange(nb)[:, None, None]
    q_pos = blk * A_BLOCK + np.arange(A_BLOCK)[None, :, None]
    k_pos = (blk - 1) * A_BLOCK + np.arange(3 * A_BLOCK)[None, None, :]
    valid = (np.abs(k_pos - q_pos) <= A_WINDOW) & (k_pos >= 0) & (k_pos < n)
    s_loc = jnp.einsum('bnqkgd,bnjkd->bnkgqj', qb, k_band).astype(jnp.float32) * scale
    s_loc = jnp.where(valid[None, :, None, None], s_loc, NEG_INF)
    s_ctx = jnp.einsum('bnqkgd,bckd->bnkgqc', qb, kc).astype(jnp.float32) * scale
    s_sink = jnp.broadcast_to(sink.astype(jnp.float32).reshape(1, 1, A_KV_HEADS, A_GROUP, 1, 1),
                              s_ctx.shape[:-1] + (1,))
    p = jax.nn.softmax(jnp.concatenate([s_sink, s_ctx, s_loc], axis=-1), axis=-1).astype(v.dtype)
    out = (jnp.einsum('bnkgqc,bckd->bnqkgd', p[..., 1:1 + L], vc)
           + jnp.einsum('bnkgqj,bnjkd->bnqkgd', p[..., 1 + L:], v_band))
    return out.reshape(B, n, H * dh)


def context_sink_attention(qc, kc, vc, sink):
    B, L, H, dh = qc.shape
    qg = qc.reshape(B, L, A_KV_HEADS, A_GROUP, dh)
    s = jnp.einsum('blkgd,bckd->bkglc', qg, kc).astype(jnp.float32) * (dh ** -0.5)
    s_sink = jnp.broadcast_to(sink.astype(jnp.float32).reshape(1, A_KV_HEADS, A_GROUP, 1, 1),
                              s.shape[:-1] + (1,))
    p = jax.nn.softmax(jnp.concatenate([s_sink, s], axis=-1), axis=-1).astype(vc.dtype)
    return jnp.einsum('bkglc,bckd->blkgd', p[..., 1:], vc).reshape(B, L, H * dh)


def context_attention(qc, kc, vc):
    B, L, H, dh = qc.shape
    s = jnp.einsum('blhd,bchd->bhlc', qc, kc).astype(jnp.float32) * (dh ** -0.5)
    p = jax.nn.softmax(s, axis=-1).astype(vc.dtype)
    return jnp.einsum('bhlc,bchd->blhd', p, vc).reshape(B, L, H * dh)


def neighbourhood_attention(q, k, v, kc, vc, rpb):
    B, n, H, dh = q.shape
    L = kc.shape[1]
    rows = n // GRID_W
    kh = min(NA_ROWS, rows)
    scale = dh ** -0.5
    kg = k.reshape(B, rows, GRID_W, H, dh)
    vg = v.reshape(B, rows, GRID_W, H, dh)
    cols = np.arange(GRID_W)
    col_idx = np.clip(cols - NA_COLS // 2, 0, GRID_W - NA_COLS)[:, None] + np.arange(NA_COLS)[None, :]
    bias_cols = rpb[:, :, col_idx - cols[:, None] + NA_COLS - 1]

    def row_block(args):
        r, q_row = args
        r0 = jnp.clip(r - kh // 2, 0, rows - kh)
        k_win = lax.dynamic_slice_in_dim(kg, r0, kh, axis=1)[:, :, col_idx]
        v_win = lax.dynamic_slice_in_dim(vg, r0, kh, axis=1)[:, :, col_idx]
        bias = bias_cols[:, r0 + jnp.arange(kh) - r + NA_ROWS - 1].transpose(2, 0, 1, 3)
        s_loc = (jnp.einsum('bqhd,brqwhd->bqhrw', q_row, k_win).astype(jnp.float32) * scale
                 + bias[None].astype(jnp.float32))
        s_ctx = jnp.einsum('bqhd,bchd->bqhc', q_row, kc).astype(jnp.float32) * scale
        logits = jnp.concatenate([s_ctx, s_loc.reshape(B, GRID_W, H, kh * NA_COLS)], axis=-1)
        p = jax.nn.softmax(logits, axis=-1).astype(v.dtype)
        p_loc = p[..., L:].reshape(B, GRID_W, H, kh, NA_COLS)
        return (jnp.einsum('bqhc,bchd->bqhd', p[..., :L], vc)
                + jnp.einsum('bqhrw,brqwhd->bqhd', p_loc, v_win))

    q_rows = jnp.moveaxis(q.reshape(B, rows, GRID_W, H, dh), 1, 0)
    out = lax.map(row_block, (jnp.arange(rows), q_rows))
    return jnp.moveaxis(out, 0, 1).reshape(B, n, H * dh)


def spatial_gating(z, ln_g, ln_b, w_s, b_s):
    u, v = z[..., :C_W], z[..., C_W:]
    B, n, _ = v.shape
    vg = v.reshape(B, n // CHUNK, CHUNK, C_GROUPS, C_GROUP_W)
    vg = layer_norm(vg, ln_g.reshape(C_GROUPS, C_GROUP_W), ln_b.reshape(C_GROUPS, C_GROUP_W))
    mixed = jnp.einsum('gpq,bnqgc->bnpgc', w_s, vg) + b_s.T[None, None, :, :, None]
    return u * mixed.reshape(B, n, C_W)


def moe(h, w_router, router_bias, w_gate, w_up, w_down):
    B, n, D = h.shape
    t = h.reshape(B * n, D)
    scores = jax.nn.sigmoid((t @ w_router).astype(jnp.float32))
    biased = (scores + router_bias.astype(jnp.float32)).reshape(-1, N_EXPERT_GROUPS, EXPERTS_PER_GROUP)
    group_score = jnp.sum(lax.top_k(biased, TOP_K)[0], axis=-1)
    grp = jnp.argmax(group_score, axis=-1)
    in_group = jnp.take_along_axis(biased, grp[:, None, None], axis=1)[:, 0]
    _, local = lax.top_k(in_group, TOP_K)
    e_idx = grp[:, None] * EXPERTS_PER_GROUP + local
    w = jnp.take_along_axis(scores, e_idx, axis=-1)
    w = w / jnp.sum(w, axis=-1, keepdims=True)
    combine = jnp.einsum('tk,tke->te', w, jax.nn.one_hot(e_idx, N_EXPERTS, dtype=jnp.float32)).astype(h.dtype)
    gate = jnp.einsum('td,edf->tef', t, w_gate)
    up = jnp.einsum('td,edf->tef', t, w_up)
    hid = jax.nn.silu(gate) * up * combine[:, :, None]
    return jnp.einsum('tef,efd->td', hid, w_down).reshape(B, n, D)


def setup_inputs(seed: int = 0) -> dict:
    key = jax.random.key(seed)
    ks = jax.random.split(key, 23)
    D = D_MODEL

    def nrm(k, shape, std):
        return jax.random.normal(k, shape, jnp.float32) * std

    return {
        'x': nrm(ks[0], (BATCH, SEQ, D), 1.0),
        'c': nrm(ks[1], (BATCH, D), 1.0),
        'ctx': nrm(ks[2], (BATCH, CTX_LEN, D), 1.0),
        'c_ctx': nrm(ks[3], (D,), 1.0),
        'w_mod': nrm(ks[4], (DEPTH, D, 6 * D), 0.5 * D ** -0.5),
        'b_mod': nrm(ks[5], (DEPTH, 6 * D), 0.01),
        'w_in': nrm(ks[6], (DEPTH, D, IN_COLS), D ** -0.5),
        'attn_sink': nrm(ks[7], (DEPTH, A_HEADS), 0.5),
        'na_rpb': nrm(ks[8], (DEPTH, B_HEADS, 2 * NA_ROWS - 1, 2 * NA_COLS - 1), 0.02),
        'sgu_ln_g': 1.0 + nrm(ks[9], (DEPTH, C_W), 0.01),
        'sgu_ln_b': nrm(ks[10], (DEPTH, C_W), 0.01),
        'sgu_w': nrm(ks[11], (DEPTH, C_GROUPS, CHUNK, CHUNK), CHUNK ** -0.5),
        'sgu_b': nrm(ks[12], (DEPTH, C_GROUPS, CHUNK), 0.01),
        'w_out': nrm(ks[13], (DEPTH, MIX_W, D), DEEPNORM_BETA * MIX_W ** -0.5),
        'ln1_g': 1.0 + nrm(ks[14], (DEPTH, D), 0.01),
        'ln1_b': nrm(ks[15], (DEPTH, D), 0.01),
        'w_router': nrm(ks[16], (D, N_EXPERTS), D ** -0.5),
        'router_bias': nrm(ks[17], (N_EXPERTS,), 0.01),
        'w_gate': nrm(ks[18], (DEPTH, N_EXPERTS, D, EXPERT_FF), D ** -0.5),
        'w_up': nrm(ks[19], (DEPTH, N_EXPERTS, D, EXPERT_FF), D ** -0.5),
        'w_down': nrm(ks[20], (DEPTH, N_EXPERTS, EXPERT_FF, D), DEEPNORM_BETA * EXPERT_FF ** -0.5),
        'ln2_g': 1.0 + nrm(ks[21], (DEPTH, D), 0.01),
        'ln2_b': nrm(ks[22], (DEPTH, D), 0.01),
    }


def reference(x, c, ctx, c_ctx, w_mod, b_mod, w_in, attn_sink, na_rpb, sgu_ln_g, sgu_ln_b, sgu_w, sgu_b,
              w_out, ln1_g, ln1_b, w_router, router_bias, w_gate, w_up, w_down, ln2_g, ln2_b):
    B, n, D = x.shape
    L = ctx.shape[1]
    cos, sin = axial_rope(n)
    silu_c = jax.nn.silu(c)
    silu_cc = jax.nn.silu(c_ctx)
    for l in range(DEPTH):
        last = l == DEPTH - 1
        sh1, sc1, g1, sh2, sc2, g2 = jnp.split(silu_c @ w_mod[l] + b_mod[l], 6, axis=-1)
        n_mod_c = 2 if last else 6
        mod_c = jnp.split(silu_cc @ w_mod[l][:, :n_mod_c * D] + b_mod[l][:n_mod_c * D], n_mod_c)
        h = x * (1.0 + sc1[:, None]) + sh1[:, None]
        hc = ctx * (1.0 + mod_c[1]) + mod_c[0]

        p = h @ w_in[l]
        if last:
            pc_a = hc @ w_in[l][:, OFF_AK:OFF_BQ]
            pc_b = hc @ w_in[l][:, OFF_BK:OFF_C]
        else:
            pc = hc @ w_in[l]
            pc_a = pc[..., OFF_AK:OFF_BQ]
            pc_b = pc[..., OFF_BK:OFF_C]
        kc_a = heads(pc_a, 0, A_KV_W, A_KV_HEADS)
        vc_a = heads(pc_a, A_KV_W, 2 * A_KV_W, A_KV_HEADS)
        kc_b = heads(pc_b, 0, B_W, B_HEADS)
        vc_b = heads(pc_b, B_W, 2 * B_W, B_HEADS)

        o_a = window_attention(apply_rope(heads(p, 0, OFF_AK, A_HEADS), cos, sin),
                               apply_rope(heads(p, OFF_AK, OFF_AV, A_KV_HEADS), cos, sin),
                               heads(p, OFF_AV, OFF_BQ, A_KV_HEADS), kc_a, vc_a, attn_sink[l])
        o_b = neighbourhood_attention(heads(p, OFF_BQ, OFF_BK, B_HEADS), heads(p, OFF_BK, OFF_BV, B_HEADS),
                                      heads(p, OFF_BV, OFF_C, B_HEADS), kc_b, vc_b, na_rpb[l])
        o_c = spatial_gating(jax.nn.gelu(p[..., OFF_C:]), sgu_ln_g[l], sgu_ln_b[l], sgu_w[l], sgu_b[l])
        mix = jnp.concatenate([o_a, o_b, o_c], axis=-1) @ w_out[l]
        x = layer_norm(DEEPNORM_ALPHA * x + g1[:, None] * mix, ln1_g[l], ln1_b[l])
        h2 = x * (1.0 + sc2[:, None]) + sh2[:, None]

        if last:
            y = moe(h2, w_router, router_bias, w_gate[l], w_up[l], w_down[l])
        else:
            oc_a = context_sink_attention(heads(pc, 0, OFF_AK, A_HEADS), kc_a, vc_a, attn_sink[l])
            oc_b = context_attention(heads(pc, OFF_BQ, OFF_BK, B_HEADS), kc_b, vc_b)
            oc_c = spatial_gating(jax.nn.gelu(pc[..., OFF_C:]), sgu_ln_g[l], sgu_ln_b[l], sgu_w[l], sgu_b[l])
            mix_c = jnp.concatenate([oc_a, oc_b, oc_c], axis=-1) @ w_out[l]
            ctx = layer_norm(DEEPNORM_ALPHA * ctx + mod_c[2] * mix_c, ln1_g[l], ln1_b[l])
            h2c = ctx * (1.0 + mod_c[4]) + mod_c[3]
            y_all = moe(jnp.concatenate([h2c, h2], axis=1), w_router, router_bias, w_gate[l], w_up[l], w_down[l])
            ctx = layer_norm(DEEPNORM_ALPHA * ctx + mod_c[5] * y_all[:, :L], ln2_g[l], ln2_b[l])
            y = y_all[:, L:]
        x = layer_norm(DEEPNORM_ALPHA * x + g2[:, None] * y, ln2_g[l], ln2_b[l])
    return x
```

```cpp
#include <hip/hip_runtime.h>
#include <cstdio>
#include <cstdint>

#define LAS __attribute__((address_space(3)))
typedef unsigned short bf16_t;

constexpr int D = 2048, SEQ = 8192, CTXL = 256, NTOK = SEQ + CTXL;
constexpr int DEPTH = 2, GRID_W = 64, HD = 128;
constexpr int INC = 4608;
constexpr int OFF_AK = 768, OFF_AV = 1024, OFF_BQ = 1280, OFF_BK = 2048, OFF_BV = 2816, OFF_C = 3584;
constexpr int NE = 32, FF = 512, CW = 512;
constexpr float LN_EPS = 1e-5f;
constexpr float ALPHA = 1.4142135623730951f;
constexpr float QSCALE = 0.08838834764831845f;
constexpr int NTHREADS = 512, NWAVES = 8;

typedef float AT;
__device__ __forceinline__ float ldv(const float* p) { return *p; }
__device__ __forceinline__ void stv(float* p, float v) { *p = v; }
__device__ __forceinline__ float bf2f(bf16_t b) { return __uint_as_float(((unsigned)b) << 16); }
__device__ __forceinline__ bf16_t f2bf(float f) { unsigned u = __float_as_uint(f); return (bf16_t)((u + 0x7fffu + ((u >> 16) & 1u)) >> 16); }
__device__ __forceinline__ float ldv(const bf16_t* p) { return bf2f(*p); }
__device__ __forceinline__ void stv(bf16_t* p, float v) { *p = f2bf(v); }

__device__ __forceinline__ float4 ld4(const float* p) { return *(const float4*)p; }
__device__ __forceinline__ void st4(float* p, float4 v) { *(float4*)p = v; }
__device__ __forceinline__ float4 ld4(const bf16_t* p) { const uint2 u = *(const uint2*)p; float4 r; r.x = __uint_as_float(u.x << 16); r.y = __uint_as_float(u.x & 0xffff0000u); r.z = __uint_as_float(u.y << 16); r.w = __uint_as_float(u.y & 0xffff0000u); return r; }
__device__ __forceinline__ void st4(bf16_t* p, float4 v) { uint2 u; u.x = (unsigned)f2bf(v.x) | ((unsigned)f2bf(v.y) << 16); u.y = (unsigned)f2bf(v.z) | ((unsigned)f2bf(v.w) << 16); *(uint2*)p = u; }

constexpr size_t MiB = 1u << 20;
constexpr size_t WS_CTL = 0, CTL_BYTES = 1 * MiB;
constexpr size_t WS_MOD = 1 * MiB;
constexpr size_t WS_ROPE = 2 * MiB;
constexpr size_t WS_ROUTE = 3 * MiB;
constexpr size_t WS_H = 8 * MiB;
constexpr size_t WS_P = WS_H + (size_t)NTOK * D * 4;
constexpr size_t WS_MIX = WS_P + (size_t)NTOK * INC * 4;
constexpr size_t WS_T = WS_MIX + (size_t)NTOK * D * 4;
constexpr size_t WS_X1 = WS_T + (size_t)NTOK * D * 4;
constexpr size_t WS_XB = WS_X1 + (size_t)NTOK * D * 4;
constexpr size_t WS_H2 = WS_XB + (size_t)NTOK * D * 4;
constexpr size_t WS_HID = WS_H2 + (size_t)NTOK * D * 4;
constexpr size_t WS_Y = WS_HID + (size_t)2 * NTOK * FF * 4;
constexpr size_t WS_END = WS_Y + (size_t)2 * NTOK * D * 4;

constexpr int LDS_BYTES = 147456;

#define XB_TMO      128
#define XB_XCNT(j)  (256  + 64 * (j))
#define XB_XSUB(j)  (1280 + 64 * (j))
#define XB_XGEN(j)  (2304 + 64 * (j))
#define XB_TOP      3328
#define XB_TOPGEN   3392
#define XCD_BAR_WORDS 3456
#define XB_SPIN_CAP (1u << 18)
__device__ __forceinline__ unsigned xb_ld(unsigned* p)              { return __hip_atomic_load(p, __ATOMIC_RELAXED, __HIP_MEMORY_SCOPE_AGENT); }
__device__ __forceinline__ unsigned xb_add(unsigned* p, unsigned v) { return __hip_atomic_fetch_add(p, v, __ATOMIC_RELAXED, __HIP_MEMORY_SCOPE_AGENT); }
__device__ __forceinline__ unsigned xb_xcc_id() { return (unsigned)__builtin_amdgcn_s_getreg((3 << 11) | 20) & 0xFu; }
#define XB_SPIN(cond, bar) do { unsigned _sp = 0; while (cond) { __builtin_amdgcn_s_sleep(1); \
    if ((++_sp & 255u) == 0u) { if (xb_ld(&(bar)[XB_TMO])) break; if (_sp > XB_SPIN_CAP) { atomicAdd(&(bar)[XB_TMO], 1u); break; } } } } while (0)
struct XcdBarrier { unsigned* bar; unsigned x; volatile LAS unsigned* st; };
__device__ __forceinline__ XcdBarrier xcd_barrier_post(unsigned* bar, volatile LAS unsigned* st) {
    XcdBarrier b; b.bar = bar; b.x = xb_xcc_id(); b.st = st;
    if (threadIdx.x == 0) (void)xb_add(&bar[XB_XCNT(b.x)], 1u);
    return b;
}
__device__ __forceinline__ void xcd_barrier_complete(unsigned* bar, unsigned x, unsigned& nloc, unsigned& nx) {
    const unsigned G = gridDim.x * gridDim.y * gridDim.z;
    unsigned sum, cnt, mine, sp = 0u;
    for (;;) {
        sum = 0u; cnt = 0u; mine = 0u;
#pragma unroll
        for (unsigned j = 0; j < 16; ++j) { const unsigned c = xb_ld(&bar[XB_XCNT(j)]); sum += c; cnt += (c > 0u) ? 1u : 0u; mine = (j == x) ? c : mine; }
        if (sum == G) break;
        __builtin_amdgcn_s_sleep(1);
        if ((++sp & 255u) == 0u) { if (xb_ld(&bar[XB_TMO])) break; if (sp > XB_SPIN_CAP) { atomicAdd(&bar[XB_TMO], 1u); break; } }
    }
    nloc = mine > 0u ? mine : 1u; nx = cnt > 0u ? cnt : 1u;
}
__device__ __forceinline__ void xcd_barrier(const XcdBarrier& b) {
    asm volatile("s_waitcnt vmcnt(0)" ::: "memory");
    __syncthreads();
    if (threadIdx.x == 0) {
        unsigned* bar = b.bar;
        __builtin_amdgcn_s_waitcnt(0);
        unsigned nloc = b.st[0], nx = b.st[1];
        if (nloc == 0u) { xcd_barrier_complete(bar, b.x, nloc, nx); b.st[0] = nloc; b.st[1] = nx; }
        const unsigned old = xb_add(&bar[XB_XSUB(b.x)], 1u);
        const unsigned gen = old / nloc;
        if (old + 1u == (gen + 1u) * nloc) {
            __builtin_amdgcn_fence(__ATOMIC_RELEASE, "agent");
            asm volatile("s_waitcnt vmcnt(0)" ::: "memory");
            const unsigned og = xb_add(&bar[XB_TOP], 1u);
            const unsigned tg = og / nx;
            if (og + 1u == (tg + 1u) * nx) xb_add(&bar[XB_TOPGEN], 1u);
            else XB_SPIN(xb_ld(&bar[XB_TOPGEN]) == tg, bar);
            __builtin_amdgcn_fence(__ATOMIC_ACQUIRE, "agent");
            xb_add(&bar[XB_XGEN(b.x)], 1u);
            asm volatile("s_waitcnt vmcnt(0)" ::: "memory");
        } else {
            XB_SPIN(xb_ld(&bar[XB_XGEN(b.x)]) == gen, bar);
            __builtin_amdgcn_fence(__ATOMIC_ACQUIRE, "agent");
            asm volatile("s_waitcnt vmcnt(0)" ::: "memory");
        }
    }
    __syncthreads();
}

struct Args {
    const float* in[23];
    float* out;
    unsigned char* ws;
    int ph_lo, ph_hi;
};

struct Ctx {
    LAS unsigned char* lds;
    int tid, lane, wave, G, bid;
    const float* const* in;
    float* out;
    unsigned char* ws;
};
#define CIN(k) (C.in[k])
#define C_x CIN(0)
#define C_c CIN(1)
#define C_ctx CIN(2)
#define C_c_ctx CIN(3)
#define C_w_mod CIN(4)
#define C_b_mod CIN(5)
#define C_w_in CIN(6)
#define C_sink CIN(7)
#define C_rpb CIN(8)
#define C_sgu_g CIN(9)
#define C_sgu_bn CIN(10)
#define C_sgu_w CIN(11)
#define C_sgu_b CIN(12)
#define C_w_out CIN(13)
#define C_ln1_g CIN(14)
#define C_ln1_b CIN(15)
#define C_w_router CIN(16)
#define C_router_bias CIN(17)
#define C_w_gate CIN(18)
#define C_w_up CIN(19)
#define C_w_down CIN(20)
#define C_ln2_g CIN(21)
#define C_ln2_b CIN(22)
#define C_MOD ((float*)(C.ws + WS_MOD))
#define C_ROPE ((float*)(C.ws + WS_ROPE))
#define C_ROUTE ((int*)(C.ws + WS_ROUTE))
#define C_H ((AT*)(C.ws + WS_H))
#define C_P ((AT*)(C.ws + WS_P))
#define C_MIX ((AT*)(C.ws + WS_MIX))
#define C_T ((float*)(C.ws + WS_T))
#define C_X1 ((float*)(C.ws + WS_X1))
#define C_XB ((float*)(C.ws + WS_XB))
#define C_H2 ((AT*)(C.ws + WS_H2))
#define C_HID ((AT*)(C.ws + WS_HID))
#define C_Y ((AT*)(C.ws + WS_Y))

__device__ __forceinline__ float silu_f(float v) { return v / (1.f + expf(-v)); }
__device__ __forceinline__ float gelu_tanh_f(float v) { return 0.5f * v * (1.f + tanhf(0.7978845608028654f * (v + 0.044715f * v * v * v))); }
__device__ __forceinline__ float wave_sum(float v) {
#pragma unroll
    for (int o = 1; o < 64; o <<= 1) v += __shfl_xor(v, o);
    return v;
}
__device__ __forceinline__ float wave_max(float v) {
#pragma unroll
    for (int o = 1; o < 64; o <<= 1) v = fmaxf(v, __shfl_xor(v, o));
    return v;
}
__device__ __forceinline__ const float* modp(const Ctx& C, int l, int kind, int j) { return C_MOD + ((size_t)(l * 2 + kind) * 6 + j) * D; }
__device__ __forceinline__ const float* xin_row(const Ctx& C, int l, int r) {
    if (l == 0) return r < SEQ ? C_x + (size_t)r * D : C_ctx + (size_t)(r - SEQ) * D;
    return C_XB + (size_t)r * D;
}

__device__ __forceinline__ void ph_prologue(const Ctx& C) {
    const int gt = C.bid * NTHREADS + C.tid, NT = C.G * NTHREADS;
    for (int idx = gt; idx < DEPTH * 6 * D; idx += NT) {
        const int l = idx / (6 * D), n = idx % (6 * D);
        const float* w = C_w_mod + (size_t)l * D * 6 * D + n;
        float a0 = 0.f, a1 = 0.f;
        for (int k = 0; k < D; ++k) { const float wv = w[(size_t)k * 6 * D]; a0 += silu_f(C_c[k]) * wv; a1 += silu_f(C_c_ctx[k]) * wv; }
        const float b = C_b_mod[l * 6 * D + n];
        C_MOD[(size_t)(l * 2 + 0) * 6 * D + n] = a0 + b;
        C_MOD[(size_t)(l * 2 + 1) * 6 * D + n] = a1 + b;
    }
    for (int idx = gt; idx < 128 * 32; idx += NT) {
        const int pos = idx / 32, j = idx % 32;
        const double inv = pow(10000.0, -(double)j / 32.0);
        const double ang = (double)pos * inv;
        C_ROPE[idx] = (float)cos(ang);
        C_ROPE[128 * 32 + idx] = (float)sin(ang);
    }
}

__device__ __forceinline__ void ph_modulate0(const Ctx& C) {
    const int gt = C.bid * NTHREADS + C.tid, NT = C.G * NTHREADS;
    for (size_t idx = gt; idx < (size_t)NTOK * D; idx += NT) {
        const int r = (int)(idx / D), d = (int)(idx % D);
        const int kind = r < SEQ ? 0 : 1;
        const float v = xin_row(C, 0, r)[d];
        stv(&C_H[idx], v * (1.f + modp(C, 0, kind, 1)[d]) + modp(C, 0, kind, 0)[d]);
    }
}

template <typename TA, typename Epi>
__device__ __forceinline__ void naive_gemm(const Ctx& C, const TA* A, int lda, const float* B, int ldb, int M, int N, int K, const Epi& epi) {
    LAS float* As = (LAS float*)C.lds;
    LAS float* Bs = As + 16 * 132;
    const int tiles_n = N / 128, tiles = (M / 128) * tiles_n;
    const int ty = C.tid >> 4, tx = C.tid & 15;
    for (int tile = C.bid; tile < tiles; tile += C.G) {
        const int tm = tile / tiles_n, tn = tile % tiles_n;
        float acc[4][8];
#pragma unroll
        for (int i = 0; i < 4; ++i)
#pragma unroll
            for (int j = 0; j < 8; ++j) acc[i][j] = 0.f;
        for (int k0 = 0; k0 < K; k0 += 16) {
            { const int row = C.tid >> 2, kq = (C.tid & 3) * 4;
              const TA* ap = A + (size_t)(tm * 128 + row) * lda + k0 + kq;
#pragma unroll
              for (int q = 0; q < 4; ++q) As[(kq + q) * 132 + row] = ldv(ap + q); }
            { const int kk = C.tid >> 5, n4 = (C.tid & 31) * 4;
              const float4 bv = *(const float4*)(B + (size_t)(k0 + kk) * ldb + tn * 128 + n4);
              Bs[kk * 132 + n4 + 0] = bv.x; Bs[kk * 132 + n4 + 1] = bv.y; Bs[kk * 132 + n4 + 2] = bv.z; Bs[kk * 132 + n4 + 3] = bv.w; }
            __syncthreads();
#pragma unroll
            for (int kk = 0; kk < 16; ++kk) {
                float a[4], b[8];
#pragma unroll
                for (int i = 0; i < 4; ++i) a[i] = As[kk * 132 + ty * 4 + i];
#pragma unroll
                for (int j = 0; j < 8; ++j) b[j] = Bs[kk * 132 + tx * 8 + j];
#pragma unroll
                for (int i = 0; i < 4; ++i)
#pragma unroll
                    for (int j = 0; j < 8; ++j) acc[i][j] += a[i] * b[j];
            }
            __syncthreads();
        }
#pragma unroll
        for (int i = 0; i < 4; ++i)
#pragma unroll
            for (int j = 0; j < 8; ++j) epi(tm * 128 + ty * 4 + i, tn * 128 + tx * 8 + j, acc[i][j]);
    }
}

__device__ __forceinline__ void rope_cs(const Ctx& C, int pos, int i, float& cs, float& sn) {
    const int comp = (i < 32) ? (pos / GRID_W) : (pos % GRID_W), f = i & 31;
    cs = C_ROPE[comp * 32 + f]; sn = C_ROPE[128 * 32 + comp * 32 + f];
}
__device__ __forceinline__ void attn_item(const Ctx& C, int l, int mode, int qi, int h) {
    LAS float* qs = (LAS float*)C.lds;
    LAS float* ss = qs + 128;
    LAS float* red = ss + 640;
    LAS float* osum = red + 16;
    const int tid = C.tid;
    const bool isA = (mode == 0 || mode == 2);
    const int qrow = (mode < 2) ? qi : SEQ + qi;
    const int qcol = isA ? h * HD : OFF_BQ + h * HD;
    const int kvh = isA ? h / 3 : h;
    const int kcol = isA ? OFF_AK + kvh * HD : OFF_BK + h * HD;
    const int vcol = isA ? OFF_AV + kvh * HD : OFF_BV + h * HD;
    const int nkeys = (mode == 0) ? 256 + 257 : (mode == 1) ? 256 + 128 : 256;
    const int qr = qi / GRID_W, qc = qi % GRID_W;
    int r0 = qr - 4; r0 = r0 < 0 ? 0 : (r0 > 120 ? 120 : r0);
    int c0 = qc - 8; c0 = c0 < 0 ? 0 : (c0 > 48 ? 48 : c0);
    __syncthreads();
    if (tid < 64) {
        const AT* qp = C_P + (size_t)qrow * INC + qcol;
        const float x1 = ldv(qp + tid), x2 = ldv(qp + 64 + tid);
        if (mode == 0) { float cs, sn; rope_cs(C, qi, tid, cs, sn); qs[tid] = x1 * cs - x2 * sn; qs[64 + tid] = x2 * cs + x1 * sn; }
        else { qs[tid] = x1; qs[64 + tid] = x2; }
    }
    __syncthreads();
    float lmax = -3.0e38f;
    for (int j = tid; j < nkeys; j += NTHREADS) {
        int krow; bool valid = true, rope = false; int kpos = 0; float bias = 0.f;
        if (j < 256) krow = SEQ + j;
        else if (mode == 0) { kpos = qi - 128 + (j - 256); valid = (kpos >= 0 && kpos < SEQ); krow = valid ? kpos : 0; rope = true; }
        else { const int i = j - 256, kr = r0 + (i >> 4), kc = c0 + (i & 15); krow = kr * GRID_W + kc;
               bias = C_rpb[((size_t)(l * 6 + h) * 15 + (kr - qr + 7)) * 31 + (kc - qc + 15)]; }
        float s = -3.0e38f;
        if (valid) {
            const AT* kp = C_P + (size_t)krow * INC + kcol;
            float acc = 0.f;
            if (rope) {
                for (int i = 0; i < 64; ++i) { float cs, sn; rope_cs(C, kpos, i, cs, sn); const float k1 = ldv(kp + i), k2 = ldv(kp + 64 + i);
                    acc += qs[i] * (k1 * cs - k2 * sn) + qs[64 + i] * (k2 * cs + k1 * sn); }
            } else {
                for (int i = 0; i < 128; ++i) acc += qs[i] * ldv(kp + i);
            }
            s = acc * QSCALE + bias;
        }
        ss[j] = s; lmax = fmaxf(lmax, s);
    }
    const bool has_sink = isA;
    const float sinkv = has_sink ? C_sink[l * 6 + h] : -3.0e38f;
    lmax = wave_max(lmax);
    if (C.lane == 0) red[C.wave] = lmax;
    __syncthreads();
    float m = sinkv;
#pragma unroll
    for (int w = 0; w < NWAVES; ++w) m = fmaxf(m, red[w]);
    float lsum = 0.f;
    for (int j = tid; j < nkeys; j += NTHREADS) { const float s = ss[j]; const float p = (s > -1.0e38f) ? expf(s - m) : 0.f; ss[j] = p; lsum += p; }
    lsum = wave_sum(lsum);
    if (C.lane == 0) red[8 + C.wave] = lsum;
    __syncthreads();
    float L = has_sink ? expf(sinkv - m) : 0.f;
#pragma unroll
    for (int w = 0; w < NWAVES; ++w) L += red[8 + w];
    { const int d = tid & 127, part = tid >> 7;
      float acc = 0.f;
      for (int j = part; j < nkeys; j += 4) {
          const float p = ss[j];
          if (p != 0.f) {
              int krow;
              if (j < 256) krow = SEQ + j;
              else if (mode == 0) krow = qi - 128 + (j - 256);
              else { const int i = j - 256; krow = (r0 + (i >> 4)) * GRID_W + c0 + (i & 15); }
              acc += p * ldv(C_P + (size_t)krow * INC + vcol + d);
          }
      }
      osum[part * 128 + d] = acc; }
    __syncthreads();
    if (tid < 128) {
        const float o = (osum[tid] + osum[128 + tid] + osum[256 + tid] + osum[384 + tid]) / L;
        stv(&C_MIX[(size_t)qrow * D + (isA ? 0 : 768) + h * HD + tid], o);
    }
}

__device__ __forceinline__ void sgu_item(const Ctx& C, int l, int ch, int g) {
    LAS float* vn = (LAS float*)C.lds;
    const int tid = C.tid, lane = C.lane, wave = C.wave;
    const int row0 = ch * 128;
    __syncthreads();
    for (int q = wave; q < 128; q += NWAVES) {
        const AT* vp = C_P + (size_t)(row0 + q) * INC + OFF_C + CW + g * 128;
        const float a = gelu_tanh_f(ldv(vp + lane)), b = gelu_tanh_f(ldv(vp + 64 + lane));
        const float mu = wave_sum(a + b) * (1.f / 128.f);
        const float da = a - mu, db = b - mu;
        const float var = wave_sum(da * da + db * db) * (1.f / 128.f);
        const float rstd = 1.0f / sqrtf(var + LN_EPS);
        vn[q * 128 + lane] = da * rstd * C_sgu_g[l * CW + g * 128 + lane] + C_sgu_bn[l * CW + g * 128 + lane];
        vn[q * 128 + 64 + lane] = db * rstd * C_sgu_g[l * CW + g * 128 + 64 + lane] + C_sgu_bn[l * CW + g * 128 + 64 + lane];
    }
    __syncthreads();
    const int c = tid & 127, pg = tid >> 7;
    const float* ws = C_sgu_w + ((size_t)(l * 4 + g) * 128) * 128;
    for (int i = 0; i < 32; ++i) {
        const int p = pg * 32 + i;
        float acc = 0.f;
        for (int q = 0; q < 128; ++q) acc += ws[p * 128 + q] * vn[q * 128 + c];
        acc += C_sgu_b[(l * 4 + g) * 128 + p];
        const float u = gelu_tanh_f(ldv(C_P + (size_t)(row0 + p) * INC + OFF_C + g * 128 + c));
        stv(&C_MIX[(size_t)(row0 + p) * D + 1536 + g * 128 + c], u * acc);
    }
}

__device__ __forceinline__ void ph_mixers(const Ctx& C, int l) {
    const bool last = (l == DEPTH - 1);
    const int nA = SEQ * 6, nB = SEQ * 6, nCA = last ? 0 : CTXL * 6, nCB = last ? 0 : CTXL * 6;
    const int nS = (last ? 64 : 66) * 4;
    const int total = nA + nB + nCA + nCB + nS;
    for (int it = C.bid; it < total; it += C.G) {
        int r = it;
        if (r < nA) { attn_item(C, l, 0, r / 6, r % 6); continue; } r -= nA;
        if (r < nB) { attn_item(C, l, 1, r / 6, r % 6); continue; } r -= nB;
        if (r < nCA) { attn_item(C, l, 2, r / 6, r % 6); continue; } r -= nCA;
        if (r < nCB) { attn_item(C, l, 3, r / 6, r % 6); continue; } r -= nCB;
        sgu_item(C, l, r / 4, r % 4);
    }
}

__device__ __forceinline__ void ph_ln1(const Ctx& C, int l) {
    const bool last = (l == DEPTH - 1);
    const int nrows = last ? SEQ : NTOK;
    const int gw = C.bid * NWAVES + C.wave, NGW = C.G * NWAVES, lane = C.lane;
    LAS float* hrow = (LAS float*)C.lds + C.wave * D;
    for (int r = gw; r < nrows; r += NGW) {
        const int kind = r < SEQ ? 0 : 1;
        const float* tp = C_T + (size_t)r * D;
        float v[32]; float s = 0.f;
#pragma unroll
        for (int j = 0; j < 8; ++j) { const float4 t4 = *(const float4*)(tp + 4 * lane + 256 * j); v[4 * j] = t4.x; v[4 * j + 1] = t4.y; v[4 * j + 2] = t4.z; v[4 * j + 3] = t4.w; s += (t4.x + t4.y) + (t4.z + t4.w); }
        const float mu = wave_sum(s) * (1.f / D);
        float q = 0.f;
#pragma unroll
        for (int i = 0; i < 32; ++i) { v[i] -= mu; q += v[i] * v[i]; }
        const float rstd = 1.0f / sqrtf(wave_sum(q) * (1.f / D) + LN_EPS);
        const float* g = C_ln1_g + l * D; const float* b = C_ln1_b + l * D;
        const float* sc2 = modp(C, l, kind, 4); const float* sh2 = modp(C, l, kind, 3);
#pragma unroll
        for (int j = 0; j < 8; ++j) {
            const int d0 = 4 * lane + 256 * j;
            const float4 g4 = *(const float4*)(g + d0), b4 = *(const float4*)(b + d0), sc4 = *(const float4*)(sc2 + d0), sh4 = *(const float4*)(sh2 + d0);
            float4 x1, h2;
            x1.x = v[4 * j + 0] * rstd * g4.x + b4.x; x1.y = v[4 * j + 1] * rstd * g4.y + b4.y; x1.z = v[4 * j + 2] * rstd * g4.z + b4.z; x1.w = v[4 * j + 3] * rstd * g4.w + b4.w;
            h2.x = x1.x * (1.f + sc4.x) + sh4.x; h2.y = x1.y * (1.f + sc4.y) + sh4.y; h2.z = x1.z * (1.f + sc4.z) + sh4.z; h2.w = x1.w * (1.f + sc4.w) + sh4.w;
            *(float4*)(C_X1 + (size_t)r * D + d0) = x1;
            stv(&C_H2[(size_t)r * D + d0], h2.x); stv(&C_H2[(size_t)r * D + d0 + 1], h2.y); stv(&C_H2[(size_t)r * D + d0 + 2], h2.z); stv(&C_H2[(size_t)r * D + d0 + 3], h2.w);
            hrow[d0] = h2.x; hrow[d0 + 1] = h2.y; hrow[d0 + 2] = h2.z; hrow[d0 + 3] = h2.w;
            asm volatile("" ::: "memory");
        }
        asm volatile("s_waitcnt lgkmcnt(0)" ::: "memory");
        float lg[32];
#pragma unroll
        for (int e = 0; e < 32; ++e) lg[e] = 0.f;
#pragma unroll 2
        for (int i = 0; i < 32; ++i) {
            const int d = lane + 64 * i;
            const float h2 = hrow[d];
            const float4* wr = (const float4*)(C_w_router + (size_t)d * NE);
#pragma unroll
            for (int e4 = 0; e4 < 8; ++e4) { const float4 w4 = wr[e4]; lg[4 * e4] += h2 * w4.x; lg[4 * e4 + 1] += h2 * w4.y; lg[4 * e4 + 2] += h2 * w4.z; lg[4 * e4 + 3] += h2 * w4.w; }
        }
#pragma unroll
        for (int e = 0; e < 32; ++e) lg[e] = wave_sum(lg[e]);
        if (lane == 0) {
            float bestgs = -3.0e38f; int be0 = 0, be1 = 0; float bw0 = 0.f, bw1 = 0.f;
#pragma unroll
            for (int gq = 0; gq < 4; ++gq) {
                float m1 = -3.0e38f, m2 = -3.0e38f, s1 = 0.f, s2 = 0.f; int i1 = 0, i2 = 0;
#pragma unroll
                for (int i = 0; i < 8; ++i) {
                    const int e = gq * 8 + i;
                    const float scv = 1.f / (1.f + expf(-lg[e])), bv = scv + C_router_bias[e];
                    if (bv > m1) { m2 = m1; i2 = i1; s2 = s1; m1 = bv; i1 = e; s1 = scv; }
                    else if (bv > m2) { m2 = bv; i2 = e; s2 = scv; }
                }
                const float gs = m1 + m2;
                if (gs > bestgs) { bestgs = gs; be0 = i1; be1 = i2; bw0 = s1; bw1 = s2; }
            }
            const float inv = 1.f / (bw0 + bw1);
            int* rp = C_ROUTE + (size_t)r * 4;
            rp[0] = be0; rp[1] = be1; rp[2] = __float_as_int(bw0 * inv); rp[3] = __float_as_int(bw1 * inv);
        }
    }
}

__device__ __forceinline__ void ph_moe(const Ctx& C, int l) {
    const bool last = (l == DEPTH - 1);
    const int nrows = last ? SEQ : NTOK;
    LAS float* hs = (LAS float*)C.lds;
    LAS float* hid = hs + D;
    const int tid = C.tid;
    for (int it = C.bid; it < nrows * 2; it += C.G) {
        const int r = it >> 1, k = it & 1;
        const int e = C_ROUTE[(size_t)r * 4 + k];
        const float w = __int_as_float(C_ROUTE[(size_t)r * 4 + 2 + k]);
        __syncthreads();
        for (int d = tid; d < D; d += NTHREADS) hs[d] = ldv(&C_H2[(size_t)r * D + d]);
        __syncthreads();
        const float* wg = C_w_gate + ((size_t)(l * NE + e) * D) * FF + tid;
        const float* wu = C_w_up + ((size_t)(l * NE + e) * D) * FF + tid;
        float ga = 0.f, ua = 0.f;
        for (int d = 0; d < D; ++d) { const float hv = hs[d]; ga += hv * wg[(size_t)d * FF]; ua += hv * wu[(size_t)d * FF]; }
        hid[tid] = silu_f(ga) * ua * w;
        __syncthreads();
        const float* wd = C_w_down + ((size_t)(l * NE + e) * FF) * D;
        float y0 = 0.f, y1 = 0.f, y2 = 0.f, y3 = 0.f;
        for (int f = 0; f < FF; ++f) { const float hv = hid[f]; const float* wp = wd + (size_t)f * D + tid;
            y0 += hv * wp[0]; y1 += hv * wp[512]; y2 += hv * wp[1024]; y3 += hv * wp[1536]; }
        AT* yp = C_Y + (size_t)it * D + tid;
        stv(yp, y0); stv(yp + 512, y1); stv(yp + 1024, y2); stv(yp + 1536, y3);
    }
}

__device__ __forceinline__ void ph_ln2(const Ctx& C, int l) {
    const bool last = (l == DEPTH - 1);
    const int nrows = last ? SEQ : NTOK;
    const int gw = C.bid * NWAVES + C.wave, NGW = C.G * NWAVES, lane = C.lane;
    for (int r = gw; r < nrows; r += NGW) {
        const int kind = r < SEQ ? 0 : 1;
        const float* g2 = modp(C, l, kind, 5);
        float v[32]; float s = 0.f;
#pragma unroll
        for (int j = 0; j < 8; ++j) {
            const int d0 = 4 * lane + 256 * j;
            const float4 ya = ld4(&C_Y[(size_t)(2 * r) * D + d0]), yb = ld4(&C_Y[(size_t)(2 * r + 1) * D + d0]);
            const float4 x1 = *(const float4*)(C_X1 + (size_t)r * D + d0), g4 = *(const float4*)(g2 + d0);
            v[4 * j + 0] = ALPHA * x1.x + g4.x * (ya.x + yb.x); v[4 * j + 1] = ALPHA * x1.y + g4.y * (ya.y + yb.y);
            v[4 * j + 2] = ALPHA * x1.z + g4.z * (ya.z + yb.z); v[4 * j + 3] = ALPHA * x1.w + g4.w * (ya.w + yb.w);
            s += (v[4 * j] + v[4 * j + 1]) + (v[4 * j + 2] + v[4 * j + 3]);
            asm volatile("" ::: "memory");
        }
        const float mu = wave_sum(s) * (1.f / D);
        float q = 0.f;
#pragma unroll
        for (int i = 0; i < 32; ++i) { v[i] -= mu; q += v[i] * v[i]; }
        const float rstd = 1.0f / sqrtf(wave_sum(q) * (1.f / D) + LN_EPS);
        const float* g = C_ln2_g + l * D; const float* b = C_ln2_b + l * D;
        const float* sc1n = modp(C, last ? l : l + 1, kind, 1); const float* sh1n = modp(C, last ? l : l + 1, kind, 0);
#pragma unroll
        for (int j = 0; j < 8; ++j) {
            const int d0 = 4 * lane + 256 * j;
            const float4 g4 = *(const float4*)(g + d0), b4 = *(const float4*)(b + d0);
            float4 xo;
            xo.x = v[4 * j + 0] * rstd * g4.x + b4.x; xo.y = v[4 * j + 1] * rstd * g4.y + b4.y; xo.z = v[4 * j + 2] * rstd * g4.z + b4.z; xo.w = v[4 * j + 3] * rstd * g4.w + b4.w;
            if (last) *(float4*)(C.out + (size_t)r * D + d0) = xo;
            else {
                *(float4*)(C_XB + (size_t)r * D + d0) = xo;
                const float4 sc4 = *(const float4*)(sc1n + d0), sh4 = *(const float4*)(sh1n + d0);
                float4 hn; hn.x = xo.x * (1.f + sc4.x) + sh4.x; hn.y = xo.y * (1.f + sc4.y) + sh4.y; hn.z = xo.z * (1.f + sc4.z) + sh4.z; hn.w = xo.w * (1.f + sc4.w) + sh4.w;
                st4(&C_H[(size_t)r * D + d0], hn);
            }
            asm volatile("" ::: "memory");
        }
    }
}

struct EpiP { AT* P; __device__ __forceinline__ void operator()(int r, int c, float v) const { stv(&P[(size_t)r * INC + c], v); } };
struct EpiT { float* T; const float* xl; const float* xc; const float* gl; const float* gc;
    __device__ __forceinline__ void operator()(int r, int c, float v) const {
        const float xv = r < SEQ ? xl[(size_t)r * D + c] : xc[(size_t)(r - SEQ) * D + c];
        const float gv = r < SEQ ? gl[c] : gc[c];
        T[(size_t)r * D + c] = ALPHA * xv + gv * v; } };
constexpr int N_PHASES = 2 + 6 * DEPTH;
__global__ void __launch_bounds__(NTHREADS, 2) fwd_kernel(Args args) {
    extern __shared__ __attribute__((aligned(16))) unsigned char lds_raw[];
    Ctx C;
    C.lds = (LAS unsigned char*)lds_raw;
    C.tid = threadIdx.x; C.lane = C.tid & 63; C.wave = __builtin_amdgcn_readfirstlane(C.tid >> 6); C.G = gridDim.x; C.bid = blockIdx.x;
    C.in = args.in; C.out = args.out; C.ws = args.ws;
    unsigned char* ws = args.ws;

    volatile LAS unsigned* bst = (volatile LAS unsigned*)(C.lds + LDS_BYTES - 16);
    if (C.tid < 4) bst[C.tid] = 0u;
    __syncthreads();
    const int lo = args.ph_lo, hi = args.ph_hi;
    XcdBarrier bar; bar.bar = (unsigned*)(ws + WS_CTL) + 4096; bar.x = 0; bar.st = bst;
    if (hi - lo > 1) bar = xcd_barrier_post((unsigned*)(ws + WS_CTL) + 4096, bst);
#define IN(k) (lo <= (k) && (k) < hi)
#define SEAM(k) do { if (IN(k) && IN((k) + 1)) xcd_barrier(bar); } while (0)

    if (IN(0)) { ph_prologue(C); } SEAM(0);
    if (IN(1)) { ph_modulate0(C); } SEAM(1);
#pragma unroll
    for (int l = 0; l < DEPTH; ++l) {
        const int pb = 2 + 6 * l;
        const bool last = (l == DEPTH - 1);
        if (IN(pb + 0)) {
            EpiP epi{C_P};
            naive_gemm<AT>(C, C_H, D, C_w_in + (size_t)l * D * INC, INC, NTOK, INC, D, epi);
        }
        SEAM(pb + 0);
        if (IN(pb + 1)) { ph_mixers(C, l); } SEAM(pb + 1);
        if (IN(pb + 2)) {
            EpiT epi{C_T, l == 0 ? C_x : C_XB, l == 0 ? C_ctx : C_XB + (size_t)SEQ * D, modp(C, l, 0, 2), modp(C, l, 1, 2)};
            naive_gemm<AT>(C, C_MIX, D, C_w_out + (size_t)l * D * D, D, last ? SEQ : NTOK, D, D, epi);
        }
        SEAM(pb + 2);
        if (IN(pb + 3)) { ph_ln1(C, l); } SEAM(pb + 3);
        if (IN(pb + 4)) { ph_moe(C, l); } SEAM(pb + 4);
        if (IN(pb + 5)) { ph_ln2(C, l); }
        if (!last) SEAM(pb + 5);
    }
#undef IN
#undef SEAM
}

#ifndef MK_N_LAUNCHES
#define MK_N_LAUNCHES 1
#endif
extern "C" void kernel_launch(void* const* d_in, const int* in_sizes, int n_in, void* d_out, int out_size, void* d_ws, size_t ws_size, hipStream_t stream) {
    static int grid = 0;
    if (grid == 0) {
        if (n_in != 23 || out_size != SEQ * D || ws_size < WS_END) {
            fprintf(stderr, "kernel_launch: unexpected shapes: n_in %d out %d ws %zu (need %zu)\n", n_in, out_size, ws_size, (size_t)WS_END); grid = -1; return; }
        int dev = 0, cus = 0;
        if (hipGetDevice(&dev) != hipSuccess || hipDeviceGetAttribute(&cus, hipDeviceAttributeMultiprocessorCount, dev) != hipSuccess) { grid = -1; return; }
        if (hipFuncSetAttribute((const void*)fwd_kernel, hipFuncAttributeMaxDynamicSharedMemorySize, LDS_BYTES) != hipSuccess) { fprintf(stderr, "kernel_launch: hipFuncSetAttribute failed\n"); grid = -1; return; }
        int per_cu = 0;
        if (hipOccupancyMaxActiveBlocksPerMultiprocessor(&per_cu, (const void*)fwd_kernel, NTHREADS, LDS_BYTES) != hipSuccess || per_cu < 1) fprintf(stderr, "kernel_launch: occupancy query says %d\n", per_cu);
        (void)hipGetLastError();
        grid = cus;
    }
    if (grid < 0) return;
    hipMemsetAsync((char*)d_ws + WS_CTL, 0, CTL_BYTES, stream);
    Args a{};
    for (int i = 0; i < 23; ++i) a.in[i] = (const float*)d_in[i];
    a.out = (float*)d_out; a.ws = (unsigned char*)d_ws;
    if (MK_N_LAUNCHES == 1) {
        a.ph_lo = 0; a.ph_hi = N_PHASES;
        hipLaunchKernelGGL(fwd_kernel, dim3(grid), dim3(NTHREADS), LDS_BYTES, stream, a);
    } else {
        for (int p = 0; p < N_PHASES; ++p) {
            a.ph_lo = p; a.ph_hi = p + 1;
            hipLaunchKernelGGL(fwd_kernel, dim3(grid), dim3(NTHREADS), LDS_BYTES, stream, a);
        }
    }
    const hipError_t le = hipPeekAtLastError();
    if (le != hipSuccess) fprintf(stderr, "kernel_launch: launch failed: %s\n", hipGetErrorName(le));
}
```

```cpp
#include <hip/hip_runtime.h>
#include <cstdio>
#include <cstdint>

#define LAS __attribute__((address_space(3)))
typedef unsigned short bf16_t;

constexpr int D = 2048, SEQ = 8192, CTXL = 256, NTOK = SEQ + CTXL;
constexpr int DEPTH = 2, GRID_W = 64, HD = 128;
constexpr int INC = 4608;
constexpr int OFF_AK = 768, OFF_AV = 1024, OFF_BQ = 1280, OFF_BK = 2048, OFF_BV = 2816, OFF_C = 3584;
constexpr int NE = 32, FF = 512, CW = 512;
constexpr float LN_EPS = 1e-5f;
constexpr float ALPHA = 1.4142135623730951f;
constexpr float QSCALE = 0.08838834764831845f;
constexpr int NTHREADS = 512, NWAVES = 8;

typedef bf16_t AT;
__device__ __forceinline__ float ldv(const float* p) { return *p; }
__device__ __forceinline__ void stv(float* p, float v) { *p = v; }
__device__ __forceinline__ float bf2f(bf16_t b) { return __uint_as_float(((unsigned)b) << 16); }
__device__ __forceinline__ bf16_t f2bf(float f) { unsigned u = __float_as_uint(f); return (bf16_t)((u + 0x7fffu + ((u >> 16) & 1u)) >> 16); }
__device__ __forceinline__ float ldv(const bf16_t* p) { return bf2f(*p); }
__device__ __forceinline__ void stv(bf16_t* p, float v) { *p = f2bf(v); }

__device__ __forceinline__ float4 ld4(const float* p) { return *(const float4*)p; }
__device__ __forceinline__ void st4(float* p, float4 v) { *(float4*)p = v; }
__device__ __forceinline__ float4 ld4(const bf16_t* p) { const uint2 u = *(const uint2*)p; float4 r; r.x = __uint_as_float(u.x << 16); r.y = __uint_as_float(u.x & 0xffff0000u); r.z = __uint_as_float(u.y << 16); r.w = __uint_as_float(u.y & 0xffff0000u); return r; }
__device__ __forceinline__ void st4(bf16_t* p, float4 v) { uint2 u; u.x = (unsigned)f2bf(v.x) | ((unsigned)f2bf(v.y) << 16); u.y = (unsigned)f2bf(v.z) | ((unsigned)f2bf(v.w) << 16); *(uint2*)p = u; }

constexpr size_t MiB = 1u << 20;
constexpr size_t WS_CTL = 0, CTL_BYTES = 1 * MiB;
constexpr int CW_BAR = 4096, CW_CNT = 16384, CW_CUR = 16384 + 128;
constexpr size_t WS_MOD = 1 * MiB;
constexpr size_t WS_ROPE = 2 * MiB;
constexpr size_t WS_ROUTE = 3 * MiB;
constexpr size_t WS_SLOT = 3 * MiB + 512 * 1024;
constexpr size_t WS_SW = 4 * MiB;
constexpr size_t WS_MODP = 5 * MiB;
constexpr int MAXSLOT = 25088;
constexpr size_t WS_WIN = 8 * MiB;
constexpr size_t WS_WOUT = 44 * MiB;
constexpr size_t WS_WGU = 64 * MiB;
constexpr size_t WS_WD = 320 * MiB;
constexpr size_t WS_H = 448 * MiB;
constexpr size_t WS_P = 482 * MiB;
constexpr size_t WS_MIX = 558 * MiB;
constexpr size_t WS_T = 592 * MiB;
constexpr size_t WS_X1 = 660 * MiB;
constexpr size_t WS_XB = 728 * MiB;
constexpr size_t WS_H2 = 796 * MiB;
constexpr size_t WS_HS = 830 * MiB;
constexpr size_t WS_HID = 930 * MiB;
constexpr size_t WS_Y = 956 * MiB;
constexpr size_t WS_END = 1056 * MiB;

constexpr int LDS_BYTES = 147456;

#define XB_TMO      128
#define XB_XCNT(j)  (256  + 64 * (j))
#define XB_XSUB(j)  (1280 + 64 * (j))
#define XB_XGEN(j)  (2304 + 64 * (j))
#define XB_TOP      3328
#define XB_TOPGEN   3392
#define XCD_BAR_WORDS 3456
#define XB_SPIN_CAP (1u << 18)
__device__ __forceinline__ unsigned xb_ld(unsigned* p)              { return __hip_atomic_load(p, __ATOMIC_RELAXED, __HIP_MEMORY_SCOPE_AGENT); }
__device__ __forceinline__ unsigned xb_add(unsigned* p, unsigned v) { return __hip_atomic_fetch_add(p, v, __ATOMIC_RELAXED, __HIP_MEMORY_SCOPE_AGENT); }
__device__ __forceinline__ unsigned xb_xcc_id() { return (unsigned)__builtin_amdgcn_s_getreg((3 << 11) | 20) & 0xFu; }
#define XB_SPIN(cond, bar) do { unsigned _sp = 0; while (cond) { __builtin_amdgcn_s_sleep(1); \
    if ((++_sp & 255u) == 0u) { if (xb_ld(&(bar)[XB_TMO])) break; if (_sp > XB_SPIN_CAP) { atomicAdd(&(bar)[XB_TMO], 1u); break; } } } } while (0)
struct XcdBarrier { unsigned* bar; unsigned x; volatile LAS unsigned* st; };
__device__ __forceinline__ XcdBarrier xcd_barrier_post(unsigned* bar, volatile LAS unsigned* st) {
    XcdBarrier b; b.bar = bar; b.x = xb_xcc_id(); b.st = st;
    if (threadIdx.x == 0) (void)xb_add(&bar[XB_XCNT(b.x)], 1u);
    return b;
}
__device__ __forceinline__ void xcd_barrier_complete(unsigned* bar, unsigned x, unsigned& nloc, unsigned& nx) {
    const unsigned G = gridDim.x * gridDim.y * gridDim.z;
    unsigned sum, cnt, mine, sp = 0u;
    for (;;) {
        sum = 0u; cnt = 0u; mine = 0u;
#pragma unroll
        for (unsigned j = 0; j < 16; ++j) { const unsigned c = xb_ld(&bar[XB_XCNT(j)]); sum += c; cnt += (c > 0u) ? 1u : 0u; mine = (j == x) ? c : mine; }
        if (sum == G) break;
        __builtin_amdgcn_s_sleep(1);
        if ((++sp & 255u) == 0u) { if (xb_ld(&bar[XB_TMO])) break; if (sp > XB_SPIN_CAP) { atomicAdd(&bar[XB_TMO], 1u); break; } }
    }
    nloc = mine > 0u ? mine : 1u; nx = cnt > 0u ? cnt : 1u;
}
__device__ __noinline__ void xcd_barrier(const XcdBarrier b) {
    asm volatile("s_waitcnt vmcnt(0)" ::: "memory");
    __syncthreads();
    if (threadIdx.x == 0) {
        unsigned* bar = b.bar;
        __builtin_amdgcn_s_waitcnt(0);
        unsigned nloc = b.st[0], nx = b.st[1];
        if (nloc == 0u) { xcd_barrier_complete(bar, b.x, nloc, nx); b.st[0] = nloc; b.st[1] = nx; }
        const unsigned old = xb_add(&bar[XB_XSUB(b.x)], 1u);
        const unsigned gen = old / nloc;
        if (old + 1u == (gen + 1u) * nloc) {
            __builtin_amdgcn_fence(__ATOMIC_RELEASE, "agent");
            asm volatile("s_waitcnt vmcnt(0)" ::: "memory");
            const unsigned og = xb_add(&bar[XB_TOP], 1u);
            const unsigned tg = og / nx;
            if (og + 1u == (tg + 1u) * nx) xb_add(&bar[XB_TOPGEN], 1u);
            else XB_SPIN(xb_ld(&bar[XB_TOPGEN]) == tg, bar);
            __builtin_amdgcn_fence(__ATOMIC_ACQUIRE, "agent");
            xb_add(&bar[XB_XGEN(b.x)], 1u);
            asm volatile("s_waitcnt vmcnt(0)" ::: "memory");
        } else {
            XB_SPIN(xb_ld(&bar[XB_XGEN(b.x)]) == gen, bar);
            __builtin_amdgcn_fence(__ATOMIC_ACQUIRE, "agent");
            asm volatile("s_waitcnt vmcnt(0)" ::: "memory");
        }
    }
    __syncthreads();
}

struct Args {
    const float* in[23];
    float* out;
    unsigned char* ws;
    int ph_lo, ph_hi;
};

struct Ctx {
    LAS unsigned char* lds;
    int tid, lane, wave, G, bid;
    const float* const* in;
    float* out;
    unsigned char* ws;
    size_t z;
};
#define CIN(k) (C.in[k] + C.z)
#define C_x CIN(0)
#define C_c CIN(1)
#define C_ctx CIN(2)
#define C_c_ctx CIN(3)
#define C_w_mod CIN(4)
#define C_b_mod CIN(5)
#define C_w_in CIN(6)
#define C_sink CIN(7)
#define C_rpb CIN(8)
#define C_sgu_g CIN(9)
#define C_sgu_bn CIN(10)
#define C_sgu_w CIN(11)
#define C_sgu_b CIN(12)
#define C_w_out CIN(13)
#define C_ln1_g CIN(14)
#define C_ln1_b CIN(15)
#define C_w_router CIN(16)
#define C_router_bias CIN(17)
#define C_w_gate CIN(18)
#define C_w_up CIN(19)
#define C_w_down CIN(20)
#define C_ln2_g CIN(21)
#define C_ln2_b CIN(22)
#define C_MOD ((float*)(C.ws + C.z + WS_MOD))
#define C_ROPE ((float*)(C.ws + C.z + WS_ROPE))
#define C_ROUTE ((int*)(C.ws + C.z + WS_ROUTE))
#define C_H ((AT*)(C.ws + C.z + WS_H))
#define C_P ((AT*)(C.ws + C.z + WS_P))
#define C_MIX ((AT*)(C.ws + C.z + WS_MIX))
#define C_T ((float*)(C.ws + C.z + WS_T))
#define C_X1 ((float*)(C.ws + C.z + WS_X1))
#define C_XB ((float*)(C.ws + C.z + WS_XB))
#define C_H2 ((AT*)(C.ws + C.z + WS_H2))
#define C_HID ((AT*)(C.ws + C.z + WS_HID))
#define C_Y ((AT*)(C.ws + C.z + WS_Y))
#define C_HS ((AT*)(C.ws + C.z + WS_HS))
#define C_SLOT ((int*)(C.ws + C.z + WS_SLOT))
#define C_SW ((float*)(C.ws + C.z + WS_SW))
#define C_MODP ((float*)(C.ws + C.z + WS_MODP))
#define C_CTLW ((unsigned*)(C.ws + C.z + WS_CTL))
#define C_WIN ((bf16_t*)(C.ws + C.z + WS_WIN))
#define C_WOUT ((bf16_t*)(C.ws + C.z + WS_WOUT))
#define C_WGU ((bf16_t*)(C.ws + C.z + WS_WGU))
#define C_WD ((bf16_t*)(C.ws + C.z + WS_WD))

__device__ __forceinline__ float silu_f(float v) { return v / (1.f + expf(-v)); }
__device__ __forceinline__ float gelu_tanh_f(float v) { return 0.5f * v * (1.f + tanhf(0.7978845608028654f * (v + 0.044715f * v * v * v))); }
__device__ __forceinline__ float wave_sum(float v) {
#pragma unroll
    for (int o = 1; o < 64; o <<= 1) v += __shfl_xor(v, o);
    return v;
}
__device__ __forceinline__ float wave_max(float v) {
#pragma unroll
    for (int o = 1; o < 64; o <<= 1) v = fmaxf(v, __shfl_xor(v, o));
    return v;
}
__device__ __forceinline__ const float* modp(const Ctx& C, int l, int kind, int j) { return C_MOD + ((size_t)(l * 2 + kind) * 6 + j) * D; }
__device__ __forceinline__ const float* xin_row(const Ctx& C, int l, int r) {
    if (l == 0) return r < SEQ ? C_x + (size_t)r * D : C_ctx + (size_t)(r - SEQ) * D;
    return C_XB + (size_t)r * D;
}

namespace pg8 {
#define PG8_LAS __attribute__((address_space(3)))
typedef short bf16x8 __attribute__((ext_vector_type(8)));
typedef float f32x4 __attribute__((ext_vector_type(4)));
typedef unsigned u32x4 __attribute__((ext_vector_type(4)));
constexpr int BM = 256, BK = 64, HALF = 128, HTB = HALF * BK * 2, STAGE_BYTES = 8 * HTB, NXCD = 8, WGM = 8;
__host__ __device__ __forceinline__ int lds_byte(int r, int c) { const int st = (r >> 4) * 2 + (c >> 5), rr = r & 15, cc = c & 31, ob = rr * 64 + cc * 2; return st * 1024 + (ob ^ (((ob >> 9) & 1) << 5)); }
__host__ __device__ __forceinline__ void stage_rc(int b, int& R, int& C) { const int st = b / 1024, sb = b % 1024, swz = sb ^ (((sb >> 9) & 1) << 5); R = (st >> 1) * 16 + swz / 64; C = (st & 1) * 32 + (swz % 64) / 2; }
__host__ __device__ __forceinline__ int perm32(int rho) { const int n = rho >> 4, i = rho & 15; return 8 * (i >> 2) + 4 * n + (i & 3); }
__device__ __forceinline__ unsigned cvt_pk_bf16(float lo, float hi) { unsigned r; asm volatile("v_cvt_pk_bf16_f32 %0, %1, %2" : "=v"(r) : "v"(lo), "v"(hi)); return r; }

struct Unit { int pm, pn; const char* A; const char* B; };

template <int NN  , int KD>
struct DenseSched {
    int nM, G, c; const char* A; const char* Bt;
    __device__ __forceinline__ bool next(int i, Unit& u) const {
        const int nwg = nM * NN;
        const int L = i * G + c; if (L >= nwg) return false;
        int wgid = L; { const int q = nwg / NXCD, r = nwg % NXCD, xcd = wgid % NXCD, off = wgid / NXCD; wgid = (xcd < r ? xcd * (q + 1) : r * (q + 1) + (xcd - r) * q) + off; }
        const int nig = WGM * NN, gid = wgid / nig, fm = gid * WGM, gsz = (nM - fm) < WGM ? (nM - fm) : WGM;
        u.pm = fm + ((wgid % nig) % gsz); u.pn = (wgid % nig) / gsz;
        u.A = A + (size_t)u.pm * (BM * KD * 2); u.B = Bt + (size_t)u.pn * (BM * KD * 2); return true;
    }
};
template <int NPN, int KD, int BROWS  >
struct MoeSched {
    const PG8_LAS int* toff; int G, c; const char* A; const char* B;
    __device__ __forceinline__ bool next(int i, Unit& u) const {
        const int MT = toff[32];
        const int L = i * G + c; if (L >= MT * NPN) return false;
        const int mt = L / NPN, pn = L % NPN;
        int e = 0;
        for (int q = 1; q < 32; ++q) e += (toff[q] <= mt) ? 1 : 0;
        u.pm = mt; u.pn = pn; u.A = A + (size_t)mt * (256 * KD * 2); u.B = B + (size_t)(e * BROWS + pn * 256) * (KD * 2); return true;
    }
};

struct EpiBf16 {
    static constexpr bool PERM = true;
    bf16_t* O; int ldc;
    __device__ __forceinline__ void operator()(const f32x4 (&acc)[2][2][4][2], const Unit& u, int wr, int wc, int fr, int fq) const {
        const int row0 = u.pm * BM + wr * 64 + fr, col0 = u.pn * BM + wc * 32 + 8 * fq;
#pragma unroll
        for (int ai = 0; ai < 2; ++ai)
#pragma unroll
            for (int m = 0; m < 4; ++m) { bf16_t* rowp = O + (size_t)(row0 + ai * HALF + m * 16) * ldc + col0;
#pragma unroll
                for (int bj = 0; bj < 2; ++bj) { const f32x4 v0 = acc[ai][bj][m][0], v1 = acc[ai][bj][m][1];
                    u32x4 w; w.x = cvt_pk_bf16(v0[0], v0[1]); w.y = cvt_pk_bf16(v0[2], v0[3]); w.z = cvt_pk_bf16(v1[0], v1[1]); w.w = cvt_pk_bf16(v1[2], v1[3]);
                    *(u32x4*)(rowp + bj * HALF) = w; } }
    }
};
struct EpiP {
    static constexpr bool PERM = true;
    bf16_t* O; const float* rope;
    __device__ __forceinline__ void operator()(const f32x4 (&acc)[2][2][4][2], const Unit& u, int wr, int wc, int fr, int fq) const {
        const int row0 = u.pm * BM + wr * 64 + fr, col0 = u.pn * BM + wc * 32 + 8 * fq;
        const bool rot = (u.pn < 4) && (u.pm < SEQ / BM);
#pragma unroll
        for (int ai = 0; ai < 2; ++ai)
#pragma unroll
            for (int m = 0; m < 4; ++m) { const int row = row0 + ai * HALF + m * 16; bf16_t* rowp = O + (size_t)row * INC + col0;
#pragma unroll
                for (int bj = 0; bj < 2; ++bj) { f32x4 v0 = acc[ai][bj][m][0], v1 = acc[ai][bj][m][1];
                    if (rot) {
                        const int i0 = ((col0 + bj * HALF) & 127) >> 1;
                        const int comp = (i0 < 32) ? (row >> 6) : (row & 63);
                        const f32x4 cs = *(const f32x4*)(rope + comp * 32 + (i0 & 31)), sn = *(const f32x4*)(rope + 4096 + comp * 32 + (i0 & 31));
                        const f32x4 a = v0, b = v1;
                        v0[0] = a[0] * cs[0] - a[1] * sn[0]; v0[1] = a[1] * cs[0] + a[0] * sn[0];
                        v0[2] = a[2] * cs[1] - a[3] * sn[1]; v0[3] = a[3] * cs[1] + a[2] * sn[1];
                        v1[0] = b[0] * cs[2] - b[1] * sn[2]; v1[1] = b[1] * cs[2] + b[0] * sn[2];
                        v1[2] = b[2] * cs[3] - b[3] * sn[3]; v1[3] = b[3] * cs[3] + b[2] * sn[3];
                    }
                    u32x4 w; w.x = cvt_pk_bf16(v0[0], v0[1]); w.y = cvt_pk_bf16(v0[2], v0[3]); w.z = cvt_pk_bf16(v1[0], v1[1]); w.w = cvt_pk_bf16(v1[2], v1[3]);
                    *(u32x4*)(rowp + bj * HALF) = w; } }
    }
};
struct EpiTres {
    static constexpr bool PERM = false;
    float* T; const float* xl; const float* xc; const float* gl; const float* gc;
    __device__ __forceinline__ void operator()(const f32x4 (&acc)[2][2][4][2], const Unit& u, int wr, int wc, int fr, int fq) const {
        const int row0 = u.pm * BM + wr * 64 + fr, col0 = u.pn * BM + wc * 32 + 4 * fq;
        const bool isctx = (u.pm == SEQ / BM);
        const float* xb = isctx ? xc - (size_t)SEQ * D : xl; const float* gb = isctx ? gc : gl;
        f32x4 gv[2][2];
#pragma unroll
        for (int bj = 0; bj < 2; ++bj)
#pragma unroll
            for (int n = 0; n < 2; ++n) gv[bj][n] = *(const f32x4*)(gb + col0 + bj * HALF + n * 16);
#pragma unroll
        for (int ai = 0; ai < 2; ++ai)
#pragma unroll
            for (int m = 0; m < 4; ++m) { const size_t off = (size_t)(row0 + ai * HALF + m * 16) * D + col0;
#pragma unroll
                for (int bj = 0; bj < 2; ++bj)
#pragma unroll
                    for (int n = 0; n < 2; ++n) { const f32x4 xv = *(const f32x4*)(xb + off + bj * HALF + n * 16);
                        *(f32x4*)(T + off + bj * HALF + n * 16) = xv * ALPHA + gv[bj][n] * acc[ai][bj][m][n]; }
                asm volatile("" ::: "memory"); }
    }
};
struct EpiMoe1 {
    static constexpr bool PERM = true;
    bf16_t* HID; const float* SW;
    __device__ __forceinline__ void operator()(const f32x4 (&acc)[2][2][4][2], const Unit& u, int wr, int wc, int fr, int fq) const {
        const int row0 = u.pm * BM + wr * 64 + fr, col0 = u.pn * HALF + wc * 32 + 8 * fq;
#pragma unroll
        for (int ai = 0; ai < 2; ++ai)
#pragma unroll
            for (int m = 0; m < 4; ++m) { const int row = row0 + ai * HALF + m * 16; const float w = SW[row];
                float h[8];
#pragma unroll
                for (int n = 0; n < 2; ++n)
#pragma unroll
                    for (int j = 0; j < 4; ++j) { const float g = acc[ai][0][m][n][j], up = acc[ai][1][m][n][j]; h[4 * n + j] = g / (1.f + __expf(-g)) * up * w; }
                u32x4 o; o.x = cvt_pk_bf16(h[0], h[1]); o.y = cvt_pk_bf16(h[2], h[3]); o.z = cvt_pk_bf16(h[4], h[5]); o.w = cvt_pk_bf16(h[6], h[7]);
                *(u32x4*)(HID + (size_t)row * FF + col0) = o; }
    }
};

template <int K, class Epi, class Sched, bool ALIGN_EPI = true, bool SP2 = true>
__device__ __forceinline__ void gemm_phase(PG8_LAS unsigned char* lds, const Sched& S, const Epi& E) {
    int tid_ = threadIdx.x; asm volatile("" : "+v"(tid_));
    const int tid = tid_, wid = __builtin_amdgcn_readfirstlane(tid >> 6), lane = tid & 63, wr = wid >> 2, wc = wid & 3, fr = lane & 15, fq = lane >> 4;
    constexpr int nt = K / BK;
    unsigned voffA[2], voffB[2];
#pragma unroll
    for (int i = 0; i < 2; ++i) { int R, C; stage_rc(tid * 16 + i * 8192, R, C); const int Rb = Epi::PERM ? ((R & ~31) + perm32(R & 31)) : R;
        voffA[i] = (unsigned)(R * K + C) * 2u; voffB[i] = (unsigned)(Rb * K + C) * 2u; }
    const size_t kstep = (size_t)(BK * 2);
    const size_t hstep = (size_t)HALF * K * 2;
    const unsigned ldsw = (unsigned)wid * 1024u;
    const int aoff = lds_byte(wr * 64 + fr, fq * 8), boff = lds_byte(wc * 32 + fr, fq * 8);
#define PG8_SA(b, h) (((b) * 2 + (h)) * HTB)
#define PG8_SB(b, h) ((4 + (b) * 2 + (h)) * HTB)
#define PG8_STAGE(bufoff, gbase, voff) do { _Pragma("unroll") for (int _i = 0; _i < 2; ++_i) \
        __builtin_amdgcn_global_load_lds((const unsigned*)((const char*)(gbase) + (voff)[_i]), (PG8_LAS unsigned*)(lds + (bufoff) + ldsw + _i * 8192), 16, 0, 0); } while (0)
#define PG8_LDA(dst, b, h) do { _Pragma("unroll") for (int m = 0; m < 4; ++m) _Pragma("unroll") for (int k = 0; k < 2; ++k) dst[m][k] = *(const PG8_LAS bf16x8*)(lds + PG8_SA(b, h) + aoff + m * 2048 + k * 1024); } while (0)
#define PG8_LDB(dst, b, h) do { _Pragma("unroll") for (int n = 0; n < 2; ++n) _Pragma("unroll") for (int k = 0; k < 2; ++k) dst[n][k] = *(const PG8_LAS bf16x8*)(lds + PG8_SB(b, h) + boff + n * 2048 + k * 1024); } while (0)
#define PG8_MMA(ai, bj, At, Bt) do { __builtin_amdgcn_s_setprio(1); _Pragma("unroll") for (int m = 0; m < 4; ++m) _Pragma("unroll") for (int n = 0; n < 2; ++n) _Pragma("unroll") for (int k = 0; k < 2; ++k) \
        acc[ai][bj][m][n] = __builtin_amdgcn_mfma_f32_16x16x32_bf16(Bt[n][k], At[m][k], acc[ai][bj][m][n], 0, 0, 0); __builtin_amdgcn_s_setprio(0); } while (0)
#define PG8_WAIT_V(n) asm volatile("s_waitcnt vmcnt(" #n ")" ::: "memory")
#define PG8_WAIT_L(n) asm volatile("s_waitcnt lgkmcnt(" #n ")" ::: "memory")
#define PG8_BAR __builtin_amdgcn_s_barrier()
#define PG8_SCHED __builtin_amdgcn_sched_barrier(0)
    Unit cur, nxt; int ui = 0;
    if (!S.next(0, cur)) return;
    f32x4 acc[2][2][4][2];
#pragma unroll
    for (int a = 0; a < 2; ++a)
#pragma unroll
        for (int b = 0; b < 2; ++b)
#pragma unroll
            for (int m = 0; m < 4; ++m)
#pragma unroll
                for (int n = 0; n < 2; ++n) acc[a][b][m][n] = (f32x4){0.f, 0.f, 0.f, 0.f};
    bf16x8 At[4][2], B0[2][2], B1[2][2];
    const char* cA = cur.A; const char* cB = cur.B;
    if constexpr (SP2) {
        PG8_STAGE(PG8_SB(0, 0), cB, voffB); PG8_STAGE(PG8_SB(0, 1), cB + hstep, voffB); PG8_STAGE(PG8_SA(0, 0), cA, voffA); PG8_STAGE(PG8_SA(0, 1), cA + hstep, voffA);
        if (wr == 1) PG8_BAR;
        PG8_WAIT_V(2); PG8_BAR;
        PG8_STAGE(PG8_SB(1, 0), cB + kstep, voffB); PG8_STAGE(PG8_SA(1, 0), cA + kstep, voffA); PG8_STAGE(PG8_SB(1, 1), cB + hstep + kstep, voffB);
        PG8_WAIT_V(6); PG8_BAR;
    } else {
        PG8_STAGE(PG8_SB(0, 0), cB, voffB); PG8_STAGE(PG8_SA(0, 0), cA, voffA); PG8_STAGE(PG8_SB(0, 1), cB + hstep, voffB); PG8_STAGE(PG8_SA(0, 1), cA + hstep, voffA);
        if (wr == 1) PG8_BAR;
        PG8_WAIT_V(4); PG8_BAR;
        PG8_STAGE(PG8_SB(1, 0), cB + kstep, voffB); PG8_STAGE(PG8_SA(1, 0), cA + kstep, voffA); PG8_STAGE(PG8_SB(1, 1), cB + hstep + kstep, voffB);
        PG8_WAIT_V(6); PG8_BAR;
    }
    for (;;) {
        const bool has_next = S.next(ui + 1, nxt);
        const char* nA = has_next ? nxt.A : cA; const char* nB = has_next ? nxt.B : cB;
        for (int t = 0; t < nt; t += 2) {
            const bool last = (t == nt - 2);
            const char* a1 = cA + (size_t)(t + 1) * kstep;
            const char* a2 = last ? nA : cA + (size_t)(t + 2) * kstep; const char* b2 = last ? nB : cB + (size_t)(t + 2) * kstep;
            const char* a3 = a2 + kstep; const char* b3 = b2 + kstep;
            if constexpr (SP2) {
            PG8_LDB(B0, 0, 0); PG8_LDB(B1, 0, 1); PG8_SCHED; PG8_LDA(At, 0, 0); PG8_STAGE(PG8_SA(1, 1), a1 + hstep, voffA);
            PG8_WAIT_V(8); PG8_WAIT_L(0); PG8_BAR; PG8_MMA(0, 0, At, B0); PG8_MMA(0, 1, At, B1); PG8_BAR; PG8_SCHED;
            PG8_LDA(At, 0, 1); PG8_STAGE(PG8_SB(0, 0), b2, voffB); PG8_STAGE(PG8_SB(0, 1), b2 + hstep, voffB); PG8_STAGE(PG8_SA(0, 0), a2, voffA);
            PG8_WAIT_V(8); PG8_WAIT_L(0); PG8_BAR; PG8_MMA(1, 0, At, B0); PG8_MMA(1, 1, At, B1); PG8_BAR; PG8_SCHED;
            PG8_LDB(B0, 1, 0); PG8_LDB(B1, 1, 1); PG8_SCHED; PG8_LDA(At, 1, 0); PG8_STAGE(PG8_SA(0, 1), a2 + hstep, voffA);
            PG8_WAIT_V(8); PG8_WAIT_L(0); PG8_BAR; PG8_MMA(0, 0, At, B0); PG8_MMA(0, 1, At, B1); PG8_BAR; PG8_SCHED;
            PG8_LDA(At, 1, 1); PG8_STAGE(PG8_SB(1, 0), b3, voffB); PG8_STAGE(PG8_SB(1, 1), b3 + hstep, voffB); PG8_STAGE(PG8_SA(1, 0), a3, voffA);
            PG8_WAIT_V(8); PG8_WAIT_L(0); PG8_BAR; PG8_MMA(1, 0, At, B0); PG8_MMA(1, 1, At, B1); PG8_BAR; PG8_SCHED;
            } else {
            PG8_LDB(B0, 0, 0); PG8_SCHED; PG8_LDA(At, 0, 0); PG8_STAGE(PG8_SA(1, 1), a1 + hstep, voffA);
            PG8_WAIT_L(8); PG8_BAR; PG8_WAIT_L(0); PG8_MMA(0, 0, At, B0); PG8_BAR; PG8_SCHED;
            PG8_LDB(B1, 0, 1); PG8_STAGE(PG8_SB(0, 0), b2, voffB);
            PG8_BAR; PG8_WAIT_L(0); PG8_MMA(0, 1, At, B1); PG8_BAR;
            PG8_LDA(At, 0, 1); PG8_STAGE(PG8_SA(0, 0), a2, voffA);
            PG8_BAR; PG8_WAIT_L(0); PG8_MMA(1, 0, At, B0); PG8_BAR; PG8_SCHED;
            PG8_STAGE(PG8_SB(0, 1), b2 + hstep, voffB);
            PG8_WAIT_V(6); PG8_BAR; PG8_MMA(1, 1, At, B1); PG8_BAR;
            PG8_LDB(B0, 1, 0); PG8_SCHED; PG8_LDA(At, 1, 0); PG8_STAGE(PG8_SA(0, 1), a2 + hstep, voffA);
            PG8_WAIT_L(8); PG8_BAR; PG8_WAIT_L(0); PG8_MMA(0, 0, At, B0); PG8_BAR; PG8_SCHED;
            PG8_LDB(B1, 1, 1); PG8_STAGE(PG8_SB(1, 0), b3, voffB);
            PG8_BAR; PG8_WAIT_L(0); PG8_MMA(0, 1, At, B1); PG8_BAR;
            PG8_LDA(At, 1, 1); PG8_STAGE(PG8_SA(1, 0), a3, voffA);
            PG8_BAR; PG8_WAIT_L(0); PG8_MMA(1, 0, At, B0); PG8_BAR; PG8_SCHED;
            PG8_STAGE(PG8_SB(1, 1), b3 + hstep, voffB);
            PG8_WAIT_V(6); PG8_BAR; PG8_MMA(1, 1, At, B1); PG8_BAR;
            }
        }
        if constexpr (ALIGN_EPI) { if (wr == 0) PG8_BAR; }
        E(acc, cur, wr, wc, fr, fq);
        if (!has_next) break;
#pragma unroll
        for (int a = 0; a < 2; ++a)
#pragma unroll
            for (int b = 0; b < 2; ++b)
#pragma unroll
                for (int m = 0; m < 4; ++m)
#pragma unroll
                    for (int n = 0; n < 2; ++n) acc[a][b][m][n] = (f32x4){0.f, 0.f, 0.f, 0.f};
        cur = nxt; cA = nA; cB = nB; ++ui;
        if constexpr (ALIGN_EPI) { if (wr == 1) PG8_BAR; }
    }
    PG8_WAIT_V(0);
    if constexpr (!ALIGN_EPI) { if (wr == 0) PG8_BAR; }
    PG8_BAR;
#undef PG8_SA
#undef PG8_SB
#undef PG8_STAGE
#undef PG8_LDA
#undef PG8_LDB
#undef PG8_MMA
#undef PG8_WAIT_V
#undef PG8_WAIT_L
#undef PG8_BAR
#undef PG8_SCHED
}
}

__device__ __forceinline__ void transpose_item(const float* W, int N, bf16_t* WT, int K, int wt_row0, int k0, int n0, LAS float* scr, int lane, int rstride = 1) {
#pragma unroll
    for (int i = 0; i < 32; ++i) { const int kk = 2 * i + (lane >> 5); scr[kk * 33 + (lane & 31)] = W[(size_t)(k0 + kk) * N + n0 + (lane & 31)]; }
    asm volatile("s_waitcnt lgkmcnt(0)" ::: "memory");
    const int c = lane & 7;
#pragma unroll
    for (int j = 0; j < 4; ++j) { const int n = (lane >> 3) + 8 * j; const LAS float* sp = scr + (8 * c) * 33 + n;
        uint4 o; o.x = pg8::cvt_pk_bf16(sp[0 * 33], sp[1 * 33]); o.y = pg8::cvt_pk_bf16(sp[2 * 33], sp[3 * 33]); o.z = pg8::cvt_pk_bf16(sp[4 * 33], sp[5 * 33]); o.w = pg8::cvt_pk_bf16(sp[6 * 33], sp[7 * 33]);
        *(uint4*)(WT + (size_t)(wt_row0 + n * rstride) * K + k0 + 8 * c) = o; }
    asm volatile("s_waitcnt lgkmcnt(0)" ::: "memory");
}
constexpr int I_IN = (D / 64) * (INC / 32), I_OUT = (D / 64) * (D / 32), I_EXP = 512, NKC = 16;
__device__ __forceinline__ void ph_prologue(const Ctx& C) {
    const int gt = C.bid * NTHREADS + C.tid, NT = C.G * NTHREADS;
    const int gw = C.bid * NWAVES + C.wave, NGW = C.G * NWAVES, lane = C.lane;
    for (int idx = gt; idx < 128 * 32; idx += NT) {
        const int pos = idx / 32, j = idx % 32;
        const double inv = pow(10000.0, -(double)j / 32.0);
        const double ang = (double)pos * inv;
        C_ROPE[idx] = (float)cos(ang);
        C_ROPE[128 * 32 + idx] = (float)sin(ang);
    }
    {
        LAS float* sl = (LAS float*)C.lds;
        for (int k = C.tid; k < D; k += NTHREADS) { sl[k] = silu_f(C_c[k]); sl[D + k] = silu_f(C_c_ctx[k]); }
        __syncthreads();
        for (int u = gw; u < DEPTH * 48 * NKC; u += NGW) {
            const int l = u / (48 * NKC), rem = u % (48 * NKC), sb = rem / NKC, kc = rem % NKC;
            const float* w = C_w_mod + (size_t)l * D * 6 * D + (size_t)(kc * 128) * 6 * D + sb * 256 + lane * 4;
            float4 a0 = {0.f, 0.f, 0.f, 0.f}, a1 = {0.f, 0.f, 0.f, 0.f};
#pragma unroll 16
            for (int k = 0; k < 128; ++k) {
                const float4 wv = *(const float4*)(w + (size_t)k * 6 * D);
                const float c0 = sl[kc * 128 + k], c1 = sl[D + kc * 128 + k];
                a0.x += c0 * wv.x; a0.y += c0 * wv.y; a0.z += c0 * wv.z; a0.w += c0 * wv.w;
                a1.x += c1 * wv.x; a1.y += c1 * wv.y; a1.z += c1 * wv.z; a1.w += c1 * wv.w;
            }
            *(float4*)(C_MODP + ((size_t)(kc * 2 + l) * 2 + 0) * 6 * D + sb * 256 + lane * 4) = a0;
            *(float4*)(C_MODP + ((size_t)(kc * 2 + l) * 2 + 1) * 6 * D + sb * 256 + lane * 4) = a1;
        }
        __syncthreads();
    }
    LAS float* scr = (LAS float*)(C.lds + C.wave * 16384);
    constexpr int TOT = 2 * I_IN + 2 * I_OUT + 3 * 64 * I_EXP;
    for (int it = gw; it < TOT; it += NGW) {
        int r = it;
        if (r < 2 * I_IN) { const int l = r / I_IN, q = r % I_IN, kb = q / (INC / 32), nb = q % (INC / 32);
            const int n0 = 32 * nb; int row0 = n0, rs = 1;
            if (n0 < OFF_AV) { const int hh = n0 / HD, d0 = n0 % HD; row0 = hh * HD + (d0 < 64 ? 2 * d0 : 2 * (d0 - 64) + 1); rs = 2; }
            transpose_item(C_w_in + (size_t)l * D * INC, INC, C_WIN + (size_t)l * INC * D, D, row0, 64 * kb, n0, scr, lane, rs); continue; }
        r -= 2 * I_IN;
        if (r < 2 * I_OUT) { const int l = r / I_OUT, q = r % I_OUT, kb = q / (D / 32), nb = q % (D / 32);
            transpose_item(C_w_out + (size_t)l * D * D, D, C_WOUT + (size_t)l * D * D, D, 32 * nb, 64 * kb, 32 * nb, scr, lane); continue; }
        r -= 2 * I_OUT;
        if (r < 2 * 64 * I_EXP) { const int up = r / (64 * I_EXP), rr = r % (64 * I_EXP); const int le = rr / I_EXP, q = rr % I_EXP, kb = q / 16, nb = q % 16, f0 = 32 * nb;
            transpose_item((up ? C_w_up : C_w_gate) + (size_t)le * D * FF, FF, C_WGU + (size_t)le * 1024 * D, D, (f0 / 128) * 256 + up * 128 + (f0 % 128), 64 * kb, f0, scr, lane); continue; }
        r -= 2 * 64 * I_EXP;
        { const int le = r / I_EXP, q = r % I_EXP, kb = q / (D / 32), nb = q % (D / 32);
          transpose_item(C_w_down + (size_t)le * FF * D, D, C_WD + (size_t)le * D * FF, FF, 32 * nb, 64 * kb, 32 * nb, scr, lane); }
    }
}

__device__ __forceinline__ void ph_modulate0(const Ctx& C) {
    const int gt = C.bid * NTHREADS + C.tid, NT = C.G * NTHREADS;
    const int gw = C.bid * NWAVES + C.wave, NGW = C.G * NWAVES, lane = C.lane;
    for (int idx = gt; idx < DEPTH * 2 * 6 * D; idx += NT) {
        const int n = idx % (6 * D), l = idx / (2 * 6 * D);
        float a = C_b_mod[l * 6 * D + n];
#pragma unroll
        for (int kc = 0; kc < NKC; ++kc) a += C_MODP[(size_t)kc * (DEPTH * 2 * 6 * D) + idx];
        C_MOD[idx] = a;
    }
    LAS float* ms = (LAS float*)C.lds;
    for (int i = C.tid; i < 2 * 2 * D; i += NTHREADS) {
        const int kind = i / (2 * D), n = i % (2 * D);
        const int idx = (0 * 2 + kind) * 6 * D + n;
        float a = C_b_mod[n];
#pragma unroll
        for (int kc = 0; kc < NKC; ++kc) a += C_MODP[(size_t)kc * (DEPTH * 2 * 6 * D) + idx];
        ms[i] = a;
    }
    __syncthreads();
    for (int r = gw; r < NTOK; r += NGW) {
        const int kind = r < SEQ ? 0 : 1;
        const float* xp = xin_row(C, 0, r);
        const LAS float* sh = ms + kind * 2 * D; const LAS float* sc = sh + D;
#pragma unroll
        for (int j = 0; j < 8; ++j) {
            const int d0 = 4 * lane + 256 * j;
            const float4 xv = *(const float4*)(xp + d0);
            float4 hv; hv.x = xv.x * (1.f + sc[d0]) + sh[d0]; hv.y = xv.y * (1.f + sc[d0 + 1]) + sh[d0 + 1]; hv.z = xv.z * (1.f + sc[d0 + 2]) + sh[d0 + 2]; hv.w = xv.w * (1.f + sc[d0 + 3]) + sh[d0 + 3];
            st4(&C_H[(size_t)r * D + d0], hv);
        }
    }
}

namespace att {
using bf16x8 = __attribute__((ext_vector_type(8))) short;
using s16x4  = __attribute__((ext_vector_type(4))) short;
using f32x16 = __attribute__((ext_vector_type(16))) float;
using u32x4  = __attribute__((ext_vector_type(4))) unsigned;
constexpr int NW = 8, QBLK = 32, KVBLK = 64;
constexpr float SCALE = QSCALE, THR = 8.f;
constexpr int SHM_V = KVBLK * HD * 2, SHM_K = KVBLK * HD * 2;
constexpr int Q_OFF = 2 * SHM_V + 2 * SHM_K  , WS_OFF = 131072 + 1024, BIAS_OFF = WS_OFF + NW * 64 * 4, QSLOT_OFF = BIAS_OFF + (64 + 15 * 32 + 64) * 4, ATT_LDS = QSLOT_OFF + 16;
#define KSWZ(row, colB) ((row) * 256 + ((colB) ^ (((row) & 7) << 4)))
#define SBAR() __builtin_amdgcn_sched_barrier(0)
__device__ __forceinline__ int crow(int r, int hi) { return (r & 3) + 8 * (r >> 2) + 4 * hi; }
__device__ __forceinline__ unsigned cvtpk(float lo, float hi) { unsigned r; asm volatile("v_cvt_pk_bf16_f32 %0, %1, %2" : "=v"(r) : "v"(lo), "v"(hi)); return r; }

__device__ __forceinline__ void partialSM(f32x16& p0, f32x16& p1, float& m_reg, float& mn, float& alpha) {
  constexpr float Cc = SCALE * 1.4426950408889634f;
  float pmax = p0[0]; for (int r = 1; r < 16; ++r) pmax = fmaxf(pmax, p0[r]); for (int r = 0; r < 16; ++r) pmax = fmaxf(pmax, p1[r]);
  { auto rr = __builtin_amdgcn_permlane32_swap(__float_as_uint(pmax), __float_as_uint(pmax), false, false);
    pmax = fmaxf(__uint_as_float(rr[0]), __uint_as_float(rr[1])); }
  if (__builtin_expect(__all(pmax - m_reg <= THR / SCALE), 1)) { mn = m_reg; alpha = 1.f; }
  else { mn = fmaxf(m_reg, pmax); alpha = __builtin_amdgcn_exp2f((m_reg - mn) * Cc); m_reg = mn; }
  float mnC = -mn * Cc;
  for (int r = 0; r < 16; ++r) p0[r] = fmaf(p0[r], Cc, mnC); for (int r = 0; r < 16; ++r) p1[r] = fmaf(p1[r], Cc, mnC);
  for (int r = 0; r < 16; ++r) p0[r] = __builtin_amdgcn_exp2f(p0[r]);
}
__device__ __forceinline__ void finishSM(f32x16& p0, f32x16& p1, float alpha, float& l_reg, bf16x8& pa0, bf16x8& pa1, bf16x8& pa2, bf16x8& pa3) {
  for (int r = 0; r < 16; ++r) p1[r] = __builtin_amdgcn_exp2f(p1[r]);
  float ps = 0; for (int r = 0; r < 16; ++r) ps += p0[r]; for (int r = 0; r < 16; ++r) ps += p1[r];
  { auto rr = __builtin_amdgcn_permlane32_swap(__float_as_uint(ps), __float_as_uint(ps), false, false);
    ps = __uint_as_float(rr[0]) + __uint_as_float(rr[1]); }
  l_reg = l_reg * alpha + ps;
#define PK4(P, BASE, OUT) do { unsigned a0 = cvtpk(P[BASE + 0], P[BASE + 1]), a1 = cvtpk(P[BASE + 2], P[BASE + 3]);   \
    unsigned b0 = cvtpk(P[BASE + 4], P[BASE + 5]), b1 = cvtpk(P[BASE + 6], P[BASE + 7]);                              \
    auto r0 = __builtin_amdgcn_permlane32_swap(a0, b0, false, false); auto r1 = __builtin_amdgcn_permlane32_swap(a1, b1, false, false); \
    u32x4 w = {r0[0], r1[0], r0[1], r1[1]}; OUT = *reinterpret_cast<bf16x8*>(&w); } while (0)
  PK4(p0, 0, pa0); PK4(p0, 8, pa1); PK4(p1, 0, pa2); PK4(p1, 8, pa3);
#undef PK4
}
__device__ __forceinline__ void qkt(f32x16& p0, f32x16& p1, const LAS char* Ks, const LAS char* Qs, int r32, int hi) {
#pragma unroll
  for (int d0 = 0; d0 < 8; ++d0) { int cb = (d0 * 16 + hi * 8) * 2;
    bf16x8 b0 = *reinterpret_cast<const LAS bf16x8*>(Ks + KSWZ(r32, cb));
    bf16x8 b1 = *reinterpret_cast<const LAS bf16x8*>(Ks + KSWZ(32 + r32, cb));
    bf16x8 q = *reinterpret_cast<const LAS bf16x8*>(Qs + KSWZ(r32, cb));
    p0 = __builtin_amdgcn_mfma_f32_32x32x16_bf16(b0, q, p0, 0, 0, 0);
    p1 = __builtin_amdgcn_mfma_f32_32x32x16_bf16(b1, q, p1, 0, 0, 0); }
}
__device__ __forceinline__ int v_st(int k, int c) { const int kk = (k & ~0xC) | ((k & 4) << 1) | ((k & 8) >> 1); return ((kk >> 3) * 4 + (c >> 5)) * 512 + ((kk & 7) * 32 + (c & 31)) * 2; }
__device__ __forceinline__ int v_rd_base(int lane) { return ((lane & 3) << 3) | (((lane >> 2) & 3) << 6) | (((lane >> 4) & 1) << 5) | (((lane >> 5) & 1) << 8); }
constexpr int v_rd_off(int d0, int ks, int half) { return d0 * 512 + ks * 4096 + half * 2048; }
template <int OFF> __device__ __forceinline__ s16x4 tr_read(int vb) {
  s16x4 r; asm volatile("ds_read_b64_tr_b16 %0, %1 offset:%2" : "=&v"(r) : "v"(vb), "i"(OFF) : "memory"); return r;
}
template <int D0> __device__ __forceinline__ void pv_one(f32x16& od, int vb, bf16x8 pa0, bf16x8 pa1, bf16x8 pa2, bf16x8 pa3) {
  const s16x4 l0 = tr_read<v_rd_off(D0, 0, 0)>(vb), h0 = tr_read<v_rd_off(D0, 0, 1)>(vb), l1 = tr_read<v_rd_off(D0, 1, 0)>(vb), h1 = tr_read<v_rd_off(D0, 1, 1)>(vb);
  const s16x4 l2 = tr_read<v_rd_off(D0, 2, 0)>(vb), h2 = tr_read<v_rd_off(D0, 2, 1)>(vb), l3 = tr_read<v_rd_off(D0, 3, 0)>(vb), h3 = tr_read<v_rd_off(D0, 3, 1)>(vb);
  asm volatile("s_waitcnt lgkmcnt(0)" ::: "memory"); SBAR();
#define PK(L, H) (bf16x8){L[0], L[1], L[2], L[3], H[0], H[1], H[2], H[3]}
  od = __builtin_amdgcn_mfma_f32_32x32x16_bf16(pa0, PK(l0, h0), od, 0, 0, 0);
  od = __builtin_amdgcn_mfma_f32_32x32x16_bf16(pa1, PK(l1, h1), od, 0, 0, 0);
  od = __builtin_amdgcn_mfma_f32_32x32x16_bf16(pa2, PK(l2, h2), od, 0, 0, 0);
  od = __builtin_amdgcn_mfma_f32_32x32x16_bf16(pa3, PK(l3, h3), od, 0, 0, 0);
#undef PK
}
__device__ __forceinline__ void pv_d0(f32x16* o, int vb, bf16x8 pa0, bf16x8 pa1, bf16x8 pa2, bf16x8 pa3) {
  pv_one<0>(o[0], vb, pa0, pa1, pa2, pa3); pv_one<1>(o[1], vb, pa0, pa1, pa2, pa3); pv_one<2>(o[2], vb, pa0, pa1, pa2, pa3); pv_one<3>(o[3], vb, pa0, pa1, pa2, pa3);
}

template <int kind>
__device__ __forceinline__ void attn_unit(const bf16_t* __restrict__ P, bf16_t* __restrict__ MIX, const float* __restrict__ rpb_l, const float* __restrict__ sink_l,
                                          const int u, const int h, LAS char* lds, const int tid) {
  const int wid = __builtin_amdgcn_readfirstlane(tid >> 6), lane = tid & 63, r32 = lane & 31, hi = lane >> 5;
  LAS char* V_lds = lds; LAS char* K_lds = lds + 2 * SHM_V;
  LAS float* ws = (LAS float*)(lds + WS_OFF) + wid * 64; LAS float* li_l = ws; LAS float* al_l = ws + 32;
  LAS float* rpbs = (LAS float*)(lds + BIAS_OFF) + 64;
  constexpr bool isA = (kind == 0 || kind == 2), lat = kind < 2;
  const int qrow0 = lat ? 256 * u : SEQ;
  const int qcol = isA ? h * HD : OFF_BQ + h * HD;
  const int kcol = isA ? OFF_AK + (h / 3) * HD : OFF_BK + h * HD;
  const int vcol = isA ? OFF_AV + (h / 3) * HD : OFF_BV + h * HD;
  const int ocol = (isA ? 0 : 768) + h * HD;
  constexpr int NT = (kind == 0) ? 12 : (kind == 1) ? 16 : 4;
  int Rs = 4 * u - 4; Rs = Rs < 0 ? 0 : (Rs > 117 ? 117 : Rs);
  __syncthreads();
  if (kind == 1) for (int i = tid; i < 64 + 15 * 32 + 64; i += 512) { const int t = i - 64; rpbs[t] = (t >= 0 && t < 15 * 32 && (t & 31) < 31) ? rpb_l[h * 465 + (t >> 5) * 31 + (t & 31)] * (1.0f / SCALE) : 0.f; }
  float m_reg = -1e30f, l_reg = 0; f32x16 o[4] = {};
  LAS char* Qs = lds + Q_OFF + wid * 8192;
  { const bf16_t* Qw = P + (size_t)(qrow0 + wid * QBLK + r32) * INC + qcol + hi * 8;
#pragma unroll
    for (int d0 = 0; d0 < 8; ++d0) *reinterpret_cast<LAS bf16x8*>(Qs + KSWZ(r32, (d0 * 16 + hi * 8) * 2)) = *reinterpret_cast<const bf16x8*>(Qw + d0 * 16); }
  const int sr = tid >> 4, sc = (tid & 15) * 8, vst0 = v_st(sr, sc), vst1 = v_st(32 + sr, sc);
  const int vb0 = (int)(size_t)V_lds + v_rd_base(lane);
  const unsigned voffk = (unsigned)(sr * INC + sc + kcol) * 2u, voffk2 = voffk + 32u * INC * 2u, voffv = (unsigned)(sr * INC + sc + vcol) * 2u, voffv2 = voffv + 32u * INC * 2u;
  struct { bf16x8 vs0, vs1, ks0, ks1; } sr_[1];
#define KROW(j) (((j) < 4) ? (SEQ + 64 * (j)) : (kind == 0 ? ({ int t_ = 256 * u - 128 + 64 * ((j) - 4); t_ < 0 ? 0 : (t_ > SEQ - 64 ? SEQ - 64 : t_); }) : ({ int jj_ = (j) - 4; jj_ = jj_ > 10 ? 10 : jj_; (Rs + jj_) * 64; })))
#define SLOAD(i, j) do { const char* kb_ = (const char*)P + (size_t)KROW(j) * (INC * 2);                                             \
    sr_[i].vs0 = *reinterpret_cast<const bf16x8*>(kb_ + voffv); sr_[i].vs1 = *reinterpret_cast<const bf16x8*>(kb_ + voffv2); \
    sr_[i].ks0 = *reinterpret_cast<const bf16x8*>(kb_ + voffk); sr_[i].ks1 = *reinterpret_cast<const bf16x8*>(kb_ + voffk2); } while (0)
#define SWRITE(b, i) do { *(LAS bf16x8*)(V_lds + (b) * SHM_V + vst0) = sr_[i].vs0;          \
    *(LAS bf16x8*)(V_lds + (b) * SHM_V + vst1) = sr_[i].vs1; int kc_ = sc * 2;               \
    *(LAS bf16x8*)(K_lds + (b) * SHM_K + KSWZ(sr, kc_)) = sr_[i].ks0;                       \
    *(LAS bf16x8*)(K_lds + (b) * SHM_K + KSWZ(32 + sr, kc_)) = sr_[i].ks1; } while (0)
#define SWAIT() asm volatile("s_waitcnt vmcnt(0)" ::: "memory")
#define RESC(a) do { if (__any((a) < 1.f)) { if (hi == 0) al_l[r32] = (a); asm volatile("s_waitcnt lgkmcnt(0)" ::: "memory"); \
    for (int d = 0; d < 4; ++d) for (int r = 0; r < 16; ++r) o[d][r] *= al_l[crow(r, hi)]; } } while (0)
#define MASK(p0, p1, j) do { const int j_ = (j);                                                                                          \
    if (lat && j_ >= 4) {                                                                                                                 \
      if (kind == 0) {                                                                                                                    \
        const int t0_ = 256 * u - 128 + 64 * (j_ - 4), qw_ = 256 * u + 32 * wid;                                                          \
        const float tp_ = (t0_ < 0 || t0_ >= SEQ) ? -1e30f : 0.f;                                     \
        const float dl_ = (float)(t0_ - (qw_ + r32) + 4 * hi);                                                                            \
        _Pragma("unroll") for (int r = 0; r < 16; ++r) { const float k0_ = dl_ + (float)((r & 3) + 8 * (r >> 2)), k1_ = k0_ + 32.f;       \
          p0[r] = fmaf(fminf(0.f, 128.5f - fabsf(k0_)), 1e30f, tp_); p1[r] = fmaf(fminf(0.f, 128.5f - fabsf(k1_)), 1e30f, tp_); }         \
      } else {                                                                                                                            \
        const int kr_ = Rs + (j_ - 4), qrw_ = 4 * u + (wid >> 1); int r0_ = qrw_ - 4; r0_ = r0_ < 0 ? 0 : (r0_ > 120 ? 120 : r0_);        \
        const float tp_ = (j_ >= 15 || kr_ < r0_ || kr_ >= r0_ + 8) ? -1e30f : 0.f;           \
        int dr_ = kr_ - qrw_ + 7; dr_ = dr_ < 0 ? 0 : (dr_ > 14 ? 14 : dr_);                                                              \
        const int qc_ = (wid & 1) * 32 + r32; int c0_ = qc_ - 8; c0_ = c0_ < 0 ? 0 : (c0_ > 48 ? 48 : c0_);                               \
        const LAS float* br_ = rpbs + dr_ * 32 + (15 - qc_ + 4 * hi);                                                                     \
        const float xb_ = (float)(4 * hi - c0_) - 7.5f;                                                                                   \
        _Pragma("unroll") for (int r = 0; r < 16; ++r) { const int kk_ = (r & 3) + 8 * (r >> 2); const float x0_ = xb_ + (float)kk_, x1_ = x0_ + 32.f;   \
          p0[r] = fmaf(fminf(0.f, 7.75f - fabsf(x0_)), 1e30f, br_[kk_] + tp_); p1[r] = fmaf(fminf(0.f, 7.75f - fabsf(x1_)), 1e30f, br_[kk_ + 32] + tp_); } \
      } }                                                                                                                                 \
    else { _Pragma("unroll") for (int r = 0; r < 16; ++r) { p0[r] = 0.f; p1[r] = 0.f; } } } while (0)
  f32x16 pA0, pA1; float mnA, alA; bf16x8 pa0, pa1, pa2, pa3;
  SLOAD(0, 0); asm volatile("s_waitcnt vmcnt(0)" ::: "memory"); SWRITE(0, 0); __syncthreads();
  for (int j = 0; j < NT; ++j) {
    const int b = j & 1;
    if (j + 1 < NT) SLOAD(0, j + 1);
    MASK(pA0, pA1, j);
    SBAR(); qkt(pA0, pA1, K_lds + b * SHM_K, Qs, r32, hi);
    partialSM(pA0, pA1, m_reg, mnA, alA);
    RESC(alA);
    finishSM(pA0, pA1, alA, l_reg, pa0, pa1, pa2, pa3); SBAR();
    pv_d0(o, vb0 + b * SHM_V, pa0, pa1, pa2, pa3);
    if (j + 1 < NT) { SWAIT(); SWRITE(b ^ 1, 0); }
    __syncthreads();
  }
  if (isA) l_reg += __builtin_amdgcn_exp2f(sink_l[h] * 1.4426950408889634f - m_reg * (SCALE * 1.4426950408889634f));
  if (hi == 0) li_l[r32] = l_reg; asm volatile("s_waitcnt lgkmcnt(0)" ::: "memory");
  float rli[16];
#pragma unroll
  for (int r = 0; r < 16; ++r) rli[r] = __builtin_amdgcn_rcpf(li_l[crow(r, hi)]);
  __syncthreads();
  LAS char* ost = lds + wid * 8192;
#pragma unroll
  for (int r = 0; r < 16; ++r) { const int orow = crow(r, hi);
#pragma unroll
    for (int d0 = 0; d0 < 4; ++d0) *(LAS bf16_t*)(ost + orow * 256 + (d0 * 32 + r32) * 2) = f2bf(o[d0][r] * rli[r]); }
  asm volatile("s_waitcnt lgkmcnt(0)" ::: "memory");
  bf16_t* Ow = MIX + (size_t)(qrow0 + wid * QBLK) * D + ocol;
#pragma unroll
  for (int i = 0; i < 8; ++i) { const int c = lane + 64 * i, row = c >> 4, c16 = c & 15;
    const u32x4 v = *(const LAS u32x4*)(ost + c * 16);
    *reinterpret_cast<u32x4*>(Ow + (size_t)row * D + c16 * 8) = v; }
#undef KROW
#undef SLOAD
#undef SWRITE
#undef SWAIT
#undef RESC
#undef MASK
}
#undef KSWZ
#undef SBAR
}

__device__ __forceinline__ void sgu_item(const Ctx& C, int l, int ch, int g) {
    LAS float* vn = (LAS float*)C.lds;
    const int tid = C.tid, lane = C.lane, wave = C.wave;
    const int row0 = ch * 128;
    __syncthreads();
    for (int q = wave; q < 128; q += NWAVES) {
        const AT* vp = C_P + (size_t)(row0 + q) * INC + OFF_C + CW + g * 128;
        const float a = gelu_tanh_f(ldv(vp + lane)), b = gelu_tanh_f(ldv(vp + 64 + lane));
        const float mu = wave_sum(a + b) * (1.f / 128.f);
        const float da = a - mu, db = b - mu;
        const float var = wave_sum(da * da + db * db) * (1.f / 128.f);
        const float rstd = 1.0f / sqrtf(var + LN_EPS);
        vn[q * 128 + lane] = da * rstd * C_sgu_g[l * CW + g * 128 + lane] + C_sgu_bn[l * CW + g * 128 + lane];
        vn[q * 128 + 64 + lane] = db * rstd * C_sgu_g[l * CW + g * 128 + 64 + lane] + C_sgu_bn[l * CW + g * 128 + 64 + lane];
    }
    __syncthreads();
    const int c = tid & 127, pg = tid >> 7;
    const float* ws = C_sgu_w + ((size_t)(l * 4 + g) * 128) * 128;
    for (int i = 0; i < 32; ++i) {
        const int p = pg * 32 + i;
        float acc = 0.f;
        for (int q = 0; q < 128; ++q) acc += ws[p * 128 + q] * vn[q * 128 + c];
        acc += C_sgu_b[(l * 4 + g) * 128 + p];
        const float u = gelu_tanh_f(ldv(C_P + (size_t)(row0 + p) * INC + OFF_C + g * 128 + c));
        stv(&C_MIX[(size_t)(row0 + p) * D + 1536 + g * 128 + c], u * acc);
    }
}

constexpr int CW_Q = 16384 + 256;
__device__ __forceinline__ void ph_mixers(const Ctx& C, int l) {
    const bool last = (l == DEPTH - 1);
    const int nB = 192, nA = 192, nC = last ? 0 : 12, nS = (last ? 64 : 66) * 4;
    const int total = nB + nA + nC + nS;
    LAS int* qs = (LAS int*)(C.lds + att::QSLOT_OFF);
    unsigned* ctr = C_CTLW + CW_Q + l;
    for (;;) {
        __syncthreads();
        if (C.tid == 0) *qs = (int)atomicAdd(ctr, 1u);
        __syncthreads();
        int r = *qs;
        if (r >= total) break;
        int kind = -1, u = 0, h = 0;
        if (r < nB) { kind = 1; u = r / 6; h = r % 6; }
        else { r -= nB;
            if (r < nA) { kind = 0; u = r / 6; h = r % 6; }
            else { r -= nA; if (r < nC) { kind = 2 + r / 6; u = 0; h = r % 6; } else r -= nC; } }
        if (kind == 1) att::attn_unit<1>(C_P, C_MIX, C_rpb + l * 6 * 465, C_sink + l * 6, u, h, (LAS char*)C.lds, C.tid);
        else if (kind == 0) att::attn_unit<0>(C_P, C_MIX, C_rpb + l * 6 * 465, C_sink + l * 6, u, h, (LAS char*)C.lds, C.tid);
        else if (kind == 2) att::attn_unit<2>(C_P, C_MIX, C_rpb + l * 6 * 465, C_sink + l * 6, u, h, (LAS char*)C.lds, C.tid);
        else if (kind == 3) att::attn_unit<3>(C_P, C_MIX, C_rpb + l * 6 * 465, C_sink + l * 6, u, h, (LAS char*)C.lds, C.tid);
        else sgu_item(C, l, r / 4, r % 4);
    }
}

__device__ __forceinline__ void ph_ln1(const Ctx& C, int l) {
    const bool last = (l == DEPTH - 1);
    const int nrows = last ? SEQ : NTOK;
    const int gw = C.bid * NWAVES + C.wave, NGW = C.G * NWAVES, lane = C.lane;
    LAS float* hrow = (LAS float*)C.lds + C.wave * D;
    for (int r = gw; r < nrows; r += NGW) {
        const int kind = r < SEQ ? 0 : 1;
        const float* tp = C_T + (size_t)r * D;
        float v[32]; float s = 0.f;
#pragma unroll
        for (int j = 0; j < 8; ++j) { const float4 t4 = *(const float4*)(tp + 4 * lane + 256 * j); v[4 * j] = t4.x; v[4 * j + 1] = t4.y; v[4 * j + 2] = t4.z; v[4 * j + 3] = t4.w; s += (t4.x + t4.y) + (t4.z + t4.w); }
        const float mu = wave_sum(s) * (1.f / D);
        float q = 0.f;
#pragma unroll
        for (int i = 0; i < 32; ++i) { v[i] -= mu; q += v[i] * v[i]; }
        const float rstd = 1.0f / sqrtf(wave_sum(q) * (1.f / D) + LN_EPS);
        const float* g = C_ln1_g + l * D; const float* b = C_ln1_b + l * D;
        const float* sc2 = modp(C, l, kind, 4); const float* sh2 = modp(C, l, kind, 3);
#pragma unroll
        for (int j = 0; j < 8; ++j) {
            const int d0 = 4 * lane + 256 * j;
            const float4 g4 = *(const float4*)(g + d0), b4 = *(const float4*)(b + d0), sc4 = *(const float4*)(sc2 + d0), sh4 = *(const float4*)(sh2 + d0);
            float4 x1, h2;
            x1.x = v[4 * j + 0] * rstd * g4.x + b4.x; x1.y = v[4 * j + 1] * rstd * g4.y + b4.y; x1.z = v[4 * j + 2] * rstd * g4.z + b4.z; x1.w = v[4 * j + 3] * rstd * g4.w + b4.w;
            h2.x = x1.x * (1.f + sc4.x) + sh4.x; h2.y = x1.y * (1.f + sc4.y) + sh4.y; h2.z = x1.z * (1.f + sc4.z) + sh4.z; h2.w = x1.w * (1.f + sc4.w) + sh4.w;
            *(float4*)(C_X1 + (size_t)r * D + d0) = x1;
            stv(&C_H2[(size_t)r * D + d0], h2.x); stv(&C_H2[(size_t)r * D + d0 + 1], h2.y); stv(&C_H2[(size_t)r * D + d0 + 2], h2.z); stv(&C_H2[(size_t)r * D + d0 + 3], h2.w);
            hrow[d0] = h2.x; hrow[d0 + 1] = h2.y; hrow[d0 + 2] = h2.z; hrow[d0 + 3] = h2.w;
            asm volatile("" ::: "memory");
        }
        asm volatile("s_waitcnt lgkmcnt(0)" ::: "memory");
        float lg[32];
#pragma unroll
        for (int e = 0; e < 32; ++e) lg[e] = 0.f;
#pragma unroll 2
        for (int i = 0; i < 32; ++i) {
            const int d = lane + 64 * i;
            const float h2 = hrow[d];
            const float4* wr = (const float4*)(C_w_router + (size_t)d * NE);
#pragma unroll
            for (int e4 = 0; e4 < 8; ++e4) { const float4 w4 = wr[e4]; lg[4 * e4] += h2 * w4.x; lg[4 * e4 + 1] += h2 * w4.y; lg[4 * e4 + 2] += h2 * w4.z; lg[4 * e4 + 3] += h2 * w4.w; }
        }
#pragma unroll
        for (int e = 0; e < 32; ++e) lg[e] = wave_sum(lg[e]);
        if (lane == 0) {
            float bestgs = -3.0e38f; int be0 = 0, be1 = 0; float bw0 = 0.f, bw1 = 0.f;
#pragma unroll
            for (int gq = 0; gq < 4; ++gq) {
                float m1 = -3.0e38f, m2 = -3.0e38f, s1 = 0.f, s2 = 0.f; int i1 = 0, i2 = 0;
#pragma unroll
                for (int i = 0; i < 8; ++i) {
                    const int e = gq * 8 + i;
                    const float scv = 1.f / (1.f + expf(-lg[e])), bv = scv + C_router_bias[e];
                    if (bv > m1) { m2 = m1; i2 = i1; s2 = s1; m1 = bv; i1 = e; s1 = scv; }
                    else if (bv > m2) { m2 = bv; i2 = e; s2 = scv; }
                }
                const float gs = m1 + m2;
                if (gs > bestgs) { bestgs = gs; be0 = i1; be1 = i2; bw0 = s1; bw1 = s2; }
            }
            const float inv = 1.f / (bw0 + bw1);
            int* rp = C_ROUTE + (size_t)r * 4;
            rp[0] = be0; rp[1] = be1; rp[2] = __float_as_int(bw0 * inv); rp[3] = __float_as_int(bw1 * inv);
            atomicAdd(C_CTLW + CW_CNT + l * 32 + be0, 1u); atomicAdd(C_CTLW + CW_CNT + l * 32 + be1, 1u);
        }
    }
}

constexpr int TOFF_OFF = 131072;
__device__ __forceinline__ void compute_toff(const Ctx& C, int l) {
    LAS int* toff = (LAS int*)(C.lds + TOFF_OFF);
    __syncthreads();
    if (C.tid == 0) { int acc = 0;
        for (int e = 0; e < NE; ++e) { toff[e] = acc; acc += ((int)__hip_atomic_load(C_CTLW + CW_CNT + l * 32 + e, __ATOMIC_RELAXED, __HIP_MEMORY_SCOPE_AGENT) + 255) >> 8; }
        toff[NE] = acc; }
    __syncthreads();
}
__device__ __forceinline__ void ph_dispatch(const Ctx& C, int l) {
    const bool last = (l == DEPTH - 1);
    const int nrows = last ? SEQ : NTOK;
    const int gw = C.bid * NWAVES + C.wave, NGW = C.G * NWAVES, lane = C.lane;
    compute_toff(C, l);
    const LAS int* toff = (const LAS int*)(C.lds + TOFF_OFF);
    for (int it = gw; it < nrows * 2; it += NGW) {
        const int r = it >> 1, k = it & 1;
        const int e = C_ROUTE[(size_t)r * 4 + k];
        int pos = 0;
        if (lane == 0) pos = (int)atomicAdd(C_CTLW + CW_CUR + l * 32 + e, 1u);
        pos = __builtin_amdgcn_readfirstlane(pos);
        const int slot = toff[e] * 256 + pos;
        if (lane == 0) { C_SLOT[it] = slot; C_SW[slot] = __int_as_float(C_ROUTE[(size_t)r * 4 + 2 + k]); }
        const uint4* src = (const uint4*)(C_H2 + (size_t)r * D); uint4* dst = (uint4*)(C_HS + (size_t)slot * D);
#pragma unroll
        for (int j = 0; j < 4; ++j) dst[lane + 64 * j] = src[lane + 64 * j];
    }
}

__device__ __forceinline__ void ph_ln2(const Ctx& C, int l) {
    const bool last = (l == DEPTH - 1);
    const int nrows = last ? SEQ : NTOK;
    const int gw = C.bid * NWAVES + C.wave, NGW = C.G * NWAVES, lane = C.lane;
    for (int r = gw; r < nrows; r += NGW) {
        const int kind = r < SEQ ? 0 : 1;
        const float* g2 = modp(C, l, kind, 5);
        const int s0 = C_SLOT[2 * r], s1 = C_SLOT[2 * r + 1];
        float v[32]; float s = 0.f;
#pragma unroll
        for (int j = 0; j < 8; ++j) {
            const int d0 = 4 * lane + 256 * j;
            const float4 ya = ld4(&C_Y[(size_t)s0 * D + d0]), yb = ld4(&C_Y[(size_t)s1 * D + d0]);
            const float4 x1 = *(const float4*)(C_X1 + (size_t)r * D + d0), g4 = *(const float4*)(g2 + d0);
            v[4 * j + 0] = ALPHA * x1.x + g4.x * (ya.x + yb.x); v[4 * j + 1] = ALPHA * x1.y + g4.y * (ya.y + yb.y);
            v[4 * j + 2] = ALPHA * x1.z + g4.z * (ya.z + yb.z); v[4 * j + 3] = ALPHA * x1.w + g4.w * (ya.w + yb.w);
            s += (v[4 * j] + v[4 * j + 1]) + (v[4 * j + 2] + v[4 * j + 3]);
            asm volatile("" ::: "memory");
        }
        const float mu = wave_sum(s) * (1.f / D);
        float q = 0.f;
#pragma unroll
        for (int i = 0; i < 32; ++i) { v[i] -= mu; q += v[i] * v[i]; }
        const float rstd = 1.0f / sqrtf(wave_sum(q) * (1.f / D) + LN_EPS);
        const float* g = C_ln2_g + l * D; const float* b = C_ln2_b + l * D;
        const float* sc1n = modp(C, last ? l : l + 1, kind, 1); const float* sh1n = modp(C, last ? l : l + 1, kind, 0);
#pragma unroll
        for (int j = 0; j < 8; ++j) {
            const int d0 = 4 * lane + 256 * j;
            const float4 g4 = *(const float4*)(g + d0), b4 = *(const float4*)(b + d0);
            float4 xo;
            xo.x = v[4 * j + 0] * rstd * g4.x + b4.x; xo.y = v[4 * j + 1] * rstd * g4.y + b4.y; xo.z = v[4 * j + 2] * rstd * g4.z + b4.z; xo.w = v[4 * j + 3] * rstd * g4.w + b4.w;
            if (last) *(float4*)(C.out + C.z + (size_t)r * D + d0) = xo;
            else {
                *(float4*)(C_XB + (size_t)r * D + d0) = xo;
                const float4 sc4 = *(const float4*)(sc1n + d0), sh4 = *(const float4*)(sh1n + d0);
                float4 hn; hn.x = xo.x * (1.f + sc4.x) + sh4.x; hn.y = xo.y * (1.f + sc4.y) + sh4.y; hn.z = xo.z * (1.f + sc4.z) + sh4.z; hn.w = xo.w * (1.f + sc4.w) + sh4.w;
                st4(&C_H[(size_t)r * D + d0], hn);
            }
            asm volatile("" ::: "memory");
        }
    }
}

__device__ __forceinline__ Ctx fresh(const Ctx& C0) { Ctx C = C0; size_t z = 0; int t = threadIdx.x; int g_ = gridDim.x, b_ = blockIdx.x; asm volatile("" : "+s"(z), "+v"(t), "+s"(g_), "+s"(b_)); C.G = g_; C.bid = b_; C.z = z; C.tid = t; C.lane = t & 63; C.wave = __builtin_amdgcn_readfirstlane(t >> 6); return C; }
constexpr int PH_PER_LAYER = 8;
constexpr int N_PHASES = 2 + PH_PER_LAYER * DEPTH;
__global__ void __launch_bounds__(NTHREADS, 2) fwd_kernel(Args args) {
    extern __shared__ __attribute__((aligned(16))) unsigned char lds_raw[];
    Ctx C0;
    C0.lds = (LAS unsigned char*)lds_raw;
    C0.tid = threadIdx.x; C0.lane = C0.tid & 63; C0.wave = __builtin_amdgcn_readfirstlane(C0.tid >> 6); C0.G = gridDim.x; C0.bid = blockIdx.x;
    C0.in = args.in; C0.out = args.out; C0.ws = args.ws; C0.z = 0;
    unsigned char* ws = args.ws;

    volatile LAS unsigned* bst = (volatile LAS unsigned*)(C0.lds + LDS_BYTES - 16);
    if (C0.tid < 4) bst[C0.tid] = 0u;
    __syncthreads();
    const int lo = args.ph_lo, hi = args.ph_hi;
    XcdBarrier bar; bar.bar = (unsigned*)(ws + WS_CTL) + CW_BAR; bar.x = 0; bar.st = bst;
    if (hi - lo > 1) bar = xcd_barrier_post((unsigned*)(ws + WS_CTL) + CW_BAR, bst);
#define IN(k) (lo <= (k) && (k) < hi)
#define SEAM(k) do { if (IN(k) && IN((k) + 1)) xcd_barrier(bar); } while (0)

    if (IN(0)) { const Ctx C = fresh(C0); ph_prologue(C); } SEAM(0);
    if (IN(1)) { const Ctx C = fresh(C0); ph_modulate0(C); } SEAM(1);
#pragma unroll 1
    for (int l = 0; l < DEPTH; ++l) {
        const int pb = 2 + PH_PER_LAYER * l;
        const bool last = (l == DEPTH - 1);
        if (IN(pb + 0)) {
            const Ctx C = fresh(C0);
            pg8::DenseSched<INC / 256, D> S{NTOK / 256, C.G, C.bid, (const char*)C_H, (const char*)(C_WIN + (size_t)l * INC * D)};
            pg8::EpiP E{C_P, C_ROPE};
            pg8::gemm_phase<D>(C.lds, S, E);
        }
        SEAM(pb + 0);
        if (IN(pb + 1)) { const Ctx C = fresh(C0); ph_mixers(C, l); } SEAM(pb + 1);
        if (IN(pb + 2)) {
            const Ctx C = fresh(C0);
            pg8::DenseSched<D / 256, D> S{(last ? SEQ : NTOK) / 256, C.G, C.bid, (const char*)C_MIX, (const char*)(C_WOUT + (size_t)l * D * D)};
            pg8::EpiTres E{C_T, l == 0 ? C_x : C_XB, l == 0 ? C_ctx : C_XB + (size_t)SEQ * D, modp(C, l, 0, 2), modp(C, l, 1, 2)};
            pg8::gemm_phase<D>(C.lds, S, E);
        }
        SEAM(pb + 2);
        if (IN(pb + 3)) { const Ctx C = fresh(C0); ph_ln1(C, l); } SEAM(pb + 3);
        if (IN(pb + 4)) { const Ctx C = fresh(C0); ph_dispatch(C, l); } SEAM(pb + 4);
        if (IN(pb + 5)) {
            const Ctx C = fresh(C0);
            compute_toff(C, l);
            pg8::MoeSched<4, D, 1024> S{(const LAS int*)(C.lds + TOFF_OFF), C.G, C.bid, (const char*)C_HS, (const char*)(C_WGU + (size_t)l * NE * 1024 * D)};
            pg8::EpiMoe1 E{C_HID, C_SW};
            pg8::gemm_phase<D>(C.lds, S, E);
        }
        SEAM(pb + 5);
        if (IN(pb + 6)) {
            const Ctx C = fresh(C0);
            compute_toff(C, l);
            pg8::MoeSched<8, FF, D> S{(const LAS int*)(C.lds + TOFF_OFF), C.G, C.bid, (const char*)C_HID, (const char*)(C_WD + (size_t)l * NE * D * FF)};
            pg8::EpiBf16 E{C_Y, D};
            pg8::gemm_phase<FF>(C.lds, S, E);
        }
        SEAM(pb + 6);
        if (IN(pb + 7)) { const Ctx C = fresh(C0); ph_ln2(C, l); }
        if (!last) SEAM(pb + 7);
    }
#undef IN
#undef SEAM
}

#ifndef MK_N_LAUNCHES
#define MK_N_LAUNCHES 1
#endif
extern "C" void kernel_launch(void* const* d_in, const int* in_sizes, int n_in, void* d_out, int out_size, void* d_ws, size_t ws_size, hipStream_t stream) {
    static int grid = 0;
    if (grid == 0) {
        if (n_in != 23 || out_size != SEQ * D || ws_size < WS_END) {
            fprintf(stderr, "kernel_launch: unexpected shapes: n_in %d out %d ws %zu (need %zu)\n", n_in, out_size, ws_size, (size_t)WS_END); grid = -1; return; }
        int dev = 0, cus = 0;
        if (hipGetDevice(&dev) != hipSuccess || hipDeviceGetAttribute(&cus, hipDeviceAttributeMultiprocessorCount, dev) != hipSuccess) { grid = -1; return; }
        if (hipFuncSetAttribute((const void*)fwd_kernel, hipFuncAttributeMaxDynamicSharedMemorySize, LDS_BYTES) != hipSuccess) { fprintf(stderr, "kernel_launch: hipFuncSetAttribute failed\n"); grid = -1; return; }
        int per_cu = 0;
        if (hipOccupancyMaxActiveBlocksPerMultiprocessor(&per_cu, (const void*)fwd_kernel, NTHREADS, LDS_BYTES) != hipSuccess || per_cu < 1) fprintf(stderr, "kernel_launch: occupancy query says %d\n", per_cu);
        (void)hipGetLastError();
        grid = cus;
    }
    if (grid < 0) return;
    hipMemsetAsync((char*)d_ws + WS_CTL, 0, CTL_BYTES, stream);
    Args a{};
    for (int i = 0; i < 23; ++i) a.in[i] = (const float*)d_in[i];
    a.out = (float*)d_out; a.ws = (unsigned char*)d_ws;
    if (MK_N_LAUNCHES == 1) {
        a.ph_lo = 0; a.ph_hi = N_PHASES;
        hipLaunchKernelGGL(fwd_kernel, dim3(grid), dim3(NTHREADS), LDS_BYTES, stream, a);
    } else {
        for (int p = 0; p < N_PHASES; ++p) {
            a.ph_lo = p; a.ph_hi = p + 1;
            hipLaunchKernelGGL(fwd_kernel, dim3(grid), dim3(NTHREADS), LDS_BYTES, stream, a);
        }
    }
    const hipError_t le = hipPeekAtLastError();
    if (le != hipSuccess) fprintf(stderr, "kernel_launch: launch failed: %s\n", hipGetErrorName(le));
}
```

```cpp
#include <hip/hip_runtime.h>
#include <cstdio>
#include <cstdint>

#define LAS __attribute__((address_space(3)))
typedef unsigned short bf16_t;

constexpr int D = 2048, SEQ = 8192, CTXL = 256, NTOK = SEQ + CTXL;
constexpr int DEPTH = 2, GRID_W = 64, HD = 128;
constexpr int INC = 4608;
constexpr int OFF_AK = 768, OFF_AV = 1024, OFF_BQ = 1280, OFF_BK = 2048, OFF_BV = 2816, OFF_C = 3584;
constexpr int NE = 32, FF = 512, CW = 512;
constexpr float LN_EPS = 1e-5f;
constexpr float ALPHA = 1.4142135623730951f;
constexpr float QSCALE = 0.08838834764831845f;
constexpr int NTHREADS = 512, NWAVES = 8;

typedef bf16_t AT;
__device__ __forceinline__ float ldv(const float* p) { return *p; }
__device__ __forceinline__ void stv(float* p, float v) { *p = v; }
__device__ __forceinline__ float bf2f(bf16_t b) { return __uint_as_float(((unsigned)b) << 16); }
__device__ __forceinline__ bf16_t f2bf(float f) { unsigned u = __float_as_uint(f); return (bf16_t)((u + 0x7fffu + ((u >> 16) & 1u)) >> 16); }
__device__ __forceinline__ float ldv(const bf16_t* p) { return bf2f(*p); }
__device__ __forceinline__ void stv(bf16_t* p, float v) { *p = f2bf(v); }

__device__ __forceinline__ float4 ld4(const float* p) { return *(const float4*)p; }
__device__ __forceinline__ void st4(float* p, float4 v) { *(float4*)p = v; }
__device__ __forceinline__ float4 ld4(const bf16_t* p) { const uint2 u = *(const uint2*)p; float4 r; r.x = __uint_as_float(u.x << 16); r.y = __uint_as_float(u.x & 0xffff0000u); r.z = __uint_as_float(u.y << 16); r.w = __uint_as_float(u.y & 0xffff0000u); return r; }
__device__ __forceinline__ void st4(bf16_t* p, float4 v) { uint2 u; u.x = (unsigned)f2bf(v.x) | ((unsigned)f2bf(v.y) << 16); u.y = (unsigned)f2bf(v.z) | ((unsigned)f2bf(v.w) << 16); *(uint2*)p = u; }

constexpr size_t MiB = 1u << 20;
constexpr size_t WS_CTL = 0, CTL_BYTES = 1 * MiB;
constexpr int CW_BAR = 4096, CW_CNT = 16384, CW_CUR = 16384 + 128;
constexpr size_t WS_MOD = 1 * MiB;
constexpr size_t WS_ROPE = 2 * MiB;
constexpr size_t WS_ROUTE = 3 * MiB;
constexpr size_t WS_SLOT = 3 * MiB + 512 * 1024;
constexpr size_t WS_SW = 4 * MiB;
constexpr size_t WS_MODP = 5 * MiB;
constexpr int MAXSLOT = 25088;
constexpr size_t WS_WIN = 8 * MiB;
constexpr size_t WS_WOUT = 44 * MiB;
constexpr size_t WS_WGU = 64 * MiB;
constexpr size_t WS_WD = 320 * MiB;
constexpr size_t WS_H = 448 * MiB;
constexpr size_t WS_P = 482 * MiB;
constexpr size_t WS_MIX = 558 * MiB;
constexpr size_t WS_T = 592 * MiB;
constexpr size_t WS_X1 = 660 * MiB;
constexpr size_t WS_XB = 728 * MiB;
constexpr size_t WS_H2 = 796 * MiB;
constexpr size_t WS_HS = 830 * MiB;
constexpr size_t WS_HID = 930 * MiB;
constexpr size_t WS_Y = 956 * MiB;
constexpr size_t WS_END = 1056 * MiB;

constexpr int LDS_BYTES = 163840;

#define XB_TMO      128
#define XB_XCNT(j)  (256  + 64 * (j))
#define XB_XSUB(j)  (1280 + 64 * (j))
#define XB_XGEN(j)  (2304 + 64 * (j))
#define XB_TOP      3328
#define XB_TOPGEN   3392
#define XCD_BAR_WORDS 3456
#define XB_SPIN_CAP (1u << 18)
__device__ __forceinline__ unsigned xb_ld(unsigned* p)              { return __hip_atomic_load(p, __ATOMIC_RELAXED, __HIP_MEMORY_SCOPE_AGENT); }
__device__ __forceinline__ unsigned xb_add(unsigned* p, unsigned v) { return __hip_atomic_fetch_add(p, v, __ATOMIC_RELAXED, __HIP_MEMORY_SCOPE_AGENT); }
__device__ __forceinline__ unsigned xb_xcc_id() { return (unsigned)__builtin_amdgcn_s_getreg((3 << 11) | 20) & 0xFu; }
#define XB_SPIN(cond, bar) do { unsigned _sp = 0; while (cond) { __builtin_amdgcn_s_sleep(1); \
    if ((++_sp & 255u) == 0u) { if (xb_ld(&(bar)[XB_TMO])) break; if (_sp > XB_SPIN_CAP) { atomicAdd(&(bar)[XB_TMO], 1u); break; } } } } while (0)
struct XcdBarrier { unsigned* bar; unsigned x; volatile LAS unsigned* st; };
__device__ __forceinline__ XcdBarrier xcd_barrier_post(unsigned* bar, volatile LAS unsigned* st) {
    XcdBarrier b; b.bar = bar; b.x = xb_xcc_id(); b.st = st;
    if (threadIdx.x == 0) (void)xb_add(&bar[XB_XCNT(b.x)], 1u);
    return b;
}
__device__ __forceinline__ void xcd_barrier_complete(unsigned* bar, unsigned x, unsigned& nloc, unsigned& nx) {
    const unsigned G = gridDim.x * gridDim.y * gridDim.z;
    unsigned sum, cnt, mine, sp = 0u;
    for (;;) {
        sum = 0u; cnt = 0u; mine = 0u;
#pragma unroll
        for (unsigned j = 0; j < 16; ++j) { const unsigned c = xb_ld(&bar[XB_XCNT(j)]); sum += c; cnt += (c > 0u) ? 1u : 0u; mine = (j == x) ? c : mine; }
        if (sum == G) break;
        __builtin_amdgcn_s_sleep(1);
        if ((++sp & 255u) == 0u) { if (xb_ld(&bar[XB_TMO])) break; if (sp > XB_SPIN_CAP) { atomicAdd(&bar[XB_TMO], 1u); break; } }
    }
    nloc = mine > 0u ? mine : 1u; nx = cnt > 0u ? cnt : 1u;
}
__device__ __noinline__ void xcd_barrier(const XcdBarrier b) {
    asm volatile("s_waitcnt vmcnt(0)" ::: "memory");
    __syncthreads();
    if (threadIdx.x == 0) {
        unsigned* bar = b.bar;
        __builtin_amdgcn_s_waitcnt(0);
        unsigned nloc = b.st[0], nx = b.st[1];
        if (nloc == 0u) { xcd_barrier_complete(bar, b.x, nloc, nx); b.st[0] = nloc; b.st[1] = nx; }
        const unsigned old = xb_add(&bar[XB_XSUB(b.x)], 1u);
        const unsigned gen = old / nloc;
        if (old + 1u == (gen + 1u) * nloc) {
            __builtin_amdgcn_fence(__ATOMIC_RELEASE, "agent");
            asm volatile("s_waitcnt vmcnt(0)" ::: "memory");
            const unsigned og = xb_add(&bar[XB_TOP], 1u);
            const unsigned tg = og / nx;
            if (og + 1u == (tg + 1u) * nx) xb_add(&bar[XB_TOPGEN], 1u);
            else XB_SPIN(xb_ld(&bar[XB_TOPGEN]) == tg, bar);
            __builtin_amdgcn_fence(__ATOMIC_ACQUIRE, "agent");
            xb_add(&bar[XB_XGEN(b.x)], 1u);
            asm volatile("s_waitcnt vmcnt(0)" ::: "memory");
        } else {
            XB_SPIN(xb_ld(&bar[XB_XGEN(b.x)]) == gen, bar);
            __builtin_amdgcn_fence(__ATOMIC_ACQUIRE, "agent");
            asm volatile("s_waitcnt vmcnt(0)" ::: "memory");
        }
    }
    __syncthreads();
}

struct Args {
    const float* in[23];
    float* out;
    unsigned char* ws;
    int ph_lo, ph_hi;
};

struct Ctx {
    LAS unsigned char* lds;
    int tid, lane, wave, G, bid;
    const float* const* in;
    float* out;
    unsigned char* ws;
    size_t z;
};
#define CIN(k) (C.in[k] + C.z)
#define C_x CIN(0)
#define C_c CIN(1)
#define C_ctx CIN(2)
#define C_c_ctx CIN(3)
#define C_w_mod CIN(4)
#define C_b_mod CIN(5)
#define C_w_in CIN(6)
#define C_sink CIN(7)
#define C_rpb CIN(8)
#define C_sgu_g CIN(9)
#define C_sgu_bn CIN(10)
#define C_sgu_w CIN(11)
#define C_sgu_b CIN(12)
#define C_w_out CIN(13)
#define C_ln1_g CIN(14)
#define C_ln1_b CIN(15)
#define C_w_router CIN(16)
#define C_router_bias CIN(17)
#define C_w_gate CIN(18)
#define C_w_up CIN(19)
#define C_w_down CIN(20)
#define C_ln2_g CIN(21)
#define C_ln2_b CIN(22)
#define C_MOD ((float*)(C.ws + C.z + WS_MOD))
#define C_ROPE ((float*)(C.ws + C.z + WS_ROPE))
#define C_ROUTE ((int*)(C.ws + C.z + WS_ROUTE))
#define C_H ((AT*)(C.ws + C.z + WS_H))
#define C_P ((AT*)(C.ws + C.z + WS_P))
#define C_MIX ((AT*)(C.ws + C.z + WS_MIX))
#define C_T ((float*)(C.ws + C.z + WS_T))
#define C_X1 ((float*)(C.ws + C.z + WS_X1))
#define C_XB ((float*)(C.ws + C.z + WS_XB))
#define C_H2 ((AT*)(C.ws + C.z + WS_H2))
#define C_HID ((AT*)(C.ws + C.z + WS_HID))
#define C_Y ((AT*)(C.ws + C.z + WS_Y))
#define C_HS ((AT*)(C.ws + C.z + WS_HS))
#define C_SLOT ((int*)(C.ws + C.z + WS_SLOT))
#define C_SW ((float*)(C.ws + C.z + WS_SW))
#define C_MODP ((float*)(C.ws + C.z + WS_MODP))
#define C_CTLW ((unsigned*)(C.ws + C.z + WS_CTL))
#define C_WIN ((bf16_t*)(C.ws + C.z + WS_WIN))
#define C_WOUT ((bf16_t*)(C.ws + C.z + WS_WOUT))
#define C_WGU ((bf16_t*)(C.ws + C.z + WS_WGU))
#define C_WD ((bf16_t*)(C.ws + C.z + WS_WD))

__device__ __forceinline__ float silu_f(float v) { return v / (1.f + expf(-v)); }
__device__ __forceinline__ float gelu_tanh_f(float v) { return 0.5f * v * (1.f + tanhf(0.7978845608028654f * (v + 0.044715f * v * v * v))); }
__device__ __forceinline__ float wave_sum(float v) {
#pragma unroll
    for (int o = 1; o < 64; o <<= 1) v += __shfl_xor(v, o);
    return v;
}
__device__ __forceinline__ float wave_max(float v) {
#pragma unroll
    for (int o = 1; o < 64; o <<= 1) v = fmaxf(v, __shfl_xor(v, o));
    return v;
}
__device__ __forceinline__ const float* modp(const Ctx& C, int l, int kind, int j) { return C_MOD + ((size_t)(l * 2 + kind) * 6 + j) * D; }
__device__ __forceinline__ const float* xin_row(const Ctx& C, int l, int r) {
    if (l == 0) return r < SEQ ? C_x + (size_t)r * D : C_ctx + (size_t)(r - SEQ) * D;
    return C_XB + (size_t)r * D;
}

namespace pg8 {
#define PG8_LAS __attribute__((address_space(3)))
typedef short bf16x8 __attribute__((ext_vector_type(8)));
typedef float f32x4 __attribute__((ext_vector_type(4)));
typedef unsigned u32x4 __attribute__((ext_vector_type(4)));
constexpr int BM = 256, BK = 64, HALF = 128, HTB = HALF * BK * 2, STAGE_BYTES = 8 * HTB, NXCD = 8, WGM = 8;
__host__ __device__ __forceinline__ int lds_byte(int r, int c) { const int st = (r >> 4) * 2 + (c >> 5), rr = r & 15, cc = c & 31, ob = rr * 64 + cc * 2; return st * 1024 + (ob ^ (((ob >> 9) & 1) << 5)); }
__host__ __device__ __forceinline__ void stage_rc(int b, int& R, int& C) { const int st = b / 1024, sb = b % 1024, swz = sb ^ (((sb >> 9) & 1) << 5); R = (st >> 1) * 16 + swz / 64; C = (st & 1) * 32 + (swz % 64) / 2; }
__host__ __device__ __forceinline__ int perm32(int rho) { const int n = rho >> 4, i = rho & 15; return 8 * (i >> 2) + 4 * n + (i & 3); }
__device__ __forceinline__ unsigned cvt_pk_bf16(float lo, float hi) { unsigned r; asm volatile("v_cvt_pk_bf16_f32 %0, %1, %2" : "=v"(r) : "v"(lo), "v"(hi)); return r; }

struct Unit { int pm, pn; const char* A; const char* B; };

template <int NN  , int KD>
struct DenseSched {
    int nM, G, c; const char* A; const char* Bt;
    __device__ __forceinline__ bool next(int i, Unit& u) const {
        const int nwg = nM * NN;
        const int L = i * G + c; if (L >= nwg) return false;
        int wgid = L; { const int q = nwg / NXCD, r = nwg % NXCD, xcd = wgid % NXCD, off = wgid / NXCD; wgid = (xcd < r ? xcd * (q + 1) : r * (q + 1) + (xcd - r) * q) + off; }
        const int nig = WGM * NN, gid = wgid / nig, fm = gid * WGM, gsz = (nM - fm) < WGM ? (nM - fm) : WGM;
        u.pm = fm + ((wgid % nig) % gsz); u.pn = (wgid % nig) / gsz;
        u.A = A + (size_t)u.pm * (BM * KD * 2); u.B = Bt + (size_t)u.pn * (BM * KD * 2); return true;
    }
};
template <int NPN, int KD, int BROWS  >
struct MoeSched {
    const PG8_LAS int* toff; int G, c; const char* A; const char* B;
    __device__ __forceinline__ bool next(int i, Unit& u) const {
        const int MT = toff[32];
        const int L = i * G + c; if (L >= MT * NPN) return false;
        const int mt = L / NPN, pn = L % NPN;
        int e = 0;
        for (int q = 1; q < 32; ++q) e += (toff[q] <= mt) ? 1 : 0;
        u.pm = mt; u.pn = pn; u.A = A + (size_t)mt * (256 * KD * 2); u.B = B + (size_t)(e * BROWS + pn * 256) * (KD * 2); return true;
    }
};

struct EpiBf16 {
    static constexpr bool PERM = true;
    bf16_t* O; int ldc;
    __device__ __forceinline__ void operator()(const f32x4 (&acc)[2][2][4][2], const Unit& u, int wr, int wc, int fr, int fq) const {
        const int row0 = u.pm * BM + wr * 64 + fr, col0 = u.pn * BM + wc * 32 + 8 * fq;
#pragma unroll
        for (int ai = 0; ai < 2; ++ai)
#pragma unroll
            for (int m = 0; m < 4; ++m) { bf16_t* rowp = O + (size_t)(row0 + ai * HALF + m * 16) * ldc + col0;
#pragma unroll
                for (int bj = 0; bj < 2; ++bj) { const f32x4 v0 = acc[ai][bj][m][0], v1 = acc[ai][bj][m][1];
                    u32x4 w; w.x = cvt_pk_bf16(v0[0], v0[1]); w.y = cvt_pk_bf16(v0[2], v0[3]); w.z = cvt_pk_bf16(v1[0], v1[1]); w.w = cvt_pk_bf16(v1[2], v1[3]);
                    *(u32x4*)(rowp + bj * HALF) = w; } }
    }
};
struct EpiP {
    static constexpr bool PERM = true;
    bf16_t* O; const float* rope;
    __device__ __forceinline__ void operator()(const f32x4 (&acc)[2][2][4][2], const Unit& u, int wr, int wc, int fr, int fq) const {
        const int row0 = u.pm * BM + wr * 64 + fr, col0 = u.pn * BM + wc * 32 + 8 * fq;
        const bool rot = (u.pn < 4) && (u.pm < SEQ / BM);
#pragma unroll
        for (int ai = 0; ai < 2; ++ai)
#pragma unroll
            for (int m = 0; m < 4; ++m) { const int row = row0 + ai * HALF + m * 16; bf16_t* rowp = O + (size_t)row * INC + col0;
#pragma unroll
                for (int bj = 0; bj < 2; ++bj) { f32x4 v0 = acc[ai][bj][m][0], v1 = acc[ai][bj][m][1];
                    if (rot) {
                        const int i0 = ((col0 + bj * HALF) & 127) >> 1;
                        const int comp = (i0 < 32) ? (row >> 6) : (row & 63);
                        const f32x4 cs = *(const f32x4*)(rope + comp * 32 + (i0 & 31)), sn = *(const f32x4*)(rope + 4096 + comp * 32 + (i0 & 31));
                        const f32x4 a = v0, b = v1;
                        v0[0] = a[0] * cs[0] - a[1] * sn[0]; v0[1] = a[1] * cs[0] + a[0] * sn[0];
                        v0[2] = a[2] * cs[1] - a[3] * sn[1]; v0[3] = a[3] * cs[1] + a[2] * sn[1];
                        v1[0] = b[0] * cs[2] - b[1] * sn[2]; v1[1] = b[1] * cs[2] + b[0] * sn[2];
                        v1[2] = b[2] * cs[3] - b[3] * sn[3]; v1[3] = b[3] * cs[3] + b[2] * sn[3];
                    }
                    u32x4 w; w.x = cvt_pk_bf16(v0[0], v0[1]); w.y = cvt_pk_bf16(v0[2], v0[3]); w.z = cvt_pk_bf16(v1[0], v1[1]); w.w = cvt_pk_bf16(v1[2], v1[3]);
                    *(u32x4*)(rowp + bj * HALF) = w; } }
    }
};
struct EpiTres {
    static constexpr bool PERM = false;
    float* T; const float* xl; const float* xc; const float* gl; const float* gc;
    __device__ __forceinline__ void operator()(const f32x4 (&acc)[2][2][4][2], const Unit& u, int wr, int wc, int fr, int fq) const {
        const int row0 = u.pm * BM + wr * 64 + fr, col0 = u.pn * BM + wc * 32 + 4 * fq;
        const bool isctx = (u.pm == SEQ / BM);
        const float* xb = isctx ? xc - (size_t)SEQ * D : xl; const float* gb = isctx ? gc : gl;
        f32x4 gv[2][2];
#pragma unroll
        for (int bj = 0; bj < 2; ++bj)
#pragma unroll
            for (int n = 0; n < 2; ++n) gv[bj][n] = *(const f32x4*)(gb + col0 + bj * HALF + n * 16);
#pragma unroll
        for (int ai = 0; ai < 2; ++ai)
#pragma unroll
            for (int m = 0; m < 4; ++m) { const size_t off = (size_t)(row0 + ai * HALF + m * 16) * D + col0;
#pragma unroll
                for (int bj = 0; bj < 2; ++bj)
#pragma unroll
                    for (int n = 0; n < 2; ++n) { const f32x4 xv = *(const f32x4*)(xb + off + bj * HALF + n * 16);
                        *(f32x4*)(T + off + bj * HALF + n * 16) = xv * ALPHA + gv[bj][n] * acc[ai][bj][m][n]; }
                asm volatile("" ::: "memory"); }
    }
};
struct EpiMoe1 {
    static constexpr bool PERM = true;
    bf16_t* HID; const float* SW;
    __device__ __forceinline__ void operator()(const f32x4 (&acc)[2][2][4][2], const Unit& u, int wr, int wc, int fr, int fq) const {
        const int row0 = u.pm * BM + wr * 64 + fr, col0 = u.pn * HALF + wc * 32 + 8 * fq;
#pragma unroll
        for (int ai = 0; ai < 2; ++ai)
#pragma unroll
            for (int m = 0; m < 4; ++m) { const int row = row0 + ai * HALF + m * 16; const float w = SW[row];
                float h[8];
#pragma unroll
                for (int n = 0; n < 2; ++n)
#pragma unroll
                    for (int j = 0; j < 4; ++j) { const float g = acc[ai][0][m][n][j], up = acc[ai][1][m][n][j]; h[4 * n + j] = g / (1.f + __expf(-g)) * up * w; }
                u32x4 o; o.x = cvt_pk_bf16(h[0], h[1]); o.y = cvt_pk_bf16(h[2], h[3]); o.z = cvt_pk_bf16(h[4], h[5]); o.w = cvt_pk_bf16(h[6], h[7]);
                *(u32x4*)(HID + (size_t)row * FF + col0) = o; }
    }
};

template <int K, class Epi, class Sched, bool ALIGN_EPI = true, bool SP2 = true>
__device__ __forceinline__ void gemm_phase(PG8_LAS unsigned char* lds, const Sched& S, const Epi& E) {
    int tid_ = threadIdx.x; asm volatile("" : "+v"(tid_));
    const int tid = tid_, wid = __builtin_amdgcn_readfirstlane(tid >> 6), lane = tid & 63, wr = wid >> 2, wc = wid & 3, fr = lane & 15, fq = lane >> 4;
    constexpr int nt = K / BK;
    unsigned voffA[2], voffB[2];
#pragma unroll
    for (int i = 0; i < 2; ++i) { int R, C; stage_rc(tid * 16 + i * 8192, R, C); const int Rb = Epi::PERM ? ((R & ~31) + perm32(R & 31)) : R;
        voffA[i] = (unsigned)(R * K + C) * 2u; voffB[i] = (unsigned)(Rb * K + C) * 2u; }
    const size_t kstep = (size_t)(BK * 2);
    const size_t hstep = (size_t)HALF * K * 2;
    const unsigned ldsw = (unsigned)wid * 1024u;
    const int aoff = lds_byte(wr * 64 + fr, fq * 8), boff = lds_byte(wc * 32 + fr, fq * 8);
#define PG8_SA(b, h) (((b) * 2 + (h)) * HTB)
#define PG8_SB(b, h) ((4 + (b) * 2 + (h)) * HTB)
#define PG8_STAGE(bufoff, gbase, voff) do { _Pragma("unroll") for (int _i = 0; _i < 2; ++_i) \
        __builtin_amdgcn_global_load_lds((const unsigned*)((const char*)(gbase) + (voff)[_i]), (PG8_LAS unsigned*)(lds + (bufoff) + ldsw + _i * 8192), 16, 0, 0); } while (0)
#define PG8_LDA(dst, b, h) do { _Pragma("unroll") for (int m = 0; m < 4; ++m) _Pragma("unroll") for (int k = 0; k < 2; ++k) dst[m][k] = *(const PG8_LAS bf16x8*)(lds + PG8_SA(b, h) + aoff + m * 2048 + k * 1024); } while (0)
#define PG8_LDB(dst, b, h) do { _Pragma("unroll") for (int n = 0; n < 2; ++n) _Pragma("unroll") for (int k = 0; k < 2; ++k) dst[n][k] = *(const PG8_LAS bf16x8*)(lds + PG8_SB(b, h) + boff + n * 2048 + k * 1024); } while (0)
#define PG8_MMA(ai, bj, At, Bt) do { __builtin_amdgcn_s_setprio(1); _Pragma("unroll") for (int m = 0; m < 4; ++m) _Pragma("unroll") for (int n = 0; n < 2; ++n) _Pragma("unroll") for (int k = 0; k < 2; ++k) \
        acc[ai][bj][m][n] = __builtin_amdgcn_mfma_f32_16x16x32_bf16(Bt[n][k], At[m][k], acc[ai][bj][m][n], 0, 0, 0); __builtin_amdgcn_s_setprio(0); } while (0)
#define PG8_WAIT_V(n) asm volatile("s_waitcnt vmcnt(" #n ")" ::: "memory")
#define PG8_WAIT_L(n) asm volatile("s_waitcnt lgkmcnt(" #n ")" ::: "memory")
#define PG8_BAR __builtin_amdgcn_s_barrier()
#define PG8_SCHED __builtin_amdgcn_sched_barrier(0)
    Unit cur, nxt; int ui = 0;
    if (!S.next(0, cur)) return;
    f32x4 acc[2][2][4][2];
#pragma unroll
    for (int a = 0; a < 2; ++a)
#pragma unroll
        for (int b = 0; b < 2; ++b)
#pragma unroll
            for (int m = 0; m < 4; ++m)
#pragma unroll
                for (int n = 0; n < 2; ++n) acc[a][b][m][n] = (f32x4){0.f, 0.f, 0.f, 0.f};
    bf16x8 At[4][2], B0[2][2], B1[2][2];
    const char* cA = cur.A; const char* cB = cur.B;
    if constexpr (SP2) {
        PG8_STAGE(PG8_SB(0, 0), cB, voffB); PG8_STAGE(PG8_SB(0, 1), cB + hstep, voffB); PG8_STAGE(PG8_SA(0, 0), cA, voffA); PG8_STAGE(PG8_SA(0, 1), cA + hstep, voffA);
        if (wr == 1) PG8_BAR;
        PG8_WAIT_V(2); PG8_BAR;
        PG8_STAGE(PG8_SB(1, 0), cB + kstep, voffB); PG8_STAGE(PG8_SA(1, 0), cA + kstep, voffA); PG8_STAGE(PG8_SB(1, 1), cB + hstep + kstep, voffB);
        PG8_WAIT_V(6); PG8_BAR;
    } else {
        PG8_STAGE(PG8_SB(0, 0), cB, voffB); PG8_STAGE(PG8_SA(0, 0), cA, voffA); PG8_STAGE(PG8_SB(0, 1), cB + hstep, voffB); PG8_STAGE(PG8_SA(0, 1), cA + hstep, voffA);
        if (wr == 1) PG8_BAR;
        PG8_WAIT_V(4); PG8_BAR;
        PG8_STAGE(PG8_SB(1, 0), cB + kstep, voffB); PG8_STAGE(PG8_SA(1, 0), cA + kstep, voffA); PG8_STAGE(PG8_SB(1, 1), cB + hstep + kstep, voffB);
        PG8_WAIT_V(6); PG8_BAR;
    }
    for (;;) {
        const bool has_next = S.next(ui + 1, nxt);
        const char* nA = has_next ? nxt.A : cA; const char* nB = has_next ? nxt.B : cB;
        for (int t = 0; t < nt; t += 2) {
            const bool last = (t == nt - 2);
            const char* a1 = cA + (size_t)(t + 1) * kstep;
            const char* a2 = last ? nA : cA + (size_t)(t + 2) * kstep; const char* b2 = last ? nB : cB + (size_t)(t + 2) * kstep;
            const char* a3 = a2 + kstep; const char* b3 = b2 + kstep;
            if constexpr (SP2) {
            PG8_LDB(B0, 0, 0); PG8_LDB(B1, 0, 1); PG8_SCHED; PG8_LDA(At, 0, 0); PG8_STAGE(PG8_SA(1, 1), a1 + hstep, voffA);
            PG8_WAIT_V(8); PG8_WAIT_L(0); PG8_BAR; PG8_MMA(0, 0, At, B0); PG8_MMA(0, 1, At, B1); PG8_BAR; PG8_SCHED;
            PG8_LDA(At, 0, 1); PG8_STAGE(PG8_SB(0, 0), b2, voffB); PG8_STAGE(PG8_SB(0, 1), b2 + hstep, voffB); PG8_STAGE(PG8_SA(0, 0), a2, voffA);
            PG8_WAIT_V(8); PG8_WAIT_L(0); PG8_BAR; PG8_MMA(1, 0, At, B0); PG8_MMA(1, 1, At, B1); PG8_BAR; PG8_SCHED;
            PG8_LDB(B0, 1, 0); PG8_LDB(B1, 1, 1); PG8_SCHED; PG8_LDA(At, 1, 0); PG8_STAGE(PG8_SA(0, 1), a2 + hstep, voffA);
            PG8_WAIT_V(8); PG8_WAIT_L(0); PG8_BAR; PG8_MMA(0, 0, At, B0); PG8_MMA(0, 1, At, B1); PG8_BAR; PG8_SCHED;
            PG8_LDA(At, 1, 1); PG8_STAGE(PG8_SB(1, 0), b3, voffB); PG8_STAGE(PG8_SB(1, 1), b3 + hstep, voffB); PG8_STAGE(PG8_SA(1, 0), a3, voffA);
            PG8_WAIT_V(8); PG8_WAIT_L(0); PG8_BAR; PG8_MMA(1, 0, At, B0); PG8_MMA(1, 1, At, B1); PG8_BAR; PG8_SCHED;
            } else {
            PG8_LDB(B0, 0, 0); PG8_SCHED; PG8_LDA(At, 0, 0); PG8_STAGE(PG8_SA(1, 1), a1 + hstep, voffA);
            PG8_WAIT_L(8); PG8_BAR; PG8_WAIT_L(0); PG8_MMA(0, 0, At, B0); PG8_BAR; PG8_SCHED;
            PG8_LDB(B1, 0, 1); PG8_STAGE(PG8_SB(0, 0), b2, voffB);
            PG8_BAR; PG8_WAIT_L(0); PG8_MMA(0, 1, At, B1); PG8_BAR;
            PG8_LDA(At, 0, 1); PG8_STAGE(PG8_SA(0, 0), a2, voffA);
            PG8_BAR; PG8_WAIT_L(0); PG8_MMA(1, 0, At, B0); PG8_BAR; PG8_SCHED;
            PG8_STAGE(PG8_SB(0, 1), b2 + hstep, voffB);
            PG8_WAIT_V(6); PG8_BAR; PG8_MMA(1, 1, At, B1); PG8_BAR;
            PG8_LDB(B0, 1, 0); PG8_SCHED; PG8_LDA(At, 1, 0); PG8_STAGE(PG8_SA(0, 1), a2 + hstep, voffA);
            PG8_WAIT_L(8); PG8_BAR; PG8_WAIT_L(0); PG8_MMA(0, 0, At, B0); PG8_BAR; PG8_SCHED;
            PG8_LDB(B1, 1, 1); PG8_STAGE(PG8_SB(1, 0), b3, voffB);
            PG8_BAR; PG8_WAIT_L(0); PG8_MMA(0, 1, At, B1); PG8_BAR;
            PG8_LDA(At, 1, 1); PG8_STAGE(PG8_SA(1, 0), a3, voffA);
            PG8_BAR; PG8_WAIT_L(0); PG8_MMA(1, 0, At, B0); PG8_BAR; PG8_SCHED;
            PG8_STAGE(PG8_SB(1, 1), b3 + hstep, voffB);
            PG8_WAIT_V(6); PG8_BAR; PG8_MMA(1, 1, At, B1); PG8_BAR;
            }
        }
        if constexpr (ALIGN_EPI) { if (wr == 0) PG8_BAR; }
        E(acc, cur, wr, wc, fr, fq);
        if (!has_next) break;
#pragma unroll
        for (int a = 0; a < 2; ++a)
#pragma unroll
            for (int b = 0; b < 2; ++b)
#pragma unroll
                for (int m = 0; m < 4; ++m)
#pragma unroll
                    for (int n = 0; n < 2; ++n) acc[a][b][m][n] = (f32x4){0.f, 0.f, 0.f, 0.f};
        cur = nxt; cA = nA; cB = nB; ++ui;
        if constexpr (ALIGN_EPI) { if (wr == 1) PG8_BAR; }
    }
    PG8_WAIT_V(0);
    if constexpr (!ALIGN_EPI) { if (wr == 0) PG8_BAR; }
    PG8_BAR;
#undef PG8_SA
#undef PG8_SB
#undef PG8_STAGE
#undef PG8_LDA
#undef PG8_LDB
#undef PG8_MMA
#undef PG8_WAIT_V
#undef PG8_WAIT_L
#undef PG8_BAR
#undef PG8_SCHED
}
}

__device__ __forceinline__ void transpose_item(const float* W, int N, bf16_t* WT, int K, int wt_row0, int k0, int n0, LAS float* scr, int lane, int rstride = 1) {
#pragma unroll
    for (int i = 0; i < 32; ++i) { const int kk = 2 * i + (lane >> 5); scr[kk * 33 + (lane & 31)] = W[(size_t)(k0 + kk) * N + n0 + (lane & 31)]; }
    asm volatile("s_waitcnt lgkmcnt(0)" ::: "memory");
    const int c = lane & 7;
#pragma unroll
    for (int j = 0; j < 4; ++j) { const int n = (lane >> 3) + 8 * j; const LAS float* sp = scr + (8 * c) * 33 + n;
        uint4 o; o.x = pg8::cvt_pk_bf16(sp[0 * 33], sp[1 * 33]); o.y = pg8::cvt_pk_bf16(sp[2 * 33], sp[3 * 33]); o.z = pg8::cvt_pk_bf16(sp[4 * 33], sp[5 * 33]); o.w = pg8::cvt_pk_bf16(sp[6 * 33], sp[7 * 33]);
        *(uint4*)(WT + (size_t)(wt_row0 + n * rstride) * K + k0 + 8 * c) = o; }
    asm volatile("s_waitcnt lgkmcnt(0)" ::: "memory");
}
constexpr int I_IN = (D / 64) * (INC / 32), I_OUT = (D / 64) * (D / 32), I_EXP = 512, NKC = 16;
__device__ __forceinline__ void ph_prologue(const Ctx& C) {
    const int gt = C.bid * NTHREADS + C.tid, NT = C.G * NTHREADS;
    const int gw = C.bid * NWAVES + C.wave, NGW = C.G * NWAVES, lane = C.lane;
    for (int idx = gt; idx < 128 * 32; idx += NT) {
        const int pos = idx / 32, j = idx % 32;
        const double inv = pow(10000.0, -(double)j / 32.0);
        const double ang = (double)pos * inv;
        C_ROPE[idx] = (float)cos(ang);
        C_ROPE[128 * 32 + idx] = (float)sin(ang);
    }
    {
        LAS float* sl = (LAS float*)C.lds;
        for (int k = C.tid; k < D; k += NTHREADS) { sl[k] = silu_f(C_c[k]); sl[D + k] = silu_f(C_c_ctx[k]); }
        __syncthreads();
        for (int u = gw; u < DEPTH * 48 * NKC; u += NGW) {
            const int l = u / (48 * NKC), rem = u % (48 * NKC), sb = rem / NKC, kc = rem % NKC;
            const float* w = C_w_mod + (size_t)l * D * 6 * D + (size_t)(kc * 128) * 6 * D + sb * 256 + lane * 4;
            float4 a0 = {0.f, 0.f, 0.f, 0.f}, a1 = {0.f, 0.f, 0.f, 0.f};
#pragma unroll 16
            for (int k = 0; k < 128; ++k) {
                const float4 wv = *(const float4*)(w + (size_t)k * 6 * D);
                const float c0 = sl[kc * 128 + k], c1 = sl[D + kc * 128 + k];
                a0.x += c0 * wv.x; a0.y += c0 * wv.y; a0.z += c0 * wv.z; a0.w += c0 * wv.w;
                a1.x += c1 * wv.x; a1.y += c1 * wv.y; a1.z += c1 * wv.z; a1.w += c1 * wv.w;
            }
            *(float4*)(C_MODP + ((size_t)(kc * 2 + l) * 2 + 0) * 6 * D + sb * 256 + lane * 4) = a0;
            *(float4*)(C_MODP + ((size_t)(kc * 2 + l) * 2 + 1) * 6 * D + sb * 256 + lane * 4) = a1;
        }
        __syncthreads();
    }
    LAS float* scr = (LAS float*)(C.lds + C.wave * 16384);
    constexpr int TOT = 2 * I_IN + 2 * I_OUT + 3 * 64 * I_EXP;
    for (int it = gw; it < TOT; it += NGW) {
        int r = it;
        if (r < 2 * I_IN) { const int l = r / I_IN, q = r % I_IN, kb = q / (INC / 32), nb = q % (INC / 32);
            const int n0 = 32 * nb; int row0 = n0, rs = 1;
            if (n0 < OFF_AV) { const int hh = n0 / HD, d0 = n0 % HD; row0 = hh * HD + (d0 < 64 ? 2 * d0 : 2 * (d0 - 64) + 1); rs = 2; }
            transpose_item(C_w_in + (size_t)l * D * INC, INC, C_WIN + (size_t)l * INC * D, D, row0, 64 * kb, n0, scr, lane, rs); continue; }
        r -= 2 * I_IN;
        if (r < 2 * I_OUT) { const int l = r / I_OUT, q = r % I_OUT, kb = q / (D / 32), nb = q % (D / 32);
            transpose_item(C_w_out + (size_t)l * D * D, D, C_WOUT + (size_t)l * D * D, D, 32 * nb, 64 * kb, 32 * nb, scr, lane); continue; }
        r -= 2 * I_OUT;
        if (r < 2 * 64 * I_EXP) { const int up = r / (64 * I_EXP), rr = r % (64 * I_EXP); const int le = rr / I_EXP, q = rr % I_EXP, kb = q / 16, nb = q % 16, f0 = 32 * nb;
            transpose_item((up ? C_w_up : C_w_gate) + (size_t)le * D * FF, FF, C_WGU + (size_t)le * 1024 * D, D, (f0 / 128) * 256 + up * 128 + (f0 % 128), 64 * kb, f0, scr, lane); continue; }
        r -= 2 * 64 * I_EXP;
        { const int le = r / I_EXP, q = r % I_EXP, kb = q / (D / 32), nb = q % (D / 32);
          transpose_item(C_w_down + (size_t)le * FF * D, D, C_WD + (size_t)le * D * FF, FF, 32 * nb, 64 * kb, 32 * nb, scr, lane); }
    }
}

__device__ __forceinline__ void ph_modulate0(const Ctx& C) {
    const int gt = C.bid * NTHREADS + C.tid, NT = C.G * NTHREADS;
    const int gw = C.bid * NWAVES + C.wave, NGW = C.G * NWAVES, lane = C.lane;
    for (int idx = gt; idx < DEPTH * 2 * 6 * D; idx += NT) {
        const int n = idx % (6 * D), l = idx / (2 * 6 * D);
        float a = C_b_mod[l * 6 * D + n];
#pragma unroll
        for (int kc = 0; kc < NKC; ++kc) a += C_MODP[(size_t)kc * (DEPTH * 2 * 6 * D) + idx];
        C_MOD[idx] = a;
    }
    LAS float* ms = (LAS float*)C.lds;
    for (int i = C.tid; i < 2 * 2 * D; i += NTHREADS) {
        const int kind = i / (2 * D), n = i % (2 * D);
        const int idx = (0 * 2 + kind) * 6 * D + n;
        float a = C_b_mod[n];
#pragma unroll
        for (int kc = 0; kc < NKC; ++kc) a += C_MODP[(size_t)kc * (DEPTH * 2 * 6 * D) + idx];
        ms[i] = a;
    }
    __syncthreads();
    for (int r = gw; r < NTOK; r += NGW) {
        const int kind = r < SEQ ? 0 : 1;
        const float* xp = xin_row(C, 0, r);
        const LAS float* sh = ms + kind * 2 * D; const LAS float* sc = sh + D;
#pragma unroll
        for (int j = 0; j < 8; ++j) {
            const int d0 = 4 * lane + 256 * j;
            const float4 xv = *(const float4*)(xp + d0);
            float4 hv; hv.x = xv.x * (1.f + sc[d0]) + sh[d0]; hv.y = xv.y * (1.f + sc[d0 + 1]) + sh[d0 + 1]; hv.z = xv.z * (1.f + sc[d0 + 2]) + sh[d0 + 2]; hv.w = xv.w * (1.f + sc[d0 + 3]) + sh[d0 + 3];
            st4(&C_H[(size_t)r * D + d0], hv);
        }
    }
}

namespace att {
using bf16x8 = __attribute__((ext_vector_type(8))) short;
using s16x4  = __attribute__((ext_vector_type(4))) short;
using f32x16 = __attribute__((ext_vector_type(16))) float;
using u32x4  = __attribute__((ext_vector_type(4))) unsigned;
constexpr int NW = 8, QBLK = 32, KVBLK = 64;
constexpr float SCALE = QSCALE, THR = 8.f;
constexpr int SHM_V = KVBLK * HD * 2, SHM_K = KVBLK * HD * 2;
constexpr int Q_OFF = 2 * SHM_V + 2 * SHM_K  , WS_OFF = 131072 + 1024, BIAS_OFF = WS_OFF + NW * 64 * 4, QSLOT_OFF = BIAS_OFF + (64 + 15 * 32 + 64) * 4, ATT_LDS = QSLOT_OFF + 16;
#define KSWZ(row, colB) ((row) * 256 + ((colB) ^ (((row) & 7) << 4)))
#define SBAR() __builtin_amdgcn_sched_barrier(0)
__device__ __forceinline__ int crow(int r, int hi) { return (r & 3) + 8 * (r >> 2) + 4 * hi; }
__device__ __forceinline__ unsigned cvtpk(float lo, float hi) { unsigned r; asm volatile("v_cvt_pk_bf16_f32 %0, %1, %2" : "=v"(r) : "v"(lo), "v"(hi)); return r; }

__device__ __forceinline__ void partialSM(f32x16& p0, f32x16& p1, float& m_reg, float& mn, float& alpha) {
  constexpr float Cc = SCALE * 1.4426950408889634f;
  float pmax = p0[0]; for (int r = 1; r < 16; ++r) pmax = fmaxf(pmax, p0[r]); for (int r = 0; r < 16; ++r) pmax = fmaxf(pmax, p1[r]);
  { auto rr = __builtin_amdgcn_permlane32_swap(__float_as_uint(pmax), __float_as_uint(pmax), false, false);
    pmax = fmaxf(__uint_as_float(rr[0]), __uint_as_float(rr[1])); }
  if (__builtin_expect(__all(pmax - m_reg <= THR / SCALE), 1)) { mn = m_reg; alpha = 1.f; }
  else { mn = fmaxf(m_reg, pmax); alpha = __builtin_amdgcn_exp2f((m_reg - mn) * Cc); m_reg = mn; }
  float mnC = -mn * Cc;
  for (int r = 0; r < 16; ++r) p0[r] = fmaf(p0[r], Cc, mnC); for (int r = 0; r < 16; ++r) p1[r] = fmaf(p1[r], Cc, mnC);
  for (int r = 0; r < 16; ++r) p0[r] = __builtin_amdgcn_exp2f(p0[r]);
}
__device__ __forceinline__ void finishSM(f32x16& p0, f32x16& p1, float alpha, float& l_reg, bf16x8& pa0, bf16x8& pa1, bf16x8& pa2, bf16x8& pa3) {
  for (int r = 0; r < 16; ++r) p1[r] = __builtin_amdgcn_exp2f(p1[r]);
  float ps = 0; for (int r = 0; r < 16; ++r) ps += p0[r]; for (int r = 0; r < 16; ++r) ps += p1[r];
  { auto rr = __builtin_amdgcn_permlane32_swap(__float_as_uint(ps), __float_as_uint(ps), false, false);
    ps = __uint_as_float(rr[0]) + __uint_as_float(rr[1]); }
  l_reg = l_reg * alpha + ps;
#define PK4(P, BASE, OUT) do { unsigned a0 = cvtpk(P[BASE + 0], P[BASE + 1]), a1 = cvtpk(P[BASE + 2], P[BASE + 3]);   \
    unsigned b0 = cvtpk(P[BASE + 4], P[BASE + 5]), b1 = cvtpk(P[BASE + 6], P[BASE + 7]);                              \
    auto r0 = __builtin_amdgcn_permlane32_swap(a0, b0, false, false); auto r1 = __builtin_amdgcn_permlane32_swap(a1, b1, false, false); \
    u32x4 w = {r0[0], r1[0], r0[1], r1[1]}; OUT = *reinterpret_cast<bf16x8*>(&w); } while (0)
  PK4(p0, 0, pa0); PK4(p0, 8, pa1); PK4(p1, 0, pa2); PK4(p1, 8, pa3);
#undef PK4
}
__device__ __forceinline__ void qkt(f32x16& p0, f32x16& p1, const LAS char* Ks, const LAS char* Qs, int r32, int hi) {
#pragma unroll
  for (int d0 = 0; d0 < 8; ++d0) { int cb = (d0 * 16 + hi * 8) * 2;
    bf16x8 b0 = *reinterpret_cast<const LAS bf16x8*>(Ks + KSWZ(r32, cb));
    bf16x8 b1 = *reinterpret_cast<const LAS bf16x8*>(Ks + KSWZ(32 + r32, cb));
    bf16x8 q = *reinterpret_cast<const LAS bf16x8*>(Qs + KSWZ(r32, cb));
    p0 = __builtin_amdgcn_mfma_f32_32x32x16_bf16(b0, q, p0, 0, 0, 0);
    p1 = __builtin_amdgcn_mfma_f32_32x32x16_bf16(b1, q, p1, 0, 0, 0); }
}
__device__ __forceinline__ int v_st(int k, int c) { const int kk = (k & ~0xC) | ((k & 4) << 1) | ((k & 8) >> 1); return ((kk >> 3) * 4 + (c >> 5)) * 512 + ((kk & 7) * 32 + (c & 31)) * 2; }
__device__ __forceinline__ int v_rd_base(int lane) { return ((lane & 3) << 3) | (((lane >> 2) & 3) << 6) | (((lane >> 4) & 1) << 5) | (((lane >> 5) & 1) << 8); }
constexpr int v_rd_off(int d0, int ks, int half) { return d0 * 512 + ks * 4096 + half * 2048; }
template <int OFF> __device__ __forceinline__ s16x4 tr_read(int vb) {
  s16x4 r; asm volatile("ds_read_b64_tr_b16 %0, %1 offset:%2" : "=&v"(r) : "v"(vb), "i"(OFF) : "memory"); return r;
}
template <int D0> __device__ __forceinline__ void pv_one(f32x16& od, int vb, bf16x8 pa0, bf16x8 pa1, bf16x8 pa2, bf16x8 pa3) {
  const s16x4 l0 = tr_read<v_rd_off(D0, 0, 0)>(vb), h0 = tr_read<v_rd_off(D0, 0, 1)>(vb), l1 = tr_read<v_rd_off(D0, 1, 0)>(vb), h1 = tr_read<v_rd_off(D0, 1, 1)>(vb);
  const s16x4 l2 = tr_read<v_rd_off(D0, 2, 0)>(vb), h2 = tr_read<v_rd_off(D0, 2, 1)>(vb), l3 = tr_read<v_rd_off(D0, 3, 0)>(vb), h3 = tr_read<v_rd_off(D0, 3, 1)>(vb);
  asm volatile("s_waitcnt lgkmcnt(0)" ::: "memory"); SBAR();
#define PK(L, H) (bf16x8){L[0], L[1], L[2], L[3], H[0], H[1], H[2], H[3]}
  od = __builtin_amdgcn_mfma_f32_32x32x16_bf16(pa0, PK(l0, h0), od, 0, 0, 0);
  od = __builtin_amdgcn_mfma_f32_32x32x16_bf16(pa1, PK(l1, h1), od, 0, 0, 0);
  od = __builtin_amdgcn_mfma_f32_32x32x16_bf16(pa2, PK(l2, h2), od, 0, 0, 0);
  od = __builtin_amdgcn_mfma_f32_32x32x16_bf16(pa3, PK(l3, h3), od, 0, 0, 0);
#undef PK
}
__device__ __forceinline__ void pv_d0(f32x16* o, int vb, bf16x8 pa0, bf16x8 pa1, bf16x8 pa2, bf16x8 pa3) {
  pv_one<0>(o[0], vb, pa0, pa1, pa2, pa3); pv_one<1>(o[1], vb, pa0, pa1, pa2, pa3); pv_one<2>(o[2], vb, pa0, pa1, pa2, pa3); pv_one<3>(o[3], vb, pa0, pa1, pa2, pa3);
}

template <int kind>
__device__ __forceinline__ void attn_unit(const bf16_t* __restrict__ P, bf16_t* __restrict__ MIX, const float* __restrict__ rpb_l, const float* __restrict__ sink_l,
                                          const int u, const int h, LAS char* lds, const int tid) {
  const int wid = __builtin_amdgcn_readfirstlane(tid >> 6), lane = tid & 63, r32 = lane & 31, hi = lane >> 5;
  LAS char* V_lds = lds; LAS char* K_lds = lds + 2 * SHM_V;
  LAS float* ws = (LAS float*)(lds + WS_OFF) + wid * 64; LAS float* li_l = ws; LAS float* al_l = ws + 32;
  LAS float* rpbs = (LAS float*)(lds + BIAS_OFF) + 64;
  constexpr bool isA = (kind == 0 || kind == 2), lat = kind < 2;
  const int qrow0 = lat ? 256 * u : SEQ;
  const int qcol = isA ? h * HD : OFF_BQ + h * HD;
  const int kcol = isA ? OFF_AK + (h / 3) * HD : OFF_BK + h * HD;
  const int vcol = isA ? OFF_AV + (h / 3) * HD : OFF_BV + h * HD;
  const int ocol = (isA ? 0 : 768) + h * HD;
  constexpr int NT = (kind == 0) ? 12 : (kind == 1) ? 16 : 4;
  int Rs = 4 * u - 4; Rs = Rs < 0 ? 0 : (Rs > 117 ? 117 : Rs);
  __syncthreads();
  if (kind == 1) for (int i = tid; i < 64 + 15 * 32 + 64; i += 512) { const int t = i - 64; rpbs[t] = (t >= 0 && t < 15 * 32 && (t & 31) < 31) ? rpb_l[h * 465 + (t >> 5) * 31 + (t & 31)] * (1.0f / SCALE) : 0.f; }
  float m_reg = -1e30f, l_reg = 0; f32x16 o[4] = {};
  LAS char* Qs = lds + Q_OFF + wid * 8192;
  { const bf16_t* Qw = P + (size_t)(qrow0 + wid * QBLK + r32) * INC + qcol + hi * 8;
#pragma unroll
    for (int d0 = 0; d0 < 8; ++d0) *reinterpret_cast<LAS bf16x8*>(Qs + KSWZ(r32, (d0 * 16 + hi * 8) * 2)) = *reinterpret_cast<const bf16x8*>(Qw + d0 * 16); }
  const int sr = tid >> 4, sc = (tid & 15) * 8, vst0 = v_st(sr, sc), vst1 = v_st(32 + sr, sc);
  const int vb0 = (int)(size_t)V_lds + v_rd_base(lane);
  const unsigned voffk = (unsigned)(sr * INC + sc + kcol) * 2u, voffk2 = voffk + 32u * INC * 2u, voffv = (unsigned)(sr * INC + sc + vcol) * 2u, voffv2 = voffv + 32u * INC * 2u;
  struct { bf16x8 vs0, vs1, ks0, ks1; } sr_[1];
#define KROW(j) (((j) < 4) ? (SEQ + 64 * (j)) : (kind == 0 ? ({ int t_ = 256 * u - 128 + 64 * ((j) - 4); t_ < 0 ? 0 : (t_ > SEQ - 64 ? SEQ - 64 : t_); }) : ({ int jj_ = (j) - 4; jj_ = jj_ > 10 ? 10 : jj_; (Rs + jj_) * 64; })))
#define SLOAD(i, j) do { const char* kb_ = (const char*)P + (size_t)KROW(j) * (INC * 2);                                             \
    sr_[i].vs0 = *reinterpret_cast<const bf16x8*>(kb_ + voffv); sr_[i].vs1 = *reinterpret_cast<const bf16x8*>(kb_ + voffv2); \
    sr_[i].ks0 = *reinterpret_cast<const bf16x8*>(kb_ + voffk); sr_[i].ks1 = *reinterpret_cast<const bf16x8*>(kb_ + voffk2); } while (0)
#define SWRITE(b, i) do { *(LAS bf16x8*)(V_lds + (b) * SHM_V + vst0) = sr_[i].vs0;          \
    *(LAS bf16x8*)(V_lds + (b) * SHM_V + vst1) = sr_[i].vs1; int kc_ = sc * 2;               \
    *(LAS bf16x8*)(K_lds + (b) * SHM_K + KSWZ(sr, kc_)) = sr_[i].ks0;                       \
    *(LAS bf16x8*)(K_lds + (b) * SHM_K + KSWZ(32 + sr, kc_)) = sr_[i].ks1; } while (0)
#define SWAIT() asm volatile("s_waitcnt vmcnt(0)" ::: "memory")
#define RESC(a) do { if (__any((a) < 1.f)) { if (hi == 0) al_l[r32] = (a); asm volatile("s_waitcnt lgkmcnt(0)" ::: "memory"); \
    for (int d = 0; d < 4; ++d) for (int r = 0; r < 16; ++r) o[d][r] *= al_l[crow(r, hi)]; } } while (0)
#define MASK(p0, p1, j) do { const int j_ = (j);                                                                                          \
    if (lat && j_ >= 4) {                                                                                                                 \
      if (kind == 0) {                                                                                                                    \
        const int t0_ = 256 * u - 128 + 64 * (j_ - 4), qw_ = 256 * u + 32 * wid;                                                          \
        const float tp_ = (t0_ < 0 || t0_ >= SEQ) ? -1e30f : 0.f;                                     \
        const float dl_ = (float)(t0_ - (qw_ + r32) + 4 * hi);                                                                            \
        _Pragma("unroll") for (int r = 0; r < 16; ++r) { const float k0_ = dl_ + (float)((r & 3) + 8 * (r >> 2)), k1_ = k0_ + 32.f;       \
          p0[r] = fmaf(fminf(0.f, 128.5f - fabsf(k0_)), 1e30f, tp_); p1[r] = fmaf(fminf(0.f, 128.5f - fabsf(k1_)), 1e30f, tp_); }         \
      } else {                                                                                                                            \
        const int kr_ = Rs + (j_ - 4), qrw_ = 4 * u + (wid >> 1); int r0_ = qrw_ - 4; r0_ = r0_ < 0 ? 0 : (r0_ > 120 ? 120 : r0_);        \
        const float tp_ = (j_ >= 15 || kr_ < r0_ || kr_ >= r0_ + 8) ? -1e30f : 0.f;           \
        int dr_ = kr_ - qrw_ + 7; dr_ = dr_ < 0 ? 0 : (dr_ > 14 ? 14 : dr_);                                                              \
        const int qc_ = (wid & 1) * 32 + r32; int c0_ = qc_ - 8; c0_ = c0_ < 0 ? 0 : (c0_ > 48 ? 48 : c0_);                               \
        const LAS float* br_ = rpbs + dr_ * 32 + (15 - qc_ + 4 * hi);                                                                     \
        const float xb_ = (float)(4 * hi - c0_) - 7.5f;                                                                                   \
        _Pragma("unroll") for (int r = 0; r < 16; ++r) { const int kk_ = (r & 3) + 8 * (r >> 2); const float x0_ = xb_ + (float)kk_, x1_ = x0_ + 32.f;   \
          p0[r] = fmaf(fminf(0.f, 7.75f - fabsf(x0_)), 1e30f, br_[kk_] + tp_); p1[r] = fmaf(fminf(0.f, 7.75f - fabsf(x1_)), 1e30f, br_[kk_ + 32] + tp_); } \
      } }                                                                                                                                 \
    else { _Pragma("unroll") for (int r = 0; r < 16; ++r) { p0[r] = 0.f; p1[r] = 0.f; } } } while (0)
  f32x16 pA0, pA1; float mnA, alA; bf16x8 pa0, pa1, pa2, pa3;
  SLOAD(0, 0); asm volatile("s_waitcnt vmcnt(0)" ::: "memory"); SWRITE(0, 0); __syncthreads();
  int jlo = 4, jhi = NT - 1;
  if (kind == 0) { const int qw_ = 32 * wid;
    jlo = 4 + (qw_ + 0) / 64; jhi = 4 + (qw_ + 31 + 256) / 64;
    const int first_ok = (256 * u - 128 < 0) ? 4 + 2 : 4, last_ok = (256 * u + 384 > SEQ) ? 4 + 5 : 4 + 7;
    jlo = jlo < first_ok ? first_ok : jlo; jhi = jhi > last_ok ? last_ok : jhi; }
  if (kind == 1) { const int qrw_ = 4 * u + (wid >> 1); int r0_ = qrw_ - 4; r0_ = r0_ < 0 ? 0 : (r0_ > 120 ? 120 : r0_); jlo = 4 + (r0_ - Rs); jhi = jlo + 7; }
#define TILE_BODY(COMPUTE) do { const int b = j & 1;                                                                    \
    if (j + 1 < NT) SLOAD(0, j + 1);                                                                                    \
    if (COMPUTE) {                                                                                                      \
      MASK(pA0, pA1, j);                                                                                                \
      SBAR(); qkt(pA0, pA1, K_lds + b * SHM_K, Qs, r32, hi);                                                            \
      partialSM(pA0, pA1, m_reg, mnA, alA);                                                                             \
      RESC(alA);                                                                                                        \
      finishSM(pA0, pA1, alA, l_reg, pa0, pa1, pa2, pa3); SBAR();                                                       \
      pv_d0(o, vb0 + b * SHM_V, pa0, pa1, pa2, pa3); }                                                                  \
    if (j + 1 < NT) { SWAIT(); SWRITE(b ^ 1, 0); }                                                                      \
    __syncthreads(); } while (0)
  int j = 0;
  for (; j < 4; ++j) TILE_BODY(true);
  if (lat) {
    for (; j < jlo; ++j) TILE_BODY(false);
    for (; j <= jhi; ++j) TILE_BODY(true);
    for (; j < NT; ++j) TILE_BODY(false);
  }
#undef TILE_BODY
  if (isA) l_reg += __builtin_amdgcn_exp2f(sink_l[h] * 1.4426950408889634f - m_reg * (SCALE * 1.4426950408889634f));
  if (hi == 0) li_l[r32] = l_reg; asm volatile("s_waitcnt lgkmcnt(0)" ::: "memory");
  float rli[16];
#pragma unroll
  for (int r = 0; r < 16; ++r) rli[r] = __builtin_amdgcn_rcpf(li_l[crow(r, hi)]);
  __syncthreads();
  LAS char* ost = lds + wid * 8192;
#pragma unroll
  for (int r = 0; r < 16; ++r) { const int orow = crow(r, hi);
#pragma unroll
    for (int d0 = 0; d0 < 4; ++d0) *(LAS bf16_t*)(ost + orow * 256 + (d0 * 32 + r32) * 2) = f2bf(o[d0][r] * rli[r]); }
  asm volatile("s_waitcnt lgkmcnt(0)" ::: "memory");
  bf16_t* Ow = MIX + (size_t)(qrow0 + wid * QBLK) * D + ocol;
#pragma unroll
  for (int i = 0; i < 8; ++i) { const int c = lane + 64 * i, row = c >> 4, c16 = c & 15;
    const u32x4 v = *(const LAS u32x4*)(ost + c * 16);
    *reinterpret_cast<u32x4*>(Ow + (size_t)row * D + c16 * 8) = v; }
#undef KROW
#undef SLOAD
#undef SWRITE
#undef SWAIT
#undef RESC
#undef MASK
}
#undef KSWZ
#undef SBAR
}

__device__ __forceinline__ void sgu_item(const Ctx& C, int l, int ch, int g) {
    typedef short bf16x8v __attribute__((ext_vector_type(8)));
    typedef float f32x4v __attribute__((ext_vector_type(4)));
    constexpr int PITCH = 272;
    LAS char* vnT = (LAS char*)C.lds;
    const int lane = C.lane, wave = C.wave;
    const int row0 = ch * 128;
    __syncthreads();
    {
        const float g0 = C_sgu_g[l * CW + g * 128 + lane], g1 = C_sgu_g[l * CW + g * 128 + 64 + lane];
        const float b0 = C_sgu_bn[l * CW + g * 128 + lane], b1 = C_sgu_bn[l * CW + g * 128 + 64 + lane];
        for (int q = wave; q < 128; q += NWAVES) {
            const AT* vp = C_P + (size_t)(row0 + q) * INC + OFF_C + CW + g * 128;
            const float a = gelu_tanh_f(ldv(vp + lane)), b = gelu_tanh_f(ldv(vp + 64 + lane));
            const float mu = wave_sum(a + b) * (1.f / 128.f);
            const float da = a - mu, db = b - mu;
            const float var = wave_sum(da * da + db * db) * (1.f / 128.f);
            const float rstd = 1.0f / sqrtf(var + LN_EPS);
            *(LAS bf16_t*)(vnT + lane * PITCH + q * 2) = f2bf(da * rstd * g0 + b0);
            *(LAS bf16_t*)(vnT + (64 + lane) * PITCH + q * 2) = f2bf(db * rstd * g1 + b1);
        }
    }
    __syncthreads();
    const int m16 = lane & 15, kg = lane >> 4;
    bf16x8v af[4];
    { const float* wp = C_sgu_w + ((size_t)(l * 4 + g) * 128 + 16 * wave + m16) * 128 + 8 * kg;
#pragma unroll
      for (int ks = 0; ks < 4; ++ks) { const float4 w0 = *(const float4*)(wp + 32 * ks), w1 = *(const float4*)(wp + 32 * ks + 4);
          uint4 pk; pk.x = pg8::cvt_pk_bf16(w0.x, w0.y); pk.y = pg8::cvt_pk_bf16(w0.z, w0.w); pk.z = pg8::cvt_pk_bf16(w1.x, w1.y); pk.w = pg8::cvt_pk_bf16(w1.z, w1.w);
          af[ks] = *reinterpret_cast<bf16x8v*>(&pk); } }
    f32x4v acc[8];
#pragma unroll
    for (int nt = 0; nt < 8; ++nt) acc[nt] = (f32x4v){0.f, 0.f, 0.f, 0.f};
#pragma unroll
    for (int nt = 0; nt < 8; ++nt)
#pragma unroll
        for (int ks = 0; ks < 4; ++ks) {
            const bf16x8v bfr = *(const LAS bf16x8v*)(vnT + (nt * 16 + m16) * PITCH + (32 * ks + 8 * kg) * 2);
            acc[nt] = __builtin_amdgcn_mfma_f32_16x16x32_bf16(af[ks], bfr, acc[nt], 0, 0, 0);
        }
#pragma unroll
    for (int reg = 0; reg < 4; ++reg) {
        const int p = 16 * wave + 4 * kg + reg;
        const float bs = C_sgu_b[(l * 4 + g) * 128 + p];
        const AT* up = C_P + (size_t)(row0 + p) * INC + OFF_C + g * 128 + m16;
        AT* op = C_MIX + (size_t)(row0 + p) * D + 1536 + g * 128 + m16;
#pragma unroll
        for (int nt = 0; nt < 8; ++nt) stv(op + 16 * nt, gelu_tanh_f(ldv(up + 16 * nt)) * (acc[nt][reg] + bs));
    }
}

constexpr int CW_Q = 16384 + 256;
__device__ __forceinline__ void ph_mixers(const Ctx& C, int l) {
    const bool last = (l == DEPTH - 1);
    const int nB = 192, nA = 192, nC = last ? 0 : 12, nS = (last ? 64 : 66) * 4;
    const int total = nB + nA + nC + nS;
    LAS int* qs = (LAS int*)(C.lds + att::QSLOT_OFF);
    unsigned* ctr = C_CTLW + CW_Q + l;
    for (;;) {
        __syncthreads();
        if (C.tid == 0) *qs = (int)atomicAdd(ctr, 1u);
        __syncthreads();
        int r = *qs;
        if (r >= total) break;
        int kind = -1, u = 0, h = 0;
        if (r < nB) { kind = 1; u = r / 6; h = r % 6; }
        else { r -= nB;
            if (r < nA) { kind = 0; u = r / 6; h = r % 6; }
            else { r -= nA; if (r < nC) { kind = 2 + r / 6; u = 0; h = r % 6; } else r -= nC; } }
        int t_ = threadIdx.x; asm volatile("" : "+v"(t_));
        if (kind == 1) att::attn_unit<1>(C_P, C_MIX, C_rpb + l * 6 * 465, C_sink + l * 6, u, h, (LAS char*)C.lds, t_);
        else if (kind == 0) att::attn_unit<0>(C_P, C_MIX, C_rpb + l * 6 * 465, C_sink + l * 6, u, h, (LAS char*)C.lds, t_);
        else if (kind == 2) att::attn_unit<2>(C_P, C_MIX, C_rpb + l * 6 * 465, C_sink + l * 6, u, h, (LAS char*)C.lds, t_);
        else if (kind == 3) att::attn_unit<3>(C_P, C_MIX, C_rpb + l * 6 * 465, C_sink + l * 6, u, h, (LAS char*)C.lds, t_);
        else { Ctx C2 = C; C2.tid = t_; C2.lane = t_ & 63; C2.wave = __builtin_amdgcn_readfirstlane(t_ >> 6); sgu_item(C2, l, r / 4, r % 4); }
    }
}

constexpr int WS_POS_OFF = 3 * 1024 * 1024 + 768 * 1024;
#define C_POS ((int*)(C.ws + C.z + WS_POS_OFF))
__device__ __forceinline__ void ph_ln1(const Ctx& C, int l) {
    const bool last = (l == DEPTH - 1);
    const int nrows = last ? SEQ : NTOK;
    const int RPB = __builtin_amdgcn_readfirstlane((nrows + C.G - 1) / C.G);
    const int row_lo = __builtin_amdgcn_readfirstlane(C.bid * RPB), row_hi = __builtin_amdgcn_readfirstlane((row_lo + RPB < nrows) ? row_lo + RPB : nrows);
    const int lane = C.lane, wave = C.wave, tid = C.tid;
    LAS float* wch = (LAS float*)(C.lds + 65536);
    constexpr int WCH = 256 * 36 + 4 * 256;
    LAS int* hist = (LAS int*)(C.lds + 65536 + 2 * WCH * 4);
    LAS int* rinfo = hist + 64;
    LAS int* rrank = rinfo + 256;
    LAS float* hrow = (LAS float*)C.lds + wave * D;
    const float* gam = C_ln1_g + l * D; const float* bet = C_ln1_b + l * D;
    if (tid < 32) hist[tid] = 0;
#define LDCH(j_) do { _Pragma("unroll") for (int t = 0; t < 4; ++t) { const int t4 = tid + 512 * t; pre[t] = *(const pg8::f32x4*)(C_w_router + (size_t)(256 * (j_)) * NE + t4 * 4); } \
        if (tid < 256) { const float* vs_ = (tid < 64) ? gam : (tid < 128) ? bet : (tid < 192) ? modp(C, l, 0, 4) : modp(C, l, 0, 3);     \
            pre[4] = *(const pg8::f32x4*)(vs_ + 256 * (j_) + (tid & 63) * 4); } } while (0)
#define STCH(buf_) do { _Pragma("unroll") for (int t = 0; t < 4; ++t) { const int t4 = tid + 512 * t, dl = t4 >> 3, e4 = t4 & 7; *(LAS pg8::f32x4*)(wch + (buf_) * WCH + ((dl & 3) * 64 + (dl >> 2)) * 36 + e4 * 4) = pre[t]; } \
        if (tid < 256) *(LAS pg8::f32x4*)(wch + (buf_) * WCH + 256 * 36 + tid * 4) = pre[4]; } while (0)
    pg8::f32x4 pre[5];
    int step = 0;
    LDCH(0); STCH(0); __syncthreads();
    for (int rnd = 0; row_lo + rnd * NWAVES < row_hi; ++rnd) {
        const int r = row_lo + rnd * NWAVES + wave;
        const bool valid = r < row_hi;
        const int kind = r < SEQ ? 0 : 1;
        float v[32]; float mu = 0.f, rstd = 0.f;
        if (valid) {
            const float* tp = C_T + (size_t)r * D; float sm = 0.f;
#pragma unroll
            for (int j = 0; j < 8; ++j) { const float4 t4 = *(const float4*)(tp + 4 * lane + 256 * j); v[4 * j] = t4.x; v[4 * j + 1] = t4.y; v[4 * j + 2] = t4.z; v[4 * j + 3] = t4.w; sm += (t4.x + t4.y) + (t4.z + t4.w); }
            mu = wave_sum(sm) * (1.f / D);
            float q = 0.f;
#pragma unroll
            for (int k = 0; k < 32; ++k) { v[k] -= mu; q += v[k] * v[k]; }
            rstd = 1.0f / sqrtf(wave_sum(q) * (1.f / D) + LN_EPS);
#pragma unroll
            for (int j = 0; j < 8; ++j) *(LAS pg8::f32x4*)(hrow + 4 * lane + 256 * j) = (pg8::f32x4){v[4 * j], v[4 * j + 1], v[4 * j + 2], v[4 * j + 3]};
        }
        const float* sc2 = modp(C, l, kind, 4); const float* sh2 = modp(C, l, kind, 3);
        float acc[32];
#pragma unroll
        for (int e = 0; e < 32; ++e) acc[e] = 0.f;
#pragma unroll 1
        for (int j = 0; j < 8; ++j) {
            const bool more = (j < 7) || (row_lo + (rnd + 1) * NWAVES < row_hi);
            if (more) LDCH((j + 1) & 7);
            const LAS float* wcur = wch + (step & 1) * WCH;
            float h2c[4];
            if (valid) {
                const int d0 = 4 * lane + 256 * j;
                const LAS float* vec = wcur + 256 * 36 + 4 * lane;
                const pg8::f32x4 g4 = *(const LAS pg8::f32x4*)(vec), b4 = *(const LAS pg8::f32x4*)(vec + 256);
                pg8::f32x4 sc4 = *(const LAS pg8::f32x4*)(vec + 512), sh4 = *(const LAS pg8::f32x4*)(vec + 768);
                if (kind) { sc4 = *(const pg8::f32x4*)(sc2 + d0); sh4 = *(const pg8::f32x4*)(sh2 + d0); }
                const pg8::f32x4 vc = *(const LAS pg8::f32x4*)(hrow + d0);
                float4 x1, h2;
                x1.x = vc[0] * rstd * g4[0] + b4[0]; x1.y = vc[1] * rstd * g4[1] + b4[1]; x1.z = vc[2] * rstd * g4[2] + b4[2]; x1.w = vc[3] * rstd * g4[3] + b4[3];
                h2.x = x1.x * (1.f + sc4[0]) + sh4[0]; h2.y = x1.y * (1.f + sc4[1]) + sh4[1]; h2.z = x1.z * (1.f + sc4[2]) + sh4[2]; h2.w = x1.w * (1.f + sc4[3]) + sh4[3];
                *(float4*)(C_X1 + (size_t)r * D + d0) = x1;
                st4(&C_H2[(size_t)r * D + d0], h2);
                h2c[0] = h2.x; h2c[1] = h2.y; h2c[2] = h2.z; h2c[3] = h2.w;
            } else { h2c[0] = 0.f; h2c[1] = 0.f; h2c[2] = 0.f; h2c[3] = 0.f; }
#pragma unroll
            for (int c = 0; c < 4; ++c) {
                float wv[32];
#pragma unroll
                for (int e4 = 0; e4 < 8; ++e4) { const pg8::f32x4 w4 = *(const LAS pg8::f32x4*)(wcur + (c * 64 + lane) * 36 + e4 * 4); wv[4 * e4] = w4[0]; wv[4 * e4 + 1] = w4[1]; wv[4 * e4 + 2] = w4[2]; wv[4 * e4 + 3] = w4[3]; }
#pragma unroll
                for (int e = 0; e < 32; ++e) acc[e] += h2c[c] * wv[e];
                __builtin_amdgcn_sched_barrier(0);
            }
            if (more) STCH((step + 1) & 1);
            ++step;
            __syncthreads();
        }
#pragma unroll
        for (int k = 0; k < 5; ++k) { const int half = 16 >> k; const bool up = (lane >> k) & 1;
#pragma unroll
            for (int t = 0; t < half; ++t) { const float keep = up ? acc[t + half] : acc[t]; const float send = up ? acc[t] : acc[t + half];
                acc[t] = keep + __shfl_xor(send, 1 << k); } }
        const float mine = acc[0] + __shfl_xor(acc[0], 32);
        float lg[32];
#pragma unroll
        for (int e = 0; e < 32; ++e) { const int src = ((e & 1) << 4) | ((e & 2) << 2) | (e & 4) | ((e & 8) >> 2) | ((e & 16) >> 4);
            lg[e] = __int_as_float(__builtin_amdgcn_readlane(__float_as_int(mine), src)); }
        if (valid && lane == 0) {
            float bestgs = -3.0e38f; int be0 = 0, be1 = 0; float bw0 = 0.f, bw1 = 0.f;
#pragma unroll
            for (int gq2 = 0; gq2 < 4; ++gq2) {
                float m1 = -3.0e38f, m2 = -3.0e38f, s1 = 0.f, s2 = 0.f; int i1 = 0, i2 = 0;
#pragma unroll
                for (int t = 0; t < 8; ++t) {
                    const int e = gq2 * 8 + t;
                    const float scv = 1.f / (1.f + expf(-lg[e])), bv = scv + C_router_bias[e];
                    if (bv > m1) { m2 = m1; i2 = i1; s2 = s1; m1 = bv; i1 = e; s1 = scv; }
                    else if (bv > m2) { m2 = bv; i2 = e; s2 = scv; }
                }
                const float gs = m1 + m2;
                if (gs > bestgs) { bestgs = gs; be0 = i1; be1 = i2; bw0 = s1; bw1 = s2; }
            }
            const float inv = 1.f / (bw0 + bw1);
            LAS int* ri = rinfo + (r - row_lo) * 4;
            ri[0] = be0; ri[1] = be1; ri[2] = __float_as_int(bw0 * inv); ri[3] = __float_as_int(bw1 * inv);
        }
    }
#undef LDCH
#undef STCH
    const int nb = row_hi - row_lo;
    __syncthreads();
    int e_mine = 0;
    if (tid < 2 * nb) { e_mine = rinfo[(tid >> 1) * 4 + (tid & 1)]; rrank[tid] = (int)__hip_atomic_fetch_add((LAS unsigned*)(hist + e_mine), 1u, __ATOMIC_RELAXED, __HIP_MEMORY_SCOPE_WORKGROUP); }
    __syncthreads();
    if (tid < 32) { const int cnt = hist[tid]; hist[32 + tid] = cnt ? (int)atomicAdd(C_CTLW + CW_CNT + l * 32 + tid, (unsigned)cnt) : 0; }
    __syncthreads();
    if (tid < 2 * nb) {
        const int r = row_lo + (tid >> 1), k = tid & 1;
        C_POS[(size_t)r * 2 + k] = hist[32 + e_mine] + rrank[tid];
        int* rp = C_ROUTE + (size_t)r * 4;
        rp[k] = e_mine; rp[2 + k] = rinfo[(tid >> 1) * 4 + 2 + k];
    }
}

constexpr int TOFF_OFF = 131072;
__device__ __forceinline__ void compute_toff(const Ctx& C, int l) {
    LAS int* toff = (LAS int*)(C.lds + TOFF_OFF);
    __syncthreads();
    if (C.tid == 0) { int acc = 0;
        for (int e = 0; e < NE; ++e) { toff[e] = acc; acc += ((int)__hip_atomic_load(C_CTLW + CW_CNT + l * 32 + e, __ATOMIC_RELAXED, __HIP_MEMORY_SCOPE_AGENT) + 255) >> 8; }
        toff[NE] = acc; }
    __syncthreads();
}
__device__ __forceinline__ void ph_dispatch(const Ctx& C, int l) {
    const bool last = (l == DEPTH - 1);
    const int nrows = last ? SEQ : NTOK;
    const int gw = C.bid * NWAVES + C.wave, NGW = C.G * NWAVES, lane = C.lane;
    compute_toff(C, l);
    const LAS int* toff = (const LAS int*)(C.lds + TOFF_OFF);
    for (int it = gw; it < nrows * 2; it += NGW) {
        const int r = it >> 1, k = it & 1;
        const int e = C_ROUTE[(size_t)r * 4 + k];
        const int slot = toff[e] * 256 + C_POS[it];
        if (lane == 0) { C_SLOT[it] = slot; C_SW[slot] = __int_as_float(C_ROUTE[(size_t)r * 4 + 2 + k]); }
        const uint4* src = (const uint4*)(C_H2 + (size_t)r * D); uint4* dst = (uint4*)(C_HS + (size_t)slot * D);
#pragma unroll
        for (int j = 0; j < 4; ++j) dst[lane + 64 * j] = src[lane + 64 * j];
    }
}

__device__ __forceinline__ void ph_ln2(const Ctx& C, int l) {
    const bool last = (l == DEPTH - 1);
    const int nrows = last ? SEQ : NTOK;
    const int gw = C.bid * NWAVES + C.wave, NGW = C.G * NWAVES, lane = C.lane;
    LAS float* vec0 = (LAS float*)C.lds;
    {
        const int ln = last ? l : l + 1;
#pragma unroll
        for (int k = 0; k < 2; ++k) {
            *(LAS pg8::f32x4*)(vec0 + (k * 5 + 0) * D + 4 * C.tid) = *(const pg8::f32x4*)(modp(C, l, k, 5) + 4 * C.tid);
            *(LAS pg8::f32x4*)(vec0 + (k * 5 + 1) * D + 4 * C.tid) = *(const pg8::f32x4*)(C_ln2_g + l * D + 4 * C.tid);
            *(LAS pg8::f32x4*)(vec0 + (k * 5 + 2) * D + 4 * C.tid) = *(const pg8::f32x4*)(C_ln2_b + l * D + 4 * C.tid);
            *(LAS pg8::f32x4*)(vec0 + (k * 5 + 3) * D + 4 * C.tid) = *(const pg8::f32x4*)(modp(C, ln, k, 1) + 4 * C.tid);
            *(LAS pg8::f32x4*)(vec0 + (k * 5 + 4) * D + 4 * C.tid) = *(const pg8::f32x4*)(modp(C, ln, k, 0) + 4 * C.tid);
        }
        __syncthreads();
    }
    for (int r = gw; r < nrows; r += NGW) {
        const LAS float* vec = vec0 + (r < SEQ ? 0 : 5 * D);
        const int s0 = C_SLOT[2 * r], s1 = C_SLOT[2 * r + 1];
        float4 xv[8]; uint2 ya[8], yb[8];
#pragma unroll
        for (int j = 0; j < 8; ++j) { const int d0 = 4 * lane + 256 * j;
            xv[j] = *(const float4*)(C_X1 + (size_t)r * D + d0); ya[j] = *(const uint2*)(C_Y + (size_t)s0 * D + d0); yb[j] = *(const uint2*)(C_Y + (size_t)s1 * D + d0); }
        float v[32]; float s = 0.f;
#pragma unroll
        for (int j = 0; j < 8; ++j) { const int d0 = 4 * lane + 256 * j;
            const pg8::f32x4 g4 = *(const LAS pg8::f32x4*)(vec + d0);
            const float y0 = __uint_as_float(ya[j].x << 16) + __uint_as_float(yb[j].x << 16), y1 = __uint_as_float(ya[j].x & 0xffff0000u) + __uint_as_float(yb[j].x & 0xffff0000u);
            const float y2 = __uint_as_float(ya[j].y << 16) + __uint_as_float(yb[j].y << 16), y3 = __uint_as_float(ya[j].y & 0xffff0000u) + __uint_as_float(yb[j].y & 0xffff0000u);
            v[4 * j + 0] = ALPHA * xv[j].x + g4[0] * y0; v[4 * j + 1] = ALPHA * xv[j].y + g4[1] * y1; v[4 * j + 2] = ALPHA * xv[j].z + g4[2] * y2; v[4 * j + 3] = ALPHA * xv[j].w + g4[3] * y3;
            s += (v[4 * j] + v[4 * j + 1]) + (v[4 * j + 2] + v[4 * j + 3]); }
        const float mu = wave_sum(s) * (1.f / D);
        float q = 0.f;
#pragma unroll
        for (int i = 0; i < 32; ++i) { v[i] -= mu; q += v[i] * v[i]; }
        const float rstd = 1.0f / sqrtf(wave_sum(q) * (1.f / D) + LN_EPS);
#pragma unroll
        for (int j = 0; j < 8; ++j) { const int d0 = 4 * lane + 256 * j;
            const pg8::f32x4 g4 = *(const LAS pg8::f32x4*)(vec + D + d0), b4 = *(const LAS pg8::f32x4*)(vec + 2 * D + d0);
            float4 xo;
            xo.x = v[4 * j + 0] * rstd * g4[0] + b4[0]; xo.y = v[4 * j + 1] * rstd * g4[1] + b4[1]; xo.z = v[4 * j + 2] * rstd * g4[2] + b4[2]; xo.w = v[4 * j + 3] * rstd * g4[3] + b4[3];
            if (last) *(float4*)(C.out + C.z + (size_t)r * D + d0) = xo;
            else {
                *(float4*)(C_XB + (size_t)r * D + d0) = xo;
                const pg8::f32x4 sc4 = *(const LAS pg8::f32x4*)(vec + 3 * D + d0), sh4 = *(const LAS pg8::f32x4*)(vec + 4 * D + d0);
                float4 hn; hn.x = xo.x * (1.f + sc4[0]) + sh4[0]; hn.y = xo.y * (1.f + sc4[1]) + sh4[1]; hn.z = xo.z * (1.f + sc4[2]) + sh4[2]; hn.w = xo.w * (1.f + sc4[3]) + sh4[3];
                st4(&C_H[(size_t)r * D + d0], hn);
            }
        }
    }
}

__device__ __forceinline__ Ctx fresh(const Ctx& C0) { Ctx C = C0; size_t z = 0; int t = threadIdx.x; int g_ = gridDim.x, b_ = blockIdx.x; asm volatile("" : "+s"(z), "+v"(t), "+s"(g_), "+s"(b_)); C.G = g_; C.bid = b_; C.z = z; C.tid = t; C.lane = t & 63; C.wave = __builtin_amdgcn_readfirstlane(t >> 6); return C; }
constexpr int PH_PER_LAYER = 8;
constexpr int N_PHASES = 2 + PH_PER_LAYER * DEPTH;
__global__ void __launch_bounds__(NTHREADS, 2) fwd_kernel(Args args) {
    extern __shared__ __attribute__((aligned(16))) unsigned char lds_raw[];
    Ctx C0;
    C0.lds = (LAS unsigned char*)lds_raw;
    C0.tid = threadIdx.x; C0.lane = C0.tid & 63; C0.wave = __builtin_amdgcn_readfirstlane(C0.tid >> 6); C0.G = gridDim.x; C0.bid = blockIdx.x;
    C0.in = args.in; C0.out = args.out; C0.ws = args.ws; C0.z = 0;
    unsigned char* ws = args.ws;

    volatile LAS unsigned* bst = (volatile LAS unsigned*)(C0.lds + LDS_BYTES - 16);
    if (C0.tid < 4) bst[C0.tid] = 0u;
    __syncthreads();
    const int lo = args.ph_lo, hi = args.ph_hi;
    XcdBarrier bar; bar.bar = (unsigned*)(ws + WS_CTL) + CW_BAR; bar.x = 0; bar.st = bst;
    if (hi - lo > 1) bar = xcd_barrier_post((unsigned*)(ws + WS_CTL) + CW_BAR, bst);
#define IN(k) (lo <= (k) && (k) < hi)
#define SEAM(k) do { if (IN(k) && IN((k) + 1)) xcd_barrier(bar); } while (0)

    if (IN(0)) { const Ctx C = fresh(C0); ph_prologue(C); } SEAM(0);
    if (IN(1)) { const Ctx C = fresh(C0); ph_modulate0(C); } SEAM(1);
#pragma unroll 1
    for (int l = 0; l < DEPTH; ++l) {
        const int pb = 2 + PH_PER_LAYER * l;
        const bool last = (l == DEPTH - 1);
        if (IN(pb + 0)) {
            const Ctx C = fresh(C0);
            pg8::DenseSched<INC / 256, D> S{NTOK / 256, C.G, C.bid, (const char*)C_H, (const char*)(C_WIN + (size_t)l * INC * D)};
            pg8::EpiP E{C_P, C_ROPE};
            pg8::gemm_phase<D>(C.lds, S, E);
        }
        SEAM(pb + 0);
        if (IN(pb + 1)) { const Ctx C = fresh(C0); ph_mixers(C, l); } SEAM(pb + 1);
        if (IN(pb + 2)) {
            const Ctx C = fresh(C0);
            pg8::DenseSched<D / 256, D> S{(last ? SEQ : NTOK) / 256, C.G, C.bid, (const char*)C_MIX, (const char*)(C_WOUT + (size_t)l * D * D)};
            pg8::EpiTres E{C_T, l == 0 ? C_x : C_XB, l == 0 ? C_ctx : C_XB + (size_t)SEQ * D, modp(C, l, 0, 2), modp(C, l, 1, 2)};
            pg8::gemm_phase<D>(C.lds, S, E);
        }
        SEAM(pb + 2);
        if (IN(pb + 3)) { const Ctx C = fresh(C0); ph_ln1(C, l); } SEAM(pb + 3);
        if (IN(pb + 4)) { const Ctx C = fresh(C0); ph_dispatch(C, l); } SEAM(pb + 4);
        if (IN(pb + 5)) {
            const Ctx C = fresh(C0);
            compute_toff(C, l);
            pg8::MoeSched<4, D, 1024> S{(const LAS int*)(C.lds + TOFF_OFF), C.G, C.bid, (const char*)C_HS, (const char*)(C_WGU + (size_t)l * NE * 1024 * D)};
            pg8::EpiMoe1 E{C_HID, C_SW};
            pg8::gemm_phase<D>(C.lds, S, E);
        }
        SEAM(pb + 5);
        if (IN(pb + 6)) {
            const Ctx C = fresh(C0);
            compute_toff(C, l);
            pg8::MoeSched<8, FF, D> S{(const LAS int*)(C.lds + TOFF_OFF), C.G, C.bid, (const char*)C_HID, (const char*)(C_WD + (size_t)l * NE * D * FF)};
            pg8::EpiBf16 E{C_Y, D};
            pg8::gemm_phase<FF>(C.lds, S, E);
        }
        SEAM(pb + 6);
        if (IN(pb + 7)) { const Ctx C = fresh(C0); ph_ln2(C, l); }
        if (!last) SEAM(pb + 7);
    }
#undef IN
#undef SEAM
}

#ifndef MK_N_LAUNCHES
#define MK_N_LAUNCHES 1
#endif
extern "C" void kernel_launch(void* const* d_in, const int* in_sizes, int n_in, void* d_out, int out_size, void* d_ws, size_t ws_size, hipStream_t stream) {
    static int grid = 0;
    if (grid == 0) {
        if (n_in != 23 || out_size != SEQ * D || ws_size < WS_END) {
            fprintf(stderr, "kernel_launch: unexpected shapes: n_in %d out %d ws %zu (need %zu)\n", n_in, out_size, ws_size, (size_t)WS_END); grid = -1; return; }
        int dev = 0, cus = 0;
        if (hipGetDevice(&dev) != hipSuccess || hipDeviceGetAttribute(&cus, hipDeviceAttributeMultiprocessorCount, dev) != hipSuccess) { grid = -1; return; }
        if (hipFuncSetAttribute((const void*)fwd_kernel, hipFuncAttributeMaxDynamicSharedMemorySize, LDS_BYTES) != hipSuccess) { fprintf(stderr, "kernel_launch: hipFuncSetAttribute failed\n"); grid = -1; return; }
        int per_cu = 0;
        if (hipOccupancyMaxActiveBlocksPerMultiprocessor(&per_cu, (const void*)fwd_kernel, NTHREADS, LDS_BYTES) != hipSuccess || per_cu < 1) fprintf(stderr, "kernel_launch: occupancy query says %d\n", per_cu);
        (void)hipGetLastError();
        grid = cus;
    }
    if (grid < 0) return;
    hipMemsetAsync((char*)d_ws + WS_CTL, 0, CTL_BYTES, stream);
    Args a{};
    for (int i = 0; i < 23; ++i) a.in[i] = (const float*)d_in[i];
    a.out = (float*)d_out; a.ws = (unsigned char*)d_ws;
    if (MK_N_LAUNCHES == 1) {
        a.ph_lo = 0; a.ph_hi = N_PHASES;
        hipLaunchKernelGGL(fwd_kernel, dim3(grid), dim3(NTHREADS), LDS_BYTES, stream, a);
    } else {
        for (int p = 0; p < N_PHASES; ++p) {
            a.ph_lo = p; a.ph_hi = p + 1;
            hipLaunchKernelGGL(fwd_kernel, dim3(grid), dim3(NTHREADS), LDS_BYTES, stream, a);
        }
    }
    const hipError_t le = hipPeekAtLastError();
    if (le != hipSuccess) fprintf(stderr, "kernel_launch: launch failed: %s\n", hipGetErrorName(le));
}
```

```cpp
#include <hip/hip_runtime.h>
#include <cstdio>
#include <cstdint>

#define LAS __attribute__((address_space(3)))
typedef unsigned short bf16_t;

constexpr int D = 2048, SEQ = 8192, CTXL = 256, NTOK = SEQ + CTXL;
constexpr int DEPTH = 2, GRID_W = 64, HD = 128;
constexpr int INC = 4608;
constexpr int OFF_AK = 768, OFF_AV = 1024, OFF_BQ = 1280, OFF_BK = 2048, OFF_BV = 2816, OFF_C = 3584;
constexpr int NE = 32, FF = 512, CW = 512;
constexpr float LN_EPS = 1e-5f;
constexpr float ALPHA = 1.4142135623730951f;
constexpr float QSCALE = 0.08838834764831845f;
constexpr int NTHREADS = 512, NWAVES = 8;

typedef bf16_t AT;
__device__ __forceinline__ float ldv(const float* p) { return *p; }
__device__ __forceinline__ void stv(float* p, float v) { *p = v; }
__device__ __forceinline__ float bf2f(bf16_t b) { return __uint_as_float(((unsigned)b) << 16); }
__device__ __forceinline__ bf16_t f2bf(float f) { unsigned u = __float_as_uint(f); return (bf16_t)((u + 0x7fffu + ((u >> 16) & 1u)) >> 16); }
__device__ __forceinline__ float ldv(const bf16_t* p) { return bf2f(*p); }
__device__ __forceinline__ void stv(bf16_t* p, float v) { *p = f2bf(v); }

__device__ __forceinline__ float4 ld4(const float* p) { return *(const float4*)p; }
__device__ __forceinline__ void st4(float* p, float4 v) { *(float4*)p = v; }
__device__ __forceinline__ float4 ld4(const bf16_t* p) { const uint2 u = *(const uint2*)p; float4 r; r.x = __uint_as_float(u.x << 16); r.y = __uint_as_float(u.x & 0xffff0000u); r.z = __uint_as_float(u.y << 16); r.w = __uint_as_float(u.y & 0xffff0000u); return r; }
__device__ __forceinline__ void st4(bf16_t* p, float4 v) { uint2 u; u.x = (unsigned)f2bf(v.x) | ((unsigned)f2bf(v.y) << 16); u.y = (unsigned)f2bf(v.z) | ((unsigned)f2bf(v.w) << 16); *(uint2*)p = u; }

constexpr size_t MiB = 1u << 20;
constexpr size_t WS_CTL = 0, CTL_BYTES = 1 * MiB;
constexpr int CW_BAR = 4096, CW_CNT = 16384, CW_CUR = 16384 + 128;
constexpr size_t WS_MOD = 1 * MiB;
constexpr size_t WS_ROPE = 2 * MiB;
constexpr size_t WS_ROUTE = 3 * MiB;
constexpr size_t WS_SLOT = 3 * MiB + 512 * 1024;
constexpr size_t WS_SW = 4 * MiB;
constexpr size_t WS_MODP = 5 * MiB;
constexpr int MAXSLOT = 25088;
constexpr size_t WS_WIN = 8 * MiB;
constexpr size_t WS_WOUT = 44 * MiB;
constexpr size_t WS_WGU = 64 * MiB;
constexpr size_t WS_WD = 320 * MiB;
constexpr size_t WS_H = 448 * MiB;
constexpr size_t WS_P = 482 * MiB;
constexpr size_t WS_MIX = 558 * MiB;
constexpr size_t WS_T = 592 * MiB;
constexpr size_t WS_X1 = 660 * MiB;
constexpr size_t WS_XB = 728 * MiB;
constexpr size_t WS_H2 = 796 * MiB;
constexpr size_t WS_HS = 830 * MiB;
constexpr size_t WS_HID = 930 * MiB;
constexpr size_t WS_Y = 956 * MiB;
constexpr size_t WS_END = 1056 * MiB;

constexpr int LDS_BYTES = 163840;

#define XB_TMO      128
#define XB_XCNT(j)  (256  + 64 * (j))
#define XB_XSUB(j)  (1280 + 64 * (j))
#define XB_XGEN(j)  (2304 + 64 * (j))
#define XB_TOP      3328
#define XB_TOPGEN   3392
#define XCD_BAR_WORDS 3456
#define XB_SPIN_CAP (1u << 18)
__device__ __forceinline__ unsigned xb_ld(unsigned* p)              { return __hip_atomic_load(p, __ATOMIC_RELAXED, __HIP_MEMORY_SCOPE_AGENT); }
__device__ __forceinline__ unsigned xb_add(unsigned* p, unsigned v) { return __hip_atomic_fetch_add(p, v, __ATOMIC_RELAXED, __HIP_MEMORY_SCOPE_AGENT); }
__device__ __forceinline__ unsigned xb_xcc_id() { return (unsigned)__builtin_amdgcn_s_getreg((3 << 11) | 20) & 0xFu; }
#define XB_SPIN(cond, bar) do { unsigned _sp = 0; while (cond) { __builtin_amdgcn_s_sleep(1); \
    if ((++_sp & 255u) == 0u) { if (xb_ld(&(bar)[XB_TMO])) break; if (_sp > XB_SPIN_CAP) { atomicAdd(&(bar)[XB_TMO], 1u); break; } } } } while (0)
struct XcdBarrier { unsigned* bar; unsigned x; volatile LAS unsigned* st; };
__device__ __forceinline__ XcdBarrier xcd_barrier_post(unsigned* bar, volatile LAS unsigned* st) {
    XcdBarrier b; b.bar = bar; b.x = xb_xcc_id(); b.st = st;
    if (threadIdx.x == 0) (void)xb_add(&bar[XB_XCNT(b.x)], 1u);
    return b;
}
__device__ __forceinline__ void xcd_barrier_complete(unsigned* bar, unsigned x, unsigned& nloc, unsigned& nx) {
    const unsigned G = gridDim.x * gridDim.y * gridDim.z;
    unsigned sum, cnt, mine, sp = 0u;
    for (;;) {
        sum = 0u; cnt = 0u; mine = 0u;
#pragma unroll
        for (unsigned j = 0; j < 16; ++j) { const unsigned c = xb_ld(&bar[XB_XCNT(j)]); sum += c; cnt += (c > 0u) ? 1u : 0u; mine = (j == x) ? c : mine; }
        if (sum == G) break;
        __builtin_amdgcn_s_sleep(1);
        if ((++sp & 255u) == 0u) { if (xb_ld(&bar[XB_TMO])) break; if (sp > XB_SPIN_CAP) { atomicAdd(&bar[XB_TMO], 1u); break; } }
    }
    nloc = mine > 0u ? mine : 1u; nx = cnt > 0u ? cnt : 1u;
}
__device__ __noinline__ void xcd_barrier(const XcdBarrier b) {
    asm volatile("s_waitcnt vmcnt(0)" ::: "memory");
    __syncthreads();
    if (threadIdx.x == 0) {
        unsigned* bar = b.bar;
        __builtin_amdgcn_s_waitcnt(0);
        unsigned nloc = b.st[0], nx = b.st[1];
        if (nloc == 0u) { xcd_barrier_complete(bar, b.x, nloc, nx); b.st[0] = nloc; b.st[1] = nx; }
        const unsigned old = xb_add(&bar[XB_XSUB(b.x)], 1u);
        const unsigned gen = old / nloc;
        if (old + 1u == (gen + 1u) * nloc) {
            __builtin_amdgcn_fence(__ATOMIC_RELEASE, "agent");
            asm volatile("s_waitcnt vmcnt(0)" ::: "memory");
            const unsigned og = xb_add(&bar[XB_TOP], 1u);
            const unsigned tg = og / nx;
            if (og + 1u == (tg + 1u) * nx) xb_add(&bar[XB_TOPGEN], 1u);
            else XB_SPIN(xb_ld(&bar[XB_TOPGEN]) == tg, bar);
            __builtin_amdgcn_fence(__ATOMIC_ACQUIRE, "agent");
            xb_add(&bar[XB_XGEN(b.x)], 1u);
            asm volatile("s_waitcnt vmcnt(0)" ::: "memory");
        } else {
            XB_SPIN(xb_ld(&bar[XB_XGEN(b.x)]) == gen, bar);
            __builtin_amdgcn_fence(__ATOMIC_ACQUIRE, "agent");
            asm volatile("s_waitcnt vmcnt(0)" ::: "memory");
        }
    }
    __syncthreads();
}

struct Args {
    const float* in[23];
    float* out;
    unsigned char* ws;
    int ph_lo, ph_hi;
};

struct Ctx {
    LAS unsigned char* lds;
    int tid, lane, wave, G, bid;
    const float* const* in;
    float* out;
    unsigned char* ws;
    size_t z;
};
#define CIN(k) (C.in[k] + C.z)
#define C_x CIN(0)
#define C_c CIN(1)
#define C_ctx CIN(2)
#define C_c_ctx CIN(3)
#define C_w_mod CIN(4)
#define C_b_mod CIN(5)
#define C_w_in CIN(6)
#define C_sink CIN(7)
#define C_rpb CIN(8)
#define C_sgu_g CIN(9)
#define C_sgu_bn CIN(10)
#define C_sgu_w CIN(11)
#define C_sgu_b CIN(12)
#define C_w_out CIN(13)
#define C_ln1_g CIN(14)
#define C_ln1_b CIN(15)
#define C_w_router CIN(16)
#define C_router_bias CIN(17)
#define C_w_gate CIN(18)
#define C_w_up CIN(19)
#define C_w_down CIN(20)
#define C_ln2_g CIN(21)
#define C_ln2_b CIN(22)
#define C_MOD ((float*)(C.ws + C.z + WS_MOD))
#define C_ROPE ((float*)(C.ws + C.z + WS_ROPE))
#define C_ROUTE ((int*)(C.ws + C.z + WS_ROUTE))
#define C_H ((AT*)(C.ws + C.z + WS_H))
#define C_P ((AT*)(C.ws + C.z + WS_P))
#define C_MIX ((AT*)(C.ws + C.z + WS_MIX))
#define C_T ((float*)(C.ws + C.z + WS_T))
#define C_X1 ((float*)(C.ws + C.z + WS_X1))
#define C_XB ((float*)(C.ws + C.z + WS_XB))
#define C_H2 ((AT*)(C.ws + C.z + WS_H2))
#define C_HID ((AT*)(C.ws + C.z + WS_HID))
#define C_Y ((AT*)(C.ws + C.z + WS_Y))
#define C_HS ((AT*)(C.ws + C.z + WS_HS))
#define C_SLOT ((int*)(C.ws + C.z + WS_SLOT))
#define C_SW ((float*)(C.ws + C.z + WS_SW))
#define C_MODP ((float*)(C.ws + C.z + WS_MODP))
#define C_CTLW ((unsigned*)(C.ws + C.z + WS_CTL))
#define C_WIN ((bf16_t*)(C.ws + C.z + WS_WIN))
#define C_WOUT ((bf16_t*)(C.ws + C.z + WS_WOUT))
#define C_WGU ((bf16_t*)(C.ws + C.z + WS_WGU))
#define C_WD ((bf16_t*)(C.ws + C.z + WS_WD))

__device__ __forceinline__ float silu_f(float v) { return v / (1.f + expf(-v)); }
__device__ __forceinline__ float gelu_tanh_f(float v) { return 0.5f * v * (1.f + tanhf(0.7978845608028654f * (v + 0.044715f * v * v * v))); }
__device__ __forceinline__ float wave_sum(float v) {
#pragma unroll
    for (int o = 1; o < 64; o <<= 1) v += __shfl_xor(v, o);
    return v;
}
__device__ __forceinline__ float wave_max(float v) {
#pragma unroll
    for (int o = 1; o < 64; o <<= 1) v = fmaxf(v, __shfl_xor(v, o));
    return v;
}
__device__ __forceinline__ const float* modp(const Ctx& C, int l, int kind, int j) { return C_MOD + ((size_t)(l * 2 + kind) * 6 + j) * D; }
__device__ __forceinline__ const float* xin_row(const Ctx& C, int l, int r) {
    if (l == 0) return r < SEQ ? C_x + (size_t)r * D : C_ctx + (size_t)(r - SEQ) * D;
    return C_XB + (size_t)r * D;
}

namespace pg8 {
#define PG8_LAS __attribute__((address_space(3)))
typedef short bf16x8 __attribute__((ext_vector_type(8)));
typedef float f32x4 __attribute__((ext_vector_type(4)));
typedef unsigned u32x4 __attribute__((ext_vector_type(4)));
constexpr int BM = 256, BK = 64, HALF = 128, HTB = HALF * BK * 2, STAGE_BYTES = 8 * HTB, NXCD = 8, WGM = 8;
__host__ __device__ __forceinline__ int lds_byte(int r, int c) { const int st = (r >> 4) * 2 + (c >> 5), rr = r & 15, cc = c & 31, ob = rr * 64 + cc * 2; return st * 1024 + (ob ^ (((ob >> 9) & 1) << 5)); }
__host__ __device__ __forceinline__ void stage_rc(int b, int& R, int& C) { const int st = b / 1024, sb = b % 1024, swz = sb ^ (((sb >> 9) & 1) << 5); R = (st >> 1) * 16 + swz / 64; C = (st & 1) * 32 + (swz % 64) / 2; }
__host__ __device__ __forceinline__ int perm32(int rho) { const int n = rho >> 4, i = rho & 15; return 8 * (i >> 2) + 4 * n + (i & 3); }
__device__ __forceinline__ unsigned cvt_pk_bf16(float lo, float hi) { unsigned r; asm volatile("v_cvt_pk_bf16_f32 %0, %1, %2" : "=v"(r) : "v"(lo), "v"(hi)); return r; }

__device__ __forceinline__ void store16_wt(void* p, u32x4 v) { asm volatile("global_store_dwordx4 %0, %1, off sc1\n\ts_nop 1" :: "v"(p), "v"(v) : "memory"); }
struct Unit { int pm, pn; const char* A; const char* B; };

template <int NN  , int KD>
struct DenseSched {
    int nM, G, c; const char* A; const char* Bt;
    __device__ __forceinline__ bool next(int i, Unit& u) const {
        const int nwg = nM * NN;
        const int L = i * G + c; if (L >= nwg) return false;
        int wgid = L; { const int q = nwg / NXCD, r = nwg % NXCD, xcd = wgid % NXCD, off = wgid / NXCD; wgid = (xcd < r ? xcd * (q + 1) : r * (q + 1) + (xcd - r) * q) + off; }
        const int nig = WGM * NN, gid = wgid / nig, fm = gid * WGM, gsz = (nM - fm) < WGM ? (nM - fm) : WGM;
        u.pm = fm + ((wgid % nig) % gsz); u.pn = (wgid % nig) / gsz;
        u.A = A + (size_t)u.pm * (BM * KD * 2); u.B = Bt + (size_t)u.pn * (BM * KD * 2); return true;
    }
    __device__ __forceinline__ void a_ready(const Unit&) const {}
    __device__ __forceinline__ void done(const Unit&) const {}
};
struct InprojSched {
    int G, v; const char* A; const char* Bt; unsigned* cnt;
    __device__ __forceinline__ bool next(int i, Unit& u) const {
        const int j = i * G + v; constexpr int N1 = (NTOK / 256) * 14, N2 = (NTOK / 256) * 4;
        if (j >= N1 + N2) return false;
        if (j < N1) { u.pm = j / 14; u.pn = j % 14; } else { const int jj = j - N1; u.pm = jj / 4; u.pn = 14 + jj % 4; }
        u.A = A + (size_t)u.pm * (BM * D * 2); u.B = Bt + (size_t)u.pn * (BM * D * 2); return true;
    }
    __device__ __forceinline__ void a_ready(const Unit&) const {}
    __device__ __forceinline__ void done(const Unit& u) const {
        asm volatile("s_waitcnt vmcnt(0)" ::: "memory");
        __builtin_amdgcn_s_barrier();
        if (threadIdx.x == 0) __hip_atomic_fetch_add(cnt + (u.pn < 14 ? 0 : 64), 1u, __ATOMIC_RELAXED, __HIP_MEMORY_SCOPE_AGENT);
    }
};
struct OneUnit { Unit u0; __device__ __forceinline__ bool next(int i, Unit& u) const { if (i != 0) return false; u = u0; return true; }
    __device__ __forceinline__ void a_ready(const Unit&) const {}
    __device__ __forceinline__ void done(const Unit&) const {} };
__device__ __forceinline__ int moe_expert_of(const PG8_LAS int* toff, int mt) { int e = 0; for (int q = 1; q < 32; ++q) e += (toff[q] <= mt) ? 1 : 0; return e; }
struct MoeSched1 {
    const PG8_LAS int* toff; int G, v; const char* A; const char* B; unsigned* mtc;
    __device__ __forceinline__ bool next(int i, Unit& u) const {
        const int MT = toff[32];
        const int L = i * G + v; if (L >= MT * 4) return false;
        const int mt = L >> 2, pn = L & 3, e = moe_expert_of(toff, mt);
        u.pm = mt; u.pn = pn; u.A = A + (size_t)mt * (256 * D * 2); u.B = B + (size_t)(e * 1024 + pn * 256) * (D * 2); return true;
    }
    __device__ __forceinline__ void a_ready(const Unit&) const {}
    __device__ __forceinline__ void done(const Unit& u) const {
        asm volatile("s_waitcnt vmcnt(0)" ::: "memory");
        __builtin_amdgcn_s_barrier();
        if (threadIdx.x == 0) __hip_atomic_fetch_add(mtc + 64 * u.pm, 1u, __ATOMIC_RELAXED, __HIP_MEMORY_SCOPE_AGENT);
    }
};
struct MoeSched2 {
    const PG8_LAS int* toff; int G, v; const char* A; const char* B; unsigned* mtc;
    __device__ __forceinline__ bool next(int i, Unit& u) const {
        const int MT = toff[32], N1 = MT * 4, N2 = MT * 8;
        const int r1 = N1 % G, nl = G - r1;
        const bool light = v >= r1;
        int j;
        if (light && i < 3) j = i * nl + (v - r1);
        else { const int ii = light ? i - 3 : i; j = 3 * nl + ii * G + (light ? v - r1 : nl + v); }
        if (j >= N2) return false;
        const int mt = j >> 3, pn = j & 7, e = moe_expert_of(toff, mt);
        u.pm = mt; u.pn = pn; u.A = A + (size_t)mt * (256 * FF * 2); u.B = B + (size_t)(e * D + pn * 256) * (FF * 2); return true;
    }
    __device__ __forceinline__ void a_ready(const Unit& u) const {
        if (threadIdx.x < 64) {
            unsigned sp = 0;
            while ((unsigned)__builtin_amdgcn_readfirstlane((int)__hip_atomic_load(mtc + 64 * u.pm, __ATOMIC_RELAXED, __HIP_MEMORY_SCOPE_AGENT)) < 4u) { __builtin_amdgcn_s_sleep(2); if (++sp > (1u << 22)) break; }
            __builtin_amdgcn_fence(__ATOMIC_ACQUIRE, "agent");
            asm volatile("s_waitcnt vmcnt(0)" ::: "memory");
        }
        asm volatile("" ::: "memory"); __builtin_amdgcn_s_barrier(); asm volatile("" ::: "memory");
    }
    __device__ __forceinline__ void done(const Unit&) const {}
};

struct EpiBf16 {
    static constexpr bool PERM = true;
    bf16_t* O; int ldc;
    __device__ __forceinline__ void operator()(const f32x4 (&acc)[2][2][4][2], const Unit& u, int wr, int wc, int fr, int fq) const {
        const int row0 = u.pm * BM + wr * 64 + fr, col0 = u.pn * BM + wc * 32 + 8 * fq;
#pragma unroll
        for (int ai = 0; ai < 2; ++ai)
#pragma unroll
            for (int m = 0; m < 4; ++m) { bf16_t* rowp = O + (size_t)(row0 + ai * HALF + m * 16) * ldc + col0;
#pragma unroll
                for (int bj = 0; bj < 2; ++bj) { const f32x4 v0 = acc[ai][bj][m][0], v1 = acc[ai][bj][m][1];
                    u32x4 w; w.x = cvt_pk_bf16(v0[0], v0[1]); w.y = cvt_pk_bf16(v0[2], v0[3]); w.z = cvt_pk_bf16(v1[0], v1[1]); w.w = cvt_pk_bf16(v1[2], v1[3]);
                    *(u32x4*)(rowp + bj * HALF) = w; } }
    }
};
struct EpiP {
    static constexpr bool PERM = true;
    bf16_t* O; const float* rope;
    __device__ __forceinline__ void operator()(const f32x4 (&acc)[2][2][4][2], const Unit& u, int wr, int wc, int fr, int fq) const {
        const int row0 = u.pm * BM + wr * 64 + fr, col0 = u.pn * BM + wc * 32 + 8 * fq;
        const bool rot = (u.pn < 4) && (u.pm < SEQ / BM);
#pragma unroll
        for (int ai = 0; ai < 2; ++ai)
#pragma unroll
            for (int m = 0; m < 4; ++m) { const int row = row0 + ai * HALF + m * 16; bf16_t* rowp = O + (size_t)row * INC + col0;
#pragma unroll
                for (int bj = 0; bj < 2; ++bj) { f32x4 v0 = acc[ai][bj][m][0], v1 = acc[ai][bj][m][1];
                    if (rot) {
                        const int i0 = ((col0 + bj * HALF) & 127) >> 1;
                        const int comp = (i0 < 32) ? (row >> 6) : (row & 63);
                        const f32x4 cs = *(const f32x4*)(rope + comp * 32 + (i0 & 31)), sn = *(const f32x4*)(rope + 4096 + comp * 32 + (i0 & 31));
                        const f32x4 a = v0, b = v1;
                        v0[0] = a[0] * cs[0] - a[1] * sn[0]; v0[1] = a[1] * cs[0] + a[0] * sn[0];
                        v0[2] = a[2] * cs[1] - a[3] * sn[1]; v0[3] = a[3] * cs[1] + a[2] * sn[1];
                        v1[0] = b[0] * cs[2] - b[1] * sn[2]; v1[1] = b[1] * cs[2] + b[0] * sn[2];
                        v1[2] = b[2] * cs[3] - b[3] * sn[3]; v1[3] = b[3] * cs[3] + b[2] * sn[3];
                    }
                    u32x4 w; w.x = cvt_pk_bf16(v0[0], v0[1]); w.y = cvt_pk_bf16(v0[2], v0[3]); w.z = cvt_pk_bf16(v1[0], v1[1]); w.w = cvt_pk_bf16(v1[2], v1[3]);
                    store16_wt(rowp + bj * HALF, w); } }
    }
};
struct EpiTres {
    static constexpr bool PERM = false;
    float* T; const float* xl; const float* xc; const float* gl; const float* gc;
    __device__ __forceinline__ void operator()(const f32x4 (&acc)[2][2][4][2], const Unit& u, int wr, int wc, int fr, int fq) const {
        const int row0 = u.pm * BM + wr * 64 + fr, col0 = u.pn * BM + wc * 32 + 4 * fq;
        const bool isctx = (u.pm == SEQ / BM);
        const float* xb = isctx ? xc - (size_t)SEQ * D : xl; const float* gb = isctx ? gc : gl;
        f32x4 gv[2][2];
#pragma unroll
        for (int bj = 0; bj < 2; ++bj)
#pragma unroll
            for (int n = 0; n < 2; ++n) gv[bj][n] = *(const f32x4*)(gb + col0 + bj * HALF + n * 16);
#pragma unroll
        for (int ai = 0; ai < 2; ++ai)
#pragma unroll
            for (int m = 0; m < 4; ++m) { const size_t off = (size_t)(row0 + ai * HALF + m * 16) * D + col0;
#pragma unroll
                for (int bj = 0; bj < 2; ++bj)
#pragma unroll
                    for (int n = 0; n < 2; ++n) { const f32x4 xv = *(const f32x4*)(xb + off + bj * HALF + n * 16);
                        *(f32x4*)(T + off + bj * HALF + n * 16) = xv * ALPHA + gv[bj][n] * acc[ai][bj][m][n]; }
                asm volatile("" ::: "memory"); }
    }
};
struct EpiMoe1 {
    static constexpr bool PERM = true;
    bf16_t* HID; const float* SW;
    __device__ __forceinline__ void operator()(const f32x4 (&acc)[2][2][4][2], const Unit& u, int wr, int wc, int fr, int fq) const {
        const int row0 = u.pm * BM + wr * 64 + fr, col0 = u.pn * HALF + wc * 32 + 8 * fq;
#pragma unroll
        for (int ai = 0; ai < 2; ++ai)
#pragma unroll
            for (int m = 0; m < 4; ++m) { const int row = row0 + ai * HALF + m * 16; const float w = SW[row];
                float h[8];
#pragma unroll
                for (int n = 0; n < 2; ++n)
#pragma unroll
                    for (int j = 0; j < 4; ++j) { const float g = acc[ai][0][m][n][j], up = acc[ai][1][m][n][j]; h[4 * n + j] = g / (1.f + __expf(-g)) * up * w; }
                u32x4 o; o.x = cvt_pk_bf16(h[0], h[1]); o.y = cvt_pk_bf16(h[2], h[3]); o.z = cvt_pk_bf16(h[4], h[5]); o.w = cvt_pk_bf16(h[6], h[7]);
                store16_wt(HID + (size_t)row * FF + col0, o); }
    }
};

template <int K, class Epi, class Sched, bool ALIGN_EPI = true, bool SP2 = true>
__device__ __forceinline__ void gemm_phase(PG8_LAS unsigned char* lds, const Sched& S, const Epi& E) {
    int tid_ = threadIdx.x; asm volatile("" : "+v"(tid_));
    const int tid = tid_, wid = __builtin_amdgcn_readfirstlane(tid >> 6), lane = tid & 63, wr = wid >> 2, wc = wid & 3, fr = lane & 15, fq = lane >> 4;
    constexpr int nt = K / BK;
    unsigned voffA[2], voffB[2];
#pragma unroll
    for (int i = 0; i < 2; ++i) { int R, C; stage_rc(tid * 16 + i * 8192, R, C); const int Rb = Epi::PERM ? ((R & ~31) + perm32(R & 31)) : R;
        voffA[i] = (unsigned)(R * K + C) * 2u; voffB[i] = (unsigned)(Rb * K + C) * 2u; }
    const size_t kstep = (size_t)(BK * 2);
    const size_t hstep = (size_t)HALF * K * 2;
    const unsigned ldsw = (unsigned)wid * 1024u;
    const int aoff = lds_byte(wr * 64 + fr, fq * 8), boff = lds_byte(wc * 32 + fr, fq * 8);
#define PG8_SA(b, h) (((b) * 2 + (h)) * HTB)
#define PG8_SB(b, h) ((4 + (b) * 2 + (h)) * HTB)
#define PG8_STAGE(bufoff, gbase, voff) do { _Pragma("unroll") for (int _i = 0; _i < 2; ++_i) \
        __builtin_amdgcn_global_load_lds((const unsigned*)((const char*)(gbase) + (voff)[_i]), (PG8_LAS unsigned*)(lds + (bufoff) + ldsw + _i * 8192), 16, 0, 0); } while (0)
#define PG8_LDA(dst, b, h) do { _Pragma("unroll") for (int m = 0; m < 4; ++m) _Pragma("unroll") for (int k = 0; k < 2; ++k) dst[m][k] = *(const PG8_LAS bf16x8*)(lds + PG8_SA(b, h) + aoff + m * 2048 + k * 1024); } while (0)
#define PG8_LDB(dst, b, h) do { _Pragma("unroll") for (int n = 0; n < 2; ++n) _Pragma("unroll") for (int k = 0; k < 2; ++k) dst[n][k] = *(const PG8_LAS bf16x8*)(lds + PG8_SB(b, h) + boff + n * 2048 + k * 1024); } while (0)
#define PG8_MMA(ai, bj, At, Bt) do { __builtin_amdgcn_s_setprio(1); _Pragma("unroll") for (int m = 0; m < 4; ++m) _Pragma("unroll") for (int n = 0; n < 2; ++n) _Pragma("unroll") for (int k = 0; k < 2; ++k) \
        acc[ai][bj][m][n] = __builtin_amdgcn_mfma_f32_16x16x32_bf16(Bt[n][k], At[m][k], acc[ai][bj][m][n], 0, 0, 0); __builtin_amdgcn_s_setprio(0); } while (0)
#define PG8_WAIT_V(n) asm volatile("s_waitcnt vmcnt(" #n ")" ::: "memory")
#define PG8_WAIT_L(n) asm volatile("s_waitcnt lgkmcnt(" #n ")" ::: "memory")
#define PG8_BAR __builtin_amdgcn_s_barrier()
#define PG8_SCHED __builtin_amdgcn_sched_barrier(0)
    Unit cur, nxt; int ui = 0;
    if (!S.next(0, cur)) return;
    f32x4 acc[2][2][4][2];
#pragma unroll
    for (int a = 0; a < 2; ++a)
#pragma unroll
        for (int b = 0; b < 2; ++b)
#pragma unroll
            for (int m = 0; m < 4; ++m)
#pragma unroll
                for (int n = 0; n < 2; ++n) acc[a][b][m][n] = (f32x4){0.f, 0.f, 0.f, 0.f};
    bf16x8 At[4][2], B0[2][2], B1[2][2];
    const char* cA = cur.A; const char* cB = cur.B;
    S.a_ready(cur);
    if constexpr (SP2) {
        PG8_STAGE(PG8_SB(0, 0), cB, voffB); PG8_STAGE(PG8_SB(0, 1), cB + hstep, voffB); PG8_STAGE(PG8_SA(0, 0), cA, voffA); PG8_STAGE(PG8_SA(0, 1), cA + hstep, voffA);
        if (wr == 1) PG8_BAR;
        PG8_WAIT_V(2); PG8_BAR;
        PG8_STAGE(PG8_SB(1, 0), cB + kstep, voffB); PG8_STAGE(PG8_SA(1, 0), cA + kstep, voffA); PG8_STAGE(PG8_SB(1, 1), cB + hstep + kstep, voffB);
        PG8_WAIT_V(6); PG8_BAR;
    } else {
        PG8_STAGE(PG8_SB(0, 0), cB, voffB); PG8_STAGE(PG8_SA(0, 0), cA, voffA); PG8_STAGE(PG8_SB(0, 1), cB + hstep, voffB); PG8_STAGE(PG8_SA(0, 1), cA + hstep, voffA);
        if (wr == 1) PG8_BAR;
        PG8_WAIT_V(4); PG8_BAR;
        PG8_STAGE(PG8_SB(1, 0), cB + kstep, voffB); PG8_STAGE(PG8_SA(1, 0), cA + kstep, voffA); PG8_STAGE(PG8_SB(1, 1), cB + hstep + kstep, voffB);
        PG8_WAIT_V(6); PG8_BAR;
    }
    for (;;) {
        const bool has_next = S.next(ui + 1, nxt);
        const char* nA = has_next ? nxt.A : cA; const char* nB = has_next ? nxt.B : cB;
        for (int t = 0; t < nt; t += 2) {
            const bool last = (t == nt - 2);
            if (last && has_next) S.a_ready(nxt);
            const char* a1 = cA + (size_t)(t + 1) * kstep;
            const char* a2 = last ? nA : cA + (size_t)(t + 2) * kstep; const char* b2 = last ? nB : cB + (size_t)(t + 2) * kstep;
            const char* a3 = a2 + kstep; const char* b3 = b2 + kstep;
            if constexpr (SP2) {
            PG8_LDB(B0, 0, 0); PG8_LDB(B1, 0, 1); PG8_SCHED; PG8_LDA(At, 0, 0); PG8_STAGE(PG8_SA(1, 1), a1 + hstep, voffA);
            PG8_WAIT_V(8); PG8_WAIT_L(0); PG8_BAR; PG8_MMA(0, 0, At, B0); PG8_MMA(0, 1, At, B1); PG8_BAR; PG8_SCHED;
            PG8_LDA(At, 0, 1); PG8_STAGE(PG8_SB(0, 0), b2, voffB); PG8_STAGE(PG8_SB(0, 1), b2 + hstep, voffB); PG8_STAGE(PG8_SA(0, 0), a2, voffA);
            PG8_WAIT_V(8); PG8_WAIT_L(0); PG8_BAR; PG8_MMA(1, 0, At, B0); PG8_MMA(1, 1, At, B1); PG8_BAR; PG8_SCHED;
            PG8_LDB(B0, 1, 0); PG8_LDB(B1, 1, 1); PG8_SCHED; PG8_LDA(At, 1, 0); PG8_STAGE(PG8_SA(0, 1), a2 + hstep, voffA);
            PG8_WAIT_V(8); PG8_WAIT_L(0); PG8_BAR; PG8_MMA(0, 0, At, B0); PG8_MMA(0, 1, At, B1); PG8_BAR; PG8_SCHED;
            PG8_LDA(At, 1, 1); PG8_STAGE(PG8_SB(1, 0), b3, voffB); PG8_STAGE(PG8_SB(1, 1), b3 + hstep, voffB); PG8_STAGE(PG8_SA(1, 0), a3, voffA);
            PG8_WAIT_V(8); PG8_WAIT_L(0); PG8_BAR; PG8_MMA(1, 0, At, B0); PG8_MMA(1, 1, At, B1); PG8_BAR; PG8_SCHED;
            } else {
            PG8_LDB(B0, 0, 0); PG8_SCHED; PG8_LDA(At, 0, 0); PG8_STAGE(PG8_SA(1, 1), a1 + hstep, voffA);
            PG8_WAIT_L(8); PG8_BAR; PG8_WAIT_L(0); PG8_MMA(0, 0, At, B0); PG8_BAR; PG8_SCHED;
            PG8_LDB(B1, 0, 1); PG8_STAGE(PG8_SB(0, 0), b2, voffB);
            PG8_BAR; PG8_WAIT_L(0); PG8_MMA(0, 1, At, B1); PG8_BAR;
            PG8_LDA(At, 0, 1); PG8_STAGE(PG8_SA(0, 0), a2, voffA);
            PG8_BAR; PG8_WAIT_L(0); PG8_MMA(1, 0, At, B0); PG8_BAR; PG8_SCHED;
            PG8_STAGE(PG8_SB(0, 1), b2 + hstep, voffB);
            PG8_WAIT_V(6); PG8_BAR; PG8_MMA(1, 1, At, B1); PG8_BAR;
            PG8_LDB(B0, 1, 0); PG8_SCHED; PG8_LDA(At, 1, 0); PG8_STAGE(PG8_SA(0, 1), a2 + hstep, voffA);
            PG8_WAIT_L(8); PG8_BAR; PG8_WAIT_L(0); PG8_MMA(0, 0, At, B0); PG8_BAR; PG8_SCHED;
            PG8_LDB(B1, 1, 1); PG8_STAGE(PG8_SB(1, 0), b3, voffB);
            PG8_BAR; PG8_WAIT_L(0); PG8_MMA(0, 1, At, B1); PG8_BAR;
            PG8_LDA(At, 1, 1); PG8_STAGE(PG8_SA(1, 0), a3, voffA);
            PG8_BAR; PG8_WAIT_L(0); PG8_MMA(1, 0, At, B0); PG8_BAR; PG8_SCHED;
            PG8_STAGE(PG8_SB(1, 1), b3 + hstep, voffB);
            PG8_WAIT_V(6); PG8_BAR; PG8_MMA(1, 1, At, B1); PG8_BAR;
            }
        }
        if constexpr (ALIGN_EPI) { if (wr == 0) PG8_BAR; }
        E(acc, cur, wr, wc, fr, fq); S.done(cur);
        if (!has_next) break;
#pragma unroll
        for (int a = 0; a < 2; ++a)
#pragma unroll
            for (int b = 0; b < 2; ++b)
#pragma unroll
                for (int m = 0; m < 4; ++m)
#pragma unroll
                    for (int n = 0; n < 2; ++n) acc[a][b][m][n] = (f32x4){0.f, 0.f, 0.f, 0.f};
        cur = nxt; cA = nA; cB = nB; ++ui;
        if constexpr (ALIGN_EPI) { if (wr == 1) PG8_BAR; }
    }
    PG8_WAIT_V(0);
    if constexpr (!ALIGN_EPI) { if (wr == 0) PG8_BAR; }
    PG8_BAR;
#undef PG8_SA
#undef PG8_SB
#undef PG8_STAGE
#undef PG8_LDA
#undef PG8_LDB
#undef PG8_MMA
#undef PG8_WAIT_V
#undef PG8_WAIT_L
#undef PG8_BAR
#undef PG8_SCHED
}
}

__device__ __forceinline__ void transpose_item(const float* W, int N, bf16_t* WT, int K, int wt_row0, int k0, int n0, LAS float* scr, int lane, int rstride = 1) {
#pragma unroll
    for (int i = 0; i < 32; ++i) { const int kk = 2 * i + (lane >> 5); scr[kk * 33 + (lane & 31)] = W[(size_t)(k0 + kk) * N + n0 + (lane & 31)]; }
    asm volatile("s_waitcnt lgkmcnt(0)" ::: "memory");
    const int c = lane & 7;
#pragma unroll
    for (int j = 0; j < 4; ++j) { const int n = (lane >> 3) + 8 * j; const LAS float* sp = scr + (8 * c) * 33 + n;
        uint4 o; o.x = pg8::cvt_pk_bf16(sp[0 * 33], sp[1 * 33]); o.y = pg8::cvt_pk_bf16(sp[2 * 33], sp[3 * 33]); o.z = pg8::cvt_pk_bf16(sp[4 * 33], sp[5 * 33]); o.w = pg8::cvt_pk_bf16(sp[6 * 33], sp[7 * 33]);
        *(uint4*)(WT + (size_t)(wt_row0 + n * rstride) * K + k0 + 8 * c) = o; }
    asm volatile("s_waitcnt lgkmcnt(0)" ::: "memory");
}
constexpr int I_IN = (D / 64) * (INC / 32), I_OUT = (D / 64) * (D / 32), I_EXP = 512, NKC = 16;
__device__ __forceinline__ void ph_prologue(const Ctx& C) {
    const int gt = C.bid * NTHREADS + C.tid, NT = C.G * NTHREADS;
    const int gw = C.bid * NWAVES + C.wave, NGW = C.G * NWAVES, lane = C.lane;
    for (int idx = gt; idx < 128 * 32; idx += NT) {
        const int pos = idx / 32, j = idx % 32;
        const double inv = pow(10000.0, -(double)j / 32.0);
        const double ang = (double)pos * inv;
        C_ROPE[idx] = (float)cos(ang);
        C_ROPE[128 * 32 + idx] = (float)sin(ang);
    }
    {
        LAS float* sl = (LAS float*)C.lds;
        for (int k = C.tid; k < D; k += NTHREADS) { sl[k] = silu_f(C_c[k]); sl[D + k] = silu_f(C_c_ctx[k]); }
        __syncthreads();
        for (int u = gw; u < DEPTH * 48 * NKC; u += NGW) {
            const int l = u / (48 * NKC), rem = u % (48 * NKC), sb = rem / NKC, kc = rem % NKC;
            const float* w = C_w_mod + (size_t)l * D * 6 * D + (size_t)(kc * 128) * 6 * D + sb * 256 + lane * 4;
            float4 a0 = {0.f, 0.f, 0.f, 0.f}, a1 = {0.f, 0.f, 0.f, 0.f};
#pragma unroll 16
            for (int k = 0; k < 128; ++k) {
                const float4 wv = *(const float4*)(w + (size_t)k * 6 * D);
                const float c0 = sl[kc * 128 + k], c1 = sl[D + kc * 128 + k];
                a0.x += c0 * wv.x; a0.y += c0 * wv.y; a0.z += c0 * wv.z; a0.w += c0 * wv.w;
                a1.x += c1 * wv.x; a1.y += c1 * wv.y; a1.z += c1 * wv.z; a1.w += c1 * wv.w;
            }
            *(float4*)(C_MODP + ((size_t)(kc * 2 + l) * 2 + 0) * 6 * D + sb * 256 + lane * 4) = a0;
            *(float4*)(C_MODP + ((size_t)(kc * 2 + l) * 2 + 1) * 6 * D + sb * 256 + lane * 4) = a1;
        }
        __syncthreads();
    }
    LAS float* scr = (LAS float*)(C.lds + C.wave * 16384);
    constexpr int TOT = 2 * I_IN + 2 * I_OUT + 3 * 64 * I_EXP;
    for (int it = gw; it < TOT; it += NGW) {
        int r = it;
        if (r < 2 * I_IN) { const int l = r / I_IN, q = r % I_IN, kb = q / (INC / 32), nb = q % (INC / 32);
            const int n0 = 32 * nb; int row0 = n0, rs = 1;
            if (n0 < OFF_AV) { const int hh = n0 / HD, d0 = n0 % HD; row0 = hh * HD + (d0 < 64 ? 2 * d0 : 2 * (d0 - 64) + 1); rs = 2; }
            transpose_item(C_w_in + (size_t)l * D * INC, INC, C_WIN + (size_t)l * INC * D, D, row0, 64 * kb, n0, scr, lane, rs); continue; }
        r -= 2 * I_IN;
        if (r < 2 * I_OUT) { const int l = r / I_OUT, q = r % I_OUT, kb = q / (D / 32), nb = q % (D / 32);
            transpose_item(C_w_out + (size_t)l * D * D, D, C_WOUT + (size_t)l * D * D, D, 32 * nb, 64 * kb, 32 * nb, scr, lane); continue; }
        r -= 2 * I_OUT;
        if (r < 2 * 64 * I_EXP) { const int up = r / (64 * I_EXP), rr = r % (64 * I_EXP); const int le = rr / I_EXP, q = rr % I_EXP, kb = q / 16, nb = q % 16, f0 = 32 * nb;
            transpose_item((up ? C_w_up : C_w_gate) + (size_t)le * D * FF, FF, C_WGU + (size_t)le * 1024 * D, D, (f0 / 128) * 256 + up * 128 + (f0 % 128), 64 * kb, f0, scr, lane); continue; }
        r -= 2 * 64 * I_EXP;
        { const int le = r / I_EXP, q = r % I_EXP, kb = q / (D / 32), nb = q % (D / 32);
          transpose_item(C_w_down + (size_t)le * FF * D, D, C_WD + (size_t)le * D * FF, FF, 32 * nb, 64 * kb, 32 * nb, scr, lane); }
    }
}

__device__ __forceinline__ void ph_modulate0(const Ctx& C) {
    const int gt = C.bid * NTHREADS + C.tid, NT = C.G * NTHREADS;
    const int gw = C.bid * NWAVES + C.wave, NGW = C.G * NWAVES, lane = C.lane;
    for (int idx = gt; idx < DEPTH * 2 * 6 * D; idx += NT) {
        const int n = idx % (6 * D), l = idx / (2 * 6 * D);
        float a = C_b_mod[l * 6 * D + n];
#pragma unroll
        for (int kc = 0; kc < NKC; ++kc) a += C_MODP[(size_t)kc * (DEPTH * 2 * 6 * D) + idx];
        C_MOD[idx] = a;
    }
    LAS float* ms = (LAS float*)C.lds;
    for (int i = C.tid; i < 2 * 2 * D; i += NTHREADS) {
        const int kind = i / (2 * D), n = i % (2 * D);
        const int idx = (0 * 2 + kind) * 6 * D + n;
        float a = C_b_mod[n];
#pragma unroll
        for (int kc = 0; kc < NKC; ++kc) a += C_MODP[(size_t)kc * (DEPTH * 2 * 6 * D) + idx];
        ms[i] = a;
    }
    __syncthreads();
    for (int r = gw; r < NTOK; r += NGW) {
        const int kind = r < SEQ ? 0 : 1;
        const float* xp = xin_row(C, 0, r);
        const LAS float* sh = ms + kind * 2 * D; const LAS float* sc = sh + D;
#pragma unroll
        for (int j = 0; j < 8; ++j) {
            const int d0 = 4 * lane + 256 * j;
            const float4 xv = *(const float4*)(xp + d0);
            float4 hv; hv.x = xv.x * (1.f + sc[d0]) + sh[d0]; hv.y = xv.y * (1.f + sc[d0 + 1]) + sh[d0 + 1]; hv.z = xv.z * (1.f + sc[d0 + 2]) + sh[d0 + 2]; hv.w = xv.w * (1.f + sc[d0 + 3]) + sh[d0 + 3];
            st4(&C_H[(size_t)r * D + d0], hv);
        }
    }
}

namespace att {
using bf16x8 = __attribute__((ext_vector_type(8))) short;
using s16x4  = __attribute__((ext_vector_type(4))) short;
using f32x16 = __attribute__((ext_vector_type(16))) float;
using u32x4  = __attribute__((ext_vector_type(4))) unsigned;
constexpr int NW = 8, QBLK = 32, KVBLK = 64;
constexpr float SCALE = QSCALE, THR = 8.f;
constexpr int SHM_V = KVBLK * HD * 2, SHM_K = KVBLK * HD * 2;
constexpr int Q_OFF = 2 * SHM_V + 2 * SHM_K  , WS_OFF = 131072 + 1024, BIAS_OFF = WS_OFF + NW * 64 * 4, QSLOT_OFF = BIAS_OFF + (64 + 15 * 32 + 64) * 4, ATT_LDS = QSLOT_OFF + 16;
#define KSWZ(row, colB) ((row) * 256 + ((colB) ^ (((row) & 7) << 4)))
#define SBAR() __builtin_amdgcn_sched_barrier(0)
__device__ __forceinline__ int crow(int r, int hi) { return (r & 3) + 8 * (r >> 2) + 4 * hi; }
__device__ __forceinline__ unsigned cvtpk(float lo, float hi) { unsigned r; asm volatile("v_cvt_pk_bf16_f32 %0, %1, %2" : "=v"(r) : "v"(lo), "v"(hi)); return r; }

__device__ __forceinline__ void partialSM(f32x16& p0, f32x16& p1, float& m_reg, float& mn, float& alpha) {
  constexpr float Cc = SCALE * 1.4426950408889634f;
  float pmax = p0[0]; for (int r = 1; r < 16; ++r) pmax = fmaxf(pmax, p0[r]); for (int r = 0; r < 16; ++r) pmax = fmaxf(pmax, p1[r]);
  { auto rr = __builtin_amdgcn_permlane32_swap(__float_as_uint(pmax), __float_as_uint(pmax), false, false);
    pmax = fmaxf(__uint_as_float(rr[0]), __uint_as_float(rr[1])); }
  if (__builtin_expect(__all(pmax - m_reg <= THR / SCALE), 1)) { mn = m_reg; alpha = 1.f; }
  else { mn = fmaxf(m_reg, pmax); alpha = __builtin_amdgcn_exp2f((m_reg - mn) * Cc); m_reg = mn; }
  float mnC = -mn * Cc;
  for (int r = 0; r < 16; ++r) p0[r] = fmaf(p0[r], Cc, mnC); for (int r = 0; r < 16; ++r) p1[r] = fmaf(p1[r], Cc, mnC);
  for (int r = 0; r < 16; ++r) p0[r] = __builtin_amdgcn_exp2f(p0[r]);
}
__device__ __forceinline__ void finishSM(f32x16& p0, f32x16& p1, float alpha, float& l_reg, bf16x8& pa0, bf16x8& pa1, bf16x8& pa2, bf16x8& pa3) {
  for (int r = 0; r < 16; ++r) p1[r] = __builtin_amdgcn_exp2f(p1[r]);
  float ps = 0; for (int r = 0; r < 16; ++r) ps += p0[r]; for (int r = 0; r < 16; ++r) ps += p1[r];
  { auto rr = __builtin_amdgcn_permlane32_swap(__float_as_uint(ps), __float_as_uint(ps), false, false);
    ps = __uint_as_float(rr[0]) + __uint_as_float(rr[1]); }
  l_reg = l_reg * alpha + ps;
#define PK4(P, BASE, OUT) do { unsigned a0 = cvtpk(P[BASE + 0], P[BASE + 1]), a1 = cvtpk(P[BASE + 2], P[BASE + 3]);   \
    unsigned b0 = cvtpk(P[BASE + 4], P[BASE + 5]), b1 = cvtpk(P[BASE + 6], P[BASE + 7]);                              \
    auto r0 = __builtin_amdgcn_permlane32_swap(a0, b0, false, false); auto r1 = __builtin_amdgcn_permlane32_swap(a1, b1, false, false); \
    u32x4 w = {r0[0], r1[0], r0[1], r1[1]}; OUT = *reinterpret_cast<bf16x8*>(&w); } while (0)
  PK4(p0, 0, pa0); PK4(p0, 8, pa1); PK4(p1, 0, pa2); PK4(p1, 8, pa3);
#undef PK4
}
__device__ __forceinline__ void qkt(f32x16& p0, f32x16& p1, const LAS char* Ks, const LAS char* Qs, int r32, int hi) {
#pragma unroll
  for (int d0 = 0; d0 < 8; ++d0) { int cb = (d0 * 16 + hi * 8) * 2;
    bf16x8 b0 = *reinterpret_cast<const LAS bf16x8*>(Ks + KSWZ(r32, cb));
    bf16x8 b1 = *reinterpret_cast<const LAS bf16x8*>(Ks + KSWZ(32 + r32, cb));
    bf16x8 q = *reinterpret_cast<const LAS bf16x8*>(Qs + KSWZ(r32, cb));
    p0 = __builtin_amdgcn_mfma_f32_32x32x16_bf16(b0, q, p0, 0, 0, 0);
    p1 = __builtin_amdgcn_mfma_f32_32x32x16_bf16(b1, q, p1, 0, 0, 0); }
}
__device__ __forceinline__ int v_st(int k, int c) { const int kk = (k & ~0xC) | ((k & 4) << 1) | ((k & 8) >> 1); return ((kk >> 3) * 4 + (c >> 5)) * 512 + ((kk & 7) * 32 + (c & 31)) * 2; }
__device__ __forceinline__ int v_rd_base(int lane) { return ((lane & 3) << 3) | (((lane >> 2) & 3) << 6) | (((lane >> 4) & 1) << 5) | (((lane >> 5) & 1) << 8); }
constexpr int v_rd_off(int d0, int ks, int half) { return d0 * 512 + ks * 4096 + half * 2048; }
template <int OFF> __device__ __forceinline__ s16x4 tr_read(int vb) {
  s16x4 r; asm volatile("ds_read_b64_tr_b16 %0, %1 offset:%2" : "=&v"(r) : "v"(vb), "i"(OFF) : "memory"); return r;
}
template <int D0> __device__ __forceinline__ void pv_one(f32x16& od, int vb, bf16x8 pa0, bf16x8 pa1, bf16x8 pa2, bf16x8 pa3) {
  const s16x4 l0 = tr_read<v_rd_off(D0, 0, 0)>(vb), h0 = tr_read<v_rd_off(D0, 0, 1)>(vb), l1 = tr_read<v_rd_off(D0, 1, 0)>(vb), h1 = tr_read<v_rd_off(D0, 1, 1)>(vb);
  const s16x4 l2 = tr_read<v_rd_off(D0, 2, 0)>(vb), h2 = tr_read<v_rd_off(D0, 2, 1)>(vb), l3 = tr_read<v_rd_off(D0, 3, 0)>(vb), h3 = tr_read<v_rd_off(D0, 3, 1)>(vb);
  asm volatile("s_waitcnt lgkmcnt(0)" ::: "memory"); SBAR();
#define PK(L, H) (bf16x8){L[0], L[1], L[2], L[3], H[0], H[1], H[2], H[3]}
  od = __builtin_amdgcn_mfma_f32_32x32x16_bf16(pa0, PK(l0, h0), od, 0, 0, 0);
  od = __builtin_amdgcn_mfma_f32_32x32x16_bf16(pa1, PK(l1, h1), od, 0, 0, 0);
  od = __builtin_amdgcn_mfma_f32_32x32x16_bf16(pa2, PK(l2, h2), od, 0, 0, 0);
  od = __builtin_amdgcn_mfma_f32_32x32x16_bf16(pa3, PK(l3, h3), od, 0, 0, 0);
#undef PK
}
__device__ __forceinline__ void pv_d0(f32x16* o, int vb, bf16x8 pa0, bf16x8 pa1, bf16x8 pa2, bf16x8 pa3) {
  pv_one<0>(o[0], vb, pa0, pa1, pa2, pa3); pv_one<1>(o[1], vb, pa0, pa1, pa2, pa3); pv_one<2>(o[2], vb, pa0, pa1, pa2, pa3); pv_one<3>(o[3], vb, pa0, pa1, pa2, pa3);
}

template <int kind>
__device__ __forceinline__ void attn_unit(const bf16_t* __restrict__ P, bf16_t* __restrict__ MIX, const float* __restrict__ rpb_l, const float* __restrict__ sink_l,
                                          const int u, const int h, LAS char* lds, const int tid) {
  const int wid = __builtin_amdgcn_readfirstlane(tid >> 6), lane = tid & 63, r32 = lane & 31, hi = lane >> 5;
  LAS char* V_lds = lds; LAS char* K_lds = lds + 2 * SHM_V;
  LAS float* ws = (LAS float*)(lds + WS_OFF) + wid * 64; LAS float* li_l = ws; LAS float* al_l = ws + 32;
  LAS float* rpbs = (LAS float*)(lds + BIAS_OFF) + 64;
  constexpr bool isA = (kind == 0 || kind == 2), lat = kind < 2;
  const int qrow0 = lat ? 256 * u : SEQ;
  const int qcol = isA ? h * HD : OFF_BQ + h * HD;
  const int kcol = isA ? OFF_AK + (h / 3) * HD : OFF_BK + h * HD;
  const int vcol = isA ? OFF_AV + (h / 3) * HD : OFF_BV + h * HD;
  const int ocol = (isA ? 0 : 768) + h * HD;
  constexpr int NT = (kind == 0) ? 12 : (kind == 1) ? 16 : 4;
  int Rs = 4 * u - 4; Rs = Rs < 0 ? 0 : (Rs > 117 ? 117 : Rs);
  __syncthreads();
  if (kind == 1) for (int i = tid; i < 64 + 15 * 32 + 64; i += 512) { const int t = i - 64; rpbs[t] = (t >= 0 && t < 15 * 32 && (t & 31) < 31) ? rpb_l[h * 465 + (t >> 5) * 31 + (t & 31)] * (1.0f / SCALE) : 0.f; }
  float m_reg = -1e30f, l_reg = 0; f32x16 o[4] = {};
  LAS char* Qs = lds + Q_OFF + wid * 8192;
  { const bf16_t* Qw = P + (size_t)(qrow0 + wid * QBLK + r32) * INC + qcol + hi * 8;
#pragma unroll
    for (int d0 = 0; d0 < 8; ++d0) *reinterpret_cast<LAS bf16x8*>(Qs + KSWZ(r32, (d0 * 16 + hi * 8) * 2)) = *reinterpret_cast<const bf16x8*>(Qw + d0 * 16); }
  const int sr = tid >> 4, sc = (tid & 15) * 8, vst0 = v_st(sr, sc), vst1 = v_st(32 + sr, sc);
  const int vb0 = (int)(size_t)V_lds + v_rd_base(lane);
  const unsigned voffk = (unsigned)(sr * INC + sc + kcol) * 2u, voffk2 = voffk + 32u * INC * 2u, voffv = (unsigned)(sr * INC + sc + vcol) * 2u, voffv2 = voffv + 32u * INC * 2u;
  struct { bf16x8 vs0, vs1, ks0, ks1; } sr_[1];
#define KROW(j) (((j) < 4) ? (SEQ + 64 * (j)) : (kind == 0 ? ({ int t_ = 256 * u - 128 + 64 * ((j) - 4); t_ < 0 ? 0 : (t_ > SEQ - 64 ? SEQ - 64 : t_); }) : ({ int jj_ = (j) - 4; jj_ = jj_ > 10 ? 10 : jj_; (Rs + jj_) * 64; })))
#define SLOAD(i, j) do { const char* kb_ = (const char*)P + (size_t)KROW(j) * (INC * 2);                                             \
    sr_[i].vs0 = *reinterpret_cast<const bf16x8*>(kb_ + voffv); sr_[i].vs1 = *reinterpret_cast<const bf16x8*>(kb_ + voffv2); \
    sr_[i].ks0 = *reinterpret_cast<const bf16x8*>(kb_ + voffk); sr_[i].ks1 = *reinterpret_cast<const bf16x8*>(kb_ + voffk2); } while (0)
#define SWRITE(b, i) do { *(LAS bf16x8*)(V_lds + (b) * SHM_V + vst0) = sr_[i].vs0;          \
    *(LAS bf16x8*)(V_lds + (b) * SHM_V + vst1) = sr_[i].vs1; int kc_ = sc * 2;               \
    *(LAS bf16x8*)(K_lds + (b) * SHM_K + KSWZ(sr, kc_)) = sr_[i].ks0;                       \
    *(LAS bf16x8*)(K_lds + (b) * SHM_K + KSWZ(32 + sr, kc_)) = sr_[i].ks1; } while (0)
#define SWAIT() asm volatile("s_waitcnt vmcnt(0)" ::: "memory")
#define RESC(a) do { if (__any((a) < 1.f)) { if (hi == 0) al_l[r32] = (a); asm volatile("s_waitcnt lgkmcnt(0)" ::: "memory"); \
    for (int d = 0; d < 4; ++d) for (int r = 0; r < 16; ++r) o[d][r] *= al_l[crow(r, hi)]; } } while (0)
#define MASK(p0, p1, j) do { const int j_ = (j);                                                                                          \
    if (lat && j_ >= 4) {                                                                                                                 \
      if (kind == 0) {                                                                                                                    \
        const int t0_ = 256 * u - 128 + 64 * (j_ - 4), qw_ = 256 * u + 32 * wid;                                                          \
        const float tp_ = (t0_ < 0 || t0_ >= SEQ) ? -1e30f : 0.f;                                     \
        const float dl_ = (float)(t0_ - (qw_ + r32) + 4 * hi);                                                                            \
        _Pragma("unroll") for (int r = 0; r < 16; ++r) { const float k0_ = dl_ + (float)((r & 3) + 8 * (r >> 2)), k1_ = k0_ + 32.f;       \
          p0[r] = fmaf(fminf(0.f, 128.5f - fabsf(k0_)), 1e30f, tp_); p1[r] = fmaf(fminf(0.f, 128.5f - fabsf(k1_)), 1e30f, tp_); }         \
      } else {                                                                                                                            \
        const int kr_ = Rs + (j_ - 4), qrw_ = 4 * u + (wid >> 1); int r0_ = qrw_ - 4; r0_ = r0_ < 0 ? 0 : (r0_ > 120 ? 120 : r0_);        \
        const float tp_ = (j_ >= 15 || kr_ < r0_ || kr_ >= r0_ + 8) ? -1e30f : 0.f;           \
        int dr_ = kr_ - qrw_ + 7; dr_ = dr_ < 0 ? 0 : (dr_ > 14 ? 14 : dr_);                                                              \
        const int qc_ = (wid & 1) * 32 + r32; int c0_ = qc_ - 8; c0_ = c0_ < 0 ? 0 : (c0_ > 48 ? 48 : c0_);                               \
        const LAS float* br_ = rpbs + dr_ * 32 + (15 - qc_ + 4 * hi);                                                                     \
        const float xb_ = (float)(4 * hi - c0_) - 7.5f;                                                                                   \
        _Pragma("unroll") for (int r = 0; r < 16; ++r) { const int kk_ = (r & 3) + 8 * (r >> 2); const float x0_ = xb_ + (float)kk_, x1_ = x0_ + 32.f;   \
          p0[r] = fmaf(fminf(0.f, 7.75f - fabsf(x0_)), 1e30f, br_[kk_] + tp_); p1[r] = fmaf(fminf(0.f, 7.75f - fabsf(x1_)), 1e30f, br_[kk_ + 32] + tp_); } \
      } }                                                                                                                                 \
    else { _Pragma("unroll") for (int r = 0; r < 16; ++r) { p0[r] = 0.f; p1[r] = 0.f; } } } while (0)
  f32x16 pA0, pA1; float mnA, alA; bf16x8 pa0, pa1, pa2, pa3;
  SLOAD(0, 0); asm volatile("s_waitcnt vmcnt(0)" ::: "memory"); SWRITE(0, 0); __syncthreads();
  int jlo = 4, jhi = NT - 1;
  if (kind == 0) { const int qw_ = 32 * wid;
    jlo = 4 + (qw_ + 0) / 64; jhi = 4 + (qw_ + 31 + 256) / 64;
    const int first_ok = (256 * u - 128 < 0) ? 4 + 2 : 4, last_ok = (256 * u + 384 > SEQ) ? 4 + 5 : 4 + 7;
    jlo = jlo < first_ok ? first_ok : jlo; jhi = jhi > last_ok ? last_ok : jhi; }
  if (kind == 1) { const int qrw_ = 4 * u + (wid >> 1); int r0_ = qrw_ - 4; r0_ = r0_ < 0 ? 0 : (r0_ > 120 ? 120 : r0_); jlo = 4 + (r0_ - Rs); jhi = jlo + 7; }
#define TILE_BODY(COMPUTE) do { const int b = j & 1;                                                                    \
    if (j + 1 < NT) SLOAD(0, j + 1);                                                                                    \
    if (COMPUTE) {                                                                                                      \
      MASK(pA0, pA1, j);                                                                                                \
      SBAR(); qkt(pA0, pA1, K_lds + b * SHM_K, Qs, r32, hi);                                                            \
      partialSM(pA0, pA1, m_reg, mnA, alA);                                                                             \
      RESC(alA);                                                                                                        \
      finishSM(pA0, pA1, alA, l_reg, pa0, pa1, pa2, pa3); SBAR();                                                       \
      pv_d0(o, vb0 + b * SHM_V, pa0, pa1, pa2, pa3); }                                                                  \
    if (j + 1 < NT) { SWAIT(); SWRITE(b ^ 1, 0); }                                                                      \
    __syncthreads(); } while (0)
  int j = 0;
  for (; j < 4; ++j) TILE_BODY(true);
  if (lat) {
    for (; j < jlo; ++j) TILE_BODY(false);
    for (; j <= jhi; ++j) TILE_BODY(true);
    for (; j < NT; ++j) TILE_BODY(false);
  }
#undef TILE_BODY
  if (isA) l_reg += __builtin_amdgcn_exp2f(sink_l[h] * 1.4426950408889634f - m_reg * (SCALE * 1.4426950408889634f));
  if (hi == 0) li_l[r32] = l_reg; asm volatile("s_waitcnt lgkmcnt(0)" ::: "memory");
  float rli[16];
#pragma unroll
  for (int r = 0; r < 16; ++r) rli[r] = __builtin_amdgcn_rcpf(li_l[crow(r, hi)]);
  __syncthreads();
  LAS char* ost = lds + wid * 8192;
#pragma unroll
  for (int r = 0; r < 16; ++r) { const int orow = crow(r, hi);
#pragma unroll
    for (int d0 = 0; d0 < 4; ++d0) *(LAS bf16_t*)(ost + orow * 256 + (d0 * 32 + r32) * 2) = f2bf(o[d0][r] * rli[r]); }
  asm volatile("s_waitcnt lgkmcnt(0)" ::: "memory");
  bf16_t* Ow = MIX + (size_t)(qrow0 + wid * QBLK) * D + ocol;
#pragma unroll
  for (int i = 0; i < 8; ++i) { const int c = lane + 64 * i, row = c >> 4, c16 = c & 15;
    const u32x4 v = *(const LAS u32x4*)(ost + c * 16);
    *reinterpret_cast<u32x4*>(Ow + (size_t)row * D + c16 * 8) = v; }
#undef KROW
#undef SLOAD
#undef SWRITE
#undef SWAIT
#undef RESC
#undef MASK
}
#undef KSWZ
#undef SBAR
}

__device__ __forceinline__ void sgu_item(const Ctx& C, int l, int ch, int g) {
    typedef short bf16x8v __attribute__((ext_vector_type(8)));
    typedef float f32x4v __attribute__((ext_vector_type(4)));
    constexpr int PITCH = 272;
    LAS char* vnT = (LAS char*)C.lds;
    const int lane = C.lane, wave = C.wave;
    const int row0 = ch * 128;
    __syncthreads();
    {
        const float g0 = C_sgu_g[l * CW + g * 128 + lane], g1 = C_sgu_g[l * CW + g * 128 + 64 + lane];
        const float b0 = C_sgu_bn[l * CW + g * 128 + lane], b1 = C_sgu_bn[l * CW + g * 128 + 64 + lane];
        for (int q = wave; q < 128; q += NWAVES) {
            const AT* vp = C_P + (size_t)(row0 + q) * INC + OFF_C + CW + g * 128;
            const float a = gelu_tanh_f(ldv(vp + lane)), b = gelu_tanh_f(ldv(vp + 64 + lane));
            const float mu = wave_sum(a + b) * (1.f / 128.f);
            const float da = a - mu, db = b - mu;
            const float var = wave_sum(da * da + db * db) * (1.f / 128.f);
            const float rstd = 1.0f / sqrtf(var + LN_EPS);
            *(LAS bf16_t*)(vnT + lane * PITCH + q * 2) = f2bf(da * rstd * g0 + b0);
            *(LAS bf16_t*)(vnT + (64 + lane) * PITCH + q * 2) = f2bf(db * rstd * g1 + b1);
        }
    }
    __syncthreads();
    const int m16 = lane & 15, kg = lane >> 4;
    bf16x8v af[4];
    { const float* wp = C_sgu_w + ((size_t)(l * 4 + g) * 128 + 16 * wave + m16) * 128 + 8 * kg;
#pragma unroll
      for (int ks = 0; ks < 4; ++ks) { const float4 w0 = *(const float4*)(wp + 32 * ks), w1 = *(const float4*)(wp + 32 * ks + 4);
          uint4 pk; pk.x = pg8::cvt_pk_bf16(w0.x, w0.y); pk.y = pg8::cvt_pk_bf16(w0.z, w0.w); pk.z = pg8::cvt_pk_bf16(w1.x, w1.y); pk.w = pg8::cvt_pk_bf16(w1.z, w1.w);
          af[ks] = *reinterpret_cast<bf16x8v*>(&pk); } }
    f32x4v acc[8];
#pragma unroll
    for (int nt = 0; nt < 8; ++nt) acc[nt] = (f32x4v){0.f, 0.f, 0.f, 0.f};
#pragma unroll
    for (int nt = 0; nt < 8; ++nt)
#pragma unroll
        for (int ks = 0; ks < 4; ++ks) {
            const bf16x8v bfr = *(const LAS bf16x8v*)(vnT + (nt * 16 + m16) * PITCH + (32 * ks + 8 * kg) * 2);
            acc[nt] = __builtin_amdgcn_mfma_f32_16x16x32_bf16(af[ks], bfr, acc[nt], 0, 0, 0);
        }
#pragma unroll
    for (int reg = 0; reg < 4; ++reg) {
        const int p = 16 * wave + 4 * kg + reg;
        const float bs = C_sgu_b[(l * 4 + g) * 128 + p];
        const AT* up = C_P + (size_t)(row0 + p) * INC + OFF_C + g * 128 + m16;
        AT* op = C_MIX + (size_t)(row0 + p) * D + 1536 + g * 128 + m16;
#pragma unroll
        for (int nt = 0; nt < 8; ++nt) stv(op + 16 * nt, gelu_tanh_f(ldv(up + 16 * nt)) * (acc[nt][reg] + bs));
    }
}

constexpr int CW_MTC = 32768;
constexpr int CW_Q = 16384 + 256;
constexpr int CW_CTXDONE = 16384 + 384;
__device__ __forceinline__ void wg_wait_ge(unsigned* w, unsigned need) {
    if (threadIdx.x < 64) {
        unsigned sp = 0;
        while ((unsigned)__builtin_amdgcn_readfirstlane((int)__hip_atomic_load(w, __ATOMIC_RELAXED, __HIP_MEMORY_SCOPE_AGENT)) < need) { __builtin_amdgcn_s_sleep(2); if (++sp > (1u << 22)) break; }
        __builtin_amdgcn_fence(__ATOMIC_ACQUIRE, "agent");
        asm volatile("s_waitcnt vmcnt(0)" ::: "memory");
    }
    __syncthreads();
}
constexpr int CW_INP = 16384 + 512;
__device__ __forceinline__ void ph_mixers(const Ctx& C, int l) {
    const bool last = (l == DEPTH - 1);
    bool attn_ok = false, sgu_ok = false;
    const int nC = last ? 0 : 12, nCS = last ? 0 : 8, nB = 192, nA = 192, nG = last ? 0 : 8, nS = 256;
    const int nA1 = 256 - nC - nCS - nB > 0 ? (256 - nC - nCS - nB < nA ? 256 - nC - nCS - nB : nA) : 0;
    const int total = nC + nCS + nB + nA + nG + nS;
    LAS int* qs = (LAS int*)(C.lds + att::QSLOT_OFF);
    unsigned* ctr = C_CTLW + CW_Q + l;
    unsigned* ctxdone = C_CTLW + CW_CTXDONE;
    for (;;) {
        __syncthreads();
        if (C.tid == 0) *qs = (int)atomicAdd(ctr, 1u);
        __syncthreads();
        int r = *qs;
        if (r >= total) break;
        int kind = -1, u = 0, h = 0;
        if (r < nC) { kind = 2 + r / 6; h = r % 6; }
        else { r -= nC;
          if (r < nCS) { kind = 5; u = 64 + r / 4; h = r % 4; }
          else { r -= nCS;
            if (r < nB) { kind = 1; u = r / 6; h = r % 6; }
            else { r -= nB;
              if (r < nA1) { kind = 0; u = r / 6; h = r % 6; }
              else { r -= nA1;
                if (r < nG) { kind = 4; u = r; }
                else { r -= nG;
                  if (r < nA - nA1) { kind = 0; u = (r + nA1) / 6; h = (r + nA1) % 6; }
                  else { r -= nA - nA1; kind = 5; u = r / 4; h = r % 4; } } } } } }
        if (kind != 5 && !attn_ok) { wg_wait_ge(C_CTLW + CW_INP + l * 128, (NTOK / 256) * 14); attn_ok = true; }
        if (kind == 5 && !sgu_ok) { wg_wait_ge(C_CTLW + CW_INP + l * 128 + 64, (NTOK / 256) * 4); sgu_ok = true; }
        int t_ = threadIdx.x; asm volatile("" : "+v"(t_));
        if (kind == 1) att::attn_unit<1>(C_P, C_MIX, C_rpb + l * 6 * 465, C_sink + l * 6, u, h, (LAS char*)C.lds, t_);
        else if (kind == 0) att::attn_unit<0>(C_P, C_MIX, C_rpb + l * 6 * 465, C_sink + l * 6, u, h, (LAS char*)C.lds, t_);
        else if (kind == 2) att::attn_unit<2>(C_P, C_MIX, C_rpb + l * 6 * 465, C_sink + l * 6, u, h, (LAS char*)C.lds, t_);
        else if (kind == 3) att::attn_unit<3>(C_P, C_MIX, C_rpb + l * 6 * 465, C_sink + l * 6, u, h, (LAS char*)C.lds, t_);
        else if (kind == 5) { Ctx C2 = C; C2.tid = t_; C2.lane = t_ & 63; C2.wave = __builtin_amdgcn_readfirstlane(t_ >> 6); sgu_item(C2, l, u, h); }
        else {
            if (t_ < 64) {
                unsigned sp = 0;
                while (__builtin_amdgcn_readfirstlane((int)__hip_atomic_load(ctxdone, __ATOMIC_RELAXED, __HIP_MEMORY_SCOPE_AGENT)) < nC + nCS) { __builtin_amdgcn_s_sleep(2); if (++sp > (1u << 22)) break; }
                __builtin_amdgcn_fence(__ATOMIC_ACQUIRE, "agent");
                asm volatile("s_waitcnt vmcnt(0)" ::: "memory");
            }
            __syncthreads();
            pg8::Unit uu; uu.pm = SEQ / 256; uu.pn = u; uu.A = (const char*)(C_MIX + (size_t)SEQ * D); uu.B = (const char*)(C_WOUT + (size_t)l * D * D + (size_t)u * 256 * D);
            pg8::OneUnit S{uu};
            pg8::EpiTres E{C_T, C_x, C_ctx, modp(C, l, 0, 2), modp(C, l, 1, 2)};
            pg8::gemm_phase<D>(C.lds, S, E);
        }
        if (kind == 2 || kind == 3 || (kind == 5 && u >= 64)) {
            asm volatile("s_waitcnt vmcnt(0)" ::: "memory");
            __syncthreads();
            if (threadIdx.x == 0) { __builtin_amdgcn_fence(__ATOMIC_RELEASE, "agent"); asm volatile("s_waitcnt vmcnt(0)" ::: "memory"); __hip_atomic_fetch_add(ctxdone, 1u, __ATOMIC_RELAXED, __HIP_MEMORY_SCOPE_AGENT); }
        }
    }
}

constexpr int WS_POS_OFF = 3 * 1024 * 1024 + 768 * 1024;
#define C_POS ((int*)(C.ws + C.z + WS_POS_OFF))
__device__ __forceinline__ void ph_ln1(const Ctx& C, int l) {
    const bool last = (l == DEPTH - 1);
    const int nrows = last ? SEQ : NTOK;
    const int RPB = __builtin_amdgcn_readfirstlane((nrows + C.G - 1) / C.G);
    const int row_lo = __builtin_amdgcn_readfirstlane(C.bid * RPB), row_hi = __builtin_amdgcn_readfirstlane((row_lo + RPB < nrows) ? row_lo + RPB : nrows);
    const int lane = C.lane, wave = C.wave, tid = C.tid;
    LAS float* wch = (LAS float*)(C.lds + 65536);
    constexpr int WCH = 256 * 36 + 4 * 256;
    LAS int* hist = (LAS int*)(C.lds + 65536 + 2 * WCH * 4);
    LAS int* rinfo = hist + 64;
    LAS int* rrank = rinfo + 256;
    LAS float* hrow = (LAS float*)C.lds + wave * D;
    const float* gam = C_ln1_g + l * D; const float* bet = C_ln1_b + l * D;
    if (tid < 32) hist[tid] = 0;
#define LDCH(j_) do { _Pragma("unroll") for (int t = 0; t < 4; ++t) { const int t4 = tid + 512 * t; pre[t] = *(const pg8::f32x4*)(C_w_router + (size_t)(256 * (j_)) * NE + t4 * 4); } \
        if (tid < 256) { const float* vs_ = (tid < 64) ? gam : (tid < 128) ? bet : (tid < 192) ? modp(C, l, 0, 4) : modp(C, l, 0, 3);     \
            pre[4] = *(const pg8::f32x4*)(vs_ + 256 * (j_) + (tid & 63) * 4); } } while (0)
#define STCH(buf_) do { _Pragma("unroll") for (int t = 0; t < 4; ++t) { const int t4 = tid + 512 * t, dl = t4 >> 3, e4 = t4 & 7; *(LAS pg8::f32x4*)(wch + (buf_) * WCH + ((dl & 3) * 64 + (dl >> 2)) * 36 + e4 * 4) = pre[t]; } \
        if (tid < 256) *(LAS pg8::f32x4*)(wch + (buf_) * WCH + 256 * 36 + tid * 4) = pre[4]; } while (0)
    pg8::f32x4 pre[5];
    int step = 0;
    LDCH(0); STCH(0); __syncthreads();
    for (int rnd = 0; row_lo + rnd * NWAVES < row_hi; ++rnd) {
        const int r = row_lo + rnd * NWAVES + wave;
        const bool valid = r < row_hi;
        const int kind = r < SEQ ? 0 : 1;
        float v[32]; float mu = 0.f, rstd = 0.f;
        if (valid) {
            const float* tp = C_T + (size_t)r * D; float sm = 0.f;
#pragma unroll
            for (int j = 0; j < 8; ++j) { const float4 t4 = *(const float4*)(tp + 4 * lane + 256 * j); v[4 * j] = t4.x; v[4 * j + 1] = t4.y; v[4 * j + 2] = t4.z; v[4 * j + 3] = t4.w; sm += (t4.x + t4.y) + (t4.z + t4.w); }
            mu = wave_sum(sm) * (1.f / D);
            float q = 0.f;
#pragma unroll
            for (int k = 0; k < 32; ++k) { v[k] -= mu; q += v[k] * v[k]; }
            rstd = 1.0f / sqrtf(wave_sum(q) * (1.f / D) + LN_EPS);
#pragma unroll
            for (int j = 0; j < 8; ++j) *(LAS pg8::f32x4*)(hrow + 4 * lane + 256 * j) = (pg8::f32x4){v[4 * j], v[4 * j + 1], v[4 * j + 2], v[4 * j + 3]};
        }
        const float* sc2 = modp(C, l, kind, 4); const float* sh2 = modp(C, l, kind, 3);
        float acc[32];
#pragma unroll
        for (int e = 0; e < 32; ++e) acc[e] = 0.f;
#pragma unroll 1
        for (int j = 0; j < 8; ++j) {
            const bool more = (j < 7) || (row_lo + (rnd + 1) * NWAVES < row_hi);
            if (more) LDCH((j + 1) & 7);
            const LAS float* wcur = wch + (step & 1) * WCH;
            float h2c[4];
            if (valid) {
                const int d0 = 4 * lane + 256 * j;
                const LAS float* vec = wcur + 256 * 36 + 4 * lane;
                const pg8::f32x4 g4 = *(const LAS pg8::f32x4*)(vec), b4 = *(const LAS pg8::f32x4*)(vec + 256);
                pg8::f32x4 sc4 = *(const LAS pg8::f32x4*)(vec + 512), sh4 = *(const LAS pg8::f32x4*)(vec + 768);
                if (kind) { sc4 = *(const pg8::f32x4*)(sc2 + d0); sh4 = *(const pg8::f32x4*)(sh2 + d0); }
                const pg8::f32x4 vc = *(const LAS pg8::f32x4*)(hrow + d0);
                float4 x1, h2;
                x1.x = vc[0] * rstd * g4[0] + b4[0]; x1.y = vc[1] * rstd * g4[1] + b4[1]; x1.z = vc[2] * rstd * g4[2] + b4[2]; x1.w = vc[3] * rstd * g4[3] + b4[3];
                h2.x = x1.x * (1.f + sc4[0]) + sh4[0]; h2.y = x1.y * (1.f + sc4[1]) + sh4[1]; h2.z = x1.z * (1.f + sc4[2]) + sh4[2]; h2.w = x1.w * (1.f + sc4[3]) + sh4[3];
                *(float4*)(C_X1 + (size_t)r * D + d0) = x1;
                st4(&C_H2[(size_t)r * D + d0], h2);
                h2c[0] = h2.x; h2c[1] = h2.y; h2c[2] = h2.z; h2c[3] = h2.w;
            } else { h2c[0] = 0.f; h2c[1] = 0.f; h2c[2] = 0.f; h2c[3] = 0.f; }
#pragma unroll
            for (int c = 0; c < 4; ++c) {
                float wv[32];
#pragma unroll
                for (int e4 = 0; e4 < 8; ++e4) { const pg8::f32x4 w4 = *(const LAS pg8::f32x4*)(wcur + (c * 64 + lane) * 36 + e4 * 4); wv[4 * e4] = w4[0]; wv[4 * e4 + 1] = w4[1]; wv[4 * e4 + 2] = w4[2]; wv[4 * e4 + 3] = w4[3]; }
#pragma unroll
                for (int e = 0; e < 32; ++e) acc[e] += h2c[c] * wv[e];
                __builtin_amdgcn_sched_barrier(0);
            }
            if (more) STCH((step + 1) & 1);
            ++step;
            __syncthreads();
        }
#pragma unroll
        for (int k = 0; k < 5; ++k) { const int half = 16 >> k; const bool up = (lane >> k) & 1;
#pragma unroll
            for (int t = 0; t < half; ++t) { const float keep = up ? acc[t + half] : acc[t]; const float send = up ? acc[t] : acc[t + half];
                acc[t] = keep + __shfl_xor(send, 1 << k); } }
        const float mine = acc[0] + __shfl_xor(acc[0], 32);
        float lg[32];
#pragma unroll
        for (int e = 0; e < 32; ++e) { const int src = ((e & 1) << 4) | ((e & 2) << 2) | (e & 4) | ((e & 8) >> 2) | ((e & 16) >> 4);
            lg[e] = __int_as_float(__builtin_amdgcn_readlane(__float_as_int(mine), src)); }
        if (valid && lane == 0) {
            float bestgs = -3.0e38f; int be0 = 0, be1 = 0; float bw0 = 0.f, bw1 = 0.f;
#pragma unroll
            for (int gq2 = 0; gq2 < 4; ++gq2) {
                float m1 = -3.0e38f, m2 = -3.0e38f, s1 = 0.f, s2 = 0.f; int i1 = 0, i2 = 0;
#pragma unroll
                for (int t = 0; t < 8; ++t) {
                    const int e = gq2 * 8 + t;
                    const float scv = 1.f / (1.f + expf(-lg[e])), bv = scv + C_router_bias[e];
                    if (bv > m1) { m2 = m1; i2 = i1; s2 = s1; m1 = bv; i1 = e; s1 = scv; }
                    else if (bv > m2) { m2 = bv; i2 = e; s2 = scv; }
                }
                const float gs = m1 + m2;
                if (gs > bestgs) { bestgs = gs; be0 = i1; be1 = i2; bw0 = s1; bw1 = s2; }
            }
            const float inv = 1.f / (bw0 + bw1);
            LAS int* ri = rinfo + (r - row_lo) * 4;
            ri[0] = be0; ri[1] = be1; ri[2] = __float_as_int(bw0 * inv); ri[3] = __float_as_int(bw1 * inv);
        }
    }
#undef LDCH
#undef STCH
    const int nb = row_hi - row_lo;
    __syncthreads();
    int e_mine = 0;
    if (tid < 2 * nb) { e_mine = rinfo[(tid >> 1) * 4 + (tid & 1)]; rrank[tid] = (int)__hip_atomic_fetch_add((LAS unsigned*)(hist + e_mine), 1u, __ATOMIC_RELAXED, __HIP_MEMORY_SCOPE_WORKGROUP); }
    __syncthreads();
    if (tid < 32) { const int cnt = hist[tid]; hist[32 + tid] = cnt ? (int)atomicAdd(C_CTLW + CW_CNT + l * 32 + tid, (unsigned)cnt) : 0; }
    __syncthreads();
    if (tid < 2 * nb) {
        const int r = row_lo + (tid >> 1), k = tid & 1;
        C_POS[(size_t)r * 2 + k] = hist[32 + e_mine] + rrank[tid];
        int* rp = C_ROUTE + (size_t)r * 4;
        rp[k] = e_mine; rp[2 + k] = rinfo[(tid >> 1) * 4 + 2 + k];
    }
}

constexpr int TOFF_OFF = 131072;
__device__ __forceinline__ void compute_toff(const Ctx& C, int l) {
    LAS int* toff = (LAS int*)(C.lds + TOFF_OFF);
    __syncthreads();
    if (C.tid == 0) { int acc = 0;
        for (int e = 0; e < NE; ++e) { toff[e] = acc; acc += ((int)__hip_atomic_load(C_CTLW + CW_CNT + l * 32 + e, __ATOMIC_RELAXED, __HIP_MEMORY_SCOPE_AGENT) + 255) >> 8; }
        toff[NE] = acc; }
    __syncthreads();
}
__device__ __forceinline__ void ph_dispatch(const Ctx& C, int l) {
    const bool last = (l == DEPTH - 1);
    const int nrows = last ? SEQ : NTOK;
    const int gw = C.bid * NWAVES + C.wave, NGW = C.G * NWAVES, lane = C.lane;
    compute_toff(C, l);
    const LAS int* toff = (const LAS int*)(C.lds + TOFF_OFF);
    for (int it = gw; it < nrows * 2; it += NGW) {
        const int r = it >> 1, k = it & 1;
        const int e = C_ROUTE[(size_t)r * 4 + k];
        const int slot = toff[e] * 256 + C_POS[it];
        if (lane == 0) { C_SLOT[it] = slot; C_SW[slot] = __int_as_float(C_ROUTE[(size_t)r * 4 + 2 + k]); }
        const uint4* src = (const uint4*)(C_H2 + (size_t)r * D); uint4* dst = (uint4*)(C_HS + (size_t)slot * D);
#pragma unroll
        for (int j = 0; j < 4; ++j) dst[lane + 64 * j] = src[lane + 64 * j];
    }
}

__device__ __forceinline__ void ph_ln2(const Ctx& C, int l) {
    const bool last = (l == DEPTH - 1);
    const int nrows = last ? SEQ : NTOK;
    const int gw = C.bid * NWAVES + C.wave, NGW = C.G * NWAVES, lane = C.lane;
    LAS float* vec0 = (LAS float*)C.lds;
    {
        const int ln = last ? l : l + 1;
#pragma unroll
        for (int k = 0; k < 2; ++k) {
            *(LAS pg8::f32x4*)(vec0 + (k * 5 + 0) * D + 4 * C.tid) = *(const pg8::f32x4*)(modp(C, l, k, 5) + 4 * C.tid);
            *(LAS pg8::f32x4*)(vec0 + (k * 5 + 1) * D + 4 * C.tid) = *(const pg8::f32x4*)(C_ln2_g + l * D + 4 * C.tid);
            *(LAS pg8::f32x4*)(vec0 + (k * 5 + 2) * D + 4 * C.tid) = *(const pg8::f32x4*)(C_ln2_b + l * D + 4 * C.tid);
            *(LAS pg8::f32x4*)(vec0 + (k * 5 + 3) * D + 4 * C.tid) = *(const pg8::f32x4*)(modp(C, ln, k, 1) + 4 * C.tid);
            *(LAS pg8::f32x4*)(vec0 + (k * 5 + 4) * D + 4 * C.tid) = *(const pg8::f32x4*)(modp(C, ln, k, 0) + 4 * C.tid);
        }
        __syncthreads();
    }
    for (int r = gw; r < nrows; r += NGW) {
        const LAS float* vec = vec0 + (r < SEQ ? 0 : 5 * D);
        const int s0 = C_SLOT[2 * r], s1 = C_SLOT[2 * r + 1];
        float4 xv[8]; uint2 ya[8], yb[8];
#pragma unroll
        for (int j = 0; j < 8; ++j) { const int d0 = 4 * lane + 256 * j;
            xv[j] = *(const float4*)(C_X1 + (size_t)r * D + d0); ya[j] = *(const uint2*)(C_Y + (size_t)s0 * D + d0); yb[j] = *(const uint2*)(C_Y + (size_t)s1 * D + d0); }
        float v[32]; float s = 0.f;
#pragma unroll
        for (int j = 0; j < 8; ++j) { const int d0 = 4 * lane + 256 * j;
            const pg8::f32x4 g4 = *(const LAS pg8::f32x4*)(vec + d0);
            const float y0 = __uint_as_float(ya[j].x << 16) + __uint_as_float(yb[j].x << 16), y1 = __uint_as_float(ya[j].x & 0xffff0000u) + __uint_as_float(yb[j].x & 0xffff0000u);
            const float y2 = __uint_as_float(ya[j].y << 16) + __uint_as_float(yb[j].y << 16), y3 = __uint_as_float(ya[j].y & 0xffff0000u) + __uint_as_float(yb[j].y & 0xffff0000u);
            v[4 * j + 0] = ALPHA * xv[j].x + g4[0] * y0; v[4 * j + 1] = ALPHA * xv[j].y + g4[1] * y1; v[4 * j + 2] = ALPHA * xv[j].z + g4[2] * y2; v[4 * j + 3] = ALPHA * xv[j].w + g4[3] * y3;
            s += (v[4 * j] + v[4 * j + 1]) + (v[4 * j + 2] + v[4 * j + 3]); }
        const float mu = wave_sum(s) * (1.f / D);
        float q = 0.f;
#pragma unroll
        for (int i = 0; i < 32; ++i) { v[i] -= mu; q += v[i] * v[i]; }
        const float rstd = 1.0f / sqrtf(wave_sum(q) * (1.f / D) + LN_EPS);
#pragma unroll
        for (int j = 0; j < 8; ++j) { const int d0 = 4 * lane + 256 * j;
            const pg8::f32x4 g4 = *(const LAS pg8::f32x4*)(vec + D + d0), b4 = *(const LAS pg8::f32x4*)(vec + 2 * D + d0);
            float4 xo;
            xo.x = v[4 * j + 0] * rstd * g4[0] + b4[0]; xo.y = v[4 * j + 1] * rstd * g4[1] + b4[1]; xo.z = v[4 * j + 2] * rstd * g4[2] + b4[2]; xo.w = v[4 * j + 3] * rstd * g4[3] + b4[3];
            if (last) *(float4*)(C.out + C.z + (size_t)r * D + d0) = xo;
            else {
                *(float4*)(C_XB + (size_t)r * D + d0) = xo;
                const pg8::f32x4 sc4 = *(const LAS pg8::f32x4*)(vec + 3 * D + d0), sh4 = *(const LAS pg8::f32x4*)(vec + 4 * D + d0);
                float4 hn; hn.x = xo.x * (1.f + sc4[0]) + sh4[0]; hn.y = xo.y * (1.f + sc4[1]) + sh4[1]; hn.z = xo.z * (1.f + sc4[2]) + sh4[2]; hn.w = xo.w * (1.f + sc4[3]) + sh4[3];
                st4(&C_H[(size_t)r * D + d0], hn);
            }
        }
    }
}

__device__ __forceinline__ Ctx fresh(const Ctx& C0) { Ctx C = C0; size_t z = 0; int t = threadIdx.x; int g_ = gridDim.x, b_ = blockIdx.x; asm volatile("" : "+s"(z), "+v"(t), "+s"(g_), "+s"(b_)); C.G = g_; C.bid = b_; C.z = z; C.tid = t; C.lane = t & 63; C.wave = __builtin_amdgcn_readfirstlane(t >> 6); return C; }
constexpr int PH_PER_LAYER = 7;
constexpr int N_PHASES = 2 + PH_PER_LAYER * DEPTH;
__global__ void __launch_bounds__(NTHREADS, 2) fwd_kernel(Args args) {
    extern __shared__ __attribute__((aligned(16))) unsigned char lds_raw[];
    Ctx C0;
    C0.lds = (LAS unsigned char*)lds_raw;
    C0.tid = threadIdx.x; C0.lane = C0.tid & 63; C0.wave = __builtin_amdgcn_readfirstlane(C0.tid >> 6); C0.G = gridDim.x; C0.bid = blockIdx.x;
    C0.in = args.in; C0.out = args.out; C0.ws = args.ws; C0.z = 0;
    unsigned char* ws = args.ws;

    volatile LAS unsigned* bst = (volatile LAS unsigned*)(C0.lds + LDS_BYTES - 16);
    if (C0.tid < 4) bst[C0.tid] = 0u;
    __syncthreads();
    const int lo = args.ph_lo, hi = args.ph_hi;
    XcdBarrier bar; bar.bar = (unsigned*)(ws + WS_CTL) + CW_BAR; bar.x = 0; bar.st = bst;
    if (hi - lo > 1) bar = xcd_barrier_post((unsigned*)(ws + WS_CTL) + CW_BAR, bst);
#define IN(k) (lo <= (k) && (k) < hi)
#define SEAM(k) do { if (IN(k) && IN((k) + 1)) xcd_barrier(bar); } while (0)

    if (IN(0)) { const Ctx C = fresh(C0); ph_prologue(C); } SEAM(0);
    if (IN(1)) { const Ctx C = fresh(C0); ph_modulate0(C); } SEAM(1);
#pragma unroll 1
    for (int l = 0; l < DEPTH; ++l) {
        const int pb = 2 + PH_PER_LAYER * l;
        const bool last = (l == DEPTH - 1);
        if (IN(pb + 0)) {
            const Ctx C = fresh(C0);
            const int vid = (C.G % 8 == 0) ? (C.bid % 8) * (C.G / 8) + C.bid / 8 : C.bid;
            pg8::InprojSched S{C.G, vid, (const char*)C_H, (const char*)(C_WIN + (size_t)l * INC * D), C_CTLW + CW_INP + l * 128};
            pg8::EpiP E{C_P, C_ROPE};
            pg8::gemm_phase<D>(C.lds, S, E);
        }
        if (IN(pb + 1)) { const Ctx C = fresh(C0); ph_mixers(C, l); } SEAM(pb + 1);
        if (IN(pb + 2)) {
            const Ctx C = fresh(C0);
            pg8::DenseSched<D / 256, D> S{SEQ / 256, C.G, C.bid, (const char*)C_MIX, (const char*)(C_WOUT + (size_t)l * D * D)};
            pg8::EpiTres E{C_T, l == 0 ? C_x : C_XB, l == 0 ? C_ctx : C_XB + (size_t)SEQ * D, modp(C, l, 0, 2), modp(C, l, 1, 2)};
            pg8::gemm_phase<D>(C.lds, S, E);
        }
        SEAM(pb + 2);
        if (IN(pb + 3)) { const Ctx C = fresh(C0); ph_ln1(C, l); } SEAM(pb + 3);
        if (IN(pb + 4)) { const Ctx C = fresh(C0); ph_dispatch(C, l); } SEAM(pb + 4);
        if (IN(pb + 5)) {
            const Ctx C = fresh(C0);
            compute_toff(C, l);
            const int vid = (C.G % 8 == 0) ? (C.bid % 8) * (C.G / 8) + C.bid / 8 : C.bid;
            unsigned* mtc = C_CTLW + CW_MTC + l * (128 * 64);
            { pg8::MoeSched1 S{(const LAS int*)(C.lds + TOFF_OFF), C.G, vid, (const char*)C_HS, (const char*)(C_WGU + (size_t)l * NE * 1024 * D), mtc};
              pg8::EpiMoe1 E{C_HID, C_SW};
              pg8::gemm_phase<D>(C.lds, S, E); }
            { pg8::MoeSched2 S{(const LAS int*)(C.lds + TOFF_OFF), C.G, vid, (const char*)C_HID, (const char*)(C_WD + (size_t)l * NE * D * FF), mtc};
              pg8::EpiBf16 E{C_Y, D};
              pg8::gemm_phase<FF>(C.lds, S, E); }
        }
        SEAM(pb + 5);
        if (IN(pb + 6)) { const Ctx C = fresh(C0); ph_ln2(C, l); }
        if (!last) SEAM(pb + 6);
    }
#undef IN
#undef SEAM
}

#ifndef MK_N_LAUNCHES
#define MK_N_LAUNCHES 1
#endif
extern "C" void kernel_launch(void* const* d_in, const int* in_sizes, int n_in, void* d_out, int out_size, void* d_ws, size_t ws_size, hipStream_t stream) {
    static int grid = 0;
    if (grid == 0) {
        if (n_in != 23 || out_size != SEQ * D || ws_size < WS_END) {
            fprintf(stderr, "kernel_launch: unexpected shapes: n_in %d out %d ws %zu (need %zu)\n", n_in, out_size, ws_size, (size_t)WS_END); grid = -1; return; }
        int dev = 0, cus = 0;
        if (hipGetDevice(&dev) != hipSuccess || hipDeviceGetAttribute(&cus, hipDeviceAttributeMultiprocessorCount, dev) != hipSuccess) { grid = -1; return; }
        if (hipFuncSetAttribute((const void*)fwd_kernel, hipFuncAttributeMaxDynamicSharedMemorySize, LDS_BYTES) != hipSuccess) { fprintf(stderr, "kernel_launch: hipFuncSetAttribute failed\n"); grid = -1; return; }
        int per_cu = 0;
        if (hipOccupancyMaxActiveBlocksPerMultiprocessor(&per_cu, (const void*)fwd_kernel, NTHREADS, LDS_BYTES) != hipSuccess || per_cu < 1) fprintf(stderr, "kernel_launch: occupancy query says %d\n", per_cu);
        (void)hipGetLastError();
        grid = cus;
    }
    if (grid < 0) return;
    hipMemsetAsync((char*)d_ws + WS_CTL, 0, CTL_BYTES, stream);
    Args a{};
    for (int i = 0; i < 23; ++i) a.in[i] = (const float*)d_in[i];
    a.out = (float*)d_out; a.ws = (unsigned char*)d_ws;
    if (MK_N_LAUNCHES == 1) {
        a.ph_lo = 0; a.ph_hi = N_PHASES;
        hipLaunchKernelGGL(fwd_kernel, dim3(grid), dim3(NTHREADS), LDS_BYTES, stream, a);
    } else {
        for (int p = 0; p < N_PHASES; ++p) {
            a.ph_lo = p; a.ph_hi = p + 1;
            hipLaunchKernelGGL(fwd_kernel, dim3(grid), dim3(NTHREADS), LDS_BYTES, stream, a);
        }
    }
    const hipError_t le = hipPeekAtLastError();
    if (le != hipSuccess) fprintf(stderr, "kernel_launch: launch failed: %s\n", hipGetErrorName(le));
}
```

```cpp
#include <hip/hip_runtime.h>
#include <cstdio>
#include <cstdint>

#define LAS __attribute__((address_space(3)))
typedef unsigned short bf16_t;

constexpr int D = 2048, SEQ = 8192, CTXL = 256, NTOK = SEQ + CTXL;
constexpr int DEPTH = 2, GRID_W = 64, HD = 128;
constexpr int INC = 4608;
constexpr int OFF_AK = 768, OFF_AV = 1024, OFF_BQ = 1280, OFF_BK = 2048, OFF_BV = 2816, OFF_C = 3584;
constexpr int NE = 32, FF = 512, CW = 512;
constexpr float LN_EPS = 1e-5f;
constexpr float ALPHA = 1.4142135623730951f;
constexpr float QSCALE = 0.08838834764831845f;
constexpr int NTHREADS = 512, NWAVES = 8;

typedef bf16_t AT;
__device__ __forceinline__ float ldv(const float* p) { return *p; }
__device__ __forceinline__ void stv(float* p, float v) { *p = v; }
__device__ __forceinline__ float bf2f(bf16_t b) { return __uint_as_float(((unsigned)b) << 16); }
__device__ __forceinline__ bf16_t f2bf(float f) { unsigned u = __float_as_uint(f); return (bf16_t)((u + 0x7fffu + ((u >> 16) & 1u)) >> 16); }
__device__ __forceinline__ float ldv(const bf16_t* p) { return bf2f(*p); }
__device__ __forceinline__ void stv(bf16_t* p, float v) { *p = f2bf(v); }

__device__ __forceinline__ float4 ld4(const float* p) { return *(const float4*)p; }
__device__ __forceinline__ void st4(float* p, float4 v) { *(float4*)p = v; }
__device__ __forceinline__ float4 ld4(const bf16_t* p) { const uint2 u = *(const uint2*)p; float4 r; r.x = __uint_as_float(u.x << 16); r.y = __uint_as_float(u.x & 0xffff0000u); r.z = __uint_as_float(u.y << 16); r.w = __uint_as_float(u.y & 0xffff0000u); return r; }
__device__ __forceinline__ void st4(bf16_t* p, float4 v) { uint2 u; u.x = (unsigned)f2bf(v.x) | ((unsigned)f2bf(v.y) << 16); u.y = (unsigned)f2bf(v.z) | ((unsigned)f2bf(v.w) << 16); *(uint2*)p = u; }

constexpr size_t MiB = 1u << 20;
constexpr size_t WS_CTL = 0, CTL_BYTES = 1 * MiB;
constexpr int CW_BAR = 4096, CW_CNT = 16384, CW_CUR = 16384 + 128;
constexpr size_t WS_MOD = 1 * MiB;
constexpr size_t WS_ROPE = 2 * MiB;
constexpr size_t WS_ROUTE = 3 * MiB;
constexpr size_t WS_SLOT = 3 * MiB + 512 * 1024;
constexpr size_t WS_SW = 4 * MiB;
constexpr size_t WS_WRT = 4 * MiB + 512 * 1024;
constexpr size_t WS_MODP = 5 * MiB;
constexpr int MAXSLOT = 25088;
constexpr size_t WS_WIN = 8 * MiB;
constexpr size_t WS_WOUT = 44 * MiB;
constexpr size_t WS_WGU = 64 * MiB;
constexpr size_t WS_WD = 320 * MiB;
constexpr size_t WS_H = 448 * MiB;
constexpr size_t WS_P = 482 * MiB;
constexpr size_t WS_MIX = 558 * MiB;
constexpr size_t WS_T = 592 * MiB;
constexpr size_t WS_X1 = 660 * MiB;
constexpr size_t WS_XB = 728 * MiB;
constexpr size_t WS_H2 = 796 * MiB;
constexpr size_t WS_HS = 830 * MiB;
constexpr size_t WS_HID = 930 * MiB;
constexpr size_t WS_Y = 956 * MiB;
constexpr size_t WS_END = 1056 * MiB;

constexpr int LDS_BYTES = 163840;

#define XB_TMO      128
#define XB_XCNT(j)  (256  + 64 * (j))
#define XB_XSUB(j)  (1280 + 64 * (j))
#define XB_XGEN(j)  (2304 + 64 * (j))
#define XB_TOP      3328
#define XB_TOPGEN   3392
#define XCD_BAR_WORDS 3456
#define XB_SPIN_CAP (1u << 18)
__device__ __forceinline__ unsigned xb_ld(unsigned* p)              { return __hip_atomic_load(p, __ATOMIC_RELAXED, __HIP_MEMORY_SCOPE_AGENT); }
__device__ __forceinline__ unsigned xb_add(unsigned* p, unsigned v) { return __hip_atomic_fetch_add(p, v, __ATOMIC_RELAXED, __HIP_MEMORY_SCOPE_AGENT); }
__device__ __forceinline__ unsigned xb_xcc_id() { return (unsigned)__builtin_amdgcn_s_getreg((3 << 11) | 20) & 0xFu; }
#define XB_SPIN(cond, bar) do { unsigned _sp = 0; while (cond) { __builtin_amdgcn_s_sleep(1); \
    if ((++_sp & 255u) == 0u) { if (xb_ld(&(bar)[XB_TMO])) break; if (_sp > XB_SPIN_CAP) { atomicAdd(&(bar)[XB_TMO], 1u); break; } } } } while (0)
struct XcdBarrier { unsigned* bar; unsigned x; volatile LAS unsigned* st; };
__device__ __forceinline__ XcdBarrier xcd_barrier_post(unsigned* bar, volatile LAS unsigned* st) {
    XcdBarrier b; b.bar = bar; b.x = xb_xcc_id(); b.st = st;
    if (threadIdx.x == 0) (void)xb_add(&bar[XB_XCNT(b.x)], 1u);
    return b;
}
__device__ __forceinline__ void xcd_barrier_complete(unsigned* bar, unsigned x, unsigned& nloc, unsigned& nx) {
    const unsigned G = gridDim.x * gridDim.y * gridDim.z;
    unsigned sum, cnt, mine, sp = 0u;
    for (;;) {
        sum = 0u; cnt = 0u; mine = 0u;
#pragma unroll
        for (unsigned j = 0; j < 16; ++j) { const unsigned c = xb_ld(&bar[XB_XCNT(j)]); sum += c; cnt += (c > 0u) ? 1u : 0u; mine = (j == x) ? c : mine; }
        if (sum == G) break;
        __builtin_amdgcn_s_sleep(1);
        if ((++sp & 255u) == 0u) { if (xb_ld(&bar[XB_TMO])) break; if (sp > XB_SPIN_CAP) { atomicAdd(&bar[XB_TMO], 1u); break; } }
    }
    nloc = mine > 0u ? mine : 1u; nx = cnt > 0u ? cnt : 1u;
}
__device__ __noinline__ void xcd_barrier(const XcdBarrier b) {
    asm volatile("s_waitcnt vmcnt(0)" ::: "memory");
    __syncthreads();
    if (threadIdx.x == 0) {
        unsigned* bar = b.bar;
        __builtin_amdgcn_s_waitcnt(0);
        unsigned nloc = b.st[0], nx = b.st[1];
        if (nloc == 0u) { xcd_barrier_complete(bar, b.x, nloc, nx); b.st[0] = nloc; b.st[1] = nx; }
        const unsigned old = xb_add(&bar[XB_XSUB(b.x)], 1u);
        const unsigned gen = old / nloc;
        if (old + 1u == (gen + 1u) * nloc) {
            __builtin_amdgcn_fence(__ATOMIC_RELEASE, "agent");
            asm volatile("s_waitcnt vmcnt(0)" ::: "memory");
            const unsigned og = xb_add(&bar[XB_TOP], 1u);
            const unsigned tg = og / nx;
            if (og + 1u == (tg + 1u) * nx) xb_add(&bar[XB_TOPGEN], 1u);
            else XB_SPIN(xb_ld(&bar[XB_TOPGEN]) == tg, bar);
            __builtin_amdgcn_fence(__ATOMIC_ACQUIRE, "agent");
            xb_add(&bar[XB_XGEN(b.x)], 1u);
            asm volatile("s_waitcnt vmcnt(0)" ::: "memory");
        } else {
            XB_SPIN(xb_ld(&bar[XB_XGEN(b.x)]) == gen, bar);
            __builtin_amdgcn_fence(__ATOMIC_ACQUIRE, "agent");
            asm volatile("s_waitcnt vmcnt(0)" ::: "memory");
        }
    }
    __syncthreads();
}

struct Args {
    const float* in[23];
    float* out;
    unsigned char* ws;
    int ph_lo, ph_hi;
};

struct Ctx {
    LAS unsigned char* lds;
    int tid, lane, wave, G, bid;
    const float* const* in;
    float* out;
    unsigned char* ws;
    size_t z;
};
#define CIN(k) (C.in[k] + C.z)
#define C_x CIN(0)
#define C_c CIN(1)
#define C_ctx CIN(2)
#define C_c_ctx CIN(3)
#define C_w_mod CIN(4)
#define C_b_mod CIN(5)
#define C_w_in CIN(6)
#define C_sink CIN(7)
#define C_rpb CIN(8)
#define C_sgu_g CIN(9)
#define C_sgu_bn CIN(10)
#define C_sgu_w CIN(11)
#define C_sgu_b CIN(12)
#define C_w_out CIN(13)
#define C_ln1_g CIN(14)
#define C_ln1_b CIN(15)
#define C_w_router CIN(16)
#define C_router_bias CIN(17)
#define C_w_gate CIN(18)
#define C_w_up CIN(19)
#define C_w_down CIN(20)
#define C_ln2_g CIN(21)
#define C_ln2_b CIN(22)
#define C_MOD ((float*)(C.ws + C.z + WS_MOD))
#define C_ROPE ((float*)(C.ws + C.z + WS_ROPE))
#define C_ROUTE ((int*)(C.ws + C.z + WS_ROUTE))
#define C_H ((AT*)(C.ws + C.z + WS_H))
#define C_P ((AT*)(C.ws + C.z + WS_P))
#define C_MIX ((AT*)(C.ws + C.z + WS_MIX))
#define C_T ((float*)(C.ws + C.z + WS_T))
#define C_X1 ((float*)(C.ws + C.z + WS_X1))
#define C_STAT ((float*)(C.ws + C.z + WS_X1))
#define C_XB ((float*)(C.ws + C.z + WS_XB))
#define C_H2 ((AT*)(C.ws + C.z + WS_H2))
#define C_HID ((AT*)(C.ws + C.z + WS_HID))
#define C_Y ((AT*)(C.ws + C.z + WS_Y))
#define C_HS ((AT*)(C.ws + C.z + WS_HS))
#define C_WRT ((bf16_t*)(C.ws + C.z + WS_WRT))
#define C_SLOT ((int*)(C.ws + C.z + WS_SLOT))
#define C_SW ((float*)(C.ws + C.z + WS_SW))
#define C_MODP ((float*)(C.ws + C.z + WS_MODP))
#define C_CTLW ((unsigned*)(C.ws + C.z + WS_CTL))
#define C_WIN ((bf16_t*)(C.ws + C.z + WS_WIN))
#define C_WOUT ((bf16_t*)(C.ws + C.z + WS_WOUT))
#define C_WGU ((bf16_t*)(C.ws + C.z + WS_WGU))
#define C_WD ((bf16_t*)(C.ws + C.z + WS_WD))

__device__ __forceinline__ float silu_f(float v) { return v / (1.f + expf(-v)); }
__device__ __forceinline__ float gelu_tanh_f(float v) { return 0.5f * v * (1.f + tanhf(0.7978845608028654f * (v + 0.044715f * v * v * v))); }
__device__ __forceinline__ float wave_sum(float v) {
#pragma unroll
    for (int o = 1; o < 64; o <<= 1) v += __shfl_xor(v, o);
    return v;
}
__device__ __forceinline__ float wave_max(float v) {
#pragma unroll
    for (int o = 1; o < 64; o <<= 1) v = fmaxf(v, __shfl_xor(v, o));
    return v;
}
__device__ __forceinline__ const float* modp(const Ctx& C, int l, int kind, int j) { return C_MOD + ((size_t)(l * 2 + kind) * 6 + j) * D; }
__device__ __forceinline__ const float* xin_row(const Ctx& C, int l, int r) {
    if (l == 0) return r < SEQ ? C_x + (size_t)r * D : C_ctx + (size_t)(r - SEQ) * D;
    return C_XB + (size_t)r * D;
}

namespace pg8 {
#define PG8_LAS __attribute__((address_space(3)))
typedef short bf16x8 __attribute__((ext_vector_type(8)));
typedef float f32x4 __attribute__((ext_vector_type(4)));
typedef unsigned u32x4 __attribute__((ext_vector_type(4)));
constexpr int BM = 256, BK = 64, HALF = 128, HTB = HALF * BK * 2, STAGE_BYTES = 8 * HTB, NXCD = 8, WGM = 8;
__host__ __device__ __forceinline__ int lds_byte(int r, int c) { const int st = (r >> 4) * 2 + (c >> 5), rr = r & 15, cc = c & 31, ob = rr * 64 + cc * 2; return st * 1024 + (ob ^ (((ob >> 9) & 1) << 5)); }
__host__ __device__ __forceinline__ void stage_rc(int b, int& R, int& C) { const int st = b / 1024, sb = b % 1024, swz = sb ^ (((sb >> 9) & 1) << 5); R = (st >> 1) * 16 + swz / 64; C = (st & 1) * 32 + (swz % 64) / 2; }
__host__ __device__ __forceinline__ int perm32(int rho) { const int n = rho >> 4, i = rho & 15; return 8 * (i >> 2) + 4 * n + (i & 3); }
__device__ __forceinline__ unsigned cvt_pk_bf16(float lo, float hi) { unsigned r; asm volatile("v_cvt_pk_bf16_f32 %0, %1, %2" : "=v"(r) : "v"(lo), "v"(hi)); return r; }

__device__ __forceinline__ void store16_wt(void* p, u32x4 v) { asm volatile("global_store_dwordx4 %0, %1, off sc1\n\ts_nop 1" :: "v"(p), "v"(v) : "memory"); }
struct Unit { int pm, pn; const char* A; const char* B; };

template <int NN  , int KD>
struct DenseSched {
    int nM, G, c; const char* A; const char* Bt;
    __device__ __forceinline__ bool next(int i, Unit& u) const {
        const int nwg = nM * NN;
        const int L = i * G + c; if (L >= nwg) return false;
        int wgid = L; { const int q = nwg / NXCD, r = nwg % NXCD, xcd = wgid % NXCD, off = wgid / NXCD; wgid = (xcd < r ? xcd * (q + 1) : r * (q + 1) + (xcd - r) * q) + off; }
        const int nig = WGM * NN, gid = wgid / nig, fm = gid * WGM, gsz = (nM - fm) < WGM ? (nM - fm) : WGM;
        u.pm = fm + ((wgid % nig) % gsz); u.pn = (wgid % nig) / gsz;
        u.A = A + (size_t)u.pm * (BM * KD * 2); u.B = Bt + (size_t)u.pn * (BM * KD * 2); return true;
    }
    __device__ __forceinline__ void a_ready(const Unit&) const {}
    __device__ __forceinline__ void done(const Unit&) const {}
};
struct InprojSched {
    int G, v; const char* A; const char* Bt; unsigned* cnt;
    __device__ __forceinline__ bool next(int i, Unit& u) const {
        const int j = i * G + v; constexpr int N1 = (NTOK / 256) * 14, N2 = (NTOK / 256) * 4;
        if (j >= N1 + N2) return false;
        if (j < N1) { u.pm = j / 14; u.pn = j % 14; } else { const int jj = j - N1; u.pm = jj / 4; u.pn = 14 + jj % 4; }
        u.A = A + (size_t)u.pm * (BM * D * 2); u.B = Bt + (size_t)u.pn * (BM * D * 2); return true;
    }
    __device__ __forceinline__ void a_ready(const Unit&) const {}
    __device__ __forceinline__ void done(const Unit& u) const {
        asm volatile("s_waitcnt vmcnt(0)" ::: "memory");
        __builtin_amdgcn_s_barrier();
        if (threadIdx.x == 0) __hip_atomic_fetch_add(cnt + (u.pn < 14 ? 0 : 64), 1u, __ATOMIC_RELAXED, __HIP_MEMORY_SCOPE_AGENT);
    }
};
struct OneUnit { Unit u0; __device__ __forceinline__ bool next(int i, Unit& u) const { if (i != 0) return false; u = u0; return true; }
    __device__ __forceinline__ void a_ready(const Unit&) const {}
    __device__ __forceinline__ void done(const Unit&) const {} };
__device__ __forceinline__ int moe_expert_of(const PG8_LAS int* toff, int mt) { int e = 0; for (int q = 1; q < 32; ++q) e += (toff[q] <= mt) ? 1 : 0; return e; }
struct MoeSched1 {
    const PG8_LAS int* toff; int G, v; const char* A; const char* B; unsigned* mtc;
    __device__ __forceinline__ bool next(int i, Unit& u) const {
        const int MT = toff[32];
        const int L = i * G + v; if (L >= MT * 4) return false;
        const int mt = L >> 2, pn = L & 3, e = moe_expert_of(toff, mt);
        u.pm = mt; u.pn = pn; u.A = A + (size_t)mt * (256 * D * 2); u.B = B + (size_t)(e * 1024 + pn * 256) * (D * 2); return true;
    }
    __device__ __forceinline__ void a_ready(const Unit&) const {}
    __device__ __forceinline__ void done(const Unit& u) const {
        asm volatile("s_waitcnt vmcnt(0)" ::: "memory");
        __builtin_amdgcn_s_barrier();
        if (threadIdx.x == 0) __hip_atomic_fetch_add(mtc + 64 * u.pm, 1u, __ATOMIC_RELAXED, __HIP_MEMORY_SCOPE_AGENT);
    }
};
struct MoeSched2 {
    const PG8_LAS int* toff; int G, v; const char* A; const char* B; unsigned* mtc;
    __device__ __forceinline__ bool next(int i, Unit& u) const {
        const int MT = toff[32], N1 = MT * 4, N2 = MT * 8;
        const int r1 = N1 % G, nl = G - r1;
        const bool light = v >= r1;
        int j;
        if (light && i < 3) j = i * nl + (v - r1);
        else { const int ii = light ? i - 3 : i; j = 3 * nl + ii * G + (light ? v - r1 : nl + v); }
        if (j >= N2) return false;
        const int mt = j >> 3, pn = j & 7, e = moe_expert_of(toff, mt);
        u.pm = mt; u.pn = pn; u.A = A + (size_t)mt * (256 * FF * 2); u.B = B + (size_t)(e * D + pn * 256) * (FF * 2); return true;
    }
    __device__ __forceinline__ void a_ready(const Unit& u) const {
        if (threadIdx.x < 64) {
            unsigned sp = 0;
            while ((unsigned)__builtin_amdgcn_readfirstlane((int)__hip_atomic_load(mtc + 64 * u.pm, __ATOMIC_RELAXED, __HIP_MEMORY_SCOPE_AGENT)) < 4u) { __builtin_amdgcn_s_sleep(2); if (++sp > (1u << 22)) break; }
            __builtin_amdgcn_fence(__ATOMIC_ACQUIRE, "agent");
            asm volatile("s_waitcnt vmcnt(0)" ::: "memory");
        }
        asm volatile("" ::: "memory"); __builtin_amdgcn_s_barrier(); asm volatile("" ::: "memory");
    }
    __device__ __forceinline__ void done(const Unit&) const {}
};

struct EpiBf16 {
    static constexpr bool PERM = true;
    bf16_t* O; int ldc;
    __device__ __forceinline__ void operator()(const f32x4 (&acc)[2][2][4][2], const Unit& u, int wr, int wc, int fr, int fq) const {
        const int row0 = u.pm * BM + wr * 64 + fr, col0 = u.pn * BM + wc * 32 + 8 * fq;
#pragma unroll
        for (int ai = 0; ai < 2; ++ai)
#pragma unroll
            for (int m = 0; m < 4; ++m) { bf16_t* rowp = O + (size_t)(row0 + ai * HALF + m * 16) * ldc + col0;
#pragma unroll
                for (int bj = 0; bj < 2; ++bj) { const f32x4 v0 = acc[ai][bj][m][0], v1 = acc[ai][bj][m][1];
                    u32x4 w; w.x = cvt_pk_bf16(v0[0], v0[1]); w.y = cvt_pk_bf16(v0[2], v0[3]); w.z = cvt_pk_bf16(v1[0], v1[1]); w.w = cvt_pk_bf16(v1[2], v1[3]);
                    *(u32x4*)(rowp + bj * HALF) = w; } }
    }
};
struct EpiP {
    static constexpr bool PERM = true;
    bf16_t* O; const float* rope;
    __device__ __forceinline__ void operator()(const f32x4 (&acc)[2][2][4][2], const Unit& u, int wr, int wc, int fr, int fq) const {
        const int row0 = u.pm * BM + wr * 64 + fr, col0 = u.pn * BM + wc * 32 + 8 * fq;
        const bool rot = (u.pn < 4) && (u.pm < SEQ / BM);
#pragma unroll
        for (int ai = 0; ai < 2; ++ai)
#pragma unroll
            for (int m = 0; m < 4; ++m) { const int row = row0 + ai * HALF + m * 16; bf16_t* rowp = O + (size_t)row * INC + col0;
#pragma unroll
                for (int bj = 0; bj < 2; ++bj) { f32x4 v0 = acc[ai][bj][m][0], v1 = acc[ai][bj][m][1];
                    if (rot) {
                        const int i0 = ((col0 + bj * HALF) & 127) >> 1;
                        const int comp = (i0 < 32) ? (row >> 6) : (row & 63);
                        const f32x4 cs = *(const f32x4*)(rope + comp * 32 + (i0 & 31)), sn = *(const f32x4*)(rope + 4096 + comp * 32 + (i0 & 31));
                        const f32x4 a = v0, b = v1;
                        v0[0] = a[0] * cs[0] - a[1] * sn[0]; v0[1] = a[1] * cs[0] + a[0] * sn[0];
                        v0[2] = a[2] * cs[1] - a[3] * sn[1]; v0[3] = a[3] * cs[1] + a[2] * sn[1];
                        v1[0] = b[0] * cs[2] - b[1] * sn[2]; v1[1] = b[1] * cs[2] + b[0] * sn[2];
                        v1[2] = b[2] * cs[3] - b[3] * sn[3]; v1[3] = b[3] * cs[3] + b[2] * sn[3];
                    }
                    u32x4 w; w.x = cvt_pk_bf16(v0[0], v0[1]); w.y = cvt_pk_bf16(v0[2], v0[3]); w.z = cvt_pk_bf16(v1[0], v1[1]); w.w = cvt_pk_bf16(v1[2], v1[3]);
                    store16_wt(rowp + bj * HALF, w); } }
    }
};
struct EpiTres {
    static constexpr bool PERM = false;
    float* T; const float* xl; const float* xc; const float* gl; const float* gc;
    __device__ __forceinline__ void operator()(const f32x4 (&acc)[2][2][4][2], const Unit& u, int wr, int wc, int fr, int fq) const {
        const int row0 = u.pm * BM + wr * 64 + fr, col0 = u.pn * BM + wc * 32 + 4 * fq;
        const bool isctx = (u.pm == SEQ / BM);
        const float* xb = isctx ? xc - (size_t)SEQ * D : xl; const float* gb = isctx ? gc : gl;
        f32x4 gv[2][2];
#pragma unroll
        for (int bj = 0; bj < 2; ++bj)
#pragma unroll
            for (int n = 0; n < 2; ++n) gv[bj][n] = *(const f32x4*)(gb + col0 + bj * HALF + n * 16);
#pragma unroll
        for (int ai = 0; ai < 2; ++ai)
#pragma unroll
            for (int m = 0; m < 4; ++m) { const size_t off = (size_t)(row0 + ai * HALF + m * 16) * D + col0;
#pragma unroll
                for (int bj = 0; bj < 2; ++bj)
#pragma unroll
                    for (int n = 0; n < 2; ++n) { const f32x4 xv = *(const f32x4*)(xb + off + bj * HALF + n * 16);
                        *(f32x4*)(T + off + bj * HALF + n * 16) = xv * ALPHA + gv[bj][n] * acc[ai][bj][m][n]; }
                if (m == 3) asm volatile("" ::: "memory"); }
    }
};
struct EpiMoe1 {
    static constexpr bool PERM = true;
    bf16_t* HID; const float* SW;
    __device__ __forceinline__ void operator()(const f32x4 (&acc)[2][2][4][2], const Unit& u, int wr, int wc, int fr, int fq) const {
        const int row0 = u.pm * BM + wr * 64 + fr, col0 = u.pn * HALF + wc * 32 + 8 * fq;
#pragma unroll
        for (int ai = 0; ai < 2; ++ai)
#pragma unroll
            for (int m = 0; m < 4; ++m) { const int row = row0 + ai * HALF + m * 16; const float w = SW[row];
                float h[8];
#pragma unroll
                for (int n = 0; n < 2; ++n)
#pragma unroll
                    for (int j = 0; j < 4; ++j) { const float g = acc[ai][0][m][n][j], up = acc[ai][1][m][n][j]; h[4 * n + j] = g / (1.f + __expf(-g)) * up * w; }
                u32x4 o; o.x = cvt_pk_bf16(h[0], h[1]); o.y = cvt_pk_bf16(h[2], h[3]); o.z = cvt_pk_bf16(h[4], h[5]); o.w = cvt_pk_bf16(h[6], h[7]);
                store16_wt(HID + (size_t)row * FF + col0, o); }
    }
};

template <int K, class Epi, class Sched, bool ALIGN_EPI = true, bool SP2 = true>
__device__ __forceinline__ void gemm_phase(PG8_LAS unsigned char* lds, const Sched& S, const Epi& E) {
    int tid_ = threadIdx.x; asm volatile("" : "+v"(tid_));
    const int tid = tid_, wid = __builtin_amdgcn_readfirstlane(tid >> 6), lane = tid & 63, wr = wid >> 2, wc = wid & 3, fr = lane & 15, fq = lane >> 4;
    constexpr int nt = K / BK;
    unsigned voffA[2], voffB[2];
#pragma unroll
    for (int i = 0; i < 2; ++i) { int R, C; stage_rc(tid * 16 + i * 8192, R, C); const int Rb = Epi::PERM ? ((R & ~31) + perm32(R & 31)) : R;
        voffA[i] = (unsigned)(R * K + C) * 2u; voffB[i] = (unsigned)(Rb * K + C) * 2u; }
    const size_t kstep = (size_t)(BK * 2);
    const size_t hstep = (size_t)HALF * K * 2;
    const unsigned ldsw = (unsigned)wid * 1024u;
    const int aoff = lds_byte(wr * 64 + fr, fq * 8), boff = lds_byte(wc * 32 + fr, fq * 8);
#define PG8_SA(b, h) (((b) * 2 + (h)) * HTB)
#define PG8_SB(b, h) ((4 + (b) * 2 + (h)) * HTB)
#define PG8_STAGE(bufoff, gbase, voff) do { _Pragma("unroll") for (int _i = 0; _i < 2; ++_i) \
        __builtin_amdgcn_global_load_lds((const unsigned*)((const char*)(gbase) + (voff)[_i]), (PG8_LAS unsigned*)(lds + (bufoff) + ldsw + _i * 8192), 16, 0, 0); } while (0)
#define PG8_LDA(dst, b, h) do { _Pragma("unroll") for (int m = 0; m < 4; ++m) _Pragma("unroll") for (int k = 0; k < 2; ++k) dst[m][k] = *(const PG8_LAS bf16x8*)(lds + PG8_SA(b, h) + aoff + m * 2048 + k * 1024); } while (0)
#define PG8_LDB(dst, b, h) do { _Pragma("unroll") for (int n = 0; n < 2; ++n) _Pragma("unroll") for (int k = 0; k < 2; ++k) dst[n][k] = *(const PG8_LAS bf16x8*)(lds + PG8_SB(b, h) + boff + n * 2048 + k * 1024); } while (0)
#define PG8_MMA(ai, bj, At, Bt) do { __builtin_amdgcn_s_setprio(1); _Pragma("unroll") for (int m = 0; m < 4; ++m) _Pragma("unroll") for (int n = 0; n < 2; ++n) _Pragma("unroll") for (int k = 0; k < 2; ++k) \
        acc[ai][bj][m][n] = __builtin_amdgcn_mfma_f32_16x16x32_bf16(Bt[n][k], At[m][k], acc[ai][bj][m][n], 0, 0, 0); __builtin_amdgcn_s_setprio(0); } while (0)
#define PG8_WAIT_V(n) asm volatile("s_waitcnt vmcnt(" #n ")" ::: "memory")
#define PG8_WAIT_L(n) asm volatile("s_waitcnt lgkmcnt(" #n ")" ::: "memory")
#define PG8_BAR __builtin_amdgcn_s_barrier()
#define PG8_SCHED __builtin_amdgcn_sched_barrier(0)
    Unit cur, nxt; int ui = 0;
    if (!S.next(0, cur)) return;
    f32x4 acc[2][2][4][2];
#pragma unroll
    for (int a = 0; a < 2; ++a)
#pragma unroll
        for (int b = 0; b < 2; ++b)
#pragma unroll
            for (int m = 0; m < 4; ++m)
#pragma unroll
                for (int n = 0; n < 2; ++n) acc[a][b][m][n] = (f32x4){0.f, 0.f, 0.f, 0.f};
    bf16x8 At[4][2], B0[2][2], B1[2][2];
    const char* cA = cur.A; const char* cB = cur.B;
    S.a_ready(cur);
    if constexpr (SP2) {
        PG8_STAGE(PG8_SB(0, 0), cB, voffB); PG8_STAGE(PG8_SB(0, 1), cB + hstep, voffB); PG8_STAGE(PG8_SA(0, 0), cA, voffA); PG8_STAGE(PG8_SA(0, 1), cA + hstep, voffA);
        if (wr == 1) PG8_BAR;
        PG8_WAIT_V(2); PG8_BAR;
        PG8_STAGE(PG8_SB(1, 0), cB + kstep, voffB); PG8_STAGE(PG8_SA(1, 0), cA + kstep, voffA); PG8_STAGE(PG8_SB(1, 1), cB + hstep + kstep, voffB);
        PG8_WAIT_V(6); PG8_BAR;
    } else {
        PG8_STAGE(PG8_SB(0, 0), cB, voffB); PG8_STAGE(PG8_SA(0, 0), cA, voffA); PG8_STAGE(PG8_SB(0, 1), cB + hstep, voffB); PG8_STAGE(PG8_SA(0, 1), cA + hstep, voffA);
        if (wr == 1) PG8_BAR;
        PG8_WAIT_V(4); PG8_BAR;
        PG8_STAGE(PG8_SB(1, 0), cB + kstep, voffB); PG8_STAGE(PG8_SA(1, 0), cA + kstep, voffA); PG8_STAGE(PG8_SB(1, 1), cB + hstep + kstep, voffB);
        PG8_WAIT_V(6); PG8_BAR;
    }
    for (;;) {
        const bool has_next = S.next(ui + 1, nxt);
        const char* nA = has_next ? nxt.A : cA; const char* nB = has_next ? nxt.B : cB;
        for (int t = 0; t < nt; t += 2) {
            const bool last = (t == nt - 2);
            if (last && has_next) S.a_ready(nxt);
            const char* a1 = cA + (size_t)(t + 1) * kstep;
            const char* a2 = last ? nA : cA + (size_t)(t + 2) * kstep; const char* b2 = last ? nB : cB + (size_t)(t + 2) * kstep;
            const char* a3 = a2 + kstep; const char* b3 = b2 + kstep;
            if constexpr (SP2) {
            PG8_LDB(B0, 0, 0); PG8_LDB(B1, 0, 1); PG8_SCHED; PG8_LDA(At, 0, 0); PG8_STAGE(PG8_SA(1, 1), a1 + hstep, voffA);
            PG8_WAIT_V(8); PG8_WAIT_L(0); PG8_BAR; PG8_MMA(0, 0, At, B0); PG8_MMA(0, 1, At, B1); PG8_BAR; PG8_SCHED;
            PG8_LDA(At, 0, 1); PG8_STAGE(PG8_SB(0, 0), b2, voffB); PG8_STAGE(PG8_SB(0, 1), b2 + hstep, voffB); PG8_STAGE(PG8_SA(0, 0), a2, voffA);
            PG8_WAIT_V(8); PG8_WAIT_L(0); PG8_BAR; PG8_MMA(1, 0, At, B0); PG8_MMA(1, 1, At, B1); PG8_BAR; PG8_SCHED;
            PG8_LDB(B0, 1, 0); PG8_LDB(B1, 1, 1); PG8_SCHED; PG8_LDA(At, 1, 0); PG8_STAGE(PG8_SA(0, 1), a2 + hstep, voffA);
            PG8_WAIT_V(8); PG8_WAIT_L(0); PG8_BAR; PG8_MMA(0, 0, At, B0); PG8_MMA(0, 1, At, B1); PG8_BAR; PG8_SCHED;
            PG8_LDA(At, 1, 1); PG8_STAGE(PG8_SB(1, 0), b3, voffB); PG8_STAGE(PG8_SB(1, 1), b3 + hstep, voffB); PG8_STAGE(PG8_SA(1, 0), a3, voffA);
            PG8_WAIT_V(8); PG8_WAIT_L(0); PG8_BAR; PG8_MMA(1, 0, At, B0); PG8_MMA(1, 1, At, B1); PG8_BAR; PG8_SCHED;
            } else {
            PG8_LDB(B0, 0, 0); PG8_SCHED; PG8_LDA(At, 0, 0); PG8_STAGE(PG8_SA(1, 1), a1 + hstep, voffA);
            PG8_WAIT_L(8); PG8_BAR; PG8_WAIT_L(0); PG8_MMA(0, 0, At, B0); PG8_BAR; PG8_SCHED;
            PG8_LDB(B1, 0, 1); PG8_STAGE(PG8_SB(0, 0), b2, voffB);
            PG8_BAR; PG8_WAIT_L(0); PG8_MMA(0, 1, At, B1); PG8_BAR;
            PG8_LDA(At, 0, 1); PG8_STAGE(PG8_SA(0, 0), a2, voffA);
            PG8_BAR; PG8_WAIT_L(0); PG8_MMA(1, 0, At, B0); PG8_BAR; PG8_SCHED;
            PG8_STAGE(PG8_SB(0, 1), b2 + hstep, voffB);
            PG8_WAIT_V(6); PG8_BAR; PG8_MMA(1, 1, At, B1); PG8_BAR;
            PG8_LDB(B0, 1, 0); PG8_SCHED; PG8_LDA(At, 1, 0); PG8_STAGE(PG8_SA(0, 1), a2 + hstep, voffA);
            PG8_WAIT_L(8); PG8_BAR; PG8_WAIT_L(0); PG8_MMA(0, 0, At, B0); PG8_BAR; PG8_SCHED;
            PG8_LDB(B1, 1, 1); PG8_STAGE(PG8_SB(1, 0), b3, voffB);
            PG8_BAR; PG8_WAIT_L(0); PG8_MMA(0, 1, At, B1); PG8_BAR;
            PG8_LDA(At, 1, 1); PG8_STAGE(PG8_SA(1, 0), a3, voffA);
            PG8_BAR; PG8_WAIT_L(0); PG8_MMA(1, 0, At, B0); PG8_BAR; PG8_SCHED;
            PG8_STAGE(PG8_SB(1, 1), b3 + hstep, voffB);
            PG8_WAIT_V(6); PG8_BAR; PG8_MMA(1, 1, At, B1); PG8_BAR;
            }
        }
        if constexpr (ALIGN_EPI) { if (wr == 0) PG8_BAR; }
        E(acc, cur, wr, wc, fr, fq); S.done(cur);
        if (!has_next) break;
#pragma unroll
        for (int a = 0; a < 2; ++a)
#pragma unroll
            for (int b = 0; b < 2; ++b)
#pragma unroll
                for (int m = 0; m < 4; ++m)
#pragma unroll
                    for (int n = 0; n < 2; ++n) acc[a][b][m][n] = (f32x4){0.f, 0.f, 0.f, 0.f};
        cur = nxt; cA = nA; cB = nB; ++ui;
        if constexpr (ALIGN_EPI) { if (wr == 1) PG8_BAR; }
    }
    PG8_WAIT_V(0);
    if constexpr (!ALIGN_EPI) { if (wr == 0) PG8_BAR; }
    PG8_BAR;
#undef PG8_SA
#undef PG8_SB
#undef PG8_STAGE
#undef PG8_LDA
#undef PG8_LDB
#undef PG8_MMA
#undef PG8_WAIT_V
#undef PG8_WAIT_L
#undef PG8_BAR
#undef PG8_SCHED
}
}

__device__ __forceinline__ void transpose_item(const float* W, int N, bf16_t* WT, int K, int wt_row0, int k0, int n0, LAS float* scr, int lane, int rstride = 1) {
#pragma unroll
    for (int i = 0; i < 32; ++i) { const int kk = 2 * i + (lane >> 5); scr[kk * 33 + (lane & 31)] = W[(size_t)(k0 + kk) * N + n0 + (lane & 31)]; }
    asm volatile("s_waitcnt lgkmcnt(0)" ::: "memory");
    const int c = lane & 7;
#pragma unroll
    for (int j = 0; j < 4; ++j) { const int n = (lane >> 3) + 8 * j; const LAS float* sp = scr + (8 * c) * 33 + n;
        uint4 o; o.x = pg8::cvt_pk_bf16(sp[0 * 33], sp[1 * 33]); o.y = pg8::cvt_pk_bf16(sp[2 * 33], sp[3 * 33]); o.z = pg8::cvt_pk_bf16(sp[4 * 33], sp[5 * 33]); o.w = pg8::cvt_pk_bf16(sp[6 * 33], sp[7 * 33]);
        *(uint4*)(WT + (size_t)(wt_row0 + n * rstride) * K + k0 + 8 * c) = o; }
    asm volatile("s_waitcnt lgkmcnt(0)" ::: "memory");
}
constexpr int I_IN = (D / 64) * (INC / 32), I_OUT = (D / 64) * (D / 32), I_EXP = 512, NKC = 8;
__device__ __forceinline__ void ph_prologue(const Ctx& C) {
    const int gt = C.bid * NTHREADS + C.tid, NT = C.G * NTHREADS;
    const int gw = C.bid * NWAVES + C.wave, NGW = C.G * NWAVES, lane = C.lane;
    for (int idx = gt; idx < 128 * 32; idx += NT) {
        const int pos = idx / 32, j = idx % 32;
        const double inv = pow(10000.0, -(double)j / 32.0);
        const double ang = (double)pos * inv;
        C_ROPE[idx] = (float)cos(ang);
        C_ROPE[128 * 32 + idx] = (float)sin(ang);
    }
    for (int idx = gt; idx < NE * D; idx += NT) {
        const int e = idx / D, d = idx % D;
        const float w = C_w_router[(size_t)d * NE + e];
        const bf16_t hi = f2bf(w); const bf16_t lo = f2bf(w - bf2f(hi));
        C_WRT[idx] = hi; C_WRT[NE * D + idx] = lo;
    }
    {
        LAS float* sl = (LAS float*)C.lds;
        for (int k = C.tid; k < D; k += NTHREADS) { sl[k] = silu_f(C_c[k]); sl[D + k] = silu_f(C_c_ctx[k]); }
        __syncthreads();
        for (int u = gw; u < DEPTH * 48 * NKC; u += NGW) {
            const int l = u / (48 * NKC), rem = u % (48 * NKC), sb = rem / NKC, kc = rem % NKC;
            const float* w = C_w_mod + (size_t)l * D * 6 * D + (size_t)(kc * (D / NKC)) * 6 * D + sb * 256 + lane * 4;
            float4 a0 = {0.f, 0.f, 0.f, 0.f}, a1 = {0.f, 0.f, 0.f, 0.f};
#pragma unroll 16
            for (int k = 0; k < D / NKC; ++k) {
                const float4 wv = *(const float4*)(w + (size_t)k * 6 * D);
                const float c0 = sl[kc * (D / NKC) + k], c1 = sl[D + kc * (D / NKC) + k];
                a0.x += c0 * wv.x; a0.y += c0 * wv.y; a0.z += c0 * wv.z; a0.w += c0 * wv.w;
                a1.x += c1 * wv.x; a1.y += c1 * wv.y; a1.z += c1 * wv.z; a1.w += c1 * wv.w;
            }
            *(float4*)(C_MODP + ((size_t)(kc * 2 + l) * 2 + 0) * 6 * D + sb * 256 + lane * 4) = a0;
            *(float4*)(C_MODP + ((size_t)(kc * 2 + l) * 2 + 1) * 6 * D + sb * 256 + lane * 4) = a1;
        }
        __syncthreads();
    }
    LAS float* scr = (LAS float*)(C.lds + C.wave * 16384);
    constexpr int TOT = 2 * I_IN + 2 * I_OUT + 3 * 64 * I_EXP;
    for (int it = gw; it < TOT; it += NGW) {
        int r = it;
        if (r < 2 * I_IN) { const int l = r / I_IN, q = r % I_IN, kb = q / (INC / 32), nb = q % (INC / 32);
            const int n0 = 32 * nb; int row0 = n0, rs = 1;
            if (n0 < OFF_AV) { const int hh = n0 / HD, d0 = n0 % HD; row0 = hh * HD + (d0 < 64 ? 2 * d0 : 2 * (d0 - 64) + 1); rs = 2; }
            transpose_item(C_w_in + (size_t)l * D * INC, INC, C_WIN + (size_t)l * INC * D, D, row0, 64 * kb, n0, scr, lane, rs); continue; }
        r -= 2 * I_IN;
        if (r < 2 * I_OUT) { const int l = r / I_OUT, q = r % I_OUT, kb = q / (D / 32), nb = q % (D / 32);
            transpose_item(C_w_out + (size_t)l * D * D, D, C_WOUT + (size_t)l * D * D, D, 32 * nb, 64 * kb, 32 * nb, scr, lane); continue; }
        r -= 2 * I_OUT;
        if (r < 2 * 64 * I_EXP) { const int up = r / (64 * I_EXP), rr = r % (64 * I_EXP); const int le = rr / I_EXP, q = rr % I_EXP, kb = q / 16, nb = q % 16, f0 = 32 * nb;
            transpose_item((up ? C_w_up : C_w_gate) + (size_t)le * D * FF, FF, C_WGU + (size_t)le * 1024 * D, D, (f0 / 128) * 256 + up * 128 + (f0 % 128), 64 * kb, f0, scr, lane); continue; }
        r -= 2 * 64 * I_EXP;
        { const int le = r / I_EXP, q = r % I_EXP, kb = q / (D / 32), nb = q % (D / 32);
          transpose_item(C_w_down + (size_t)le * FF * D, D, C_WD + (size_t)le * D * FF, FF, 32 * nb, 64 * kb, 32 * nb, scr, lane); }
    }
}

__device__ __forceinline__ void ph_modulate0(const Ctx& C) {
    const int gt = C.bid * NTHREADS + C.tid, NT = C.G * NTHREADS;
    const int gw = C.bid * NWAVES + C.wave, NGW = C.G * NWAVES, lane = C.lane;
    for (int idx = gt; idx < DEPTH * 2 * 6 * D; idx += NT) {
        const int n = idx % (6 * D), l = idx / (2 * 6 * D);
        float a = C_b_mod[l * 6 * D + n];
#pragma unroll
        for (int kc = 0; kc < NKC; ++kc) a += C_MODP[(size_t)kc * (DEPTH * 2 * 6 * D) + idx];
        C_MOD[idx] = a;
    }
    LAS float* ms = (LAS float*)C.lds;
    for (int i = C.tid; i < 2 * 2 * D; i += NTHREADS) {
        const int kind = i / (2 * D), n = i % (2 * D);
        const int idx = (0 * 2 + kind) * 6 * D + n;
        float a = C_b_mod[n];
#pragma unroll
        for (int kc = 0; kc < NKC; ++kc) a += C_MODP[(size_t)kc * (DEPTH * 2 * 6 * D) + idx];
        ms[i] = a;
    }
    __syncthreads();
    for (int r = gw; r < NTOK; r += NGW) {
        const int kind = r < SEQ ? 0 : 1;
        const float* xp = xin_row(C, 0, r);
        const LAS float* sh = ms + kind * 2 * D; const LAS float* sc = sh + D;
#pragma unroll
        for (int j = 0; j < 8; ++j) {
            const int d0 = 4 * lane + 256 * j;
            const float4 xv = *(const float4*)(xp + d0);
            float4 hv; hv.x = xv.x * (1.f + sc[d0]) + sh[d0]; hv.y = xv.y * (1.f + sc[d0 + 1]) + sh[d0 + 1]; hv.z = xv.z * (1.f + sc[d0 + 2]) + sh[d0 + 2]; hv.w = xv.w * (1.f + sc[d0 + 3]) + sh[d0 + 3];
            st4(&C_H[(size_t)r * D + d0], hv);
        }
    }
}

namespace att {
using bf16x8 = __attribute__((ext_vector_type(8))) short;
using s16x4  = __attribute__((ext_vector_type(4))) short;
using f32x16 = __attribute__((ext_vector_type(16))) float;
using u32x4  = __attribute__((ext_vector_type(4))) unsigned;
constexpr int NW = 8, QBLK = 32, KVBLK = 64;
constexpr float SCALE = QSCALE, THR = 8.f;
constexpr int SHM_V = KVBLK * HD * 2, SHM_K = KVBLK * HD * 2;
constexpr int Q_OFF = 2 * SHM_V + 2 * SHM_K  , WS_OFF = 131072 + 1024, BIAS_OFF = WS_OFF + NW * 64 * 4, QSLOT_OFF = BIAS_OFF + (64 + 15 * 32 + 64) * 4, ATT_LDS = QSLOT_OFF + 16;
#define KSWZ(row, colB) ((row) * 256 + ((colB) ^ (((row) & 7) << 4)))
#define SBAR() __builtin_amdgcn_sched_barrier(0)
__device__ __forceinline__ int crow(int r, int hi) { return (r & 3) + 8 * (r >> 2) + 4 * hi; }
__device__ __forceinline__ unsigned cvtpk(float lo, float hi) { unsigned r; asm volatile("v_cvt_pk_bf16_f32 %0, %1, %2" : "=v"(r) : "v"(lo), "v"(hi)); return r; }

__device__ __forceinline__ void partialSM(f32x16& p0, f32x16& p1, float& m_reg, float& mn, float& alpha) {
  constexpr float Cc = SCALE * 1.4426950408889634f;
  float pmax = p0[0]; for (int r = 1; r < 16; ++r) pmax = fmaxf(pmax, p0[r]); for (int r = 0; r < 16; ++r) pmax = fmaxf(pmax, p1[r]);
  { auto rr = __builtin_amdgcn_permlane32_swap(__float_as_uint(pmax), __float_as_uint(pmax), false, false);
    pmax = fmaxf(__uint_as_float(rr[0]), __uint_as_float(rr[1])); }
  if (__builtin_expect(__all(pmax - m_reg <= THR / SCALE), 1)) { mn = m_reg; alpha = 1.f; }
  else { mn = fmaxf(m_reg, pmax); alpha = __builtin_amdgcn_exp2f((m_reg - mn) * Cc); m_reg = mn; }
  float mnC = -mn * Cc;
  for (int r = 0; r < 16; ++r) p0[r] = fmaf(p0[r], Cc, mnC); for (int r = 0; r < 16; ++r) p1[r] = fmaf(p1[r], Cc, mnC);
  for (int r = 0; r < 16; ++r) p0[r] = __builtin_amdgcn_exp2f(p0[r]);
}
__device__ __forceinline__ void finishSM(f32x16& p0, f32x16& p1, float alpha, float& l_reg, bf16x8& pa0, bf16x8& pa1, bf16x8& pa2, bf16x8& pa3) {
  for (int r = 0; r < 16; ++r) p1[r] = __builtin_amdgcn_exp2f(p1[r]);
  float ps = 0; for (int r = 0; r < 16; ++r) ps += p0[r]; for (int r = 0; r < 16; ++r) ps += p1[r];
  { auto rr = __builtin_amdgcn_permlane32_swap(__float_as_uint(ps), __float_as_uint(ps), false, false);
    ps = __uint_as_float(rr[0]) + __uint_as_float(rr[1]); }
  l_reg = l_reg * alpha + ps;
#define PK4(P, BASE, OUT) do { unsigned a0 = cvtpk(P[BASE + 0], P[BASE + 1]), a1 = cvtpk(P[BASE + 2], P[BASE + 3]);   \
    unsigned b0 = cvtpk(P[BASE + 4], P[BASE + 5]), b1 = cvtpk(P[BASE + 6], P[BASE + 7]);                              \
    auto r0 = __builtin_amdgcn_permlane32_swap(a0, b0, false, false); auto r1 = __builtin_amdgcn_permlane32_swap(a1, b1, false, false); \
    u32x4 w = {r0[0], r1[0], r0[1], r1[1]}; OUT = *reinterpret_cast<bf16x8*>(&w); } while (0)
  PK4(p0, 0, pa0); PK4(p0, 8, pa1); PK4(p1, 0, pa2); PK4(p1, 8, pa3);
#undef PK4
}
__device__ __forceinline__ void qkt(f32x16& p0, f32x16& p1, const LAS char* Ks, const LAS char* Qs, int r32, int hi) {
#pragma unroll
  for (int d0 = 0; d0 < 8; ++d0) { int cb = (d0 * 16 + hi * 8) * 2;
    bf16x8 b0 = *reinterpret_cast<const LAS bf16x8*>(Ks + KSWZ(r32, cb));
    bf16x8 b1 = *reinterpret_cast<const LAS bf16x8*>(Ks + KSWZ(32 + r32, cb));
    bf16x8 q = *reinterpret_cast<const LAS bf16x8*>(Qs + KSWZ(r32, cb));
    p0 = __builtin_amdgcn_mfma_f32_32x32x16_bf16(b0, q, p0, 0, 0, 0);
    p1 = __builtin_amdgcn_mfma_f32_32x32x16_bf16(b1, q, p1, 0, 0, 0); }
}
__device__ __forceinline__ int v_st(int k, int c) { const int kk = (k & ~0xC) | ((k & 4) << 1) | ((k & 8) >> 1); return ((kk >> 3) * 4 + (c >> 5)) * 512 + ((kk & 7) * 32 + (c & 31)) * 2; }
__device__ __forceinline__ int v_rd_base(int lane) { return ((lane & 3) << 3) | (((lane >> 2) & 3) << 6) | (((lane >> 4) & 1) << 5) | (((lane >> 5) & 1) << 8); }
constexpr int v_rd_off(int d0, int ks, int half) { return d0 * 512 + ks * 4096 + half * 2048; }
template <int OFF> __device__ __forceinline__ s16x4 tr_read(int vb) {
  s16x4 r; asm volatile("ds_read_b64_tr_b16 %0, %1 offset:%2" : "=&v"(r) : "v"(vb), "i"(OFF) : "memory"); return r;
}
template <int D0> __device__ __forceinline__ void pv_one(f32x16& od, int vb, bf16x8 pa0, bf16x8 pa1, bf16x8 pa2, bf16x8 pa3) {
  const s16x4 l0 = tr_read<v_rd_off(D0, 0, 0)>(vb), h0 = tr_read<v_rd_off(D0, 0, 1)>(vb), l1 = tr_read<v_rd_off(D0, 1, 0)>(vb), h1 = tr_read<v_rd_off(D0, 1, 1)>(vb);
  const s16x4 l2 = tr_read<v_rd_off(D0, 2, 0)>(vb), h2 = tr_read<v_rd_off(D0, 2, 1)>(vb), l3 = tr_read<v_rd_off(D0, 3, 0)>(vb), h3 = tr_read<v_rd_off(D0, 3, 1)>(vb);
  asm volatile("s_waitcnt lgkmcnt(0)" ::: "memory"); SBAR();
#define PK(L, H) (bf16x8){L[0], L[1], L[2], L[3], H[0], H[1], H[2], H[3]}
  od = __builtin_amdgcn_mfma_f32_32x32x16_bf16(pa0, PK(l0, h0), od, 0, 0, 0);
  od = __builtin_amdgcn_mfma_f32_32x32x16_bf16(pa1, PK(l1, h1), od, 0, 0, 0);
  od = __builtin_amdgcn_mfma_f32_32x32x16_bf16(pa2, PK(l2, h2), od, 0, 0, 0);
  od = __builtin_amdgcn_mfma_f32_32x32x16_bf16(pa3, PK(l3, h3), od, 0, 0, 0);
#undef PK
}
__device__ __forceinline__ void pv_d0(f32x16* o, int vb, bf16x8 pa0, bf16x8 pa1, bf16x8 pa2, bf16x8 pa3) {
  pv_one<0>(o[0], vb, pa0, pa1, pa2, pa3); pv_one<1>(o[1], vb, pa0, pa1, pa2, pa3); pv_one<2>(o[2], vb, pa0, pa1, pa2, pa3); pv_one<3>(o[3], vb, pa0, pa1, pa2, pa3);
}

template <int kind>
__device__ __forceinline__ void attn_unit(const bf16_t* __restrict__ P, bf16_t* __restrict__ MIX, const float* __restrict__ rpb_l, const float* __restrict__ sink_l,
                                          const int u, const int h, LAS char* lds, const int tid) {
  const int wid = __builtin_amdgcn_readfirstlane(tid >> 6), lane = tid & 63, r32 = lane & 31, hi = lane >> 5;
  LAS char* V_lds = lds; LAS char* K_lds = lds + 2 * SHM_V;
  LAS float* ws = (LAS float*)(lds + WS_OFF) + wid * 64; LAS float* li_l = ws; LAS float* al_l = ws + 32;
  LAS float* rpbs = (LAS float*)(lds + BIAS_OFF) + 64;
  constexpr bool isA = (kind == 0 || kind == 2), lat = kind < 2;
  const int qrow0 = lat ? 256 * u : SEQ;
  const int qcol = isA ? h * HD : OFF_BQ + h * HD;
  const int kcol = isA ? OFF_AK + (h / 3) * HD : OFF_BK + h * HD;
  const int vcol = isA ? OFF_AV + (h / 3) * HD : OFF_BV + h * HD;
  const int ocol = (isA ? 0 : 768) + h * HD;
  constexpr int NT = (kind == 0) ? 12 : (kind == 1) ? 16 : 4;
  int Rs = 4 * u - 4; Rs = Rs < 0 ? 0 : (Rs > 117 ? 117 : Rs);
  __syncthreads();
  if (kind == 1) for (int i = tid; i < 64 + 15 * 32 + 64; i += 512) { const int t = i - 64; rpbs[t] = (t >= 0 && t < 15 * 32 && (t & 31) < 31) ? rpb_l[h * 465 + (t >> 5) * 31 + (t & 31)] * (1.0f / SCALE) : 0.f; }
  float m_reg = -1e30f, l_reg = 0; f32x16 o[4] = {};
  LAS char* Qs = lds + Q_OFF + wid * 8192;
  { const bf16_t* Qw = P + (size_t)(qrow0 + wid * QBLK + r32) * INC + qcol + hi * 8;
#pragma unroll
    for (int d0 = 0; d0 < 8; ++d0) *reinterpret_cast<LAS bf16x8*>(Qs + KSWZ(r32, (d0 * 16 + hi * 8) * 2)) = *reinterpret_cast<const bf16x8*>(Qw + d0 * 16); }
  const int sr = tid >> 4, sc = (tid & 15) * 8, vst0 = v_st(sr, sc), vst1 = v_st(32 + sr, sc);
  const int vb0 = (int)(size_t)V_lds + v_rd_base(lane);
  const unsigned voffk = (unsigned)(sr * INC + sc + kcol) * 2u, voffk2 = voffk + 32u * INC * 2u, voffv = (unsigned)(sr * INC + sc + vcol) * 2u, voffv2 = voffv + 32u * INC * 2u;
  struct { bf16x8 vs0, vs1, ks0, ks1; } sr_[1];
#define KROW(j) (((j) < 4) ? (SEQ + 64 * (j)) : (kind == 0 ? ({ int t_ = 256 * u - 128 + 64 * ((j) - 4); t_ < 0 ? 0 : (t_ > SEQ - 64 ? SEQ - 64 : t_); }) : ({ int jj_ = (j) - 4; jj_ = jj_ > 10 ? 10 : jj_; (Rs + jj_) * 64; })))
#define SLOAD(i, j) do { const char* kb_ = (const char*)P + (size_t)KROW(j) * (INC * 2);                                             \
    sr_[i].vs0 = *reinterpret_cast<const bf16x8*>(kb_ + voffv); sr_[i].vs1 = *reinterpret_cast<const bf16x8*>(kb_ + voffv2); \
    sr_[i].ks0 = *reinterpret_cast<const bf16x8*>(kb_ + voffk); sr_[i].ks1 = *reinterpret_cast<const bf16x8*>(kb_ + voffk2); } while (0)
#define SWRITE(b, i) do { *(LAS bf16x8*)(V_lds + (b) * SHM_V + vst0) = sr_[i].vs0;          \
    *(LAS bf16x8*)(V_lds + (b) * SHM_V + vst1) = sr_[i].vs1; int kc_ = sc * 2;               \
    *(LAS bf16x8*)(K_lds + (b) * SHM_K + KSWZ(sr, kc_)) = sr_[i].ks0;                       \
    *(LAS bf16x8*)(K_lds + (b) * SHM_K + KSWZ(32 + sr, kc_)) = sr_[i].ks1; } while (0)
#define SWAIT() asm volatile("s_waitcnt vmcnt(0)" ::: "memory")
#define RESC(a) do { if (__any((a) < 1.f)) { if (hi == 0) al_l[r32] = (a); asm volatile("s_waitcnt lgkmcnt(0)" ::: "memory"); \
    for (int d = 0; d < 4; ++d) for (int r = 0; r < 16; ++r) o[d][r] *= al_l[crow(r, hi)]; } } while (0)
#define MASK(p0, p1, j) do { const int j_ = (j);                                                                                          \
    if (lat && j_ >= 4) {                                                                                                                 \
      if (kind == 0) {                                                                                                                    \
        const int t0_ = 256 * u - 128 + 64 * (j_ - 4), qw_ = 256 * u + 32 * wid;                                                          \
        const float tp_ = (t0_ < 0 || t0_ >= SEQ) ? -1e30f : 0.f;                                     \
        const float dl_ = (float)(t0_ - (qw_ + r32) + 4 * hi);                                                                            \
        _Pragma("unroll") for (int r = 0; r < 16; ++r) { const float k0_ = dl_ + (float)((r & 3) + 8 * (r >> 2)), k1_ = k0_ + 32.f;       \
          p0[r] = fmaf(fminf(0.f, 128.5f - fabsf(k0_)), 1e30f, tp_); p1[r] = fmaf(fminf(0.f, 128.5f - fabsf(k1_)), 1e30f, tp_); }         \
      } else {                                                                                                                            \
        const int kr_ = Rs + (j_ - 4), qrw_ = 4 * u + (wid >> 1); int r0_ = qrw_ - 4; r0_ = r0_ < 0 ? 0 : (r0_ > 120 ? 120 : r0_);        \
        const float tp_ = (j_ >= 15 || kr_ < r0_ || kr_ >= r0_ + 8) ? -1e30f : 0.f;           \
        int dr_ = kr_ - qrw_ + 7; dr_ = dr_ < 0 ? 0 : (dr_ > 14 ? 14 : dr_);                                                              \
        const int qc_ = (wid & 1) * 32 + r32; int c0_ = qc_ - 8; c0_ = c0_ < 0 ? 0 : (c0_ > 48 ? 48 : c0_);                               \
        const LAS float* br_ = rpbs + dr_ * 32 + (15 - qc_ + 4 * hi);                                                                     \
        const float xb_ = (float)(4 * hi - c0_) - 7.5f;                                                                                   \
        _Pragma("unroll") for (int r = 0; r < 16; ++r) { const int kk_ = (r & 3) + 8 * (r >> 2); const float x0_ = xb_ + (float)kk_, x1_ = x0_ + 32.f;   \
          p0[r] = fmaf(fminf(0.f, 7.75f - fabsf(x0_)), 1e30f, br_[kk_] + tp_); p1[r] = fmaf(fminf(0.f, 7.75f - fabsf(x1_)), 1e30f, br_[kk_ + 32] + tp_); } \
      } }                                                                                                                                 \
    else { _Pragma("unroll") for (int r = 0; r < 16; ++r) { p0[r] = 0.f; p1[r] = 0.f; } } } while (0)
  f32x16 pA0, pA1; float mnA, alA; bf16x8 pa0, pa1, pa2, pa3;
  SLOAD(0, 0); asm volatile("s_waitcnt vmcnt(0)" ::: "memory"); SWRITE(0, 0); __syncthreads();
  int jlo = 4, jhi = NT - 1;
  if (kind == 0) { const int qw_ = 32 * wid;
    jlo = 4 + (qw_ + 0) / 64; jhi = 4 + (qw_ + 31 + 256) / 64;
    const int first_ok = (256 * u - 128 < 0) ? 4 + 2 : 4, last_ok = (256 * u + 384 > SEQ) ? 4 + 5 : 4 + 7;
    jlo = jlo < first_ok ? first_ok : jlo; jhi = jhi > last_ok ? last_ok : jhi; }
  if (kind == 1) { const int qrw_ = 4 * u + (wid >> 1); int r0_ = qrw_ - 4; r0_ = r0_ < 0 ? 0 : (r0_ > 120 ? 120 : r0_); jlo = 4 + (r0_ - Rs); jhi = jlo + 7; }
#define TILE_BODY(COMPUTE) do { const int b = j & 1;                                                                    \
    if (j + 1 < NT) SLOAD(0, j + 1);                                                                                    \
    if (COMPUTE) {                                                                                                      \
      MASK(pA0, pA1, j);                                                                                                \
      SBAR(); qkt(pA0, pA1, K_lds + b * SHM_K, Qs, r32, hi);                                                            \
      partialSM(pA0, pA1, m_reg, mnA, alA);                                                                             \
      RESC(alA);                                                                                                        \
      finishSM(pA0, pA1, alA, l_reg, pa0, pa1, pa2, pa3); SBAR();                                                       \
      pv_d0(o, vb0 + b * SHM_V, pa0, pa1, pa2, pa3); }                                                                  \
    if (j + 1 < NT) { SWAIT(); SWRITE(b ^ 1, 0); }                                                                      \
    __syncthreads(); } while (0)
  int j = 0;
  for (; j < 4; ++j) TILE_BODY(true);
  if (lat) {
    for (; j < jlo; ++j) TILE_BODY(false);
    for (; j <= jhi; ++j) TILE_BODY(true);
    for (; j < NT; ++j) TILE_BODY(false);
  }
#undef TILE_BODY
  if (isA) l_reg += __builtin_amdgcn_exp2f(sink_l[h] * 1.4426950408889634f - m_reg * (SCALE * 1.4426950408889634f));
  if (hi == 0) li_l[r32] = l_reg; asm volatile("s_waitcnt lgkmcnt(0)" ::: "memory");
  float rli[16];
#pragma unroll
  for (int r = 0; r < 16; ++r) rli[r] = __builtin_amdgcn_rcpf(li_l[crow(r, hi)]);
  __syncthreads();
  LAS char* ost = lds + wid * 8192;
#pragma unroll
  for (int r = 0; r < 16; ++r) { const int orow = crow(r, hi);
#pragma unroll
    for (int d0 = 0; d0 < 4; ++d0) *(LAS bf16_t*)(ost + orow * 256 + (d0 * 32 + r32) * 2) = f2bf(o[d0][r] * rli[r]); }
  asm volatile("s_waitcnt lgkmcnt(0)" ::: "memory");
  bf16_t* Ow = MIX + (size_t)(qrow0 + wid * QBLK) * D + ocol;
#pragma unroll
  for (int i = 0; i < 8; ++i) { const int c = lane + 64 * i, row = c >> 4, c16 = c & 15;
    const u32x4 v = *(const LAS u32x4*)(ost + c * 16);
    *reinterpret_cast<u32x4*>(Ow + (size_t)row * D + c16 * 8) = v; }
#undef KROW
#undef SLOAD
#undef SWRITE
#undef SWAIT
#undef RESC
#undef MASK
}
#undef KSWZ
#undef SBAR
}

__device__ __forceinline__ void sgu_item(const Ctx& C, int l, int ch, int g) {
    typedef short bf16x8v __attribute__((ext_vector_type(8)));
    typedef float f32x4v __attribute__((ext_vector_type(4)));
    constexpr int PITCH = 272;
    LAS char* vnT = (LAS char*)C.lds;
    const int lane = C.lane, wave = C.wave;
    const int row0 = ch * 128;
    __syncthreads();
    {
        const float g0 = C_sgu_g[l * CW + g * 128 + lane], g1 = C_sgu_g[l * CW + g * 128 + 64 + lane];
        const float b0 = C_sgu_bn[l * CW + g * 128 + lane], b1 = C_sgu_bn[l * CW + g * 128 + 64 + lane];
        for (int q = wave; q < 128; q += NWAVES) {
            const AT* vp = C_P + (size_t)(row0 + q) * INC + OFF_C + CW + g * 128;
            const float a = gelu_tanh_f(ldv(vp + lane)), b = gelu_tanh_f(ldv(vp + 64 + lane));
            const float mu = wave_sum(a + b) * (1.f / 128.f);
            const float da = a - mu, db = b - mu;
            const float var = wave_sum(da * da + db * db) * (1.f / 128.f);
            const float rstd = 1.0f / sqrtf(var + LN_EPS);
            *(LAS bf16_t*)(vnT + lane * PITCH + q * 2) = f2bf(da * rstd * g0 + b0);
            *(LAS bf16_t*)(vnT + (64 + lane) * PITCH + q * 2) = f2bf(db * rstd * g1 + b1);
        }
    }
    __syncthreads();
    const int m16 = lane & 15, kg = lane >> 4;
    bf16x8v af[4];
    { const float* wp = C_sgu_w + ((size_t)(l * 4 + g) * 128 + 16 * wave + m16) * 128 + 8 * kg;
#pragma unroll
      for (int ks = 0; ks < 4; ++ks) { const float4 w0 = *(const float4*)(wp + 32 * ks), w1 = *(const float4*)(wp + 32 * ks + 4);
          uint4 pk; pk.x = pg8::cvt_pk_bf16(w0.x, w0.y); pk.y = pg8::cvt_pk_bf16(w0.z, w0.w); pk.z = pg8::cvt_pk_bf16(w1.x, w1.y); pk.w = pg8::cvt_pk_bf16(w1.z, w1.w);
          af[ks] = *reinterpret_cast<bf16x8v*>(&pk); } }
    f32x4v acc[8];
#pragma unroll
    for (int nt = 0; nt < 8; ++nt) acc[nt] = (f32x4v){0.f, 0.f, 0.f, 0.f};
#pragma unroll
    for (int nt = 0; nt < 8; ++nt)
#pragma unroll
        for (int ks = 0; ks < 4; ++ks) {
            const bf16x8v bfr = *(const LAS bf16x8v*)(vnT + (nt * 16 + m16) * PITCH + (32 * ks + 8 * kg) * 2);
            acc[nt] = __builtin_amdgcn_mfma_f32_16x16x32_bf16(af[ks], bfr, acc[nt], 0, 0, 0);
        }
#pragma unroll
    for (int reg = 0; reg < 4; ++reg) {
        const int p = 16 * wave + 4 * kg + reg;
        const float bs = C_sgu_b[(l * 4 + g) * 128 + p];
        const AT* up = C_P + (size_t)(row0 + p) * INC + OFF_C + g * 128 + m16;
        AT* op = C_MIX + (size_t)(row0 + p) * D + 1536 + g * 128 + m16;
#pragma unroll
        for (int nt = 0; nt < 8; ++nt) stv(op + 16 * nt, gelu_tanh_f(ldv(up + 16 * nt)) * (acc[nt][reg] + bs));
    }
}

constexpr int CW_MTC = 32768;
constexpr int CW_Q = 16384 + 256;
constexpr int CW_CTXDONE = 16384 + 384;
__device__ __forceinline__ void wg_wait_ge(unsigned* w, unsigned need) {
    if (threadIdx.x < 64) {
        unsigned sp = 0;
        while ((unsigned)__builtin_amdgcn_readfirstlane((int)__hip_atomic_load(w, __ATOMIC_RELAXED, __HIP_MEMORY_SCOPE_AGENT)) < need) { __builtin_amdgcn_s_sleep(2); if (++sp > (1u << 22)) break; }
        __builtin_amdgcn_fence(__ATOMIC_ACQUIRE, "agent");
        asm volatile("s_waitcnt vmcnt(0)" ::: "memory");
    }
    __syncthreads();
}
constexpr int CW_INP = 16384 + 512;
__device__ __forceinline__ void ph_mixers(const Ctx& C, int l) {
    const bool last = (l == DEPTH - 1);
    bool attn_ok = false, sgu_ok = false;
    const int nC = last ? 0 : 12, nCS = last ? 0 : 8, nB = 192, nA = 192, nG = last ? 0 : 8, nS = 256;
    const int nA1 = 256 - nC - nCS - nB > 0 ? (256 - nC - nCS - nB < nA ? 256 - nC - nCS - nB : nA) : 0;
    const int total = nC + nCS + nB + nA + nG + nS;
    LAS int* qs = (LAS int*)(C.lds + att::QSLOT_OFF);
    unsigned* ctr = C_CTLW + CW_Q + l;
    unsigned* ctxdone = C_CTLW + CW_CTXDONE;
    for (;;) {
        __syncthreads();
        if (C.tid == 0) *qs = (int)atomicAdd(ctr, 1u);
        __syncthreads();
        int r = *qs;
        if (r >= total) break;
        int kind = -1, u = 0, h = 0;
        if (r < nC) { kind = 2 + r / 6; h = r % 6; }
        else { r -= nC;
          if (r < nCS) { kind = 5; u = 64 + r / 4; h = r % 4; }
          else { r -= nCS;
            if (r < nB) { kind = 1; u = r / 6; h = r % 6; }
            else { r -= nB;
              if (r < nA1) { kind = 0; u = r / 6; h = r % 6; }
              else { r -= nA1;
                if (r < nG) { kind = 4; u = r; }
                else { r -= nG;
                  if (r < nA - nA1) { kind = 0; u = (r + nA1) / 6; h = (r + nA1) % 6; }
                  else { r -= nA - nA1; kind = 5; u = r / 4; h = r % 4; } } } } } }
        if (kind != 5 && !attn_ok) { wg_wait_ge(C_CTLW + CW_INP + l * 128, (NTOK / 256) * 14); attn_ok = true; }
        if (kind == 5 && !sgu_ok) { wg_wait_ge(C_CTLW + CW_INP + l * 128 + 64, (NTOK / 256) * 4); sgu_ok = true; }
        int t_ = threadIdx.x; asm volatile("" : "+v"(t_));
        if (kind == 1) att::attn_unit<1>(C_P, C_MIX, C_rpb + l * 6 * 465, C_sink + l * 6, u, h, (LAS char*)C.lds, t_);
        else if (kind == 0) att::attn_unit<0>(C_P, C_MIX, C_rpb + l * 6 * 465, C_sink + l * 6, u, h, (LAS char*)C.lds, t_);
        else if (kind == 2) att::attn_unit<2>(C_P, C_MIX, C_rpb + l * 6 * 465, C_sink + l * 6, u, h, (LAS char*)C.lds, t_);
        else if (kind == 3) att::attn_unit<3>(C_P, C_MIX, C_rpb + l * 6 * 465, C_sink + l * 6, u, h, (LAS char*)C.lds, t_);
        else if (kind == 5) { Ctx C2 = C; C2.tid = t_; C2.lane = t_ & 63; C2.wave = __builtin_amdgcn_readfirstlane(t_ >> 6); sgu_item(C2, l, u, h); }
        else {
            if (t_ < 64) {
                unsigned sp = 0;
                while (__builtin_amdgcn_readfirstlane((int)__hip_atomic_load(ctxdone, __ATOMIC_RELAXED, __HIP_MEMORY_SCOPE_AGENT)) < nC + nCS) { __builtin_amdgcn_s_sleep(2); if (++sp > (1u << 22)) break; }
                __builtin_amdgcn_fence(__ATOMIC_ACQUIRE, "agent");
                asm volatile("s_waitcnt vmcnt(0)" ::: "memory");
            }
            __syncthreads();
            pg8::Unit uu; uu.pm = SEQ / 256; uu.pn = u; uu.A = (const char*)(C_MIX + (size_t)SEQ * D); uu.B = (const char*)(C_WOUT + (size_t)l * D * D + (size_t)u * 256 * D);
            pg8::OneUnit S{uu};
            pg8::EpiTres E{C_T, C_x, C_ctx, modp(C, l, 0, 2), modp(C, l, 1, 2)};
            pg8::gemm_phase<D>(C.lds, S, E);
        }
        if (kind == 2 || kind == 3 || (kind == 5 && u >= 64)) {
            asm volatile("s_waitcnt vmcnt(0)" ::: "memory");
            __syncthreads();
            if (threadIdx.x == 0) { __builtin_amdgcn_fence(__ATOMIC_RELEASE, "agent"); asm volatile("s_waitcnt vmcnt(0)" ::: "memory"); __hip_atomic_fetch_add(ctxdone, 1u, __ATOMIC_RELAXED, __HIP_MEMORY_SCOPE_AGENT); }
        }
    }
}

constexpr int WS_POS_OFF = 3 * 1024 * 1024 + 768 * 1024;
#define C_POS ((int*)(C.ws + C.z + WS_POS_OFF))
__device__ __forceinline__ void ph_ln1(const Ctx& C, int l) {
    typedef short bf16x8v __attribute__((ext_vector_type(8)));
    typedef float f32x4v __attribute__((ext_vector_type(4)));
    const bool last = (l == DEPTH - 1);
    const int nrows = last ? SEQ : NTOK;
    const int RPB = __builtin_amdgcn_readfirstlane((nrows + C.G - 1) / C.G);
    const int row_lo = __builtin_amdgcn_readfirstlane(C.bid * RPB), row_hi = __builtin_amdgcn_readfirstlane((row_lo + RPB < nrows) ? row_lo + RPB : nrows);
    const int lane = C.lane, wave = C.wave, tid = C.tid;
    LAS float* hbuf = (LAS float*)C.lds;
    LAS float* red = (LAS float*)C.lds;
    LAS int* hist = (LAS int*)(C.lds + 131072 + 1024);
    LAS int* rinfo = hist + 64;
    LAS int* rrank = rinfo + 256;
    const float* gam = C_ln1_g + l * D; const float* bet = C_ln1_b + l * D;
    if (tid < 32) hist[tid] = 0;
    LAS float* vecs = (LAS float*)(C.lds + 135168);
    { *(LAS f32x4v*)(vecs + 4 * tid) = *(const f32x4v*)(gam + 4 * tid); *(LAS f32x4v*)(vecs + D + 4 * tid) = *(const f32x4v*)(bet + 4 * tid);
      *(LAS f32x4v*)(vecs + 2 * D + 4 * tid) = *(const f32x4v*)(modp(C, l, 0, 4) + 4 * tid); }
    for (int sr = 0; row_lo + 16 * sr < row_hi; ++sr) {
        __syncthreads();
#pragma unroll
        for (int hsel = 0; hsel < 2; ++hsel) {
            const int slot = wave + 8 * hsel, r = row_lo + 16 * sr + slot;
            LAS float* hr = hbuf + slot * D;
            if (r < row_hi) {
                const int kind = r < SEQ ? 0 : 1;
                const float* tp = C_T + (size_t)r * D;
                const float* sc2 = modp(C, l, kind, 4); const float* sh2 = modp(C, l, kind, 3);
                float v[32]; float sm = 0.f;
                f32x4v shv[8];
#pragma unroll
                for (int j = 0; j < 8; ++j) { const float4 t4 = *(const float4*)(tp + 4 * lane + 256 * j); shv[j] = *(const f32x4v*)(sh2 + 4 * lane + 256 * j);
                    v[4 * j] = t4.x; v[4 * j + 1] = t4.y; v[4 * j + 2] = t4.z; v[4 * j + 3] = t4.w; sm += (t4.x + t4.y) + (t4.z + t4.w); }
                const float mu = wave_sum(sm) * (1.f / D);
                float q = 0.f;
#pragma unroll
                for (int k = 0; k < 32; ++k) { v[k] -= mu; q += v[k] * v[k]; }
                const float rstd = 1.0f / sqrtf(wave_sum(q) * (1.f / D) + LN_EPS);
                if (lane == 0) { C_STAT[2 * r] = mu; C_STAT[2 * r + 1] = rstd; }
#pragma unroll
                for (int j = 0; j < 8; ++j) {
                    const int d0 = 4 * lane + 256 * j;
                    const f32x4v g4v = *(const LAS f32x4v*)(vecs + d0), b4v = *(const LAS f32x4v*)(vecs + D + d0);
                    f32x4v sc4v = *(const LAS f32x4v*)(vecs + 2 * D + d0);
                    if (kind) sc4v = *(const f32x4v*)(sc2 + d0);
                    const float4 g4 = {g4v[0], g4v[1], g4v[2], g4v[3]}, b4 = {b4v[0], b4v[1], b4v[2], b4v[3]}, sc4 = {sc4v[0], sc4v[1], sc4v[2], sc4v[3]}, sh4 = {shv[j][0], shv[j][1], shv[j][2], shv[j][3]};
                    float4 x1, h2;
                    x1.x = v[4 * j + 0] * rstd * g4.x + b4.x; x1.y = v[4 * j + 1] * rstd * g4.y + b4.y; x1.z = v[4 * j + 2] * rstd * g4.z + b4.z; x1.w = v[4 * j + 3] * rstd * g4.w + b4.w;
                    h2.x = x1.x * (1.f + sc4.x) + sh4.x; h2.y = x1.y * (1.f + sc4.y) + sh4.y; h2.z = x1.z * (1.f + sc4.z) + sh4.z; h2.w = x1.w * (1.f + sc4.w) + sh4.w;
                    st4(&C_H2[(size_t)r * D + d0], h2);
                    *(LAS f32x4v*)(hr + d0) = (f32x4v){h2.x, h2.y, h2.z, h2.w};
                }
            } else {
#pragma unroll
                for (int j = 0; j < 8; ++j) *(LAS f32x4v*)(hr + 4 * lane + 256 * j) = (f32x4v){0.f, 0.f, 0.f, 0.f};
            }
        }
        __syncthreads();
        f32x4v acc0 = {0.f, 0.f, 0.f, 0.f}, acc1 = {0.f, 0.f, 0.f, 0.f};
        {
            const int m16 = lane & 15, kg = lane >> 4;
            const bf16_t* wt = C_WRT + (size_t)m16 * D + 256 * wave + 8 * kg;
            const LAS float* ar = hbuf + m16 * D + 256 * wave + 8 * kg;
#pragma unroll 4
            for (int ks = 0; ks < 8; ++ks) {
                const f32x4v a0 = *(const LAS f32x4v*)(ar + 32 * ks), a1 = *(const LAS f32x4v*)(ar + 32 * ks + 4);
                uint4 hi, lo;
                hi.x = pg8::cvt_pk_bf16(a0[0], a0[1]); hi.y = pg8::cvt_pk_bf16(a0[2], a0[3]); hi.z = pg8::cvt_pk_bf16(a1[0], a1[1]); hi.w = pg8::cvt_pk_bf16(a1[2], a1[3]);
                lo.x = pg8::cvt_pk_bf16(a0[0] - __uint_as_float(hi.x << 16), a0[1] - __uint_as_float(hi.x & 0xffff0000u));
                lo.y = pg8::cvt_pk_bf16(a0[2] - __uint_as_float(hi.y << 16), a0[3] - __uint_as_float(hi.y & 0xffff0000u));
                lo.z = pg8::cvt_pk_bf16(a1[0] - __uint_as_float(hi.z << 16), a1[1] - __uint_as_float(hi.z & 0xffff0000u));
                lo.w = pg8::cvt_pk_bf16(a1[2] - __uint_as_float(hi.w << 16), a1[3] - __uint_as_float(hi.w & 0xffff0000u));
                const bf16x8v Ah = *reinterpret_cast<bf16x8v*>(&hi), Al = *reinterpret_cast<bf16x8v*>(&lo);
                const bf16x8v B0h = *reinterpret_cast<const bf16x8v*>(wt + 32 * ks), B1h = *reinterpret_cast<const bf16x8v*>(wt + 16 * D + 32 * ks);
                const bf16x8v B0l = *reinterpret_cast<const bf16x8v*>(wt + NE * D + 32 * ks), B1l = *reinterpret_cast<const bf16x8v*>(wt + NE * D + 16 * D + 32 * ks);
                acc0 = __builtin_amdgcn_mfma_f32_16x16x32_bf16(Ah, B0h, acc0, 0, 0, 0); acc1 = __builtin_amdgcn_mfma_f32_16x16x32_bf16(Ah, B1h, acc1, 0, 0, 0);
                acc0 = __builtin_amdgcn_mfma_f32_16x16x32_bf16(Ah, B0l, acc0, 0, 0, 0); acc1 = __builtin_amdgcn_mfma_f32_16x16x32_bf16(Ah, B1l, acc1, 0, 0, 0);
                acc0 = __builtin_amdgcn_mfma_f32_16x16x32_bf16(Al, B0h, acc0, 0, 0, 0); acc1 = __builtin_amdgcn_mfma_f32_16x16x32_bf16(Al, B1h, acc1, 0, 0, 0);
            }
        }
        __syncthreads();
        {
            const int m16 = lane & 15, kg = lane >> 4;
#pragma unroll
            for (int reg = 0; reg < 4; ++reg) { red[(wave * 16 + 4 * kg + reg) * 32 + m16] = acc0[reg]; red[(wave * 16 + 4 * kg + reg) * 32 + 16 + m16] = acc1[reg]; }
        }
        __syncthreads();
        if (tid < 16 && row_lo + 16 * sr + tid < row_hi) {
            const int r = row_lo + 16 * sr + tid;
            float bestgs = -3.0e38f; int be0 = 0, be1 = 0; float bw0 = 0.f, bw1 = 0.f;
#pragma unroll 1
            for (int gq2 = 0; gq2 < 4; ++gq2) {
                float m1 = -3.0e38f, m2 = -3.0e38f, s1 = 0.f, s2 = 0.f; int i1 = 0, i2 = 0;
#pragma unroll 1
                for (int t = 0; t < 8; ++t) {
                    const int e = gq2 * 8 + t;
                    float lg = 0.f;
#pragma unroll
                    for (int w = 0; w < 8; ++w) lg += red[(w * 16 + tid) * 32 + e];
                    const float scv = 1.f / (1.f + expf(-lg)), bv = scv + C_router_bias[e];
                    if (bv > m1) { m2 = m1; i2 = i1; s2 = s1; m1 = bv; i1 = e; s1 = scv; }
                    else if (bv > m2) { m2 = bv; i2 = e; s2 = scv; }
                }
                const float gs = m1 + m2;
                if (gs > bestgs) { bestgs = gs; be0 = i1; be1 = i2; bw0 = s1; bw1 = s2; }
            }
            const float inv = 1.f / (bw0 + bw1);
            LAS int* ri = rinfo + (r - row_lo) * 4;
            ri[0] = be0; ri[1] = be1; ri[2] = __float_as_int(bw0 * inv); ri[3] = __float_as_int(bw1 * inv);
        }
    }
    const int nb = row_hi - row_lo;
    __syncthreads();
    int e_mine = 0;
    if (tid < 2 * nb) { e_mine = rinfo[(tid >> 1) * 4 + (tid & 1)]; rrank[tid] = (int)__hip_atomic_fetch_add((LAS unsigned*)(hist + e_mine), 1u, __ATOMIC_RELAXED, __HIP_MEMORY_SCOPE_WORKGROUP); }
    __syncthreads();
    if (tid < 32) { const int cnt = hist[tid]; hist[32 + tid] = cnt ? (int)atomicAdd(C_CTLW + CW_CNT + l * 32 + tid, (unsigned)cnt) : 0; }
    __syncthreads();
    if (tid < 2 * nb) {
        const int r = row_lo + (tid >> 1), k = tid & 1;
        C_POS[(size_t)r * 2 + k] = hist[32 + e_mine] + rrank[tid];
        int* rp = C_ROUTE + (size_t)r * 4;
        rp[k] = e_mine; rp[2 + k] = rinfo[(tid >> 1) * 4 + 2 + k];
    }
}

constexpr int TOFF_OFF = 131072;
__device__ __forceinline__ void compute_toff(const Ctx& C, int l) {
    LAS int* toff = (LAS int*)(C.lds + TOFF_OFF);
    __syncthreads();
    if (C.tid == 0) { int acc = 0;
        for (int e = 0; e < NE; ++e) { toff[e] = acc; acc += ((int)__hip_atomic_load(C_CTLW + CW_CNT + l * 32 + e, __ATOMIC_RELAXED, __HIP_MEMORY_SCOPE_AGENT) + 255) >> 8; }
        toff[NE] = acc; }
    __syncthreads();
}
__device__ __forceinline__ void ph_dispatch(const Ctx& C, int l) {
    const bool last = (l == DEPTH - 1);
    const int nrows = last ? SEQ : NTOK;
    const int gw = C.bid * NWAVES + C.wave, NGW = C.G * NWAVES, lane = C.lane;
    compute_toff(C, l);
    const LAS int* toff = (const LAS int*)(C.lds + TOFF_OFF);
    for (int it = gw; it < nrows * 2; it += NGW) {
        const int r = it >> 1, k = it & 1;
        const int e = C_ROUTE[(size_t)r * 4 + k];
        const int slot = toff[e] * 256 + C_POS[it];
        if (lane == 0) { C_SLOT[it] = slot; C_SW[slot] = __int_as_float(C_ROUTE[(size_t)r * 4 + 2 + k]); }
        const uint4* src = (const uint4*)(C_H2 + (size_t)r * D); uint4* dst = (uint4*)(C_HS + (size_t)slot * D);
#pragma unroll
        for (int j = 0; j < 4; ++j) dst[lane + 64 * j] = src[lane + 64 * j];
    }
}

__device__ __forceinline__ void ph_ln2(const Ctx& C, int l) {
    const bool last = (l == DEPTH - 1);
    const int nrows = last ? SEQ : NTOK;
    const int gw = C.bid * NWAVES + C.wave, NGW = C.G * NWAVES, lane = C.lane;
    LAS float* vec0 = (LAS float*)C.lds;
    {
        const int ln = last ? l : l + 1;
#pragma unroll
        for (int k = 0; k < 2; ++k) {
            *(LAS pg8::f32x4*)(vec0 + (k * 5 + 0) * D + 4 * C.tid) = *(const pg8::f32x4*)(modp(C, l, k, 5) + 4 * C.tid);
            *(LAS pg8::f32x4*)(vec0 + (k * 5 + 1) * D + 4 * C.tid) = *(const pg8::f32x4*)(C_ln2_g + l * D + 4 * C.tid);
            *(LAS pg8::f32x4*)(vec0 + (k * 5 + 2) * D + 4 * C.tid) = *(const pg8::f32x4*)(C_ln2_b + l * D + 4 * C.tid);
            *(LAS pg8::f32x4*)(vec0 + (k * 5 + 3) * D + 4 * C.tid) = *(const pg8::f32x4*)(modp(C, ln, k, 1) + 4 * C.tid);
            *(LAS pg8::f32x4*)(vec0 + (k * 5 + 4) * D + 4 * C.tid) = *(const pg8::f32x4*)(modp(C, ln, k, 0) + 4 * C.tid);
        }
        *(LAS pg8::f32x4*)(vec0 + 10 * D + 4 * C.tid) = *(const pg8::f32x4*)(C_ln1_g + l * D + 4 * C.tid);
        *(LAS pg8::f32x4*)(vec0 + 11 * D + 4 * C.tid) = *(const pg8::f32x4*)(C_ln1_b + l * D + 4 * C.tid);
        __syncthreads();
    }
    for (int r = gw; r < nrows; r += NGW) {
        const LAS float* vec = vec0 + (r < SEQ ? 0 : 5 * D);
        const int s0 = C_SLOT[2 * r], s1 = C_SLOT[2 * r + 1];
        float4 xv[8]; uint2 ya[8], yb[8];
#pragma unroll
        for (int j = 0; j < 8; ++j) { const int d0 = 4 * lane + 256 * j;
            xv[j] = *(const float4*)(C_T + (size_t)r * D + d0); ya[j] = *(const uint2*)(C_Y + (size_t)s0 * D + d0); yb[j] = *(const uint2*)(C_Y + (size_t)s1 * D + d0); }
        const float mu1 = C_STAT[2 * r], rs1 = C_STAT[2 * r + 1];
        float v[32]; float s = 0.f;
#pragma unroll
        for (int j = 0; j < 8; ++j) { const int d0 = 4 * lane + 256 * j;
            { const pg8::f32x4 ga = *(const LAS pg8::f32x4*)(vec0 + 10 * D + d0), be = *(const LAS pg8::f32x4*)(vec0 + 11 * D + d0);
              xv[j].x = (xv[j].x - mu1) * rs1 * ga[0] + be[0]; xv[j].y = (xv[j].y - mu1) * rs1 * ga[1] + be[1]; xv[j].z = (xv[j].z - mu1) * rs1 * ga[2] + be[2]; xv[j].w = (xv[j].w - mu1) * rs1 * ga[3] + be[3]; }
            const pg8::f32x4 g4 = *(const LAS pg8::f32x4*)(vec + d0);
            const float y0 = __uint_as_float(ya[j].x << 16) + __uint_as_float(yb[j].x << 16), y1 = __uint_as_float(ya[j].x & 0xffff0000u) + __uint_as_float(yb[j].x & 0xffff0000u);
            const float y2 = __uint_as_float(ya[j].y << 16) + __uint_as_float(yb[j].y << 16), y3 = __uint_as_float(ya[j].y & 0xffff0000u) + __uint_as_float(yb[j].y & 0xffff0000u);
            v[4 * j + 0] = ALPHA * xv[j].x + g4[0] * y0; v[4 * j + 1] = ALPHA * xv[j].y + g4[1] * y1; v[4 * j + 2] = ALPHA * xv[j].z + g4[2] * y2; v[4 * j + 3] = ALPHA * xv[j].w + g4[3] * y3;
            s += (v[4 * j] + v[4 * j + 1]) + (v[4 * j + 2] + v[4 * j + 3]); }
        const float mu = wave_sum(s) * (1.f / D);
        float q = 0.f;
#pragma unroll
        for (int i = 0; i < 32; ++i) { v[i] -= mu; q += v[i] * v[i]; }
        const float rstd = 1.0f / sqrtf(wave_sum(q) * (1.f / D) + LN_EPS);
#pragma unroll
        for (int j = 0; j < 8; ++j) { const int d0 = 4 * lane + 256 * j;
            const pg8::f32x4 g4 = *(const LAS pg8::f32x4*)(vec + D + d0), b4 = *(const LAS pg8::f32x4*)(vec + 2 * D + d0);
            float4 xo;
            xo.x = v[4 * j + 0] * rstd * g4[0] + b4[0]; xo.y = v[4 * j + 1] * rstd * g4[1] + b4[1]; xo.z = v[4 * j + 2] * rstd * g4[2] + b4[2]; xo.w = v[4 * j + 3] * rstd * g4[3] + b4[3];
            if (last) *(float4*)(C.out + C.z + (size_t)r * D + d0) = xo;
            else {
                *(float4*)(C_XB + (size_t)r * D + d0) = xo;
                const pg8::f32x4 sc4 = *(const LAS pg8::f32x4*)(vec + 3 * D + d0), sh4 = *(const LAS pg8::f32x4*)(vec + 4 * D + d0);
                float4 hn; hn.x = xo.x * (1.f + sc4[0]) + sh4[0]; hn.y = xo.y * (1.f + sc4[1]) + sh4[1]; hn.z = xo.z * (1.f + sc4[2]) + sh4[2]; hn.w = xo.w * (1.f + sc4[3]) + sh4[3];
                st4(&C_H[(size_t)r * D + d0], hn);
            }
        }
    }
}

__device__ __forceinline__ Ctx fresh(const Ctx& C0) { Ctx C = C0; size_t z = 0; int t = threadIdx.x; int g_ = gridDim.x, b_ = blockIdx.x; asm volatile("" : "+s"(z), "+v"(t), "+s"(g_), "+s"(b_)); C.G = g_; C.bid = b_; C.z = z; C.tid = t; C.lane = t & 63; C.wave = __builtin_amdgcn_readfirstlane(t >> 6); return C; }
constexpr int PH_PER_LAYER = 7;
constexpr int N_PHASES = 2 + PH_PER_LAYER * DEPTH;
__global__ void __launch_bounds__(NTHREADS, 2) fwd_kernel(Args args) {
    extern __shared__ __attribute__((aligned(16))) unsigned char lds_raw[];
    Ctx C0;
    C0.lds = (LAS unsigned char*)lds_raw;
    C0.tid = threadIdx.x; C0.lane = C0.tid & 63; C0.wave = __builtin_amdgcn_readfirstlane(C0.tid >> 6); C0.G = gridDim.x; C0.bid = blockIdx.x;
    C0.in = args.in; C0.out = args.out; C0.ws = args.ws; C0.z = 0;
    unsigned char* ws = args.ws;

    volatile LAS unsigned* bst = (volatile LAS unsigned*)(C0.lds + LDS_BYTES - 16);
    if (C0.tid < 4) bst[C0.tid] = 0u;
    __syncthreads();
    const int lo = args.ph_lo, hi = args.ph_hi;
    XcdBarrier bar; bar.bar = (unsigned*)(ws + WS_CTL) + CW_BAR; bar.x = 0; bar.st = bst;
    if (hi - lo > 1) bar = xcd_barrier_post((unsigned*)(ws + WS_CTL) + CW_BAR, bst);
#define IN(k) (lo <= (k) && (k) < hi)
#define SEAM(k) do { if (IN(k) && IN((k) + 1)) xcd_barrier(bar); } while (0)

    if (IN(0)) { const Ctx C = fresh(C0); ph_prologue(C); } SEAM(0);
    if (IN(1)) { const Ctx C = fresh(C0); ph_modulate0(C); } SEAM(1);
#pragma unroll 1
    for (int l = 0; l < DEPTH; ++l) {
        const int pb = 2 + PH_PER_LAYER * l;
        const bool last = (l == DEPTH - 1);
        if (IN(pb + 0)) {
            const Ctx C = fresh(C0);
            const int vid = (C.G % 8 == 0) ? (C.bid % 8) * (C.G / 8) + C.bid / 8 : C.bid;
            pg8::InprojSched S{C.G, vid, (const char*)C_H, (const char*)(C_WIN + (size_t)l * INC * D), C_CTLW + CW_INP + l * 128};
            pg8::EpiP E{C_P, C_ROPE};
            pg8::gemm_phase<D>(C.lds, S, E);
        }
        if (IN(pb + 1)) { const Ctx C = fresh(C0); ph_mixers(C, l); } SEAM(pb + 1);
        if (IN(pb + 2)) {
            const Ctx C = fresh(C0);
            pg8::DenseSched<D / 256, D> S{SEQ / 256, C.G, C.bid, (const char*)C_MIX, (const char*)(C_WOUT + (size_t)l * D * D)};
            pg8::EpiTres E{C_T, l == 0 ? C_x : C_XB, l == 0 ? C_ctx : C_XB + (size_t)SEQ * D, modp(C, l, 0, 2), modp(C, l, 1, 2)};
            pg8::gemm_phase<D>(C.lds, S, E);
        }
        SEAM(pb + 2);
        if (IN(pb + 3)) { const Ctx C = fresh(C0); ph_ln1(C, l); } SEAM(pb + 3);
        if (IN(pb + 4)) { const Ctx C = fresh(C0); ph_dispatch(C, l); } SEAM(pb + 4);
        if (IN(pb + 5)) {
            const Ctx C = fresh(C0);
            compute_toff(C, l);
            const int vid = (C.G % 8 == 0) ? (C.bid % 8) * (C.G / 8) + C.bid / 8 : C.bid;
            unsigned* mtc = C_CTLW + CW_MTC + l * (128 * 64);
            { pg8::MoeSched1 S{(const LAS int*)(C.lds + TOFF_OFF), C.G, vid, (const char*)C_HS, (const char*)(C_WGU + (size_t)l * NE * 1024 * D), mtc};
              pg8::EpiMoe1 E{C_HID, C_SW};
              pg8::gemm_phase<D>(C.lds, S, E); }
            { pg8::MoeSched2 S{(const LAS int*)(C.lds + TOFF_OFF), C.G, vid, (const char*)C_HID, (const char*)(C_WD + (size_t)l * NE * D * FF), mtc};
              pg8::EpiBf16 E{C_Y, D};
              pg8::gemm_phase<FF>(C.lds, S, E); }
        }
        SEAM(pb + 5);
        if (IN(pb + 6)) { const Ctx C = fresh(C0); ph_ln2(C, l); }
        if (!last) SEAM(pb + 6);
    }
#undef IN
#undef SEAM
}

#ifndef MK_N_LAUNCHES
#define MK_N_LAUNCHES 1
#endif
extern "C" void kernel_launch(void* const* d_in, const int* in_sizes, int n_in, void* d_out, int out_size, void* d_ws, size_t ws_size, hipStream_t stream) {
    static int grid = 0;
    if (grid == 0) {
        if (n_in != 23 || out_size != SEQ * D || ws_size < WS_END) {
            fprintf(stderr, "kernel_launch: unexpected shapes: n_in %d out %d ws %zu (need %zu)\n", n_in, out_size, ws_size, (size_t)WS_END); grid = -1; return; }
        int dev = 0, cus = 0;
        if (hipGetDevice(&dev) != hipSuccess || hipDeviceGetAttribute(&cus, hipDeviceAttributeMultiprocessorCount, dev) != hipSuccess) { grid = -1; return; }
        if (hipFuncSetAttribute((const void*)fwd_kernel, hipFuncAttributeMaxDynamicSharedMemorySize, LDS_BYTES) != hipSuccess) { fprintf(stderr, "kernel_launch: hipFuncSetAttribute failed\n"); grid = -1; return; }
        int per_cu = 0;
        if (hipOccupancyMaxActiveBlocksPerMultiprocessor(&per_cu, (const void*)fwd_kernel, NTHREADS, LDS_BYTES) != hipSuccess || per_cu < 1) fprintf(stderr, "kernel_launch: occupancy query says %d\n", per_cu);
        (void)hipGetLastError();
        grid = cus;
    }
    if (grid < 0) return;
    hipMemsetAsync((char*)d_ws + WS_CTL, 0, CTL_BYTES, stream);
    Args a{};
    for (int i = 0; i < 23; ++i) a.in[i] = (const float*)d_in[i];
    a.out = (float*)d_out; a.ws = (unsigned char*)d_ws;
    if (MK_N_LAUNCHES == 1) {
        a.ph_lo = 0; a.ph_hi = N_PHASES;
        hipLaunchKernelGGL(fwd_kernel, dim3(grid), dim3(NTHREADS), LDS_BYTES, stream, a);
    } else {
        for (int p = 0; p < N_PHASES; ++p) {
            a.ph_lo = p; a.ph_hi = p + 1;
            hipLaunchKernelGGL(fwd_kernel, dim3(grid), dim3(NTHREADS), LDS_BYTES, stream, a);
        }
    }
    const hipError_t le = hipPeekAtLastError();
    if (le != hipSuccess) fprintf(stderr, "kernel_launch: launch failed: %s\n", hipGetErrorName(le));
}
```

```cpp
#include <hip/hip_runtime.h>
#include <cstdio>
#include <cstdint>

#define LAS __attribute__((address_space(3)))
typedef unsigned short bf16_t;

constexpr int D = 2048, SEQ = 8192, CTXL = 256, NTOK = SEQ + CTXL;
constexpr int DEPTH = 2, GRID_W = 64, HD = 128;
constexpr int INC = 4608;
constexpr int OFF_AK = 768, OFF_AV = 1024, OFF_BQ = 1280, OFF_BK = 2048, OFF_BV = 2816, OFF_C = 3584;
constexpr int NE = 32, FF = 512, CW = 512;
constexpr float LN_EPS = 1e-5f;
constexpr float ALPHA = 1.4142135623730951f;
constexpr float QSCALE = 0.08838834764831845f;
constexpr int NTHREADS = 512, NWAVES = 8;

typedef bf16_t AT;
__device__ __forceinline__ float ldv(const float* p) { return *p; }
__device__ __forceinline__ void stv(float* p, float v) { *p = v; }
__device__ __forceinline__ float bf2f(bf16_t b) { return __uint_as_float(((unsigned)b) << 16); }
__device__ __forceinline__ bf16_t f2bf(float f) { unsigned u = __float_as_uint(f); return (bf16_t)((u + 0x7fffu + ((u >> 16) & 1u)) >> 16); }
__device__ __forceinline__ float ldv(const bf16_t* p) { return bf2f(*p); }
__device__ __forceinline__ void stv(bf16_t* p, float v) { *p = f2bf(v); }

__device__ __forceinline__ float4 ld4(const float* p) { return *(const float4*)p; }
__device__ __forceinline__ void st4(float* p, float4 v) { *(float4*)p = v; }
__device__ __forceinline__ float4 ld4(const bf16_t* p) { const uint2 u = *(const uint2*)p; float4 r; r.x = __uint_as_float(u.x << 16); r.y = __uint_as_float(u.x & 0xffff0000u); r.z = __uint_as_float(u.y << 16); r.w = __uint_as_float(u.y & 0xffff0000u); return r; }
__device__ __forceinline__ void st4(bf16_t* p, float4 v) { uint2 u; u.x = (unsigned)f2bf(v.x) | ((unsigned)f2bf(v.y) << 16); u.y = (unsigned)f2bf(v.z) | ((unsigned)f2bf(v.w) << 16); *(uint2*)p = u; }

constexpr size_t MiB = 1u << 20;
constexpr size_t WS_CTL = 0, CTL_BYTES = 1 * MiB;
constexpr int CW_BAR = 4096, CW_CNT = 16384, CW_CUR = 16384 + 128;
constexpr size_t WS_MOD = 1 * MiB;
constexpr size_t WS_ROPE = 2 * MiB;
constexpr size_t WS_ROUTE = 3 * MiB;
constexpr size_t WS_SLOT = 3 * MiB + 512 * 1024;
constexpr size_t WS_SW = 4 * MiB;
constexpr size_t WS_WRT = 4 * MiB + 512 * 1024;
constexpr size_t WS_MODP = 5 * MiB;
constexpr int MAXSLOT = 25088;
constexpr size_t WS_WIN = 8 * MiB;
constexpr size_t WS_WOUT = 44 * MiB;
constexpr size_t WS_WGU = 64 * MiB;
constexpr size_t WS_WD = 320 * MiB;
constexpr size_t WS_H = 448 * MiB;
constexpr size_t WS_P = 482 * MiB;
constexpr size_t WS_MIX = 558 * MiB;
constexpr size_t WS_T = 592 * MiB;
constexpr size_t WS_X1 = 660 * MiB;
constexpr size_t WS_XB = 728 * MiB;
constexpr size_t WS_H2 = 796 * MiB;
constexpr size_t WS_HS = 830 * MiB;
constexpr size_t WS_HID = 930 * MiB;
constexpr size_t WS_Y = 956 * MiB;
constexpr size_t WS_END = 1056 * MiB;

constexpr int LDS_BYTES = 163840;

#define XB_TMO      128
#define XB_XCNT(j)  (256  + 64 * (j))
#define XB_XSUB(j)  (1280 + 64 * (j))
#define XB_XGEN(j)  (2304 + 64 * (j))
#define XB_TOP      3328
#define XB_TOPGEN   3392
#define XCD_BAR_WORDS 3456
#define XB_SPIN_CAP (1u << 18)
__device__ __forceinline__ unsigned xb_ld(unsigned* p)              { return __hip_atomic_load(p, __ATOMIC_RELAXED, __HIP_MEMORY_SCOPE_AGENT); }
__device__ __forceinline__ unsigned xb_add(unsigned* p, unsigned v) { return __hip_atomic_fetch_add(p, v, __ATOMIC_RELAXED, __HIP_MEMORY_SCOPE_AGENT); }
__device__ __forceinline__ unsigned xb_xcc_id() { return (unsigned)__builtin_amdgcn_s_getreg((3 << 11) | 20) & 0xFu; }
#define XB_SPIN(cond, bar) do { unsigned _sp = 0; while (cond) { __builtin_amdgcn_s_sleep(1); \
    if ((++_sp & 255u) == 0u) { if (xb_ld(&(bar)[XB_TMO])) break; if (_sp > XB_SPIN_CAP) { atomicAdd(&(bar)[XB_TMO], 1u); break; } } } } while (0)
struct XcdBarrier { unsigned* bar; unsigned x; volatile LAS unsigned* st; };
__device__ __forceinline__ XcdBarrier xcd_barrier_post(unsigned* bar, volatile LAS unsigned* st) {
    XcdBarrier b; b.bar = bar; b.x = xb_xcc_id(); b.st = st;
    if (threadIdx.x == 0) (void)xb_add(&bar[XB_XCNT(b.x)], 1u);
    return b;
}
__device__ __forceinline__ void xcd_barrier_complete(unsigned* bar, unsigned x, unsigned& nloc, unsigned& nx) {
    const unsigned G = gridDim.x * gridDim.y * gridDim.z;
    unsigned sum, cnt, mine, sp = 0u;
    for (;;) {
        sum = 0u; cnt = 0u; mine = 0u;
#pragma unroll
        for (unsigned j = 0; j < 16; ++j) { const unsigned c = xb_ld(&bar[XB_XCNT(j)]); sum += c; cnt += (c > 0u) ? 1u : 0u; mine = (j == x) ? c : mine; }
        if (sum == G) break;
        __builtin_amdgcn_s_sleep(1);
        if ((++sp & 255u) == 0u) { if (xb_ld(&bar[XB_TMO])) break; if (sp > XB_SPIN_CAP) { atomicAdd(&bar[XB_TMO], 1u); break; } }
    }
    nloc = mine > 0u ? mine : 1u; nx = cnt > 0u ? cnt : 1u;
}
__device__ __noinline__ void xcd_barrier(const XcdBarrier b) {
    asm volatile("s_waitcnt vmcnt(0)" ::: "memory");
    __syncthreads();
    if (threadIdx.x == 0) {
        unsigned* bar = b.bar;
        __builtin_amdgcn_s_waitcnt(0);
        unsigned nloc = b.st[0], nx = b.st[1];
        if (nloc == 0u) { xcd_barrier_complete(bar, b.x, nloc, nx); b.st[0] = nloc; b.st[1] = nx; }
        const unsigned old = xb_add(&bar[XB_XSUB(b.x)], 1u);
        const unsigned gen = old / nloc;
        if (old + 1u == (gen + 1u) * nloc) {
            __builtin_amdgcn_fence(__ATOMIC_RELEASE, "agent");
            asm volatile("s_waitcnt vmcnt(0)" ::: "memory");
            const unsigned og = xb_add(&bar[XB_TOP], 1u);
            const unsigned tg = og / nx;
            if (og + 1u == (tg + 1u) * nx) xb_add(&bar[XB_TOPGEN], 1u);
            else XB_SPIN(xb_ld(&bar[XB_TOPGEN]) == tg, bar);
            __builtin_amdgcn_fence(__ATOMIC_ACQUIRE, "agent");
            xb_add(&bar[XB_XGEN(b.x)], 1u);
            asm volatile("s_waitcnt vmcnt(0)" ::: "memory");
        } else {
            XB_SPIN(xb_ld(&bar[XB_XGEN(b.x)]) == gen, bar);
            __builtin_amdgcn_fence(__ATOMIC_ACQUIRE, "agent");
            asm volatile("s_waitcnt vmcnt(0)" ::: "memory");
        }
    }
    __syncthreads();
}

struct Args {
    const float* in[23];
    float* out;
    unsigned char* ws;
    int ph_lo, ph_hi;
};

struct Ctx {
    LAS unsigned char* lds;
    int tid, lane, wave, G, bid;
    const float* const* in;
    float* out;
    unsigned char* ws;
    size_t z;
};
#define CIN(k) (C.in[k] + C.z)
#define C_x CIN(0)
#define C_c CIN(1)
#define C_ctx CIN(2)
#define C_c_ctx CIN(3)
#define C_w_mod CIN(4)
#define C_b_mod CIN(5)
#define C_w_in CIN(6)
#define C_sink CIN(7)
#define C_rpb CIN(8)
#define C_sgu_g CIN(9)
#define C_sgu_bn CIN(10)
#define C_sgu_w CIN(11)
#define C_sgu_b CIN(12)
#define C_w_out CIN(13)
#define C_ln1_g CIN(14)
#define C_ln1_b CIN(15)
#define C_w_router CIN(16)
#define C_router_bias CIN(17)
#define C_w_gate CIN(18)
#define C_w_up CIN(19)
#define C_w_down CIN(20)
#define C_ln2_g CIN(21)
#define C_ln2_b CIN(22)
#define C_MOD ((float*)(C.ws + C.z + WS_MOD))
#define C_ROPE ((float*)(C.ws + C.z + WS_ROPE))
#define C_ROUTE ((int*)(C.ws + C.z + WS_ROUTE))
#define C_H ((AT*)(C.ws + C.z + WS_H))
#define C_P ((AT*)(C.ws + C.z + WS_P))
#define C_MIX ((AT*)(C.ws + C.z + WS_MIX))
#define C_T ((bf16_t*)(C.ws + C.z + WS_T))
#define C_X1 ((float*)(C.ws + C.z + WS_X1))
#define C_STAT ((float*)(C.ws + C.z + WS_X1))
#define C_XB ((float*)(C.ws + C.z + WS_XB))
#define C_H2 ((AT*)(C.ws + C.z + WS_H2))
#define C_HID ((AT*)(C.ws + C.z + WS_HID))
#define C_Y ((AT*)(C.ws + C.z + WS_Y))
#define C_HS ((AT*)(C.ws + C.z + WS_HS))
#define C_WRT ((bf16_t*)(C.ws + C.z + WS_WRT))
#define C_SLOT ((int*)(C.ws + C.z + WS_SLOT))
#define C_SW ((float*)(C.ws + C.z + WS_SW))
#define C_MODP ((float*)(C.ws + C.z + WS_MODP))
#define C_CTLW ((unsigned*)(C.ws + C.z + WS_CTL))
#define C_WIN ((bf16_t*)(C.ws + C.z + WS_WIN))
#define C_WOUT ((bf16_t*)(C.ws + C.z + WS_WOUT))
#define C_WGU ((bf16_t*)(C.ws + C.z + WS_WGU))
#define C_WD ((bf16_t*)(C.ws + C.z + WS_WD))

__device__ __forceinline__ float silu_f(float v) { return v / (1.f + expf(-v)); }
__device__ __forceinline__ float gelu_tanh_f(float v) { return 0.5f * v * (1.f + tanhf(0.7978845608028654f * (v + 0.044715f * v * v * v))); }
__device__ __forceinline__ float wave_sum(float v) {
#pragma unroll
    for (int o = 1; o < 64; o <<= 1) v += __shfl_xor(v, o);
    return v;
}
__device__ __forceinline__ float wave_max(float v) {
#pragma unroll
    for (int o = 1; o < 64; o <<= 1) v = fmaxf(v, __shfl_xor(v, o));
    return v;
}
__device__ __forceinline__ const float* modp(const Ctx& C, int l, int kind, int j) { return C_MOD + ((size_t)(l * 2 + kind) * 6 + j) * D; }
__device__ __forceinline__ const float* xin_row(const Ctx& C, int l, int r) {
    if (l == 0) return r < SEQ ? C_x + (size_t)r * D : C_ctx + (size_t)(r - SEQ) * D;
    return C_XB + (size_t)r * D;
}

namespace pg8 {
#define PG8_LAS __attribute__((address_space(3)))
typedef short bf16x8 __attribute__((ext_vector_type(8)));
typedef float f32x4 __attribute__((ext_vector_type(4)));
typedef unsigned u32x4 __attribute__((ext_vector_type(4)));
constexpr int BM = 256, BK = 64, HALF = 128, HTB = HALF * BK * 2, STAGE_BYTES = 8 * HTB, NXCD = 8, WGM = 8;
__host__ __device__ __forceinline__ int lds_byte(int r, int c) { const int st = (r >> 4) * 2 + (c >> 5), rr = r & 15, cc = c & 31, ob = rr * 64 + cc * 2; return st * 1024 + (ob ^ (((ob >> 9) & 1) << 5)); }
__host__ __device__ __forceinline__ void stage_rc(int b, int& R, int& C) { const int st = b / 1024, sb = b % 1024, swz = sb ^ (((sb >> 9) & 1) << 5); R = (st >> 1) * 16 + swz / 64; C = (st & 1) * 32 + (swz % 64) / 2; }
__host__ __device__ __forceinline__ int perm32(int rho) { const int n = rho >> 4, i = rho & 15; return 8 * (i >> 2) + 4 * n + (i & 3); }
__device__ __forceinline__ unsigned cvt_pk_bf16(float lo, float hi) { unsigned r; asm volatile("v_cvt_pk_bf16_f32 %0, %1, %2" : "=v"(r) : "v"(lo), "v"(hi)); return r; }

__device__ __forceinline__ void store16_wt(void* p, u32x4 v) { asm volatile("global_store_dwordx4 %0, %1, off sc1\n\ts_nop 1" :: "v"(p), "v"(v) : "memory"); }
struct Unit { int pm, pn; const char* A; const char* B; };

template <int NN  , int KD>
struct DenseSched {
    int nM, G, c; const char* A; const char* Bt;
    __device__ __forceinline__ bool next(int i, Unit& u) const {
        const int nwg = nM * NN;
        const int L = i * G + c; if (L >= nwg) return false;
        int wgid = L; { const int q = nwg / NXCD, r = nwg % NXCD, xcd = wgid % NXCD, off = wgid / NXCD; wgid = (xcd < r ? xcd * (q + 1) : r * (q + 1) + (xcd - r) * q) + off; }
        const int nig = WGM * NN, gid = wgid / nig, fm = gid * WGM, gsz = (nM - fm) < WGM ? (nM - fm) : WGM;
        u.pm = fm + ((wgid % nig) % gsz); u.pn = (wgid % nig) / gsz;
        u.A = A + (size_t)u.pm * (BM * KD * 2); u.B = Bt + (size_t)u.pn * (BM * KD * 2); return true;
    }
    __device__ __forceinline__ void a_ready(const Unit&) const {}
    __device__ __forceinline__ void done(const Unit&) const {}
};
struct InprojSched {
    int G, v; const char* A; const char* Bt; unsigned* cnt;
    __device__ __forceinline__ bool next(int i, Unit& u) const {
        const int j = i * G + v; constexpr int N1 = (NTOK / 256) * 14, N2 = (NTOK / 256) * 4;
        if (j >= N1 + N2) return false;
        if (j < N1) { if (j < 8 * 56) { const int g = j / 56, r = j % 56; u.pm = 4 * g + (r & 3); u.pn = r >> 2; } else { u.pm = 32; u.pn = j - 8 * 56; } }
        else { const int jj = j - N1; if (jj < 128) { const int g = jj >> 5, r = jj & 31; u.pm = 8 * g + (r & 7); u.pn = 14 + (r >> 3); } else { u.pm = 32; u.pn = 14 + (jj - 128); } }
        u.A = A + (size_t)u.pm * (BM * D * 2); u.B = Bt + (size_t)u.pn * (BM * D * 2); return true;
    }
    __device__ __forceinline__ void a_ready(const Unit&) const {}
    __device__ __forceinline__ void done(const Unit& u) const {
        asm volatile("s_waitcnt vmcnt(0)" ::: "memory");
        __builtin_amdgcn_s_barrier();
        if (threadIdx.x == 0) __hip_atomic_fetch_add(cnt + (u.pn < 14 ? 0 : 64), 1u, __ATOMIC_RELAXED, __HIP_MEMORY_SCOPE_AGENT);
    }
};
struct OneUnit { Unit u0; __device__ __forceinline__ bool next(int i, Unit& u) const { if (i != 0) return false; u = u0; return true; }
    __device__ __forceinline__ void a_ready(const Unit&) const {}
    __device__ __forceinline__ void done(const Unit&) const {} };
__device__ __forceinline__ int moe_expert_of(const PG8_LAS int* toff, int mt) { int e = 0; for (int q = 1; q < 32; ++q) e += (toff[q] <= mt) ? 1 : 0; return e; }
struct MoeSched1 {
    const PG8_LAS int* toff; int G, v; const char* A; const char* B; unsigned* mtc;
    __device__ __forceinline__ bool next(int i, Unit& u) const {
        const int MT = toff[32];
        const int L = i * G + v; if (L >= MT * 4) return false;
        const int mt = L >> 2, pn = L & 3, e = moe_expert_of(toff, mt);
        u.pm = mt; u.pn = pn; u.A = A + (size_t)mt * (256 * D * 2); u.B = B + (size_t)(e * 1024 + pn * 256) * (D * 2); return true;
    }
    __device__ __forceinline__ void a_ready(const Unit&) const {}
    __device__ __forceinline__ void done(const Unit& u) const {
        asm volatile("s_waitcnt vmcnt(0)" ::: "memory");
        __builtin_amdgcn_s_barrier();
        if (threadIdx.x == 0) __hip_atomic_fetch_add(mtc + 64 * u.pm, 1u, __ATOMIC_RELAXED, __HIP_MEMORY_SCOPE_AGENT);
    }
};
struct MoeSched2 {
    const PG8_LAS int* toff; int G, v; const char* A; const char* B; unsigned* mtc;
    __device__ __forceinline__ bool next(int i, Unit& u) const {
        const int MT = toff[32], N1 = MT * 4, N2 = MT * 8;
        const int r1 = N1 % G, nl = G - r1;
        const bool light = v >= r1;
        int j;
        if (light && i < 3) j = i * nl + (v - r1);
        else { const int ii = light ? i - 3 : i; j = 3 * nl + ii * G + (light ? v - r1 : nl + v); }
        if (j >= N2) return false;
        const int mt = j >> 3, pn = j & 7, e = moe_expert_of(toff, mt);
        u.pm = mt; u.pn = pn; u.A = A + (size_t)mt * (256 * FF * 2); u.B = B + (size_t)(e * D + pn * 256) * (FF * 2); return true;
    }
    __device__ __forceinline__ void a_ready(const Unit& u) const {
        if (threadIdx.x < 64) {
            unsigned sp = 0;
            while ((unsigned)__builtin_amdgcn_readfirstlane((int)__hip_atomic_load(mtc + 64 * u.pm, __ATOMIC_RELAXED, __HIP_MEMORY_SCOPE_AGENT)) < 4u) { __builtin_amdgcn_s_sleep(2); if (++sp > (1u << 22)) break; }
            __builtin_amdgcn_fence(__ATOMIC_ACQUIRE, "agent");
            asm volatile("s_waitcnt vmcnt(0)" ::: "memory");
        }
        asm volatile("" ::: "memory"); __builtin_amdgcn_s_barrier(); asm volatile("" ::: "memory");
    }
    __device__ __forceinline__ void done(const Unit&) const {}
};

struct EpiBf16 {
    static constexpr bool PERM = true;
    bf16_t* O; int ldc;
    __device__ __forceinline__ void operator()(const f32x4 (&acc)[2][2][4][2], const Unit& u, int wr, int wc, int fr, int fq) const {
        const int row0 = u.pm * BM + wr * 64 + fr, col0 = u.pn * BM + wc * 32 + 8 * fq;
#pragma unroll
        for (int ai = 0; ai < 2; ++ai)
#pragma unroll
            for (int m = 0; m < 4; ++m) { bf16_t* rowp = O + (size_t)(row0 + ai * HALF + m * 16) * ldc + col0;
#pragma unroll
                for (int bj = 0; bj < 2; ++bj) { const f32x4 v0 = acc[ai][bj][m][0], v1 = acc[ai][bj][m][1];
                    u32x4 w; w.x = cvt_pk_bf16(v0[0], v0[1]); w.y = cvt_pk_bf16(v0[2], v0[3]); w.z = cvt_pk_bf16(v1[0], v1[1]); w.w = cvt_pk_bf16(v1[2], v1[3]);
                    *(u32x4*)(rowp + bj * HALF) = w; } }
    }
};
struct EpiP {
    static constexpr bool PERM = true;
    bf16_t* O; const float* rope;
    __device__ __forceinline__ void operator()(const f32x4 (&acc)[2][2][4][2], const Unit& u, int wr, int wc, int fr, int fq) const {
        const int row0 = u.pm * BM + wr * 64 + fr, col0 = u.pn * BM + wc * 32 + 8 * fq;
        const bool rot = (u.pn < 4) && (u.pm < SEQ / BM);
#pragma unroll
        for (int ai = 0; ai < 2; ++ai)
#pragma unroll
            for (int m = 0; m < 4; ++m) { const int row = row0 + ai * HALF + m * 16; bf16_t* rowp = O + (size_t)row * INC + col0;
#pragma unroll
                for (int bj = 0; bj < 2; ++bj) { f32x4 v0 = acc[ai][bj][m][0], v1 = acc[ai][bj][m][1];
                    if (rot) {
                        const int i0 = ((col0 + bj * HALF) & 127) >> 1;
                        const int comp = (i0 < 32) ? (row >> 6) : (row & 63);
                        const f32x4 cs = *(const f32x4*)(rope + comp * 32 + (i0 & 31)), sn = *(const f32x4*)(rope + 4096 + comp * 32 + (i0 & 31));
                        const f32x4 a = v0, b = v1;
                        v0[0] = a[0] * cs[0] - a[1] * sn[0]; v0[1] = a[1] * cs[0] + a[0] * sn[0];
                        v0[2] = a[2] * cs[1] - a[3] * sn[1]; v0[3] = a[3] * cs[1] + a[2] * sn[1];
                        v1[0] = b[0] * cs[2] - b[1] * sn[2]; v1[1] = b[1] * cs[2] + b[0] * sn[2];
                        v1[2] = b[2] * cs[3] - b[3] * sn[3]; v1[3] = b[3] * cs[3] + b[2] * sn[3];
                    }
                    u32x4 w; w.x = cvt_pk_bf16(v0[0], v0[1]); w.y = cvt_pk_bf16(v0[2], v0[3]); w.z = cvt_pk_bf16(v1[0], v1[1]); w.w = cvt_pk_bf16(v1[2], v1[3]);
                    store16_wt(rowp + bj * HALF, w); } }
    }
};
struct EpiTres {
    static constexpr bool PERM = true;
    bf16_t* T; const float* xl; const float* xc; const float* gl; const float* gc;
    __device__ __forceinline__ void operator()(const f32x4 (&acc)[2][2][4][2], const Unit& u, int wr, int wc, int fr, int fq) const {
        const int row0 = u.pm * BM + wr * 64 + fr, col0 = u.pn * BM + wc * 32 + 8 * fq;
        const bool isctx = (u.pm == SEQ / BM);
        const float* xb = isctx ? xc - (size_t)SEQ * D : xl; const float* gb = isctx ? gc : gl;
        f32x4 gv[2][2];
#pragma unroll
        for (int bj = 0; bj < 2; ++bj)
#pragma unroll
            for (int n = 0; n < 2; ++n) gv[bj][n] = *(const f32x4*)(gb + col0 + bj * HALF + n * 4);
#pragma unroll
        for (int ai = 0; ai < 2; ++ai)
#pragma unroll
            for (int m = 0; m < 4; ++m) { const size_t off = (size_t)(row0 + ai * HALF + m * 16) * D + col0;
#pragma unroll
                for (int bj = 0; bj < 2; ++bj) { const f32x4 x0 = *(const f32x4*)(xb + off + bj * HALF), x1 = *(const f32x4*)(xb + off + bj * HALF + 4);
                    const f32x4 v0 = x0 * ALPHA + gv[bj][0] * acc[ai][bj][m][0], v1 = x1 * ALPHA + gv[bj][1] * acc[ai][bj][m][1];
                    u32x4 w; w.x = cvt_pk_bf16(v0[0], v0[1]); w.y = cvt_pk_bf16(v0[2], v0[3]); w.z = cvt_pk_bf16(v1[0], v1[1]); w.w = cvt_pk_bf16(v1[2], v1[3]);
                    *(u32x4*)(T + off + bj * HALF) = w; }
                if (m == 3) asm volatile("" ::: "memory"); }
    }
};
struct EpiMoe1 {
    static constexpr bool PERM = true;
    bf16_t* HID; const float* SW;
    __device__ __forceinline__ void operator()(const f32x4 (&acc)[2][2][4][2], const Unit& u, int wr, int wc, int fr, int fq) const {
        const int row0 = u.pm * BM + wr * 64 + fr, col0 = u.pn * HALF + wc * 32 + 8 * fq;
#pragma unroll
        for (int ai = 0; ai < 2; ++ai)
#pragma unroll
            for (int m = 0; m < 4; ++m) { const int row = row0 + ai * HALF + m * 16; const float w = SW[row];
                float h[8];
#pragma unroll
                for (int n = 0; n < 2; ++n)
#pragma unroll
                    for (int j = 0; j < 4; ++j) { const float g = acc[ai][0][m][n][j], up = acc[ai][1][m][n][j]; h[4 * n + j] = g / (1.f + __expf(-g)) * up * w; }
                u32x4 o; o.x = cvt_pk_bf16(h[0], h[1]); o.y = cvt_pk_bf16(h[2], h[3]); o.z = cvt_pk_bf16(h[4], h[5]); o.w = cvt_pk_bf16(h[6], h[7]);
                store16_wt(HID + (size_t)row * FF + col0, o); }
    }
};

template <int K, class Epi, class Sched, bool ALIGN_EPI = true, bool SP2 = true>
__device__ __forceinline__ void gemm_phase(PG8_LAS unsigned char* lds, const Sched& S, const Epi& E) {
    int tid_ = threadIdx.x; asm volatile("" : "+v"(tid_));
    const int tid = tid_, wid = __builtin_amdgcn_readfirstlane(tid >> 6), lane = tid & 63, wr = wid >> 2, wc = wid & 3, fr = lane & 15, fq = lane >> 4;
    constexpr int nt = K / BK;
    unsigned voffA[2], voffB[2];
#pragma unroll
    for (int i = 0; i < 2; ++i) { int R, C; stage_rc(tid * 16 + i * 8192, R, C); const int Rb = Epi::PERM ? ((R & ~31) + perm32(R & 31)) : R;
        voffA[i] = (unsigned)(R * K + C) * 2u; voffB[i] = (unsigned)(Rb * K + C) * 2u; }
    const size_t kstep = (size_t)(BK * 2);
    const size_t hstep = (size_t)HALF * K * 2;
    const unsigned ldsw = (unsigned)wid * 1024u;
    const int aoff = lds_byte(wr * 64 + fr, fq * 8), boff = lds_byte(wc * 32 + fr, fq * 8);
#define PG8_SA(b, h) (((b) * 2 + (h)) * HTB)
#define PG8_SB(b, h) ((4 + (b) * 2 + (h)) * HTB)
#define PG8_STAGE(bufoff, gbase, voff) do { _Pragma("unroll") for (int _i = 0; _i < 2; ++_i) \
        __builtin_amdgcn_global_load_lds((const unsigned*)((const char*)(gbase) + (voff)[_i]), (PG8_LAS unsigned*)(lds + (bufoff) + ldsw + _i * 8192), 16, 0, 0); } while (0)
#define PG8_LDA(dst, b, h) do { _Pragma("unroll") for (int m = 0; m < 4; ++m) _Pragma("unroll") for (int k = 0; k < 2; ++k) dst[m][k] = *(const PG8_LAS bf16x8*)(lds + PG8_SA(b, h) + aoff + m * 2048 + k * 1024); } while (0)
#define PG8_LDB(dst, b, h) do { _Pragma("unroll") for (int n = 0; n < 2; ++n) _Pragma("unroll") for (int k = 0; k < 2; ++k) dst[n][k] = *(const PG8_LAS bf16x8*)(lds + PG8_SB(b, h) + boff + n * 2048 + k * 1024); } while (0)
#define PG8_MMA(ai, bj, At, Bt) do { __builtin_amdgcn_s_setprio(1); _Pragma("unroll") for (int m = 0; m < 4; ++m) _Pragma("unroll") for (int n = 0; n < 2; ++n) _Pragma("unroll") for (int k = 0; k < 2; ++k) \
        acc[ai][bj][m][n] = __builtin_amdgcn_mfma_f32_16x16x32_bf16(Bt[n][k], At[m][k], acc[ai][bj][m][n], 0, 0, 0); __builtin_amdgcn_s_setprio(0); } while (0)
#define PG8_WAIT_V(n) asm volatile("s_waitcnt vmcnt(" #n ")" ::: "memory")
#define PG8_WAIT_L(n) asm volatile("s_waitcnt lgkmcnt(" #n ")" ::: "memory")
#define PG8_BAR __builtin_amdgcn_s_barrier()
#define PG8_SCHED __builtin_amdgcn_sched_barrier(0)
    Unit cur, nxt; int ui = 0;
    if (!S.next(0, cur)) return;
    f32x4 acc[2][2][4][2];
#pragma unroll
    for (int a = 0; a < 2; ++a)
#pragma unroll
        for (int b = 0; b < 2; ++b)
#pragma unroll
            for (int m = 0; m < 4; ++m)
#pragma unroll
                for (int n = 0; n < 2; ++n) acc[a][b][m][n] = (f32x4){0.f, 0.f, 0.f, 0.f};
    bf16x8 At[4][2], B0[2][2], B1[2][2];
    const char* cA = cur.A; const char* cB = cur.B;
    S.a_ready(cur);
    if constexpr (SP2) {
        PG8_STAGE(PG8_SB(0, 0), cB, voffB); PG8_STAGE(PG8_SB(0, 1), cB + hstep, voffB); PG8_STAGE(PG8_SA(0, 0), cA, voffA); PG8_STAGE(PG8_SA(0, 1), cA + hstep, voffA);
        if (wr == 1) PG8_BAR;
        PG8_WAIT_V(2); PG8_BAR;
        PG8_STAGE(PG8_SB(1, 0), cB + kstep, voffB); PG8_STAGE(PG8_SA(1, 0), cA + kstep, voffA); PG8_STAGE(PG8_SB(1, 1), cB + hstep + kstep, voffB);
        PG8_WAIT_V(6); PG8_BAR;
    } else {
        PG8_STAGE(PG8_SB(0, 0), cB, voffB); PG8_STAGE(PG8_SA(0, 0), cA, voffA); PG8_STAGE(PG8_SB(0, 1), cB + hstep, voffB); PG8_STAGE(PG8_SA(0, 1), cA + hstep, voffA);
        if (wr == 1) PG8_BAR;
        PG8_WAIT_V(4); PG8_BAR;
        PG8_STAGE(PG8_SB(1, 0), cB + kstep, voffB); PG8_STAGE(PG8_SA(1, 0), cA + kstep, voffA); PG8_STAGE(PG8_SB(1, 1), cB + hstep + kstep, voffB);
        PG8_WAIT_V(6); PG8_BAR;
    }
    for (;;) {
        const bool has_next = S.next(ui + 1, nxt);
        const char* nA = has_next ? nxt.A : cA; const char* nB = has_next ? nxt.B : cB;
        for (int t = 0; t < nt; t += 2) {
            const bool last = (t == nt - 2);
            if (last && has_next) S.a_ready(nxt);
            const char* a1 = cA + (size_t)(t + 1) * kstep;
            const char* a2 = last ? nA : cA + (size_t)(t + 2) * kstep; const char* b2 = last ? nB : cB + (size_t)(t + 2) * kstep;
            const char* a3 = a2 + kstep; const char* b3 = b2 + kstep;
            if constexpr (SP2) {
            PG8_LDB(B0, 0, 0); PG8_LDB(B1, 0, 1); PG8_SCHED; PG8_LDA(At, 0, 0); PG8_STAGE(PG8_SA(1, 1), a1 + hstep, voffA);
            PG8_WAIT_V(8); PG8_WAIT_L(0); PG8_BAR; PG8_MMA(0, 0, At, B0); PG8_MMA(0, 1, At, B1); PG8_BAR; PG8_SCHED;
            PG8_LDA(At, 0, 1); PG8_STAGE(PG8_SB(0, 0), b2, voffB); PG8_STAGE(PG8_SB(0, 1), b2 + hstep, voffB); PG8_STAGE(PG8_SA(0, 0), a2, voffA);
            PG8_WAIT_V(8); PG8_WAIT_L(0); PG8_BAR; PG8_MMA(1, 0, At, B0); PG8_MMA(1, 1, At, B1); PG8_BAR; PG8_SCHED;
            PG8_LDB(B0, 1, 0); PG8_LDB(B1, 1, 1); PG8_SCHED; PG8_LDA(At, 1, 0); PG8_STAGE(PG8_SA(0, 1), a2 + hstep, voffA);
            PG8_WAIT_V(8); PG8_WAIT_L(0); PG8_BAR; PG8_MMA(0, 0, At, B0); PG8_MMA(0, 1, At, B1); PG8_BAR; PG8_SCHED;
            PG8_LDA(At, 1, 1); PG8_STAGE(PG8_SB(1, 0), b3, voffB); PG8_STAGE(PG8_SB(1, 1), b3 + hstep, voffB); PG8_STAGE(PG8_SA(1, 0), a3, voffA);
            PG8_WAIT_V(8); PG8_WAIT_L(0); PG8_BAR; PG8_MMA(1, 0, At, B0); PG8_MMA(1, 1, At, B1); PG8_BAR; PG8_SCHED;
            } else {
            PG8_LDB(B0, 0, 0); PG8_SCHED; PG8_LDA(At, 0, 0); PG8_STAGE(PG8_SA(1, 1), a1 + hstep, voffA);
            PG8_WAIT_L(8); PG8_BAR; PG8_WAIT_L(0); PG8_MMA(0, 0, At, B0); PG8_BAR; PG8_SCHED;
            PG8_LDB(B1, 0, 1); PG8_STAGE(PG8_SB(0, 0), b2, voffB);
            PG8_BAR; PG8_WAIT_L(0); PG8_MMA(0, 1, At, B1); PG8_BAR;
            PG8_LDA(At, 0, 1); PG8_STAGE(PG8_SA(0, 0), a2, voffA);
            PG8_BAR; PG8_WAIT_L(0); PG8_MMA(1, 0, At, B0); PG8_BAR; PG8_SCHED;
            PG8_STAGE(PG8_SB(0, 1), b2 + hstep, voffB);
            PG8_WAIT_V(6); PG8_BAR; PG8_MMA(1, 1, At, B1); PG8_BAR;
            PG8_LDB(B0, 1, 0); PG8_SCHED; PG8_LDA(At, 1, 0); PG8_STAGE(PG8_SA(0, 1), a2 + hstep, voffA);
            PG8_WAIT_L(8); PG8_BAR; PG8_WAIT_L(0); PG8_MMA(0, 0, At, B0); PG8_BAR; PG8_SCHED;
            PG8_LDB(B1, 1, 1); PG8_STAGE(PG8_SB(1, 0), b3, voffB);
            PG8_BAR; PG8_WAIT_L(0); PG8_MMA(0, 1, At, B1); PG8_BAR;
            PG8_LDA(At, 1, 1); PG8_STAGE(PG8_SA(1, 0), a3, voffA);
            PG8_BAR; PG8_WAIT_L(0); PG8_MMA(1, 0, At, B0); PG8_BAR; PG8_SCHED;
            PG8_STAGE(PG8_SB(1, 1), b3 + hstep, voffB);
            PG8_WAIT_V(6); PG8_BAR; PG8_MMA(1, 1, At, B1); PG8_BAR;
            }
        }
        if constexpr (ALIGN_EPI) { if (wr == 0) PG8_BAR; }
        E(acc, cur, wr, wc, fr, fq); S.done(cur);
        if (!has_next) break;
#pragma unroll
        for (int a = 0; a < 2; ++a)
#pragma unroll
            for (int b = 0; b < 2; ++b)
#pragma unroll
                for (int m = 0; m < 4; ++m)
#pragma unroll
                    for (int n = 0; n < 2; ++n) acc[a][b][m][n] = (f32x4){0.f, 0.f, 0.f, 0.f};
        cur = nxt; cA = nA; cB = nB; ++ui;
        if constexpr (ALIGN_EPI) { if (wr == 1) PG8_BAR; }
    }
    PG8_WAIT_V(0);
    if constexpr (!ALIGN_EPI) { if (wr == 0) PG8_BAR; }
    PG8_BAR;
#undef PG8_SA
#undef PG8_SB
#undef PG8_STAGE
#undef PG8_LDA
#undef PG8_LDB
#undef PG8_MMA
#undef PG8_WAIT_V
#undef PG8_WAIT_L
#undef PG8_BAR
#undef PG8_SCHED
}
}

__device__ __forceinline__ void transpose_item(const float* W, int N, bf16_t* WT, int K, int wt_row0, int k0, int n0, LAS float* scr, int lane, int rstride = 1) {
#pragma unroll
    for (int i = 0; i < 32; ++i) { const int kk = 2 * i + (lane >> 5); scr[kk * 33 + (lane & 31)] = W[(size_t)(k0 + kk) * N + n0 + (lane & 31)]; }
    asm volatile("s_waitcnt lgkmcnt(0)" ::: "memory");
    const int c = lane & 7;
#pragma unroll
    for (int j = 0; j < 4; ++j) { const int n = (lane >> 3) + 8 * j; const LAS float* sp = scr + (8 * c) * 33 + n;
        uint4 o; o.x = pg8::cvt_pk_bf16(sp[0 * 33], sp[1 * 33]); o.y = pg8::cvt_pk_bf16(sp[2 * 33], sp[3 * 33]); o.z = pg8::cvt_pk_bf16(sp[4 * 33], sp[5 * 33]); o.w = pg8::cvt_pk_bf16(sp[6 * 33], sp[7 * 33]);
        *(uint4*)(WT + (size_t)(wt_row0 + n * rstride) * K + k0 + 8 * c) = o; }
    asm volatile("s_waitcnt lgkmcnt(0)" ::: "memory");
}
constexpr int I_IN = (D / 64) * (INC / 32), I_OUT = (D / 64) * (D / 32), I_EXP = 512, NKC = 8;
__device__ __forceinline__ void ph_prologue(const Ctx& C) {
    const int gt = C.bid * NTHREADS + C.tid, NT = C.G * NTHREADS;
    const int gw = C.bid * NWAVES + C.wave, NGW = C.G * NWAVES, lane = C.lane;
    for (int idx = gt; idx < 128 * 32; idx += NT) {
        const int pos = idx / 32, j = idx % 32;
        const double inv = pow(10000.0, -(double)j / 32.0);
        const double ang = (double)pos * inv;
        C_ROPE[idx] = (float)cos(ang);
        C_ROPE[128 * 32 + idx] = (float)sin(ang);
    }
    for (int idx = gt; idx < NE * D; idx += NT) {
        const int e = idx / D, d = idx % D;
        const float w = C_w_router[(size_t)d * NE + e];
        const bf16_t hi = f2bf(w); const bf16_t lo = f2bf(w - bf2f(hi));
        C_WRT[idx] = hi; C_WRT[NE * D + idx] = lo;
    }
    {
        LAS float* sl = (LAS float*)C.lds;
        for (int k = C.tid; k < D; k += NTHREADS) { sl[k] = silu_f(C_c[k]); sl[D + k] = silu_f(C_c_ctx[k]); }
        __syncthreads();
        for (int u = gw; u < DEPTH * 48 * NKC; u += NGW) {
            const int l = u / (48 * NKC), rem = u % (48 * NKC), sb = rem / NKC, kc = rem % NKC;
            const float* w = C_w_mod + (size_t)l * D * 6 * D + (size_t)(kc * (D / NKC)) * 6 * D + sb * 256 + lane * 4;
            float4 a0 = {0.f, 0.f, 0.f, 0.f}, a1 = {0.f, 0.f, 0.f, 0.f};
#pragma unroll 16
            for (int k = 0; k < D / NKC; ++k) {
                const float4 wv = *(const float4*)(w + (size_t)k * 6 * D);
                const float c0 = sl[kc * (D / NKC) + k], c1 = sl[D + kc * (D / NKC) + k];
                a0.x += c0 * wv.x; a0.y += c0 * wv.y; a0.z += c0 * wv.z; a0.w += c0 * wv.w;
                a1.x += c1 * wv.x; a1.y += c1 * wv.y; a1.z += c1 * wv.z; a1.w += c1 * wv.w;
            }
            *(float4*)(C_MODP + ((size_t)(kc * 2 + l) * 2 + 0) * 6 * D + sb * 256 + lane * 4) = a0;
            *(float4*)(C_MODP + ((size_t)(kc * 2 + l) * 2 + 1) * 6 * D + sb * 256 + lane * 4) = a1;
        }
        __syncthreads();
    }
    LAS float* scr = (LAS float*)(C.lds + C.wave * 16384);
    constexpr int TOT = 2 * I_IN + 2 * I_OUT + 3 * 64 * I_EXP;
    for (int it = gw; it < TOT; it += NGW) {
        int r = it;
        if (r < 2 * I_IN) { const int l = r / I_IN, q = r % I_IN, kb = q / (INC / 32), nb = q % (INC / 32);
            const int n0 = 32 * nb; int row0 = n0, rs = 1;
            if (n0 < OFF_AV) { const int hh = n0 / HD, d0 = n0 % HD; row0 = hh * HD + (d0 < 64 ? 2 * d0 : 2 * (d0 - 64) + 1); rs = 2; }
            transpose_item(C_w_in + (size_t)l * D * INC, INC, C_WIN + (size_t)l * INC * D, D, row0, 64 * kb, n0, scr, lane, rs); continue; }
        r -= 2 * I_IN;
        if (r < 2 * I_OUT) { const int l = r / I_OUT, q = r % I_OUT, kb = q / (D / 32), nb = q % (D / 32);
            transpose_item(C_w_out + (size_t)l * D * D, D, C_WOUT + (size_t)l * D * D, D, 32 * nb, 64 * kb, 32 * nb, scr, lane); continue; }
        r -= 2 * I_OUT;
        if (r < 2 * 64 * I_EXP) { const int up = r / (64 * I_EXP), rr = r % (64 * I_EXP); const int le = rr / I_EXP, q = rr % I_EXP, kb = q / 16, nb = q % 16, f0 = 32 * nb;
            transpose_item((up ? C_w_up : C_w_gate) + (size_t)le * D * FF, FF, C_WGU + (size_t)le * 1024 * D, D, (f0 / 128) * 256 + up * 128 + (f0 % 128), 64 * kb, f0, scr, lane); continue; }
        r -= 2 * 64 * I_EXP;
        { const int le = r / I_EXP, q = r % I_EXP, kb = q / (D / 32), nb = q % (D / 32);
          transpose_item(C_w_down + (size_t)le * FF * D, D, C_WD + (size_t)le * D * FF, FF, 32 * nb, 64 * kb, 32 * nb, scr, lane); }
    }
}

__device__ __forceinline__ void ph_modulate0(const Ctx& C) {
    const int gt = C.bid * NTHREADS + C.tid, NT = C.G * NTHREADS;
    const int gw = C.bid * NWAVES + C.wave, NGW = C.G * NWAVES, lane = C.lane;
    for (int idx = gt; idx < DEPTH * 2 * 6 * D; idx += NT) {
        const int n = idx % (6 * D), l = idx / (2 * 6 * D);
        float a = C_b_mod[l * 6 * D + n];
#pragma unroll
        for (int kc = 0; kc < NKC; ++kc) a += C_MODP[(size_t)kc * (DEPTH * 2 * 6 * D) + idx];
        C_MOD[idx] = a;
    }
    LAS float* ms = (LAS float*)C.lds;
    for (int i = C.tid; i < 2 * 2 * D; i += NTHREADS) {
        const int kind = i / (2 * D), n = i % (2 * D);
        const int idx = (0 * 2 + kind) * 6 * D + n;
        float a = C_b_mod[n];
#pragma unroll
        for (int kc = 0; kc < NKC; ++kc) a += C_MODP[(size_t)kc * (DEPTH * 2 * 6 * D) + idx];
        ms[i] = a;
    }
    __syncthreads();
    for (int r = gw; r < NTOK; r += NGW) {
        const int kind = r < SEQ ? 0 : 1;
        const float* xp = xin_row(C, 0, r);
        const LAS float* sh = ms + kind * 2 * D; const LAS float* sc = sh + D;
#pragma unroll
        for (int j = 0; j < 8; ++j) {
            const int d0 = 4 * lane + 256 * j;
            const float4 xv = *(const float4*)(xp + d0);
            float4 hv; hv.x = xv.x * (1.f + sc[d0]) + sh[d0]; hv.y = xv.y * (1.f + sc[d0 + 1]) + sh[d0 + 1]; hv.z = xv.z * (1.f + sc[d0 + 2]) + sh[d0 + 2]; hv.w = xv.w * (1.f + sc[d0 + 3]) + sh[d0 + 3];
            st4(&C_H[(size_t)r * D + d0], hv);
        }
    }
}

namespace att {
using bf16x8 = __attribute__((ext_vector_type(8))) short;
using s16x4  = __attribute__((ext_vector_type(4))) short;
using f32x16 = __attribute__((ext_vector_type(16))) float;
using u32x4  = __attribute__((ext_vector_type(4))) unsigned;
constexpr int NW = 8, QBLK = 32, KVBLK = 64;
constexpr float SCALE = QSCALE, THR = 8.f;
constexpr int SHM_V = KVBLK * HD * 2, SHM_K = KVBLK * HD * 2;
constexpr int Q_OFF = 2 * SHM_V + 2 * SHM_K  , WS_OFF = 131072 + 1024, BIAS_OFF = WS_OFF + NW * 64 * 4, QSLOT_OFF = BIAS_OFF + (64 + 15 * 32 + 64) * 4, ATT_LDS = QSLOT_OFF + 16;
#define KSWZ(row, colB) ((row) * 256 + ((colB) ^ (((row) & 7) << 4)))
#define SBAR() __builtin_amdgcn_sched_barrier(0)
__device__ __forceinline__ int crow(int r, int hi) { return (r & 3) + 8 * (r >> 2) + 4 * hi; }
__device__ __forceinline__ unsigned cvtpk(float lo, float hi) { unsigned r; asm volatile("v_cvt_pk_bf16_f32 %0, %1, %2" : "=v"(r) : "v"(lo), "v"(hi)); return r; }

__device__ __forceinline__ void partialSM(f32x16& p0, f32x16& p1, float& m_reg, float& mn, float& alpha) {
  constexpr float Cc = SCALE * 1.4426950408889634f;
  float pmax = p0[0]; for (int r = 1; r < 16; ++r) pmax = fmaxf(pmax, p0[r]); for (int r = 0; r < 16; ++r) pmax = fmaxf(pmax, p1[r]);
  { auto rr = __builtin_amdgcn_permlane32_swap(__float_as_uint(pmax), __float_as_uint(pmax), false, false);
    pmax = fmaxf(__uint_as_float(rr[0]), __uint_as_float(rr[1])); }
  if (__builtin_expect(__all(pmax - m_reg <= THR / SCALE), 1)) { mn = m_reg; alpha = 1.f; }
  else { mn = fmaxf(m_reg, pmax); alpha = __builtin_amdgcn_exp2f((m_reg - mn) * Cc); m_reg = mn; }
  float mnC = -mn * Cc;
  for (int r = 0; r < 16; ++r) p0[r] = fmaf(p0[r], Cc, mnC); for (int r = 0; r < 16; ++r) p1[r] = fmaf(p1[r], Cc, mnC);
  for (int r = 0; r < 16; ++r) p0[r] = __builtin_amdgcn_exp2f(p0[r]);
}
__device__ __forceinline__ void finishSM(f32x16& p0, f32x16& p1, float alpha, float& l_reg, bf16x8& pa0, bf16x8& pa1, bf16x8& pa2, bf16x8& pa3) {
  for (int r = 0; r < 16; ++r) p1[r] = __builtin_amdgcn_exp2f(p1[r]);
  float ps = 0; for (int r = 0; r < 16; ++r) ps += p0[r]; for (int r = 0; r < 16; ++r) ps += p1[r];
  { auto rr = __builtin_amdgcn_permlane32_swap(__float_as_uint(ps), __float_as_uint(ps), false, false);
    ps = __uint_as_float(rr[0]) + __uint_as_float(rr[1]); }
  l_reg = l_reg * alpha + ps;
#define PK4(P, BASE, OUT) do { unsigned a0 = cvtpk(P[BASE + 0], P[BASE + 1]), a1 = cvtpk(P[BASE + 2], P[BASE + 3]);   \
    unsigned b0 = cvtpk(P[BASE + 4], P[BASE + 5]), b1 = cvtpk(P[BASE + 6], P[BASE + 7]);                              \
    auto r0 = __builtin_amdgcn_permlane32_swap(a0, b0, false, false); auto r1 = __builtin_amdgcn_permlane32_swap(a1, b1, false, false); \
    u32x4 w = {r0[0], r1[0], r0[1], r1[1]}; OUT = *reinterpret_cast<bf16x8*>(&w); } while (0)
  PK4(p0, 0, pa0); PK4(p0, 8, pa1); PK4(p1, 0, pa2); PK4(p1, 8, pa3);
#undef PK4
}
__device__ __forceinline__ void qkt(f32x16& p0, f32x16& p1, const LAS char* Ks, const LAS char* Qs, int r32, int hi) {
#pragma unroll
  for (int d0 = 0; d0 < 8; ++d0) { int cb = (d0 * 16 + hi * 8) * 2;
    bf16x8 b0 = *reinterpret_cast<const LAS bf16x8*>(Ks + KSWZ(r32, cb));
    bf16x8 b1 = *reinterpret_cast<const LAS bf16x8*>(Ks + KSWZ(32 + r32, cb));
    bf16x8 q = *reinterpret_cast<const LAS bf16x8*>(Qs + KSWZ(r32, cb));
    p0 = __builtin_amdgcn_mfma_f32_32x32x16_bf16(b0, q, p0, 0, 0, 0);
    p1 = __builtin_amdgcn_mfma_f32_32x32x16_bf16(b1, q, p1, 0, 0, 0); }
}
__device__ __forceinline__ int v_st(int k, int c) { const int kk = (k & ~0xC) | ((k & 4) << 1) | ((k & 8) >> 1); return ((kk >> 3) * 4 + (c >> 5)) * 512 + ((kk & 7) * 32 + (c & 31)) * 2; }
__device__ __forceinline__ int v_rd_base(int lane) { return ((lane & 3) << 3) | (((lane >> 2) & 3) << 6) | (((lane >> 4) & 1) << 5) | (((lane >> 5) & 1) << 8); }
constexpr int v_rd_off(int d0, int ks, int half) { return d0 * 512 + ks * 4096 + half * 2048; }
template <int OFF> __device__ __forceinline__ s16x4 tr_read(int vb) {
  s16x4 r; asm volatile("ds_read_b64_tr_b16 %0, %1 offset:%2" : "=&v"(r) : "v"(vb), "i"(OFF) : "memory"); return r;
}
template <int D0> __device__ __forceinline__ void pv_one(f32x16& od, int vb, bf16x8 pa0, bf16x8 pa1, bf16x8 pa2, bf16x8 pa3) {
  const s16x4 l0 = tr_read<v_rd_off(D0, 0, 0)>(vb), h0 = tr_read<v_rd_off(D0, 0, 1)>(vb), l1 = tr_read<v_rd_off(D0, 1, 0)>(vb), h1 = tr_read<v_rd_off(D0, 1, 1)>(vb);
  const s16x4 l2 = tr_read<v_rd_off(D0, 2, 0)>(vb), h2 = tr_read<v_rd_off(D0, 2, 1)>(vb), l3 = tr_read<v_rd_off(D0, 3, 0)>(vb), h3 = tr_read<v_rd_off(D0, 3, 1)>(vb);
  asm volatile("s_waitcnt lgkmcnt(0)" ::: "memory"); SBAR();
#define PK(L, H) (bf16x8){L[0], L[1], L[2], L[3], H[0], H[1], H[2], H[3]}
  od = __builtin_amdgcn_mfma_f32_32x32x16_bf16(pa0, PK(l0, h0), od, 0, 0, 0);
  od = __builtin_amdgcn_mfma_f32_32x32x16_bf16(pa1, PK(l1, h1), od, 0, 0, 0);
  od = __builtin_amdgcn_mfma_f32_32x32x16_bf16(pa2, PK(l2, h2), od, 0, 0, 0);
  od = __builtin_amdgcn_mfma_f32_32x32x16_bf16(pa3, PK(l3, h3), od, 0, 0, 0);
#undef PK
}
__device__ __forceinline__ void pv_d0(f32x16* o, int vb, bf16x8 pa0, bf16x8 pa1, bf16x8 pa2, bf16x8 pa3) {
  pv_one<0>(o[0], vb, pa0, pa1, pa2, pa3); pv_one<1>(o[1], vb, pa0, pa1, pa2, pa3); pv_one<2>(o[2], vb, pa0, pa1, pa2, pa3); pv_one<3>(o[3], vb, pa0, pa1, pa2, pa3);
}

template <int kind>
__device__ __forceinline__ void attn_unit(const bf16_t* __restrict__ P, bf16_t* __restrict__ MIX, const float* __restrict__ rpb_l, const float* __restrict__ sink_l,
                                          const int u, const int h, LAS char* lds, const int tid) {
  const int wid = __builtin_amdgcn_readfirstlane(tid >> 6), lane = tid & 63, r32 = lane & 31, hi = lane >> 5;
  LAS char* V_lds = lds; LAS char* K_lds = lds + 2 * SHM_V;
  LAS float* ws = (LAS float*)(lds + WS_OFF) + wid * 64; LAS float* li_l = ws; LAS float* al_l = ws + 32;
  LAS float* rpbs = (LAS float*)(lds + BIAS_OFF) + 64;
  constexpr bool isA = (kind == 0 || kind == 2), lat = kind < 2;
  const int qrow0 = lat ? 256 * u : SEQ;
  const int qcol = isA ? h * HD : OFF_BQ + h * HD;
  const int kcol = isA ? OFF_AK + (h / 3) * HD : OFF_BK + h * HD;
  const int vcol = isA ? OFF_AV + (h / 3) * HD : OFF_BV + h * HD;
  const int ocol = (isA ? 0 : 768) + h * HD;
  constexpr int NT = (kind == 0) ? 12 : (kind == 1) ? 16 : 4;
  int Rs = 4 * u - 4; Rs = Rs < 0 ? 0 : (Rs > 117 ? 117 : Rs);
  __syncthreads();
  if (kind == 1) for (int i = tid; i < 64 + 15 * 32 + 64; i += 512) { const int t = i - 64; rpbs[t] = (t >= 0 && t < 15 * 32 && (t & 31) < 31) ? rpb_l[h * 465 + (t >> 5) * 31 + (t & 31)] * (1.0f / SCALE) : 0.f; }
  float m_reg = -1e30f, l_reg = 0; f32x16 o[4] = {};
  LAS char* Qs = lds + Q_OFF + wid * 8192;
  { const bf16_t* Qw = P + (size_t)(qrow0 + wid * QBLK + r32) * INC + qcol + hi * 8;
#pragma unroll
    for (int d0 = 0; d0 < 8; ++d0) *reinterpret_cast<LAS bf16x8*>(Qs + KSWZ(r32, (d0 * 16 + hi * 8) * 2)) = *reinterpret_cast<const bf16x8*>(Qw + d0 * 16); }
  const int sr = tid >> 4, sc = (tid & 15) * 8, vst0 = v_st(sr, sc), vst1 = v_st(32 + sr, sc);
  const int vb0 = (int)(size_t)V_lds + v_rd_base(lane);
  const unsigned voffk = (unsigned)(sr * INC + sc + kcol) * 2u, voffk2 = voffk + 32u * INC * 2u, voffv = (unsigned)(sr * INC + sc + vcol) * 2u, voffv2 = voffv + 32u * INC * 2u;
  struct { bf16x8 vs0, vs1, ks0, ks1; } sr_[1];
#define KROW(j) (((j) < 4) ? (SEQ + 64 * (j)) : (kind == 0 ? ({ int t_ = 256 * u - 128 + 64 * ((j) - 4); t_ < 0 ? 0 : (t_ > SEQ - 64 ? SEQ - 64 : t_); }) : ({ int jj_ = (j) - 4; jj_ = jj_ > 10 ? 10 : jj_; (Rs + jj_) * 64; })))
#define SLOAD(i, j) do { const char* kb_ = (const char*)P + (size_t)KROW(j) * (INC * 2);                                             \
    sr_[i].vs0 = *reinterpret_cast<const bf16x8*>(kb_ + voffv); sr_[i].vs1 = *reinterpret_cast<const bf16x8*>(kb_ + voffv2); \
    sr_[i].ks0 = *reinterpret_cast<const bf16x8*>(kb_ + voffk); sr_[i].ks1 = *reinterpret_cast<const bf16x8*>(kb_ + voffk2); } while (0)
#define SWRITE(b, i) do { *(LAS bf16x8*)(V_lds + (b) * SHM_V + vst0) = sr_[i].vs0;          \
    *(LAS bf16x8*)(V_lds + (b) * SHM_V + vst1) = sr_[i].vs1; int kc_ = sc * 2;               \
    *(LAS bf16x8*)(K_lds + (b) * SHM_K + KSWZ(sr, kc_)) = sr_[i].ks0;                       \
    *(LAS bf16x8*)(K_lds + (b) * SHM_K + KSWZ(32 + sr, kc_)) = sr_[i].ks1; } while (0)
#define SWAIT() asm volatile("s_waitcnt vmcnt(0)" ::: "memory")
#define RESC(a) do { if (__any((a) < 1.f)) { if (hi == 0) al_l[r32] = (a); asm volatile("s_waitcnt lgkmcnt(0)" ::: "memory"); \
    for (int d = 0; d < 4; ++d) for (int r = 0; r < 16; ++r) o[d][r] *= al_l[crow(r, hi)]; } } while (0)
#define MASK(p0, p1, j) do { const int j_ = (j);                                                                                          \
    if (lat && j_ >= 4) {                                                                                                                 \
      if (kind == 0) {                                                                                                                    \
        const int t0_ = 256 * u - 128 + 64 * (j_ - 4), qw_ = 256 * u + 32 * wid;                                                          \
        const float tp_ = (t0_ < 0 || t0_ >= SEQ) ? -1e30f : 0.f;                                     \
        const float dl_ = (float)(t0_ - (qw_ + r32) + 4 * hi);                                                                            \
        _Pragma("unroll") for (int r = 0; r < 16; ++r) { const float k0_ = dl_ + (float)((r & 3) + 8 * (r >> 2)), k1_ = k0_ + 32.f;       \
          p0[r] = fmaf(fminf(0.f, 128.5f - fabsf(k0_)), 1e30f, tp_); p1[r] = fmaf(fminf(0.f, 128.5f - fabsf(k1_)), 1e30f, tp_); }         \
      } else {                                                                                                                            \
        const int kr_ = Rs + (j_ - 4), qrw_ = 4 * u + (wid >> 1); int r0_ = qrw_ - 4; r0_ = r0_ < 0 ? 0 : (r0_ > 120 ? 120 : r0_);        \
        const float tp_ = (j_ >= 15 || kr_ < r0_ || kr_ >= r0_ + 8) ? -1e30f : 0.f;           \
        int dr_ = kr_ - qrw_ + 7; dr_ = dr_ < 0 ? 0 : (dr_ > 14 ? 14 : dr_);                                                              \
        const int qc_ = (wid & 1) * 32 + r32; int c0_ = qc_ - 8; c0_ = c0_ < 0 ? 0 : (c0_ > 48 ? 48 : c0_);                               \
        const LAS float* br_ = rpbs + dr_ * 32 + (15 - qc_ + 4 * hi);                                                                     \
        const float xb_ = (float)(4 * hi - c0_) - 7.5f;                                                                                   \
        _Pragma("unroll") for (int r = 0; r < 16; ++r) { const int kk_ = (r & 3) + 8 * (r >> 2); const float x0_ = xb_ + (float)kk_, x1_ = x0_ + 32.f;   \
          p0[r] = fmaf(fminf(0.f, 7.75f - fabsf(x0_)), 1e30f, br_[kk_] + tp_); p1[r] = fmaf(fminf(0.f, 7.75f - fabsf(x1_)), 1e30f, br_[kk_ + 32] + tp_); } \
      } }                                                                                                                                 \
    else { _Pragma("unroll") for (int r = 0; r < 16; ++r) { p0[r] = 0.f; p1[r] = 0.f; } } } while (0)
  f32x16 pA0, pA1; float mnA, alA; bf16x8 pa0, pa1, pa2, pa3;
  SLOAD(0, 0); asm volatile("s_waitcnt vmcnt(0)" ::: "memory"); SWRITE(0, 0); __syncthreads();
  int jlo = 4, jhi = NT - 1;
  if (kind == 0) { const int qw_ = 32 * wid;
    jlo = 4 + (qw_ + 0) / 64; jhi = 4 + (qw_ + 31 + 256) / 64;
    const int first_ok = (256 * u - 128 < 0) ? 4 + 2 : 4, last_ok = (256 * u + 384 > SEQ) ? 4 + 5 : 4 + 7;
    jlo = jlo < first_ok ? first_ok : jlo; jhi = jhi > last_ok ? last_ok : jhi; }
  if (kind == 1) { const int qrw_ = 4 * u + (wid >> 1); int r0_ = qrw_ - 4; r0_ = r0_ < 0 ? 0 : (r0_ > 120 ? 120 : r0_); jlo = 4 + (r0_ - Rs); jhi = jlo + 7; }
#define TILE_BODY(COMPUTE) do { const int b = j & 1;                                                                    \
    if (j + 1 < NT) SLOAD(0, j + 1);                                                                                    \
    if (COMPUTE) {                                                                                                      \
      MASK(pA0, pA1, j);                                                                                                \
      SBAR(); qkt(pA0, pA1, K_lds + b * SHM_K, Qs, r32, hi);                                                            \
      partialSM(pA0, pA1, m_reg, mnA, alA);                                                                             \
      RESC(alA);                                                                                                        \
      finishSM(pA0, pA1, alA, l_reg, pa0, pa1, pa2, pa3); SBAR();                                                       \
      pv_d0(o, vb0 + b * SHM_V, pa0, pa1, pa2, pa3); }                                                                  \
    if (j + 1 < NT) { SWAIT(); SWRITE(b ^ 1, 0); }                                                                      \
    __syncthreads(); } while (0)
  int j = 0;
  for (; j < 4; ++j) TILE_BODY(true);
  if (lat) {
    for (; j < jlo; ++j) TILE_BODY(false);
    for (; j <= jhi; ++j) TILE_BODY(true);
    for (; j < NT; ++j) TILE_BODY(false);
  }
#undef TILE_BODY
  if (isA) l_reg += __builtin_amdgcn_exp2f(sink_l[h] * 1.4426950408889634f - m_reg * (SCALE * 1.4426950408889634f));
  if (hi == 0) li_l[r32] = l_reg; asm volatile("s_waitcnt lgkmcnt(0)" ::: "memory");
  float rli[16];
#pragma unroll
  for (int r = 0; r < 16; ++r) rli[r] = __builtin_amdgcn_rcpf(li_l[crow(r, hi)]);
  __syncthreads();
  LAS char* ost = lds + wid * 8192;
#pragma unroll
  for (int r = 0; r < 16; ++r) { const int orow = crow(r, hi);
#pragma unroll
    for (int d0 = 0; d0 < 4; ++d0) *(LAS bf16_t*)(ost + orow * 256 + (d0 * 32 + r32) * 2) = f2bf(o[d0][r] * rli[r]); }
  asm volatile("s_waitcnt lgkmcnt(0)" ::: "memory");
  bf16_t* Ow = MIX + (size_t)(qrow0 + wid * QBLK) * D + ocol;
#pragma unroll
  for (int i = 0; i < 8; ++i) { const int c = lane + 64 * i, row = c >> 4, c16 = c & 15;
    const u32x4 v = *(const LAS u32x4*)(ost + c * 16);
    *reinterpret_cast<u32x4*>(Ow + (size_t)row * D + c16 * 8) = v; }
#undef KROW
#undef SLOAD
#undef SWRITE
#undef SWAIT
#undef RESC
#undef MASK
}
#undef KSWZ
#undef SBAR
}

__device__ __forceinline__ void sgu_item(const Ctx& C, int l, int ch, int g) {
    typedef short bf16x8v __attribute__((ext_vector_type(8)));
    typedef float f32x4v __attribute__((ext_vector_type(4)));
    constexpr int PITCH = 272;
    LAS char* vnT = (LAS char*)C.lds;
    const int lane = C.lane, wave = C.wave;
    const int row0 = ch * 128;
    __syncthreads();
    {
        const float g0 = C_sgu_g[l * CW + g * 128 + lane], g1 = C_sgu_g[l * CW + g * 128 + 64 + lane];
        const float b0 = C_sgu_bn[l * CW + g * 128 + lane], b1 = C_sgu_bn[l * CW + g * 128 + 64 + lane];
        for (int q = wave; q < 128; q += NWAVES) {
            const AT* vp = C_P + (size_t)(row0 + q) * INC + OFF_C + CW + g * 128;
            const float a = gelu_tanh_f(ldv(vp + lane)), b = gelu_tanh_f(ldv(vp + 64 + lane));
            const float mu = wave_sum(a + b) * (1.f / 128.f);
            const float da = a - mu, db = b - mu;
            const float var = wave_sum(da * da + db * db) * (1.f / 128.f);
            const float rstd = 1.0f / sqrtf(var + LN_EPS);
            *(LAS bf16_t*)(vnT + lane * PITCH + q * 2) = f2bf(da * rstd * g0 + b0);
            *(LAS bf16_t*)(vnT + (64 + lane) * PITCH + q * 2) = f2bf(db * rstd * g1 + b1);
        }
    }
    __syncthreads();
    const int m16 = lane & 15, kg = lane >> 4;
    bf16x8v af[4];
    { const float* wp = C_sgu_w + ((size_t)(l * 4 + g) * 128 + 16 * wave + m16) * 128 + 8 * kg;
#pragma unroll
      for (int ks = 0; ks < 4; ++ks) { const float4 w0 = *(const float4*)(wp + 32 * ks), w1 = *(const float4*)(wp + 32 * ks + 4);
          uint4 pk; pk.x = pg8::cvt_pk_bf16(w0.x, w0.y); pk.y = pg8::cvt_pk_bf16(w0.z, w0.w); pk.z = pg8::cvt_pk_bf16(w1.x, w1.y); pk.w = pg8::cvt_pk_bf16(w1.z, w1.w);
          af[ks] = *reinterpret_cast<bf16x8v*>(&pk); } }
    f32x4v acc[8];
#pragma unroll
    for (int nt = 0; nt < 8; ++nt) acc[nt] = (f32x4v){0.f, 0.f, 0.f, 0.f};
#pragma unroll
    for (int nt = 0; nt < 8; ++nt)
#pragma unroll
        for (int ks = 0; ks < 4; ++ks) {
            const bf16x8v bfr = *(const LAS bf16x8v*)(vnT + (nt * 16 + m16) * PITCH + (32 * ks + 8 * kg) * 2);
            acc[nt] = __builtin_amdgcn_mfma_f32_16x16x32_bf16(af[ks], bfr, acc[nt], 0, 0, 0);
        }
#pragma unroll
    for (int reg = 0; reg < 4; ++reg) {
        const int p = 16 * wave + 4 * kg + reg;
        const float bs = C_sgu_b[(l * 4 + g) * 128 + p];
        const AT* up = C_P + (size_t)(row0 + p) * INC + OFF_C + g * 128 + m16;
        AT* op = C_MIX + (size_t)(row0 + p) * D + 1536 + g * 128 + m16;
#pragma unroll
        for (int nt = 0; nt < 8; ++nt) stv(op + 16 * nt, gelu_tanh_f(ldv(up + 16 * nt)) * (acc[nt][reg] + bs));
    }
}

constexpr int CW_MTC = 32768;
constexpr int CW_Q = 16384 + 256;
constexpr int CW_CTXDONE = 16384 + 384;
__device__ __forceinline__ void wg_wait_ge(unsigned* w, unsigned need) {
    if (threadIdx.x < 64) {
        unsigned sp = 0;
        while ((unsigned)__builtin_amdgcn_readfirstlane((int)__hip_atomic_load(w, __ATOMIC_RELAXED, __HIP_MEMORY_SCOPE_AGENT)) < need) { __builtin_amdgcn_s_sleep(2); if (++sp > (1u << 22)) break; }
        __builtin_amdgcn_fence(__ATOMIC_ACQUIRE, "agent");
        asm volatile("s_waitcnt vmcnt(0)" ::: "memory");
    }
    __syncthreads();
}
constexpr int CW_INP = 16384 + 512;
__device__ __forceinline__ void ph_mixers(const Ctx& C, int l) {
    const bool last = (l == DEPTH - 1);
    bool attn_ok = false, sgu_ok = false;
    const int nC = last ? 0 : 12, nCS = last ? 0 : 8, nB = 192, nA = 192, nG = last ? 0 : 8, nS = 256;
    const int nA1 = 256 - nC - nCS - nB > 0 ? (256 - nC - nCS - nB < nA ? 256 - nC - nCS - nB : nA) : 0;
    const int total = nC + nCS + nB + nA + nG + nS;
    LAS int* qs = (LAS int*)(C.lds + att::QSLOT_OFF);
    unsigned* ctr = C_CTLW + CW_Q + l;
    unsigned* ctxdone = C_CTLW + CW_CTXDONE;
    for (;;) {
        __syncthreads();
        if (C.tid == 0) *qs = (int)atomicAdd(ctr, 1u);
        __syncthreads();
        int r = *qs;
        if (r >= total) break;
        int kind = -1, u = 0, h = 0;
        if (r < nC) { kind = 2 + r / 6; h = r % 6; }
        else { r -= nC;
          if (r < nCS) { kind = 5; u = 64 + r / 4; h = r % 4; }
          else { r -= nCS;
            if (r < nB) { kind = 1; u = r / 6; h = r % 6; }
            else { r -= nB;
              if (r < nA1) { kind = 0; u = r / 6; h = r % 6; }
              else { r -= nA1;
                if (r < nG) { kind = 4; u = r; }
                else { r -= nG;
                  if (r < nA - nA1) { kind = 0; u = (r + nA1) / 6; h = (r + nA1) % 6; }
                  else { r -= nA - nA1; kind = 5; u = r / 4; h = r % 4; } } } } } }
        if (kind != 5 && !attn_ok) { wg_wait_ge(C_CTLW + CW_INP + l * 128, (NTOK / 256) * 14); attn_ok = true; }
        if (kind == 5 && !sgu_ok) { wg_wait_ge(C_CTLW + CW_INP + l * 128 + 64, (NTOK / 256) * 4); sgu_ok = true; }
        int t_ = threadIdx.x; asm volatile("" : "+v"(t_));
        if (kind == 1) att::attn_unit<1>(C_P, C_MIX, C_rpb + l * 6 * 465, C_sink + l * 6, u, h, (LAS char*)C.lds, t_);
        else if (kind == 0) att::attn_unit<0>(C_P, C_MIX, C_rpb + l * 6 * 465, C_sink + l * 6, u, h, (LAS char*)C.lds, t_);
        else if (kind == 2) att::attn_unit<2>(C_P, C_MIX, C_rpb + l * 6 * 465, C_sink + l * 6, u, h, (LAS char*)C.lds, t_);
        else if (kind == 3) att::attn_unit<3>(C_P, C_MIX, C_rpb + l * 6 * 465, C_sink + l * 6, u, h, (LAS char*)C.lds, t_);
        else if (kind == 5) { Ctx C2 = C; C2.tid = t_; C2.lane = t_ & 63; C2.wave = __builtin_amdgcn_readfirstlane(t_ >> 6); sgu_item(C2, l, u, h); }
        else {
            if (t_ < 64) {
                unsigned sp = 0;
                while (__builtin_amdgcn_readfirstlane((int)__hip_atomic_load(ctxdone, __ATOMIC_RELAXED, __HIP_MEMORY_SCOPE_AGENT)) < nC + nCS) { __builtin_amdgcn_s_sleep(2); if (++sp > (1u << 22)) break; }
                __builtin_amdgcn_fence(__ATOMIC_ACQUIRE, "agent");
                asm volatile("s_waitcnt vmcnt(0)" ::: "memory");
            }
            __syncthreads();
            pg8::Unit uu; uu.pm = SEQ / 256; uu.pn = u; uu.A = (const char*)(C_MIX + (size_t)SEQ * D); uu.B = (const char*)(C_WOUT + (size_t)l * D * D + (size_t)u * 256 * D);
            pg8::OneUnit S{uu};
            pg8::EpiTres E{C_T, C_x, C_ctx, modp(C, l, 0, 2), modp(C, l, 1, 2)};
            pg8::gemm_phase<D>(C.lds, S, E);
        }
        if (kind == 2 || kind == 3 || (kind == 5 && u >= 64)) {
            asm volatile("s_waitcnt vmcnt(0)" ::: "memory");
            __syncthreads();
            if (threadIdx.x == 0) { __builtin_amdgcn_fence(__ATOMIC_RELEASE, "agent"); asm volatile("s_waitcnt vmcnt(0)" ::: "memory"); __hip_atomic_fetch_add(ctxdone, 1u, __ATOMIC_RELAXED, __HIP_MEMORY_SCOPE_AGENT); }
        }
    }
}

constexpr int WS_POS_OFF = 3 * 1024 * 1024 + 768 * 1024;
#define C_POS ((int*)(C.ws + C.z + WS_POS_OFF))
__device__ __forceinline__ void ph_ln1(const Ctx& C, int l) {
    typedef short bf16x8v __attribute__((ext_vector_type(8)));
    typedef float f32x4v __attribute__((ext_vector_type(4)));
    const bool last = (l == DEPTH - 1);
    const int nrows = last ? SEQ : NTOK;
    const int RPB = __builtin_amdgcn_readfirstlane((nrows + C.G - 1) / C.G);
    const int row_lo = __builtin_amdgcn_readfirstlane(C.bid * RPB), row_hi = __builtin_amdgcn_readfirstlane((row_lo + RPB < nrows) ? row_lo + RPB : nrows);
    const int lane = C.lane, wave = C.wave, tid = C.tid;
    LAS float* hbuf = (LAS float*)C.lds;
    LAS float* red = (LAS float*)C.lds;
    LAS int* hist = (LAS int*)(C.lds + 131072 + 1024);
    LAS int* rinfo = hist + 64;
    LAS int* rrank = rinfo + 256;
    const float* gam = C_ln1_g + l * D; const float* bet = C_ln1_b + l * D;
    if (tid < 32) hist[tid] = 0;
    LAS float* vecs = (LAS float*)(C.lds + 135168);
    { *(LAS f32x4v*)(vecs + 4 * tid) = *(const f32x4v*)(gam + 4 * tid); *(LAS f32x4v*)(vecs + D + 4 * tid) = *(const f32x4v*)(bet + 4 * tid);
      *(LAS f32x4v*)(vecs + 2 * D + 4 * tid) = *(const f32x4v*)(modp(C, l, 0, 4) + 4 * tid); }
    for (int sr = 0; row_lo + 16 * sr < row_hi; ++sr) {
        __syncthreads();
#pragma unroll
        for (int hsel = 0; hsel < 2; ++hsel) {
            const int slot = wave + 8 * hsel, r = row_lo + 16 * sr + slot;
            LAS float* hr = hbuf + slot * D;
            if (r < row_hi) {
                const int kind = r < SEQ ? 0 : 1;
                const bf16_t* tp = C_T + (size_t)r * D;
                const float* sc2 = modp(C, l, kind, 4); const float* sh2 = modp(C, l, kind, 3);
                float v[32]; float sm = 0.f;
                f32x4v shv[8];
#pragma unroll
                for (int j = 0; j < 8; ++j) { const float4 t4 = ld4(tp + 4 * lane + 256 * j); shv[j] = *(const f32x4v*)(sh2 + 4 * lane + 256 * j);
                    v[4 * j] = t4.x; v[4 * j + 1] = t4.y; v[4 * j + 2] = t4.z; v[4 * j + 3] = t4.w; sm += (t4.x + t4.y) + (t4.z + t4.w); }
                const float mu = wave_sum(sm) * (1.f / D);
                float q = 0.f;
#pragma unroll
                for (int k = 0; k < 32; ++k) { v[k] -= mu; q += v[k] * v[k]; }
                const float rstd = 1.0f / sqrtf(wave_sum(q) * (1.f / D) + LN_EPS);
                if (lane == 0) { C_STAT[2 * r] = mu; C_STAT[2 * r + 1] = rstd; }
#pragma unroll
                for (int j = 0; j < 8; ++j) {
                    const int d0 = 4 * lane + 256 * j;
                    const f32x4v g4v = *(const LAS f32x4v*)(vecs + d0), b4v = *(const LAS f32x4v*)(vecs + D + d0);
                    f32x4v sc4v = *(const LAS f32x4v*)(vecs + 2 * D + d0);
                    if (kind) sc4v = *(const f32x4v*)(sc2 + d0);
                    const float4 g4 = {g4v[0], g4v[1], g4v[2], g4v[3]}, b4 = {b4v[0], b4v[1], b4v[2], b4v[3]}, sc4 = {sc4v[0], sc4v[1], sc4v[2], sc4v[3]}, sh4 = {shv[j][0], shv[j][1], shv[j][2], shv[j][3]};
                    float4 x1, h2;
                    x1.x = v[4 * j + 0] * rstd * g4.x + b4.x; x1.y = v[4 * j + 1] * rstd * g4.y + b4.y; x1.z = v[4 * j + 2] * rstd * g4.z + b4.z; x1.w = v[4 * j + 3] * rstd * g4.w + b4.w;
                    h2.x = x1.x * (1.f + sc4.x) + sh4.x; h2.y = x1.y * (1.f + sc4.y) + sh4.y; h2.z = x1.z * (1.f + sc4.z) + sh4.z; h2.w = x1.w * (1.f + sc4.w) + sh4.w;
                    st4(&C_H2[(size_t)r * D + d0], h2);
                    *(LAS f32x4v*)(hr + d0) = (f32x4v){h2.x, h2.y, h2.z, h2.w};
                }
            } else {
#pragma unroll
                for (int j = 0; j < 8; ++j) *(LAS f32x4v*)(hr + 4 * lane + 256 * j) = (f32x4v){0.f, 0.f, 0.f, 0.f};
            }
        }
        __syncthreads();
        f32x4v acc0 = {0.f, 0.f, 0.f, 0.f}, acc1 = {0.f, 0.f, 0.f, 0.f};
        {
            const int m16 = lane & 15, kg = lane >> 4;
            const bf16_t* wt = C_WRT + (size_t)m16 * D + 256 * wave + 8 * kg;
            const LAS float* ar = hbuf + m16 * D + 256 * wave + 8 * kg;
#pragma unroll 4
            for (int ks = 0; ks < 8; ++ks) {
                const f32x4v a0 = *(const LAS f32x4v*)(ar + 32 * ks), a1 = *(const LAS f32x4v*)(ar + 32 * ks + 4);
                uint4 hi, lo;
                hi.x = pg8::cvt_pk_bf16(a0[0], a0[1]); hi.y = pg8::cvt_pk_bf16(a0[2], a0[3]); hi.z = pg8::cvt_pk_bf16(a1[0], a1[1]); hi.w = pg8::cvt_pk_bf16(a1[2], a1[3]);
                lo.x = pg8::cvt_pk_bf16(a0[0] - __uint_as_float(hi.x << 16), a0[1] - __uint_as_float(hi.x & 0xffff0000u));
                lo.y = pg8::cvt_pk_bf16(a0[2] - __uint_as_float(hi.y << 16), a0[3] - __uint_as_float(hi.y & 0xffff0000u));
                lo.z = pg8::cvt_pk_bf16(a1[0] - __uint_as_float(hi.z << 16), a1[1] - __uint_as_float(hi.z & 0xffff0000u));
                lo.w = pg8::cvt_pk_bf16(a1[2] - __uint_as_float(hi.w << 16), a1[3] - __uint_as_float(hi.w & 0xffff0000u));
                const bf16x8v Ah = *reinterpret_cast<bf16x8v*>(&hi), Al = *reinterpret_cast<bf16x8v*>(&lo);
                const bf16x8v B0h = *reinterpret_cast<const bf16x8v*>(wt + 32 * ks), B1h = *reinterpret_cast<const bf16x8v*>(wt + 16 * D + 32 * ks);
                const bf16x8v B0l = *reinterpret_cast<const bf16x8v*>(wt + NE * D + 32 * ks), B1l = *reinterpret_cast<const bf16x8v*>(wt + NE * D + 16 * D + 32 * ks);
                acc0 = __builtin_amdgcn_mfma_f32_16x16x32_bf16(Ah, B0h, acc0, 0, 0, 0); acc1 = __builtin_amdgcn_mfma_f32_16x16x32_bf16(Ah, B1h, acc1, 0, 0, 0);
                acc0 = __builtin_amdgcn_mfma_f32_16x16x32_bf16(Ah, B0l, acc0, 0, 0, 0); acc1 = __builtin_amdgcn_mfma_f32_16x16x32_bf16(Ah, B1l, acc1, 0, 0, 0);
                acc0 = __builtin_amdgcn_mfma_f32_16x16x32_bf16(Al, B0h, acc0, 0, 0, 0); acc1 = __builtin_amdgcn_mfma_f32_16x16x32_bf16(Al, B1h, acc1, 0, 0, 0);
            }
        }
        __syncthreads();
        {
            const int m16 = lane & 15, kg = lane >> 4;
#pragma unroll
            for (int reg = 0; reg < 4; ++reg) { red[(wave * 16 + 4 * kg + reg) * 32 + m16] = acc0[reg]; red[(wave * 16 + 4 * kg + reg) * 32 + 16 + m16] = acc1[reg]; }
        }
        __syncthreads();
        if (tid < 16 && row_lo + 16 * sr + tid < row_hi) {
            const int r = row_lo + 16 * sr + tid;
            float bestgs = -3.0e38f; int be0 = 0, be1 = 0; float bw0 = 0.f, bw1 = 0.f;
#pragma unroll 1
            for (int gq2 = 0; gq2 < 4; ++gq2) {
                float m1 = -3.0e38f, m2 = -3.0e38f, s1 = 0.f, s2 = 0.f; int i1 = 0, i2 = 0;
#pragma unroll 1
                for (int t = 0; t < 8; ++t) {
                    const int e = gq2 * 8 + t;
                    float lg = 0.f;
#pragma unroll
                    for (int w = 0; w < 8; ++w) lg += red[(w * 16 + tid) * 32 + e];
                    const float scv = 1.f / (1.f + expf(-lg)), bv = scv + C_router_bias[e];
                    if (bv > m1) { m2 = m1; i2 = i1; s2 = s1; m1 = bv; i1 = e; s1 = scv; }
                    else if (bv > m2) { m2 = bv; i2 = e; s2 = scv; }
                }
                const float gs = m1 + m2;
                if (gs > bestgs) { bestgs = gs; be0 = i1; be1 = i2; bw0 = s1; bw1 = s2; }
            }
            const float inv = 1.f / (bw0 + bw1);
            LAS int* ri = rinfo + (r - row_lo) * 4;
            ri[0] = be0; ri[1] = be1; ri[2] = __float_as_int(bw0 * inv); ri[3] = __float_as_int(bw1 * inv);
        }
    }
    const int nb = row_hi - row_lo;
    __syncthreads();
    int e_mine = 0;
    if (tid < 2 * nb) { e_mine = rinfo[(tid >> 1) * 4 + (tid & 1)]; rrank[tid] = (int)__hip_atomic_fetch_add((LAS unsigned*)(hist + e_mine), 1u, __ATOMIC_RELAXED, __HIP_MEMORY_SCOPE_WORKGROUP); }
    __syncthreads();
    if (tid < 32) { const int cnt = hist[tid]; hist[32 + tid] = cnt ? (int)atomicAdd(C_CTLW + CW_CNT + l * 32 + tid, (unsigned)cnt) : 0; }
    __syncthreads();
    if (tid < 2 * nb) {
        const int r = row_lo + (tid >> 1), k = tid & 1;
        C_POS[(size_t)r * 2 + k] = hist[32 + e_mine] + rrank[tid];
        int* rp = C_ROUTE + (size_t)r * 4;
        rp[k] = e_mine; rp[2 + k] = rinfo[(tid >> 1) * 4 + 2 + k];
    }
}

constexpr int TOFF_OFF = 131072;
__device__ __forceinline__ void compute_toff(const Ctx& C, int l) {
    LAS int* toff = (LAS int*)(C.lds + TOFF_OFF);
    __syncthreads();
    if (C.tid == 0) { int acc = 0;
        for (int e = 0; e < NE; ++e) { toff[e] = acc; acc += ((int)__hip_atomic_load(C_CTLW + CW_CNT + l * 32 + e, __ATOMIC_RELAXED, __HIP_MEMORY_SCOPE_AGENT) + 255) >> 8; }
        toff[NE] = acc; }
    __syncthreads();
}
__device__ __forceinline__ void ph_dispatch(const Ctx& C, int l) {
    const bool last = (l == DEPTH - 1);
    const int nrows = last ? SEQ : NTOK;
    const int gw = C.bid * NWAVES + C.wave, NGW = C.G * NWAVES, lane = C.lane;
    compute_toff(C, l);
    const LAS int* toff = (const LAS int*)(C.lds + TOFF_OFF);
    for (int it = gw; it < nrows * 2; it += NGW) {
        const int r = it >> 1, k = it & 1;
        const int e = C_ROUTE[(size_t)r * 4 + k];
        const int slot = toff[e] * 256 + C_POS[it];
        if (lane == 0) { C_SLOT[it] = slot; C_SW[slot] = __int_as_float(C_ROUTE[(size_t)r * 4 + 2 + k]); }
        const uint4* src = (const uint4*)(C_H2 + (size_t)r * D); uint4* dst = (uint4*)(C_HS + (size_t)slot * D);
#pragma unroll
        for (int j = 0; j < 4; ++j) dst[lane + 64 * j] = src[lane + 64 * j];
    }
}

__device__ __forceinline__ void ph_ln2(const Ctx& C, int l) {
    const bool last = (l == DEPTH - 1);
    const int nrows = last ? SEQ : NTOK;
    const int gw = C.bid * NWAVES + C.wave, NGW = C.G * NWAVES, lane = C.lane;
    LAS float* vec0 = (LAS float*)C.lds;
    {
        const int ln = last ? l : l + 1;
#pragma unroll
        for (int k = 0; k < 2; ++k) {
            *(LAS pg8::f32x4*)(vec0 + (k * 5 + 0) * D + 4 * C.tid) = *(const pg8::f32x4*)(modp(C, l, k, 5) + 4 * C.tid);
            *(LAS pg8::f32x4*)(vec0 + (k * 5 + 1) * D + 4 * C.tid) = *(const pg8::f32x4*)(C_ln2_g + l * D + 4 * C.tid);
            *(LAS pg8::f32x4*)(vec0 + (k * 5 + 2) * D + 4 * C.tid) = *(const pg8::f32x4*)(C_ln2_b + l * D + 4 * C.tid);
            *(LAS pg8::f32x4*)(vec0 + (k * 5 + 3) * D + 4 * C.tid) = *(const pg8::f32x4*)(modp(C, ln, k, 1) + 4 * C.tid);
            *(LAS pg8::f32x4*)(vec0 + (k * 5 + 4) * D + 4 * C.tid) = *(const pg8::f32x4*)(modp(C, ln, k, 0) + 4 * C.tid);
        }
        *(LAS pg8::f32x4*)(vec0 + 10 * D + 4 * C.tid) = *(const pg8::f32x4*)(C_ln1_g + l * D + 4 * C.tid);
        *(LAS pg8::f32x4*)(vec0 + 11 * D + 4 * C.tid) = *(const pg8::f32x4*)(C_ln1_b + l * D + 4 * C.tid);
        __syncthreads();
    }
    for (int r = gw; r < nrows; r += NGW) {
        const LAS float* vec = vec0 + (r < SEQ ? 0 : 5 * D);
        const int s0 = C_SLOT[2 * r], s1 = C_SLOT[2 * r + 1];
        float4 xv[8]; uint2 ya[8], yb[8];
#pragma unroll
        for (int j = 0; j < 8; ++j) { const int d0 = 4 * lane + 256 * j;
            xv[j] = ld4(C_T + (size_t)r * D + d0); ya[j] = *(const uint2*)(C_Y + (size_t)s0 * D + d0); yb[j] = *(const uint2*)(C_Y + (size_t)s1 * D + d0); }
        const float mu1 = C_STAT[2 * r], rs1 = C_STAT[2 * r + 1];
        float v[32]; float s = 0.f;
#pragma unroll
        for (int j = 0; j < 8; ++j) { const int d0 = 4 * lane + 256 * j;
            { const pg8::f32x4 ga = *(const LAS pg8::f32x4*)(vec0 + 10 * D + d0), be = *(const LAS pg8::f32x4*)(vec0 + 11 * D + d0);
              xv[j].x = (xv[j].x - mu1) * rs1 * ga[0] + be[0]; xv[j].y = (xv[j].y - mu1) * rs1 * ga[1] + be[1]; xv[j].z = (xv[j].z - mu1) * rs1 * ga[2] + be[2]; xv[j].w = (xv[j].w - mu1) * rs1 * ga[3] + be[3]; }
            const pg8::f32x4 g4 = *(const LAS pg8::f32x4*)(vec + d0);
            const float y0 = __uint_as_float(ya[j].x << 16) + __uint_as_float(yb[j].x << 16), y1 = __uint_as_float(ya[j].x & 0xffff0000u) + __uint_as_float(yb[j].x & 0xffff0000u);
            const float y2 = __uint_as_float(ya[j].y << 16) + __uint_as_float(yb[j].y << 16), y3 = __uint_as_float(ya[j].y & 0xffff0000u) + __uint_as_float(yb[j].y & 0xffff0000u);
            v[4 * j + 0] = ALPHA * xv[j].x + g4[0] * y0; v[4 * j + 1] = ALPHA * xv[j].y + g4[1] * y1; v[4 * j + 2] = ALPHA * xv[j].z + g4[2] * y2; v[4 * j + 3] = ALPHA * xv[j].w + g4[3] * y3;
            s += (v[4 * j] + v[4 * j + 1]) + (v[4 * j + 2] + v[4 * j + 3]); }
        const float mu = wave_sum(s) * (1.f / D);
        float q = 0.f;
#pragma unroll
        for (int i = 0; i < 32; ++i) { v[i] -= mu; q += v[i] * v[i]; }
        const float rstd = 1.0f / sqrtf(wave_sum(q) * (1.f / D) + LN_EPS);
#pragma unroll
        for (int j = 0; j < 8; ++j) { const int d0 = 4 * lane + 256 * j;
            const pg8::f32x4 g4 = *(const LAS pg8::f32x4*)(vec + D + d0), b4 = *(const LAS pg8::f32x4*)(vec + 2 * D + d0);
            float4 xo;
            xo.x = v[4 * j + 0] * rstd * g4[0] + b4[0]; xo.y = v[4 * j + 1] * rstd * g4[1] + b4[1]; xo.z = v[4 * j + 2] * rstd * g4[2] + b4[2]; xo.w = v[4 * j + 3] * rstd * g4[3] + b4[3];
            if (last) *(float4*)(C.out + C.z + (size_t)r * D + d0) = xo;
            else {
                *(float4*)(C_XB + (size_t)r * D + d0) = xo;
                const pg8::f32x4 sc4 = *(const LAS pg8::f32x4*)(vec + 3 * D + d0), sh4 = *(const LAS pg8::f32x4*)(vec + 4 * D + d0);
                float4 hn; hn.x = xo.x * (1.f + sc4[0]) + sh4[0]; hn.y = xo.y * (1.f + sc4[1]) + sh4[1]; hn.z = xo.z * (1.f + sc4[2]) + sh4[2]; hn.w = xo.w * (1.f + sc4[3]) + sh4[3];
                st4(&C_H[(size_t)r * D + d0], hn);
            }
        }
    }
}

__device__ __forceinline__ Ctx fresh(const Ctx& C0) { Ctx C = C0; size_t z = 0; int t = threadIdx.x; int g_ = gridDim.x, b_ = blockIdx.x; asm volatile("" : "+s"(z), "+v"(t), "+s"(g_), "+s"(b_)); C.G = g_; C.bid = b_; C.z = z; C.tid = t; C.lane = t & 63; C.wave = __builtin_amdgcn_readfirstlane(t >> 6); return C; }
constexpr int PH_PER_LAYER = 7;
constexpr int N_PHASES = 2 + PH_PER_LAYER * DEPTH;
__global__ void __launch_bounds__(NTHREADS, 2) fwd_kernel(Args args) {
    extern __shared__ __attribute__((aligned(16))) unsigned char lds_raw[];
    Ctx C0;
    C0.lds = (LAS unsigned char*)lds_raw;
    C0.tid = threadIdx.x; C0.lane = C0.tid & 63; C0.wave = __builtin_amdgcn_readfirstlane(C0.tid >> 6); C0.G = gridDim.x; C0.bid = blockIdx.x;
    C0.in = args.in; C0.out = args.out; C0.ws = args.ws; C0.z = 0;
    unsigned char* ws = args.ws;

    volatile LAS unsigned* bst = (volatile LAS unsigned*)(C0.lds + LDS_BYTES - 16);
    if (C0.tid < 4) bst[C0.tid] = 0u;
    __syncthreads();
    const int lo = args.ph_lo, hi = args.ph_hi;
    XcdBarrier bar; bar.bar = (unsigned*)(ws + WS_CTL) + CW_BAR; bar.x = 0; bar.st = bst;
    if (hi - lo > 1) bar = xcd_barrier_post((unsigned*)(ws + WS_CTL) + CW_BAR, bst);
#define IN(k) (lo <= (k) && (k) < hi)
#define SEAM(k) do { if (IN(k) && IN((k) + 1)) xcd_barrier(bar); } while (0)

    if (IN(0)) { const Ctx C = fresh(C0); ph_prologue(C); } SEAM(0);
    if (IN(1)) { const Ctx C = fresh(C0); ph_modulate0(C); } SEAM(1);
#pragma unroll 1
    for (int l = 0; l < DEPTH; ++l) {
        const int pb = 2 + PH_PER_LAYER * l;
        const bool last = (l == DEPTH - 1);
        if (IN(pb + 0)) {
            const Ctx C = fresh(C0);
            const int vid = (C.G % 8 == 0) ? (C.bid % 8) * (C.G / 8) + C.bid / 8 : C.bid;
            pg8::InprojSched S{C.G, vid, (const char*)C_H, (const char*)(C_WIN + (size_t)l * INC * D), C_CTLW + CW_INP + l * 128};
            pg8::EpiP E{C_P, C_ROPE};
            pg8::gemm_phase<D>(C.lds, S, E);
        }
        if (IN(pb + 1)) { const Ctx C = fresh(C0); ph_mixers(C, l); } SEAM(pb + 1);
        if (IN(pb + 2)) {
            const Ctx C = fresh(C0);
            pg8::DenseSched<D / 256, D> S{SEQ / 256, C.G, C.bid, (const char*)C_MIX, (const char*)(C_WOUT + (size_t)l * D * D)};
            pg8::EpiTres E{C_T, l == 0 ? C_x : C_XB, l == 0 ? C_ctx : C_XB + (size_t)SEQ * D, modp(C, l, 0, 2), modp(C, l, 1, 2)};
            pg8::gemm_phase<D>(C.lds, S, E);
        }
        SEAM(pb + 2);
        if (IN(pb + 3)) { const Ctx C = fresh(C0); ph_ln1(C, l); } SEAM(pb + 3);
        if (IN(pb + 4)) { const Ctx C = fresh(C0); ph_dispatch(C, l); } SEAM(pb + 4);
        if (IN(pb + 5)) {
            const Ctx C = fresh(C0);
            compute_toff(C, l);
            const int vid = (C.G % 8 == 0) ? (C.bid % 8) * (C.G / 8) + C.bid / 8 : C.bid;
            unsigned* mtc = C_CTLW + CW_MTC + l * (128 * 64);
            { pg8::MoeSched1 S{(const LAS int*)(C.lds + TOFF_OFF), C.G, vid, (const char*)C_HS, (const char*)(C_WGU + (size_t)l * NE * 1024 * D), mtc};
              pg8::EpiMoe1 E{C_HID, C_SW};
              pg8::gemm_phase<D>(C.lds, S, E); }
            { pg8::MoeSched2 S{(const LAS int*)(C.lds + TOFF_OFF), C.G, vid, (const char*)C_HID, (const char*)(C_WD + (size_t)l * NE * D * FF), mtc};
              pg8::EpiBf16 E{C_Y, D};
              pg8::gemm_phase<FF, pg8::EpiBf16, pg8::MoeSched2, true, false>(C.lds, S, E); }
        }
        SEAM(pb + 5);
        if (IN(pb + 6)) { const Ctx C = fresh(C0); ph_ln2(C, l); }
        if (!last) SEAM(pb + 6);
    }
#undef IN
#undef SEAM
}

#ifndef MK_N_LAUNCHES
#define MK_N_LAUNCHES 1
#endif
extern "C" void kernel_launch(void* const* d_in, const int* in_sizes, int n_in, void* d_out, int out_size, void* d_ws, size_t ws_size, hipStream_t stream) {
    static int grid = 0;
    if (grid == 0) {
        if (n_in != 23 || out_size != SEQ * D || ws_size < WS_END) {
            fprintf(stderr, "kernel_launch: unexpected shapes: n_in %d out %d ws %zu (need %zu)\n", n_in, out_size, ws_size, (size_t)WS_END); grid = -1; return; }
        int dev = 0, cus = 0;
        if (hipGetDevice(&dev) != hipSuccess || hipDeviceGetAttribute(&cus, hipDeviceAttributeMultiprocessorCount, dev) != hipSuccess) { grid = -1; return; }
        if (hipFuncSetAttribute((const void*)fwd_kernel, hipFuncAttributeMaxDynamicSharedMemorySize, LDS_BYTES) != hipSuccess) { fprintf(stderr, "kernel_launch: hipFuncSetAttribute failed\n"); grid = -1; return; }
        int per_cu = 0;
        if (hipOccupancyMaxActiveBlocksPerMultiprocessor(&per_cu, (const void*)fwd_kernel, NTHREADS, LDS_BYTES) != hipSuccess || per_cu < 1) fprintf(stderr, "kernel_launch: occupancy query says %d\n", per_cu);
        (void)hipGetLastError();
        grid = cus;
    }
    if (grid < 0) return;
    hipMemsetAsync((char*)d_ws + WS_CTL, 0, CTL_BYTES, stream);
    Args a{};
    for (int i = 0; i < 23; ++i) a.in[i] = (const float*)d_in[i];
    a.out = (float*)d_out; a.ws = (unsigned char*)d_ws;
    if (MK_N_LAUNCHES == 1) {
        a.ph_lo = 0; a.ph_hi = N_PHASES;
        hipLaunchKernelGGL(fwd_kernel, dim3(grid), dim3(NTHREADS), LDS_BYTES, stream, a);
    } else {
        for (int p = 0; p < N_PHASES; ++p) {
            a.ph_lo = p; a.ph_hi = p + 1;
            hipLaunchKernelGGL(fwd_kernel, dim3(grid), dim3(NTHREADS), LDS_BYTES, stream, a);
        }
    }
    const hipError_t le = hipPeekAtLastError();
    if (le != hipSuccess) fprintf(stderr, "kernel_launch: launch failed: %s\n", hipGetErrorName(le));
}
```

```cpp
#include <hip/hip_runtime.h>
#include <cstdio>
#include <cstdint>

#define LAS __attribute__((address_space(3)))
typedef unsigned short bf16_t;

constexpr int D = 2048, SEQ = 8192, CTXL = 256, NTOK = SEQ + CTXL;
constexpr int DEPTH = 2, GRID_W = 64, HD = 128;
constexpr int INC = 4608;
constexpr int OFF_AK = 768, OFF_AV = 1024, OFF_BQ = 1280, OFF_BK = 2048, OFF_BV = 2816, OFF_C = 3584;
constexpr int NE = 32, FF = 512, CW = 512;
constexpr float LN_EPS = 1e-5f;
constexpr float ALPHA = 1.4142135623730951f;
constexpr float QSCALE = 0.08838834764831845f;
constexpr int NTHREADS = 512, NWAVES = 8;

typedef bf16_t AT;
__device__ __forceinline__ float ldv(const float* p) { return *p; }
__device__ __forceinline__ void stv(float* p, float v) { *p = v; }
__device__ __forceinline__ float bf2f(bf16_t b) { return __uint_as_float(((unsigned)b) << 16); }
__device__ __forceinline__ bf16_t f2bf(float f) { unsigned u = __float_as_uint(f); return (bf16_t)((u + 0x7fffu + ((u >> 16) & 1u)) >> 16); }
__device__ __forceinline__ float ldv(const bf16_t* p) { return bf2f(*p); }
__device__ __forceinline__ void stv(bf16_t* p, float v) { *p = f2bf(v); }

__device__ __forceinline__ float4 ld4(const float* p) { return *(const float4*)p; }
__device__ __forceinline__ void st4(float* p, float4 v) { *(float4*)p = v; }
__device__ __forceinline__ float4 ld4(const bf16_t* p) { const uint2 u = *(const uint2*)p; float4 r; r.x = __uint_as_float(u.x << 16); r.y = __uint_as_float(u.x & 0xffff0000u); r.z = __uint_as_float(u.y << 16); r.w = __uint_as_float(u.y & 0xffff0000u); return r; }
__device__ __forceinline__ void st4(bf16_t* p, float4 v) { uint2 u; u.x = (unsigned)f2bf(v.x) | ((unsigned)f2bf(v.y) << 16); u.y = (unsigned)f2bf(v.z) | ((unsigned)f2bf(v.w) << 16); *(uint2*)p = u; }

constexpr size_t MiB = 1u << 20;
constexpr size_t WS_CTL = 0, CTL_BYTES = 1 * MiB;
constexpr int CW_BAR = 4096, CW_CNT = 16384, CW_CUR = 16384 + 128;
constexpr size_t WS_MOD = 1 * MiB;
constexpr size_t WS_ROPE = 2 * MiB;
constexpr size_t WS_ROUTE = 3 * MiB;
constexpr size_t WS_SLOT = 3 * MiB + 512 * 1024;
constexpr size_t WS_SW = 4 * MiB;
constexpr size_t WS_WRT = 4 * MiB + 512 * 1024;
constexpr size_t WS_MODP = 5 * MiB;
constexpr int MAXSLOT = 25088;
constexpr size_t WS_WIN = 8 * MiB;
constexpr size_t WS_WOUT = 44 * MiB;
constexpr size_t WS_WGU = 64 * MiB;
constexpr size_t WS_WD = 320 * MiB;
constexpr size_t WS_H = 448 * MiB;
constexpr size_t WS_P = 482 * MiB;
constexpr size_t WS_MIX = 558 * MiB;
constexpr size_t WS_T = 592 * MiB;
constexpr size_t WS_X1 = 660 * MiB;
constexpr size_t WS_XB = 728 * MiB;
constexpr size_t WS_H2 = 796 * MiB;
constexpr size_t WS_HS = 830 * MiB;
constexpr size_t WS_HID = 930 * MiB;
constexpr size_t WS_Y = 956 * MiB;
constexpr size_t WS_END = 1056 * MiB;

constexpr size_t WS_XW = WS_X1 + 4 * MiB;
constexpr int CW_OUT = 65536;
constexpr int LDS_BYTES = 163840;

#define XB_TMO      128
#define XB_XCNT(j)  (256  + 64 * (j))
#define XB_XSUB(j)  (1280 + 64 * (j))
#define XB_XGEN(j)  (2304 + 64 * (j))
#define XB_TOP      3328
#define XB_TOPGEN   3392
#define XCD_BAR_WORDS 3456
#define XB_SPIN_CAP (1u << 18)
__device__ __forceinline__ unsigned xb_ld(unsigned* p)              { return __hip_atomic_load(p, __ATOMIC_RELAXED, __HIP_MEMORY_SCOPE_AGENT); }
__device__ __forceinline__ unsigned xb_add(unsigned* p, unsigned v) { return __hip_atomic_fetch_add(p, v, __ATOMIC_RELAXED, __HIP_MEMORY_SCOPE_AGENT); }
__device__ __forceinline__ unsigned xb_xcc_id() { return (unsigned)__builtin_amdgcn_s_getreg((3 << 11) | 20) & 0xFu; }
#define XB_SPIN(cond, bar) do { unsigned _sp = 0; while (cond) { __builtin_amdgcn_s_sleep(1); \
    if ((++_sp & 255u) == 0u) { if (xb_ld(&(bar)[XB_TMO])) break; if (_sp > XB_SPIN_CAP) { atomicAdd(&(bar)[XB_TMO], 1u); break; } } } } while (0)
struct XcdBarrier { unsigned* bar; unsigned x; volatile LAS unsigned* st; };
__device__ __forceinline__ XcdBarrier xcd_barrier_post(unsigned* bar, volatile LAS unsigned* st) {
    XcdBarrier b; b.bar = bar; b.x = xb_xcc_id(); b.st = st;
    if (threadIdx.x == 0) (void)xb_add(&bar[XB_XCNT(b.x)], 1u);
    return b;
}
__device__ __forceinline__ void xcd_barrier_complete(unsigned* bar, unsigned x, unsigned& nloc, unsigned& nx) {
    const unsigned G = gridDim.x * gridDim.y * gridDim.z;
    unsigned sum, cnt, mine, sp = 0u;
    for (;;) {
        sum = 0u; cnt = 0u; mine = 0u;
#pragma unroll
        for (unsigned j = 0; j < 16; ++j) { const unsigned c = xb_ld(&bar[XB_XCNT(j)]); sum += c; cnt += (c > 0u) ? 1u : 0u; mine = (j == x) ? c : mine; }
        if (sum == G) break;
        __builtin_amdgcn_s_sleep(1);
        if ((++sp & 255u) == 0u) { if (xb_ld(&bar[XB_TMO])) break; if (sp > XB_SPIN_CAP) { atomicAdd(&bar[XB_TMO], 1u); break; } }
    }
    nloc = mine > 0u ? mine : 1u; nx = cnt > 0u ? cnt : 1u;
}
__device__ __noinline__ void xcd_barrier(const XcdBarrier b) {
    asm volatile("s_waitcnt vmcnt(0)" ::: "memory");
    __syncthreads();
    if (threadIdx.x == 0) {
        unsigned* bar = b.bar;
        __builtin_amdgcn_s_waitcnt(0);
        unsigned nloc = b.st[0], nx = b.st[1];
        if (nloc == 0u) { xcd_barrier_complete(bar, b.x, nloc, nx); b.st[0] = nloc; b.st[1] = nx; }
        const unsigned old = xb_add(&bar[XB_XSUB(b.x)], 1u);
        const unsigned gen = old / nloc;
        if (old + 1u == (gen + 1u) * nloc) {
            __builtin_amdgcn_fence(__ATOMIC_RELEASE, "agent");
            asm volatile("s_waitcnt vmcnt(0)" ::: "memory");
            const unsigned og = xb_add(&bar[XB_TOP], 1u);
            const unsigned tg = og / nx;
            if (og + 1u == (tg + 1u) * nx) xb_add(&bar[XB_TOPGEN], 1u);
            else XB_SPIN(xb_ld(&bar[XB_TOPGEN]) == tg, bar);
            __builtin_amdgcn_fence(__ATOMIC_ACQUIRE, "agent");
            xb_add(&bar[XB_XGEN(b.x)], 1u);
            asm volatile("s_waitcnt vmcnt(0)" ::: "memory");
        } else {
            XB_SPIN(xb_ld(&bar[XB_XGEN(b.x)]) == gen, bar);
            __builtin_amdgcn_fence(__ATOMIC_ACQUIRE, "agent");
            asm volatile("s_waitcnt vmcnt(0)" ::: "memory");
        }
    }
    __syncthreads();
}

struct Args {
    const float* in[23];
    float* out;
    unsigned char* ws;
    int ph_lo, ph_hi;
};

struct Ctx {
    LAS unsigned char* lds;
    int tid, lane, wave, G, bid;
    const float* const* in;
    float* out;
    unsigned char* ws;
    size_t z;
};
#define CIN(k) (C.in[k] + C.z)
#define C_x CIN(0)
#define C_c CIN(1)
#define C_ctx CIN(2)
#define C_c_ctx CIN(3)
#define C_w_mod CIN(4)
#define C_b_mod CIN(5)
#define C_w_in CIN(6)
#define C_sink CIN(7)
#define C_rpb CIN(8)
#define C_sgu_g CIN(9)
#define C_sgu_bn CIN(10)
#define C_sgu_w CIN(11)
#define C_sgu_b CIN(12)
#define C_w_out CIN(13)
#define C_ln1_g CIN(14)
#define C_ln1_b CIN(15)
#define C_w_router CIN(16)
#define C_router_bias CIN(17)
#define C_w_gate CIN(18)
#define C_w_up CIN(19)
#define C_w_down CIN(20)
#define C_ln2_g CIN(21)
#define C_ln2_b CIN(22)
#define C_MOD ((float*)(C.ws + C.z + WS_MOD))
#define C_ROPE ((float*)(C.ws + C.z + WS_ROPE))
#define C_ROUTE ((int*)(C.ws + C.z + WS_ROUTE))
#define C_H ((AT*)(C.ws + C.z + WS_H))
#define C_P ((AT*)(C.ws + C.z + WS_P))
#define C_MIX ((AT*)(C.ws + C.z + WS_MIX))
#define C_T ((bf16_t*)(C.ws + C.z + WS_T))
#define C_X1 ((float*)(C.ws + C.z + WS_X1))
#define C_STAT ((float*)(C.ws + C.z + WS_X1))
#define C_XB ((float*)(C.ws + C.z + WS_XB))
#define C_H2 ((AT*)(C.ws + C.z + WS_H2))
#define C_HID ((AT*)(C.ws + C.z + WS_HID))
#define C_Y ((AT*)(C.ws + C.z + WS_Y))
#define C_HS ((AT*)(C.ws + C.z + WS_HS))
#define C_WRT ((bf16_t*)(C.ws + C.z + WS_WRT))
constexpr int LCAP = NTOK;
#define C_LIST ((int*)(C.ws + C.z + WS_HS))
#define C_SWL ((float*)(C.ws + C.z + WS_HS + 2 * MiB))
#define C_SLOT ((int*)(C.ws + C.z + WS_SLOT))
#define C_SW ((float*)(C.ws + C.z + WS_SW))
#define C_MODP ((float*)(C.ws + C.z + WS_MODP))
#define C_CTLW ((unsigned*)(C.ws + C.z + WS_CTL))
constexpr int WS_POS_OFF = 3 * 1024 * 1024 + 768 * 1024;
#define C_POS ((int*)(C.ws + C.z + WS_POS_OFF))
#define C_WIN ((bf16_t*)(C.ws + C.z + WS_WIN))
#define C_WOUT ((bf16_t*)(C.ws + C.z + WS_WOUT))
#define C_WGU ((bf16_t*)(C.ws + C.z + WS_WGU))
#define C_WD ((bf16_t*)(C.ws + C.z + WS_WD))

template <class T> __device__ __forceinline__ T* uni(T* p) { const unsigned long long v = (unsigned long long)p; const unsigned lo = (unsigned)__builtin_amdgcn_readfirstlane((int)(unsigned)v), hi = (unsigned)__builtin_amdgcn_readfirstlane((int)(unsigned)(v >> 32)); return (T*)(((unsigned long long)hi << 32) | lo); }
__device__ __forceinline__ float silu_f(float v) { return v / (1.f + expf(-v)); }
__device__ __forceinline__ float gelu_tanh_f(float v) { return 0.5f * v * (1.f + tanhf(0.7978845608028654f * (v + 0.044715f * v * v * v))); }
__device__ __forceinline__ float wave_sum(float v) {
#pragma unroll
    for (int o = 1; o < 64; o <<= 1) v += __shfl_xor(v, o);
    return v;
}
__device__ __forceinline__ float wave_max(float v) {
#pragma unroll
    for (int o = 1; o < 64; o <<= 1) v = fmaxf(v, __shfl_xor(v, o));
    return v;
}
__device__ __forceinline__ const float* modp(const Ctx& C, int l, int kind, int j) { return C_MOD + ((size_t)(l * 2 + kind) * 6 + j) * D; }
__device__ __forceinline__ const float* xin_row(const Ctx& C, int l, int r) {
    if (l == 0) return r < SEQ ? C_x + (size_t)r * D : C_ctx + (size_t)(r - SEQ) * D;
    return C_XB + (size_t)r * D;
}

namespace pg8 {
#define PG8_LAS __attribute__((address_space(3)))
typedef short bf16x8 __attribute__((ext_vector_type(8)));
typedef float f32x4 __attribute__((ext_vector_type(4)));
typedef unsigned u32x4 __attribute__((ext_vector_type(4)));
constexpr int BM = 256, BK = 64, HALF = 128, HTB = HALF * BK * 2, STAGE_BYTES = 8 * HTB, NXCD = 8, WGM = 8;
__host__ __device__ __forceinline__ int lds_byte(int r, int c) { const int st = (r >> 4) * 2 + (c >> 5), rr = r & 15, cc = c & 31, ob = rr * 64 + cc * 2; return st * 1024 + (ob ^ (((ob >> 9) & 1) << 5)); }
__host__ __device__ __forceinline__ void stage_rc(int b, int& R, int& C) { const int st = b / 1024, sb = b % 1024, swz = sb ^ (((sb >> 9) & 1) << 5); R = (st >> 1) * 16 + swz / 64; C = (st & 1) * 32 + (swz % 64) / 2; }
__host__ __device__ __forceinline__ int perm32(int rho) { const int n = rho >> 4, i = rho & 15; return 8 * (i >> 2) + 4 * n + (i & 3); }
__device__ __forceinline__ unsigned cvt_pk_bf16(float lo, float hi) { unsigned r; asm volatile("v_cvt_pk_bf16_f32 %0, %1, %2" : "=v"(r) : "v"(lo), "v"(hi)); return r; }

__device__ __forceinline__ void store16_wt(void* p, u32x4 v) { asm volatile("global_store_dwordx4 %0, %1, off sc1\n\ts_nop 1" :: "v"(p), "v"(v) : "memory"); }
struct Unit { int pm, pn; const char* A; const char* B; const int* rows; const float* sw; int nvalid; };

template <int NN  , int KD>
struct DenseSched {
    int nM, G, c; const char* A; const char* Bt;
    __device__ __forceinline__ bool next(int i, Unit& u) const {
        const int nwg = nM * NN;
        const int L = i * G + c; if (L >= nwg) return false;
        int wgid = L; { const int q = nwg / NXCD, r = nwg % NXCD, xcd = wgid % NXCD, off = wgid / NXCD; wgid = (xcd < r ? xcd * (q + 1) : r * (q + 1) + (xcd - r) * q) + off; }
        const int nig = WGM * NN, gid = wgid / nig, fm = gid * WGM, gsz = (nM - fm) < WGM ? (nM - fm) : WGM;
        u.pm = fm + ((wgid % nig) % gsz); u.pn = (wgid % nig) / gsz;
        u.A = A + (size_t)u.pm * (BM * KD * 2); u.B = Bt + (size_t)u.pn * (BM * KD * 2); return true;
    }
    __device__ __forceinline__ void a_ready(const Unit&) const {}
    __device__ __forceinline__ void done(const Unit&) const {}
};
struct InprojSched {
    int G, v; const char* A; const char* Bt; unsigned* cnt; unsigned* cnt3; int ded;
    __device__ __forceinline__ bool next(int i, Unit& u) const {
        constexpr int N1 = (NTOK / 256) * 14, N2 = (NTOK / 256) * 4;
        int j;
        if (i == 0) j = v;
        else if (i == 1) { if (v >= G - ded) return false; j = G + v; }
        else j = i * G - ded + v;
        if (j >= N1 + N2) return false;
        if (j < 14) { u.pm = 32; u.pn = j; }
        else if (j < 18) { u.pm = 32; u.pn = j; }
        else if (j < 18 + 8 * 56) { const int k = j - 18, g = k / 56, r = k % 56; u.pm = 4 * g + (r & 3); u.pn = r >> 2; }
        else { const int jj = j - 18 - 8 * 56; const int g = jj >> 5, r = jj & 31; u.pm = 8 * g + (r & 7); u.pn = 14 + (r >> 3); }
        u.A = A + (size_t)u.pm * (BM * D * 2); u.B = Bt + (size_t)u.pn * (BM * D * 2); return true;
    }
    __device__ __forceinline__ void a_ready(const Unit&) const {}
    __device__ __forceinline__ void done(const Unit& u) const {
        asm volatile("s_waitcnt vmcnt(0)" ::: "memory");
        __builtin_amdgcn_s_barrier();
        if (threadIdx.x == 0) {
            const bool ctxt = (u.pm == SEQ / BM);
            __hip_atomic_fetch_add(u.pn < 14 ? cnt : (ctxt ? cnt3 : cnt + 64), 1u, __ATOMIC_RELAXED, __HIP_MEMORY_SCOPE_AGENT);
            if (ctxt && u.pn < 14) __hip_atomic_fetch_add(cnt3 + 32, 1u, __ATOMIC_RELAXED, __HIP_MEMORY_SCOPE_AGENT);
        }
    }
};
struct OneUnit { Unit u0; __device__ __forceinline__ bool next(int i, Unit& u) const { if (i != 0) return false; u = u0; return true; }
    __device__ __forceinline__ void a_ready(const Unit&) const {}
    __device__ __forceinline__ void done(const Unit&) const {} };
__device__ __forceinline__ int moe_expert_of(const PG8_LAS int* toff, int mt) { int e = 0; for (int q = 1; q < 32; ++q) e += (toff[q] <= mt) ? 1 : 0; return e; }
struct MoeSched1 {
    const PG8_LAS int* toff; int G, v; const char* A; const char* B; unsigned* mtc; const int* list; const float* swl;
    __device__ __forceinline__ bool next(int i, Unit& u) const {
        const int MT = toff[32];
        const int L = i * G + v; if (L >= MT * 4) return false;
        const int mt = L >> 2, pn = L & 3, e = moe_expert_of(toff, mt), p0 = 256 * (mt - toff[e]);
        u.pm = mt; u.pn = pn; u.A = A; u.B = B + (size_t)(e * 1024 + pn * 256) * (D * 2);
        u.rows = list + (size_t)e * NTOK + p0; u.sw = swl + (size_t)e * NTOK + p0; const int left = toff[40 + e] - p0; u.nvalid = left < 256 ? left : 256; return true;
    }
    __device__ __forceinline__ void a_ready(const Unit&) const {}
    __device__ __forceinline__ void done(const Unit& u) const {
        asm volatile("s_waitcnt vmcnt(0)" ::: "memory");
        __builtin_amdgcn_s_barrier();
        if (threadIdx.x == 0) __hip_atomic_fetch_add(mtc + 64 * u.pm, 1u, __ATOMIC_RELAXED, __HIP_MEMORY_SCOPE_AGENT);
    }
};
struct MoeSched2 {
    const PG8_LAS int* toff; int G, v; const char* A; const char* B; unsigned* mtc;
    __device__ __forceinline__ bool next(int i, Unit& u) const {
        const int MT = toff[32], N1 = MT * 4, N2 = MT * 8;
        const int r1 = N1 % G, nl = G - r1;
        const bool light = v >= r1;
        int j;
        if (light && i < 3) j = i * nl + (v - r1);
        else { const int ii = light ? i - 3 : i; j = 3 * nl + ii * G + (light ? v - r1 : nl + v); }
        if (j >= N2) return false;
        const int mt = j >> 3, pn = j & 7, e = moe_expert_of(toff, mt);
        u.pm = mt; u.pn = pn; u.A = A + (size_t)mt * (256 * FF * 2); u.B = B + (size_t)(e * D + pn * 256) * (FF * 2);
        const int left = toff[40 + e] - 256 * (mt - toff[e]); u.nvalid = left < 256 ? left : 256; return true;
    }
    __device__ __forceinline__ void a_ready(const Unit& u) const {
        if (threadIdx.x < 64) {
            unsigned sp = 0;
            while ((unsigned)__builtin_amdgcn_readfirstlane((int)__hip_atomic_load(mtc + 64 * u.pm, __ATOMIC_RELAXED, __HIP_MEMORY_SCOPE_AGENT)) < 4u) { __builtin_amdgcn_s_sleep(2); if (++sp > (1u << 22)) break; }
            __builtin_amdgcn_fence(__ATOMIC_ACQUIRE, "agent");
            asm volatile("s_waitcnt vmcnt(0)" ::: "memory");
        }
        asm volatile("" ::: "memory"); __builtin_amdgcn_s_barrier(); asm volatile("" ::: "memory");
    }
    __device__ __forceinline__ void done(const Unit&) const {}
};

struct EpiBf16 {
    static constexpr bool PERM = true, FUSED = false;
    bf16_t* O; int ldc;
    __device__ __forceinline__ void operator()(const f32x4 (&acc)[2][2][4][2], const Unit& u, int wr, int wc, int fr, int fq) const {
        const int row0 = u.pm * BM + wr * 64 + fr, col0 = u.pn * BM + wc * 32 + 8 * fq;
#pragma unroll
        for (int ai = 0; ai < 2; ++ai)
#pragma unroll
            for (int m = 0; m < 4; ++m) { bf16_t* rowp = O + (size_t)(row0 + ai * HALF + m * 16) * ldc + col0;
#pragma unroll
                for (int bj = 0; bj < 2; ++bj) { const f32x4 v0 = acc[ai][bj][m][0], v1 = acc[ai][bj][m][1];
                    u32x4 w; w.x = cvt_pk_bf16(v0[0], v0[1]); w.y = cvt_pk_bf16(v0[2], v0[3]); w.z = cvt_pk_bf16(v1[0], v1[1]); w.w = cvt_pk_bf16(v1[2], v1[3]);
                    *(u32x4*)(rowp + bj * HALF) = w; } }
    }
};
struct EpiP {
    static constexpr bool PERM = true, FUSED = false;
    bf16_t* O; const float* rope;
    __device__ __forceinline__ void operator()(const f32x4 (&acc)[2][2][4][2], const Unit& u, int wr, int wc, int fr, int fq) const {
        const int row0 = u.pm * BM + wr * 64 + fr, col0 = u.pn * BM + wc * 32 + 8 * fq;
        const bool rot = (u.pn < 4) && (u.pm < SEQ / BM);
#pragma unroll
        for (int ai = 0; ai < 2; ++ai)
#pragma unroll
            for (int m = 0; m < 4; ++m) { const int row = row0 + ai * HALF + m * 16; bf16_t* rowp = O + (size_t)row * INC + col0;
#pragma unroll
                for (int bj = 0; bj < 2; ++bj) { f32x4 v0 = acc[ai][bj][m][0], v1 = acc[ai][bj][m][1];
                    if (rot) {
                        const int i0 = ((col0 + bj * HALF) & 127) >> 1;
                        const int comp = (i0 < 32) ? (row >> 6) : (row & 63);
                        const f32x4 cs = *(const f32x4*)(rope + comp * 32 + (i0 & 31)), sn = *(const f32x4*)(rope + 4096 + comp * 32 + (i0 & 31));
                        const f32x4 a = v0, b = v1;
                        v0[0] = a[0] * cs[0] - a[1] * sn[0]; v0[1] = a[1] * cs[0] + a[0] * sn[0];
                        v0[2] = a[2] * cs[1] - a[3] * sn[1]; v0[3] = a[3] * cs[1] + a[2] * sn[1];
                        v1[0] = b[0] * cs[2] - b[1] * sn[2]; v1[1] = b[1] * cs[2] + b[0] * sn[2];
                        v1[2] = b[2] * cs[3] - b[3] * sn[3]; v1[3] = b[3] * cs[3] + b[2] * sn[3];
                    }
                    u32x4 w; w.x = cvt_pk_bf16(v0[0], v0[1]); w.y = cvt_pk_bf16(v0[2], v0[3]); w.z = cvt_pk_bf16(v1[0], v1[1]); w.w = cvt_pk_bf16(v1[2], v1[3]);
                    store16_wt(rowp + bj * HALF, w); } }
    }
};
struct EpiTres {
    static constexpr bool PERM = true, FUSED = false;
    bf16_t* T; const float* xl; const float* xc; const float* gl; const float* gc;
    __device__ __forceinline__ void operator()(const f32x4 (&acc)[2][2][4][2], const Unit& u, int wr, int wc, int fr, int fq) const {
        const int row0 = u.pm * BM + wr * 64 + fr, col0 = u.pn * BM + wc * 32 + 8 * fq;
        const bool isctx = (u.pm == SEQ / BM);
        const float* xb = isctx ? xc - (size_t)SEQ * D : xl; const float* gb = isctx ? gc : gl;
        f32x4 gv[2][2];
#pragma unroll
        for (int bj = 0; bj < 2; ++bj)
#pragma unroll
            for (int n = 0; n < 2; ++n) gv[bj][n] = *(const f32x4*)(gb + col0 + bj * HALF + n * 4);
#pragma unroll
        for (int ai = 0; ai < 2; ++ai)
#pragma unroll
            for (int m = 0; m < 4; ++m) { const size_t off = (size_t)(row0 + ai * HALF + m * 16) * D + col0;
#pragma unroll
                for (int bj = 0; bj < 2; ++bj) { const f32x4 x0 = *(const f32x4*)(xb + off + bj * HALF), x1 = *(const f32x4*)(xb + off + bj * HALF + 4);
                    const f32x4 v0 = x0 * ALPHA + gv[bj][0] * acc[ai][bj][m][0], v1 = x1 * ALPHA + gv[bj][1] * acc[ai][bj][m][1];
                    u32x4 w; w.x = cvt_pk_bf16(v0[0], v0[1]); w.y = cvt_pk_bf16(v0[2], v0[3]); w.z = cvt_pk_bf16(v1[0], v1[1]); w.w = cvt_pk_bf16(v1[2], v1[3]);
                    *(u32x4*)(T + off + bj * HALF) = w; }
                if (m == 3) asm volatile("" ::: "memory"); }
    }
};
struct EpiMoe1 {
    static constexpr bool PERM = true, FUSED = false;
    bf16_t* HID;
    __device__ __forceinline__ void operator()(const f32x4 (&acc)[2][2][4][2], const Unit& u, int wr, int wc, int fr, int fq) const {
        const int row0 = u.pm * BM + wr * 64 + fr, col0 = u.pn * HALF + wc * 32 + 8 * fq;
#pragma unroll
        for (int ai = 0; ai < 2; ++ai)
#pragma unroll
            for (int m = 0; m < 4; ++m) { const int row = row0 + ai * HALF + m * 16; const int rl = row - u.pm * BM; const float w = (rl < u.nvalid) ? u.sw[rl] : 0.f;
                float h[8];
#pragma unroll
                for (int n = 0; n < 2; ++n)
#pragma unroll
                    for (int j = 0; j < 4; ++j) { const float g = acc[ai][0][m][n][j], up = acc[ai][1][m][n][j]; h[4 * n + j] = g / (1.f + __expf(-g)) * up * w; }
                u32x4 o; o.x = cvt_pk_bf16(h[0], h[1]); o.y = cvt_pk_bf16(h[2], h[3]); o.z = cvt_pk_bf16(h[4], h[5]); o.w = cvt_pk_bf16(h[6], h[7]);
                store16_wt(HID + (size_t)row * FF + col0, o); }
    }
};

__device__ __forceinline__ void store4_wt(void* p, unsigned v) { asm volatile("global_store_dword %0, %1, off sc1" :: "v"(p), "v"(v) : "memory"); }
struct EpiTln {
    static constexpr bool PERM = true, FUSED = true;
    const float* const* in; unsigned char* ws; int l;
    __device__ __forceinline__ void fused(f32x4 (&acc)[2][2][4][2], const Unit& u, int wr, int wc, int fr_, int fq_, PG8_LAS unsigned char* lds, int wid, int lane_) const {
        typedef float f32x2v __attribute__((ext_vector_type(2)));
        int lane = lane_; asm volatile("" : "+v"(lane));
        const int fr = lane & 15, fq = lane >> 4;
        const int tid = wid * 64 + lane;
        const bool isctx = (u.pm == SEQ / BM);
        bf16_t* T = (bf16_t*)(ws + WS_T); bf16_t* H2 = (bf16_t*)(ws + WS_H2);
        const float* xl = l == 0 ? in[0] : (const float*)(ws + WS_XB); const float* xc = l == 0 ? in[2] : (const float*)(ws + WS_XB) + (size_t)SEQ * D;
        const float* mod = (const float*)(ws + WS_MOD) + (size_t)(l * 2) * 6 * D;
        const float* g1 = in[14] + l * D; const float* b1 = in[15] + l * D; const float* wrf = in[16]; const bf16_t* wrt = (const bf16_t*)(ws + WS_WRT); const float* rbias = in[17];
        unsigned char* xw = ws + WS_XW + (size_t)l * (16 * MiB);
        unsigned* cnt = (unsigned*)(ws + WS_CTL) + CW_OUT + l * (64 * 64); float* stat = (float*)(ws + WS_X1); unsigned* ecnt = (unsigned*)(ws + WS_CTL) + CW_CNT + l * 32;
        int* pos = (int*)(ws + WS_POS_OFF); int* route = (int*)(ws + WS_ROUTE); int* list = (int*)(ws + WS_HS); float* swl = (float*)(ws + WS_HS + 2 * MiB);
        const float* xb = isctx ? xc - (size_t)SEQ * D : xl; const float* md = mod + (isctx ? 6 * D : 0);
        const int col0 = u.pn * BM + wc * 32 + 8 * fq;
        constexpr int RP = 36;
        PG8_LAS float* RED = (PG8_LAS float*)lds;
        PG8_LAS f32x2v* P = (PG8_LAS f32x2v*)(lds + 73728);
        PG8_LAS f32x2v* S = (PG8_LAS f32x2v*)(lds + 81920);
        PG8_LAS float* SCO = (PG8_LAS float*)(lds + 83968);
        PG8_LAS float* CB = (PG8_LAS float*)(lds + 92416);
        PG8_LAS float* GB = (PG8_LAS float*)(lds + 96768);
        PG8_LAS int* hist = (PG8_LAS int*)(lds + 98816);
        PG8_LAS int* rinfo = hist + 64;
        PG8_LAS int* rrank = rinfo + 128;
        if (tid < 256) { const int c = u.pn * BM + tid; const float sc = md[4 * D + c]; GB[tid] = g1[c] * (1.f + sc); GB[256 + tid] = b1[c] * (1.f + sc) + md[3 * D + c]; }
        if (tid < 32) hist[tid] = 0;
        u32x4 wq[2][4][2];
        {
            f32x4 gv[2][2];
#pragma unroll
            for (int bj = 0; bj < 2; ++bj)
#pragma unroll
                for (int n = 0; n < 2; ++n) gv[bj][n] = *(const f32x4*)(md + 2 * D + col0 + bj * HALF + n * 4);
#pragma unroll
            for (int ai = 0; ai < 2; ++ai)
#pragma unroll
                for (int m = 0; m < 4; ++m) { const int rl = ai * HALF + wr * 64 + m * 16 + fr; const size_t off = (size_t)(u.pm * BM + rl) * D + col0;
                    float tv[16];
#pragma unroll
                    for (int bj = 0; bj < 2; ++bj) { f32x4 x0, x1;
                        if (l == 0) { x0 = *(const f32x4*)(xb + off + bj * HALF); x1 = *(const f32x4*)(xb + off + bj * HALF + 4); }
                        else { const u32x4 xr = *(const u32x4*)((const bf16_t*)(ws + WS_XB) + off + bj * HALF);
                            x0 = (f32x4){__uint_as_float(xr.x << 16), __uint_as_float(xr.x & 0xffff0000u), __uint_as_float(xr.y << 16), __uint_as_float(xr.y & 0xffff0000u)};
                            x1 = (f32x4){__uint_as_float(xr.z << 16), __uint_as_float(xr.z & 0xffff0000u), __uint_as_float(xr.w << 16), __uint_as_float(xr.w & 0xffff0000u)}; }
                        const f32x4 v0 = x0 * ALPHA + gv[bj][0] * acc[ai][bj][m][0], v1 = x1 * ALPHA + gv[bj][1] * acc[ai][bj][m][1];
                        u32x4 w; w.x = cvt_pk_bf16(v0[0], v0[1]); w.y = cvt_pk_bf16(v0[2], v0[3]); w.z = cvt_pk_bf16(v1[0], v1[1]); w.w = cvt_pk_bf16(v1[2], v1[3]);
                        *(u32x4*)(T + off + bj * HALF) = w; wq[ai][m][bj] = w;
#pragma unroll
                        for (int j = 0; j < 4; ++j) { tv[8 * bj + 2 * j] = __uint_as_float(w[j] << 16); tv[8 * bj + 2 * j + 1] = __uint_as_float(w[j] & 0xffff0000u); } }
                    float s = 0.f;
#pragma unroll
                    for (int j = 0; j < 16; j += 4) s += (tv[j] + tv[j + 1]) + (tv[j + 2] + tv[j + 3]);
                    s += __shfl_xor(s, 16); s += __shfl_xor(s, 32);
                    const float mw = s * (1.0f / 64.0f); float q = 0.f;
#pragma unroll
                    for (int j = 0; j < 16; ++j) { const float d = tv[j] - mw; q += d * d; }
                    q += __shfl_xor(q, 16); q += __shfl_xor(q, 32);
                    if (fq == 0) P[rl * 4 + wc] = (f32x2v){mw, q};
                    if (m == 3) asm volatile("" ::: "memory"); }
        }
        asm volatile("s_waitcnt lgkmcnt(0)" ::: "memory"); __builtin_amdgcn_s_barrier(); asm volatile("" ::: "memory");
        u32x4 wh[2][2], wl[2][2];
#pragma unroll
        for (int bj = 0; bj < 2; ++bj)
#pragma unroll
            for (int nt = 0; nt < 2; ++nt) { const bf16_t* p = wrt + (size_t)(fr + 16 * nt) * D + col0 + bj * HALF; wh[bj][nt] = *(const u32x4*)p; wl[bj][nt] = *(const u32x4*)(p + (size_t)NE * D); }
        { const int e = tid & 31, part = tid >> 5; float cs = 0.f, bw = 0.f; const float* wp = wrf + (size_t)(u.pn * BM + part * 16) * NE + e;
          float wv[16];
#pragma unroll
          for (int c = 0; c < 16; ++c) wv[c] = wp[c * NE];
#pragma unroll
          for (int c = 0; c < 16; ++c) { cs += GB[part * 16 + c] * wv[c]; bw += GB[256 + part * 16 + c] * wv[c]; }
          CB[part * 64 + e] = cs; CB[part * 64 + 32 + e] = bw; }
        {
            bf16x8 Bh[2][2], Bl[2][2];
#pragma unroll
            for (int bj = 0; bj < 2; ++bj) {
                const f32x4 ga = *(const PG8_LAS f32x4*)(GB + bj * HALF + wc * 32 + 8 * fq), gb = *(const PG8_LAS f32x4*)(GB + bj * HALF + wc * 32 + 8 * fq + 4);
                const float gq[8] = {ga[0], ga[1], ga[2], ga[3], gb[0], gb[1], gb[2], gb[3]};
#pragma unroll
                for (int nt = 0; nt < 2; ++nt) {
                    const u32x4 h = wh[bj][nt], lo = wl[bj][nt]; float w[8];
#pragma unroll
                    for (int j = 0; j < 4; ++j) { w[2 * j] = (__uint_as_float(h[j] << 16) + __uint_as_float(lo[j] << 16)) * gq[2 * j]; w[2 * j + 1] = (__uint_as_float(h[j] & 0xffff0000u) + __uint_as_float(lo[j] & 0xffff0000u)) * gq[2 * j + 1]; }
                    u32x4 hh, ll;
#pragma unroll
                    for (int j = 0; j < 4; ++j) { hh[j] = cvt_pk_bf16(w[2 * j], w[2 * j + 1]); ll[j] = cvt_pk_bf16(w[2 * j] - __uint_as_float(hh[j] << 16), w[2 * j + 1] - __uint_as_float(hh[j] & 0xffff0000u)); }
                    Bh[bj][nt] = *reinterpret_cast<bf16x8*>(&hh); Bl[bj][nt] = *reinterpret_cast<bf16x8*>(&ll);
                }
            }
            f32x4 dd[2][4][2];
#pragma unroll
            for (int ai = 0; ai < 2; ++ai)
#pragma unroll
                for (int m = 0; m < 4; ++m)
#pragma unroll
                    for (int nt = 0; nt < 2; ++nt) { f32x4 d = {0.f, 0.f, 0.f, 0.f};
#pragma unroll
                        for (int bj = 0; bj < 2; ++bj) { const bf16x8 a = *reinterpret_cast<const bf16x8*>(&wq[ai][m][bj]);
                            d = __builtin_amdgcn_mfma_f32_16x16x32_bf16(a, Bh[bj][nt], d, 0, 0, 0); d = __builtin_amdgcn_mfma_f32_16x16x32_bf16(a, Bl[bj][nt], d, 0, 0, 0); }
                        dd[ai][m][nt] = d; }
            PG8_LAS float* rb = RED + (wc & 1) * (256 * RP) + (wr * 64 + 4 * fq) * RP + fr;
            if (wc < 2) {
#pragma unroll
                for (int ai = 0; ai < 2; ++ai)
#pragma unroll
                    for (int m = 0; m < 4; ++m)
#pragma unroll
                        for (int nt = 0; nt < 2; ++nt)
#pragma unroll
                            for (int reg = 0; reg < 4; ++reg) rb[(ai * HALF + m * 16 + reg) * RP + 16 * nt] = dd[ai][m][nt][reg];
            }
            asm volatile("s_waitcnt lgkmcnt(0)" ::: "memory"); __builtin_amdgcn_s_barrier(); asm volatile("" ::: "memory");
            if (wc >= 2) {
#pragma unroll
                for (int ai = 0; ai < 2; ++ai)
#pragma unroll
                    for (int m = 0; m < 4; ++m)
#pragma unroll
                        for (int nt = 0; nt < 2; ++nt)
#pragma unroll
                            for (int reg = 0; reg < 4; ++reg) rb[(ai * HALF + m * 16 + reg) * RP + 16 * nt] += dd[ai][m][nt][reg];
            }
        }
        const int row = wid * 32 + (lane & 31);
        if (lane < 32) {
            const f32x2v a = P[row * 4 + 0], b = P[row * 4 + 1], c = P[row * 4 + 2], d = P[row * 4 + 3];
            const float mt = (a.x + b.x + c.x + d.x) * 0.25f;
            const float da = a.x - mt, db = b.x - mt, dc = c.x - mt, dd2 = d.x - mt;
            const float m2 = (a.y + b.y) + (c.y + d.y) + 64.0f * ((da * da + db * db) + (dc * dc + dd2 * dd2));
            unsigned long long* slot = (unsigned long long*)xw + ((size_t)(u.pm * BM + row) * 8 + u.pn);
            __hip_atomic_store(slot, ((unsigned long long)__float_as_uint(m2) << 32) | __float_as_uint(mt), __ATOMIC_RELAXED, __HIP_MEMORY_SCOPE_AGENT);
        }
        asm volatile("s_waitcnt lgkmcnt(0)" ::: "memory"); __builtin_amdgcn_s_barrier(); asm volatile("" ::: "memory");
        {
            float* xl_ = (float*)(xw + 2 * MiB);
#pragma unroll
            for (int i = 0; i < 4; ++i) { const int p = tid + 512 * i, rw = p >> 3, eg = p & 7;
                const f32x4 v = *(const PG8_LAS f32x4*)(RED + rw * RP + 4 * eg) + *(const PG8_LAS f32x4*)(RED + 256 * RP + rw * RP + 4 * eg);
                u32x4 o = {__float_as_uint(v[0]), __float_as_uint(v[1]), __float_as_uint(v[2]), __float_as_uint(v[3])};
                store16_wt(xl_ + ((size_t)(u.pm * BM + rw) * 8 + u.pn) * 32 + 4 * eg, o); }
        }
        if (tid < 64) { float a = 0.f;
#pragma unroll
            for (int p = 0; p < 16; ++p) a += CB[p * 64 + tid];
            store4_wt((float*)(xw + 1 * MiB) + (size_t)(u.pm * 8 + u.pn) * 64 + tid, __float_as_uint(a)); }
        asm volatile("s_waitcnt vmcnt(0)" ::: "memory");
        if (lane == 0) __hip_atomic_fetch_add(cnt + 64 * u.pm, 1u, __ATOMIC_RELAXED, __HIP_MEMORY_SCOPE_AGENT);
        if (wid == 0) {
            unsigned sp = 0;
            while ((unsigned)__builtin_amdgcn_readfirstlane((int)__hip_atomic_load(cnt + 64 * u.pm, __ATOMIC_RELAXED, __HIP_MEMORY_SCOPE_AGENT)) < 64u) { __builtin_amdgcn_s_sleep(2); if (++sp > (1u << 22)) break; }
            __builtin_amdgcn_fence(__ATOMIC_ACQUIRE, "agent");
        }
        asm volatile("s_waitcnt vmcnt(0) lgkmcnt(0)" ::: "memory"); __builtin_amdgcn_s_barrier(); asm volatile("" ::: "memory");
        if (lane < 32) {
            const unsigned long long* slot = (const unsigned long long*)xw + (size_t)(u.pm * BM + row) * 8; float mt[8], m2[8]; float ms = 0.f;
#pragma unroll
            for (int t = 0; t < 8; ++t) { const unsigned long long w = __hip_atomic_load(slot + t, __ATOMIC_RELAXED, __HIP_MEMORY_SCOPE_AGENT); mt[t] = __uint_as_float((unsigned)w); m2[t] = __uint_as_float((unsigned)(w >> 32)); ms += mt[t]; }
            const float mean = ms * 0.125f; float q = 0.f;
#pragma unroll
            for (int t = 0; t < 8; ++t) { const float dm = mt[t] - mean; q += m2[t] + 256.0f * dm * dm; }
            S[row] = (f32x2v){mean, 1.0f / sqrtf(q * (1.0f / D) + LN_EPS)};
        }
        if (tid >= 64 && tid < 128) { const int i = tid - 64; float a = 0.f; const float* xcp = (const float*)(xw + 1 * MiB) + (size_t)(u.pm * 8) * 64 + i;
#pragma unroll
            for (int p = 0; p < 8; ++p) a += xcp[p * 64];
            CB[1024 + i] = a; }
        const int grow0 = u.pm * BM + 32 * u.pn;
        float raw0 = 0.f, raw1 = 0.f;
        { const int j = tid >> 4, e2 = tid & 15; const float* xl_ = (const float*)(xw + 2 * MiB) + (size_t)(grow0 + j) * 8 * 32 + e2;
#pragma unroll
          for (int p = 0; p < 8; ++p) { raw0 += xl_[p * 32]; raw1 += xl_[p * 32 + 16]; } }
        asm volatile("s_waitcnt lgkmcnt(0)" ::: "memory"); __builtin_amdgcn_s_barrier(); asm volatile("" ::: "memory");
        { const int j = tid >> 4, e2 = tid & 15; const f32x2v sr = S[32 * u.pn + j];
          const float lg0 = sr.y * (raw0 - sr.x * CB[1024 + e2]) + CB[1024 + 32 + e2], lg1 = sr.y * (raw1 - sr.x * CB[1024 + 16 + e2]) + CB[1024 + 48 + e2];
          const float s0 = 1.f / (1.f + expf(-lg0)), s1 = 1.f / (1.f + expf(-lg1));
          SCO[j * 33 + e2] = s0; SCO[32 * 33 + j * 33 + e2] = s0 + rbias[e2];
          SCO[j * 33 + 16 + e2] = s1; SCO[32 * 33 + j * 33 + 16 + e2] = s1 + rbias[16 + e2]; }
        {
            f32x4 gq[2][2], bq[2][2];
#pragma unroll
            for (int bj = 0; bj < 2; ++bj)
#pragma unroll
                for (int n = 0; n < 2; ++n) { const int cl = bj * HALF + wc * 32 + 8 * fq + 4 * n; gq[bj][n] = *(const PG8_LAS f32x4*)(GB + cl); bq[bj][n] = *(const PG8_LAS f32x4*)(GB + 256 + cl); }
#pragma unroll
            for (int ai = 0; ai < 2; ++ai)
#pragma unroll
                for (int m = 0; m < 4; ++m) { const int rl = ai * HALF + wr * 64 + m * 16 + fr; const f32x2v sr = S[rl]; const size_t off = (size_t)(u.pm * BM + rl) * D + col0;
#pragma unroll
                    for (int bj = 0; bj < 2; ++bj) { u32x4 t = wq[ai][m][bj]; asm volatile("" : "+v"(t));
                        const f32x4 t0 = {__uint_as_float(t.x << 16), __uint_as_float(t.x & 0xffff0000u), __uint_as_float(t.y << 16), __uint_as_float(t.y & 0xffff0000u)};
                        const f32x4 t1 = {__uint_as_float(t.z << 16), __uint_as_float(t.z & 0xffff0000u), __uint_as_float(t.w << 16), __uint_as_float(t.w & 0xffff0000u)};
                        const f32x4 v0 = (t0 - sr.x) * sr.y * gq[bj][0] + bq[bj][0], v1 = (t1 - sr.x) * sr.y * gq[bj][1] + bq[bj][1];
                        u32x4 w; w.x = cvt_pk_bf16(v0[0], v0[1]); w.y = cvt_pk_bf16(v0[2], v0[3]); w.z = cvt_pk_bf16(v1[0], v1[1]); w.w = cvt_pk_bf16(v1[2], v1[3]);
                        *(u32x4*)(H2 + off + bj * HALF) = w; } }
        }
        asm volatile("s_waitcnt lgkmcnt(0)" ::: "memory"); __builtin_amdgcn_s_barrier(); asm volatile("" ::: "memory");
        if (tid < 32) {
            const int j = tid; const f32x2v sr = S[32 * u.pn + j];
            stat[2 * (size_t)(grow0 + j)] = sr.x; stat[2 * (size_t)(grow0 + j) + 1] = sr.y;
            float bestgs = -3.0e38f; int be0 = 0, be1 = 0; float bw0 = 0.f, bw1 = 0.f;
#pragma unroll 1
            for (int gq2 = 0; gq2 < 4; ++gq2) {
                float m1 = -3.0e38f, m2 = -3.0e38f, s1 = 0.f, s2 = 0.f; int i1 = 0, i2 = 0;
#pragma unroll
                for (int t = 0; t < 8; ++t) {
                    const int e = gq2 * 8 + t;
                    const float scv = SCO[j * 33 + e], bv = SCO[32 * 33 + j * 33 + e];
                    if (bv > m1) { m2 = m1; i2 = i1; s2 = s1; m1 = bv; i1 = e; s1 = scv; }
                    else if (bv > m2) { m2 = bv; i2 = e; s2 = scv; }
                }
                const float gs = m1 + m2;
                if (gs > bestgs) { bestgs = gs; be0 = i1; be1 = i2; bw0 = s1; bw1 = s2; }
            }
            const float inv = 1.f / (bw0 + bw1);
            PG8_LAS int* ri = rinfo + j * 4;
            ri[0] = be0; ri[1] = be1; ri[2] = __float_as_int(bw0 * inv); ri[3] = __float_as_int(bw1 * inv);
        }
        asm volatile("s_waitcnt lgkmcnt(0)" ::: "memory"); __builtin_amdgcn_s_barrier(); asm volatile("" ::: "memory");
        int e_mine = 0;
        if (tid < 64) { e_mine = rinfo[(tid >> 1) * 4 + (tid & 1)]; rrank[tid] = (int)__hip_atomic_fetch_add((PG8_LAS unsigned*)(hist + e_mine), 1u, __ATOMIC_RELAXED, __HIP_MEMORY_SCOPE_WORKGROUP); }
        asm volatile("s_waitcnt lgkmcnt(0)" ::: "memory"); __builtin_amdgcn_s_barrier(); asm volatile("" ::: "memory");
        if (tid < 32) { const int c = hist[tid]; hist[32 + tid] = c ? (int)atomicAdd(ecnt + tid, (unsigned)c) : 0; }
        asm volatile("s_waitcnt vmcnt(0) lgkmcnt(0)" ::: "memory"); __builtin_amdgcn_s_barrier(); asm volatile("" ::: "memory");
        if (tid < 64) {
            const int r = grow0 + (tid >> 1), k = tid & 1;
            const int ps = hist[32 + e_mine] + rrank[tid];
            pos[(size_t)r * 2 + k] = ps;
            route[(size_t)r * 4 + k] = e_mine;
            list[(size_t)e_mine * LCAP + ps] = r;
            swl[(size_t)e_mine * LCAP + ps] = __int_as_float(rinfo[(tid >> 1) * 4 + 2 + k]);
        }
    }
};

template <int K, class Epi, class Sched, bool ALIGN_EPI = true, bool SP2 = true, bool GATHER = false, bool SKIPH = false  >
__device__ __forceinline__ void gemm_phase(PG8_LAS unsigned char* lds, const Sched& S, const Epi& E) {
    int tid_ = threadIdx.x; asm volatile("" : "+v"(tid_));
    const int tid = tid_, wid = __builtin_amdgcn_readfirstlane(tid >> 6), lane = tid & 63, wr = wid >> 2, wc = wid & 3, fr = lane & 15, fq = lane >> 4;
    constexpr int nt = K / BK;
    unsigned voffA[2], voffB[2];
#pragma unroll
    for (int i = 0; i < 2; ++i) { int R, C; stage_rc(tid * 16 + i * 8192, R, C); const int Rb = Epi::PERM ? ((R & ~31) + perm32(R & 31)) : R;
        voffA[i] = (unsigned)(R * K + C) * 2u; voffB[i] = (unsigned)(Rb * K + C) * 2u; }
    const size_t kstep = (size_t)(BK * 2);
    const size_t hstep = (size_t)HALF * K * 2;
    const unsigned ldsw = (unsigned)wid * 1024u;
    const int aoff = lds_byte(wr * 64 + fr, fq * 8), boff = lds_byte(wc * 32 + fr, fq * 8);
#define PG8_SA(b, h) (((b) * 2 + (h)) * HTB)
#define PG8_SB(b, h) ((4 + (b) * 2 + (h)) * HTB)
#define PG8_STAGE(bufoff, gbase, voff) do { _Pragma("unroll") for (int _i = 0; _i < 2; ++_i) \
        __builtin_amdgcn_global_load_lds((const unsigned*)((const char*)(gbase) + (voff)[_i]), (PG8_LAS unsigned*)(lds + (bufoff) + ldsw + _i * 8192), 16, 0, 0); } while (0)
    unsigned gA[2][2];
    PG8_LAS unsigned* gnl = (PG8_LAS unsigned*)(lds + 147456) + tid * 4;
#define PG8_MKG(u_, g_) do { _Pragma("unroll") for (int h_ = 0; h_ < 2; ++h_) _Pragma("unroll") for (int i_ = 0; i_ < 2; ++i_) { int R_, C_; stage_rc(tid * 16 + i_ * 8192, R_, C_); \
        const int rr_ = R_ + HALF * h_; const int idx_ = (rr_ < (u_).nvalid) ? (u_).rows[rr_] : 0; g_[h_][i_] = (unsigned)(idx_ * K + C_) * 2u; } } while (0)
#define PG8_STAGEA(bufoff, base, h, G_) do { if constexpr (GATHER) { PG8_STAGE(bufoff, base, G_[h]); } else { PG8_STAGE(bufoff, (base) + (h) * hstep, voffA); } } while (0)
#define PG8_LDA(dst, b, h) do { _Pragma("unroll") for (int m = 0; m < 4; ++m) _Pragma("unroll") for (int k = 0; k < 2; ++k) dst[m][k] = *(const PG8_LAS bf16x8*)(lds + PG8_SA(b, h) + aoff + m * 2048 + k * 1024); } while (0)
#define PG8_LDB(dst, b, h) do { _Pragma("unroll") for (int n = 0; n < 2; ++n) _Pragma("unroll") for (int k = 0; k < 2; ++k) dst[n][k] = *(const PG8_LAS bf16x8*)(lds + PG8_SB(b, h) + boff + n * 2048 + k * 1024); } while (0)
#define PG8_MMA(ai, bj, At, Bt) do { __builtin_amdgcn_s_setprio(1); _Pragma("unroll") for (int m = 0; m < 4; ++m) _Pragma("unroll") for (int n = 0; n < 2; ++n) _Pragma("unroll") for (int k = 0; k < 2; ++k) \
        acc[ai][bj][m][n] = __builtin_amdgcn_mfma_f32_16x16x32_bf16(Bt[n][k], At[m][k], acc[ai][bj][m][n], 0, 0, 0); __builtin_amdgcn_s_setprio(0); } while (0)
#define PG8_WAIT_V(n) asm volatile("s_waitcnt vmcnt(" #n ")" ::: "memory")
#define PG8_WAIT_L(n) asm volatile("s_waitcnt lgkmcnt(" #n ")" ::: "memory")
#define PG8_BAR __builtin_amdgcn_s_barrier()
#define PG8_SCHED __builtin_amdgcn_sched_barrier(0)
    Unit cur, nxt; int ui = 0;
    if (!S.next(0, cur)) return;
    f32x4 acc[2][2][4][2];
#pragma unroll
    for (int a = 0; a < 2; ++a)
#pragma unroll
        for (int b = 0; b < 2; ++b)
#pragma unroll
            for (int m = 0; m < 4; ++m)
#pragma unroll
                for (int n = 0; n < 2; ++n) acc[a][b][m][n] = (f32x4){0.f, 0.f, 0.f, 0.f};
    bf16x8 At[4][2], B0[2][2], B1[2][2];
    const char* cA = cur.A; const char* cB = cur.B;
    S.a_ready(cur);
    if constexpr (GATHER) PG8_MKG(cur, gA);
    if constexpr (SP2) {
        PG8_STAGE(PG8_SB(0, 0), cB, voffB); PG8_STAGE(PG8_SB(0, 1), cB + hstep, voffB); PG8_STAGEA(PG8_SA(0, 0), cA, 0, gA); PG8_STAGEA(PG8_SA(0, 1), cA, 1, gA);
        if (wr == 1) PG8_BAR;
        PG8_WAIT_V(2); PG8_BAR;
        PG8_STAGE(PG8_SB(1, 0), cB + kstep, voffB); PG8_STAGEA(PG8_SA(1, 0), cA + kstep, 0, gA); PG8_STAGE(PG8_SB(1, 1), cB + hstep + kstep, voffB);
        PG8_WAIT_V(6); PG8_BAR;
    } else {
        PG8_STAGE(PG8_SB(0, 0), cB, voffB); PG8_STAGEA(PG8_SA(0, 0), cA, 0, gA); PG8_STAGE(PG8_SB(0, 1), cB + hstep, voffB); PG8_STAGEA(PG8_SA(0, 1), cA, 1, gA);
        if (wr == 1) PG8_BAR;
        PG8_WAIT_V(4); PG8_BAR;
        PG8_STAGE(PG8_SB(1, 0), cB + kstep, voffB); PG8_STAGEA(PG8_SA(1, 0), cA + kstep, 0, gA); PG8_STAGE(PG8_SB(1, 1), cB + hstep + kstep, voffB);
        PG8_WAIT_V(6); PG8_BAR;
    }
    for (;;) {
        const bool has_next = S.next(ui + 1, nxt);
        const char* nA = has_next ? nxt.A : cA; const char* nB = has_next ? nxt.B : cB;
        if constexpr (GATHER) { unsigned gT[2][2];
            if (has_next) PG8_MKG(nxt, gT); else { _Pragma("unroll") for (int h_ = 0; h_ < 2; ++h_) _Pragma("unroll") for (int i_ = 0; i_ < 2; ++i_) gT[h_][i_] = gA[h_][i_]; }
            gnl[0] = gT[0][0]; gnl[1] = gT[0][1]; gnl[2] = gT[1][0]; gnl[3] = gT[1][1]; }
        for (int t = 0; t < nt; t += 2) {
            const bool last = (t == nt - 2);
            if (last && has_next) S.a_ready(nxt);
            const char* a1 = cA + (size_t)(t + 1) * kstep;
            const char* a2 = last ? nA : cA + (size_t)(t + 2) * kstep; const char* b2 = last ? nB : cB + (size_t)(t + 2) * kstep;
            const char* a3 = a2 + kstep; const char* b3 = b2 + kstep;
            if constexpr (SP2) {
            PG8_LDB(B0, 0, 0); PG8_LDB(B1, 0, 1); PG8_SCHED; PG8_LDA(At, 0, 0); PG8_STAGEA(PG8_SA(1, 1), a1, 1, gA);
            if constexpr (GATHER) { if (last) { gA[0][0] = gnl[0]; gA[0][1] = gnl[1]; gA[1][0] = gnl[2]; gA[1][1] = gnl[3]; } }
            PG8_WAIT_V(8); PG8_WAIT_L(0); PG8_BAR; PG8_MMA(0, 0, At, B0); PG8_MMA(0, 1, At, B1); PG8_BAR; PG8_SCHED;
            PG8_LDA(At, 0, 1); PG8_STAGE(PG8_SB(0, 0), b2, voffB); PG8_STAGE(PG8_SB(0, 1), b2 + hstep, voffB); PG8_STAGEA(PG8_SA(0, 0), a2, 0, gA);
            PG8_WAIT_V(8); PG8_WAIT_L(0); PG8_BAR; if (!(SKIPH && cur.nvalid <= HALF)) { PG8_MMA(1, 0, At, B0); PG8_MMA(1, 1, At, B1); } PG8_BAR; PG8_SCHED;
            PG8_LDB(B0, 1, 0); PG8_LDB(B1, 1, 1); PG8_SCHED; PG8_LDA(At, 1, 0); PG8_STAGEA(PG8_SA(0, 1), a2, 1, gA);
            PG8_WAIT_V(8); PG8_WAIT_L(0); PG8_BAR; PG8_MMA(0, 0, At, B0); PG8_MMA(0, 1, At, B1); PG8_BAR; PG8_SCHED;
            PG8_LDA(At, 1, 1); PG8_STAGE(PG8_SB(1, 0), b3, voffB); PG8_STAGE(PG8_SB(1, 1), b3 + hstep, voffB); PG8_STAGEA(PG8_SA(1, 0), a3, 0, gA);
            PG8_WAIT_V(8); PG8_WAIT_L(0); PG8_BAR; if (!(SKIPH && cur.nvalid <= HALF)) { PG8_MMA(1, 0, At, B0); PG8_MMA(1, 1, At, B1); } PG8_BAR; PG8_SCHED;
            } else {
            PG8_LDB(B0, 0, 0); PG8_SCHED; PG8_LDA(At, 0, 0); PG8_STAGEA(PG8_SA(1, 1), a1, 1, gA);
            if constexpr (GATHER) { if (last) { gA[0][0] = gnl[0]; gA[0][1] = gnl[1]; gA[1][0] = gnl[2]; gA[1][1] = gnl[3]; } }
            PG8_WAIT_L(8); PG8_BAR; PG8_WAIT_L(0); PG8_MMA(0, 0, At, B0); PG8_BAR; PG8_SCHED;
            PG8_LDB(B1, 0, 1); PG8_STAGE(PG8_SB(0, 0), b2, voffB);
            PG8_BAR; PG8_WAIT_L(0); PG8_MMA(0, 1, At, B1); PG8_BAR;
            PG8_LDA(At, 0, 1); PG8_STAGEA(PG8_SA(0, 0), a2, 0, gA);
            PG8_BAR; PG8_WAIT_L(0); if (!(SKIPH && cur.nvalid <= HALF)) PG8_MMA(1, 0, At, B0); PG8_BAR; PG8_SCHED;
            PG8_STAGE(PG8_SB(0, 1), b2 + hstep, voffB);
            PG8_WAIT_V(6); PG8_BAR; if (!(SKIPH && cur.nvalid <= HALF)) PG8_MMA(1, 1, At, B1); PG8_BAR;
            PG8_LDB(B0, 1, 0); PG8_SCHED; PG8_LDA(At, 1, 0); PG8_STAGEA(PG8_SA(0, 1), a2, 1, gA);
            PG8_WAIT_L(8); PG8_BAR; PG8_WAIT_L(0); PG8_MMA(0, 0, At, B0); PG8_BAR; PG8_SCHED;
            PG8_LDB(B1, 1, 1); PG8_STAGE(PG8_SB(1, 0), b3, voffB);
            PG8_BAR; PG8_WAIT_L(0); PG8_MMA(0, 1, At, B1); PG8_BAR;
            PG8_LDA(At, 1, 1); PG8_STAGEA(PG8_SA(1, 0), a3, 0, gA);
            PG8_BAR; PG8_WAIT_L(0); if (!(SKIPH && cur.nvalid <= HALF)) PG8_MMA(1, 0, At, B0); PG8_BAR; PG8_SCHED;
            PG8_STAGE(PG8_SB(1, 1), b3 + hstep, voffB);
            PG8_WAIT_V(6); PG8_BAR; if (!(SKIPH && cur.nvalid <= HALF)) PG8_MMA(1, 1, At, B1); PG8_BAR;
            }
        }
        if constexpr (ALIGN_EPI) { if (wr == 0) PG8_BAR; }
        if constexpr (Epi::FUSED) { PG8_WAIT_V(0); PG8_BAR; E.fused(acc, cur, wr, wc, fr, fq, lds, wid, lane); } else E(acc, cur, wr, wc, fr, fq);
        S.done(cur);
        if (!has_next) break;
#pragma unroll
        for (int a = 0; a < 2; ++a)
#pragma unroll
            for (int b = 0; b < 2; ++b)
#pragma unroll
                for (int m = 0; m < 4; ++m)
#pragma unroll
                    for (int n = 0; n < 2; ++n) acc[a][b][m][n] = (f32x4){0.f, 0.f, 0.f, 0.f};
        cur = nxt; cA = nA; cB = nB; ++ui;
        if constexpr (ALIGN_EPI) { if (wr == 1) PG8_BAR; }
    }
    PG8_WAIT_V(0);
    if constexpr (!ALIGN_EPI) { if (wr == 0) PG8_BAR; }
    PG8_BAR;
#undef PG8_SA
#undef PG8_SB
#undef PG8_STAGE
#undef PG8_STAGEA
#undef PG8_MKG
#undef PG8_LDA
#undef PG8_LDB
#undef PG8_MMA
#undef PG8_WAIT_V
#undef PG8_WAIT_L
#undef PG8_BAR
#undef PG8_SCHED
}
}

constexpr int CW_GEMV = 16384 + 448;
__device__ __forceinline__ void wg_wait_ge(unsigned* w, unsigned need) {
    if (threadIdx.x < 64) {
        unsigned sp = 0;
        while ((unsigned)__builtin_amdgcn_readfirstlane((int)__hip_atomic_load(w, __ATOMIC_RELAXED, __HIP_MEMORY_SCOPE_AGENT)) < need) { __builtin_amdgcn_s_sleep(2); if (++sp > (1u << 22)) break; }
        __builtin_amdgcn_fence(__ATOMIC_ACQUIRE, "agent");
        asm volatile("s_waitcnt vmcnt(0)" ::: "memory");
    }
    __syncthreads();
}
__device__ __forceinline__ void transpose_item(const float* W, int N, bf16_t* WT, int K, int wt_row0, int k0, int n0, LAS float* scr, int lane, int rstride = 1) {
#pragma unroll
    for (int i = 0; i < 32; ++i) { const int kk = 2 * i + (lane >> 5); scr[kk * 33 + (lane & 31)] = __builtin_nontemporal_load(W + (size_t)(k0 + kk) * N + n0 + (lane & 31)); }
    asm volatile("s_waitcnt lgkmcnt(0)" ::: "memory");
    const int c = lane & 7;
#pragma unroll
    for (int j = 0; j < 4; ++j) { const int n = (lane >> 3) + 8 * j; const LAS float* sp = scr + (8 * c) * 33 + n;
        uint4 o; o.x = pg8::cvt_pk_bf16(sp[0 * 33], sp[1 * 33]); o.y = pg8::cvt_pk_bf16(sp[2 * 33], sp[3 * 33]); o.z = pg8::cvt_pk_bf16(sp[4 * 33], sp[5 * 33]); o.w = pg8::cvt_pk_bf16(sp[6 * 33], sp[7 * 33]);
        *(uint4*)(WT + (size_t)(wt_row0 + n * rstride) * K + k0 + 8 * c) = o; }
    asm volatile("s_waitcnt lgkmcnt(0)" ::: "memory");
}
constexpr int I_IN = (D / 64) * (INC / 32), I_OUT = (D / 64) * (D / 32), I_EXP = 512, NKC = 8;
__device__ __forceinline__ void ph_prologue(const Ctx& C) {
    const int gt = C.bid * NTHREADS + C.tid, NT = C.G * NTHREADS;
    const int gw = C.bid * NWAVES + C.wave, NGW = C.G * NWAVES, lane = C.lane;
    for (int idx = C.bid * 16 + C.tid; C.tid < 16 && idx < 128 * 32; idx += C.G * 16) {
        const int pos = idx / 32, j = idx % 32;
        const double inv = pow(10000.0, -(double)j / 32.0);
        const double ang = (double)pos * inv;
        C_ROPE[idx] = (float)cos(ang);
        C_ROPE[128 * 32 + idx] = (float)sin(ang);
    }
    for (int idx = gt; idx < NE * D; idx += NT) {
        const int e = idx / D, d = idx % D;
        const float w = C_w_router[(size_t)d * NE + e];
        const bf16_t hi = f2bf(w); const bf16_t lo = f2bf(w - bf2f(hi));
        C_WRT[idx] = hi; C_WRT[NE * D + idx] = lo;
    }
    {
        LAS float* sl = (LAS float*)C.lds;
        for (int k = C.tid; k < D; k += NTHREADS) { sl[k] = silu_f(C_c[k]); sl[D + k] = silu_f(C_c_ctx[k]); }
        __syncthreads();
        const bool spread = (C.G * 3 == DEPTH * 48 * NKC);
        for (int u = spread ? (C.wave < 3 ? C.wave * C.G + C.bid : DEPTH * 48 * NKC) : gw; u < DEPTH * 48 * NKC; u += NGW) {
            const int l = u / (48 * NKC), rem = u % (48 * NKC), sb = rem / NKC, kc = rem % NKC;
            const float* w = C_w_mod + (size_t)l * D * 6 * D + (size_t)(kc * (D / NKC)) * 6 * D + sb * 256 + lane * 4;
            float4 a0 = {0.f, 0.f, 0.f, 0.f}, a1 = {0.f, 0.f, 0.f, 0.f};
#pragma unroll 16
            for (int k = 0; k < D / NKC; ++k) {
                const pg8::f32x4 wv4 = __builtin_nontemporal_load((const pg8::f32x4*)(w + (size_t)k * 6 * D)); const float4 wv = {wv4[0], wv4[1], wv4[2], wv4[3]};
                const float c0 = sl[kc * (D / NKC) + k], c1 = sl[D + kc * (D / NKC) + k];
                a0.x += c0 * wv.x; a0.y += c0 * wv.y; a0.z += c0 * wv.z; a0.w += c0 * wv.w;
                a1.x += c1 * wv.x; a1.y += c1 * wv.y; a1.z += c1 * wv.z; a1.w += c1 * wv.w;
            }
            *(float4*)(C_MODP + ((size_t)(kc * 2 + l) * 2 + 0) * 6 * D + sb * 256 + lane * 4) = a0;
            *(float4*)(C_MODP + ((size_t)(kc * 2 + l) * 2 + 1) * 6 * D + sb * 256 + lane * 4) = a1;
        }
        asm volatile("s_waitcnt vmcnt(0)" ::: "memory");
        __syncthreads();
        if (C.tid == 0) { __builtin_amdgcn_fence(__ATOMIC_RELEASE, "agent"); asm volatile("s_waitcnt vmcnt(0)" ::: "memory"); __hip_atomic_fetch_add(C_CTLW + CW_GEMV, 1u, __ATOMIC_RELAXED, __HIP_MEMORY_SCOPE_AGENT); }
    }
    LAS float* scr = (LAS float*)(C.lds + C.wave * 16384);
    constexpr int TOT = 2 * I_IN + 2 * I_OUT + 3 * 64 * I_EXP;
    constexpr int NGEMV = DEPTH * 48 * NKC;
    const int nlight = NGW - NGEMV;
    const int R1 = (nlight > 0 && NGW == 2048) ? 28 : (TOT + NGW - 1) / NGW;
    const int T1 = R1 * NGW < TOT ? R1 * NGW : TOT;
    for (int q = 0;; ++q) {
        int it;
        if (q < R1) { it = q * NGW + gw; if (it >= T1) { if (T1 == TOT) break; continue; } }
        else { const bool spread_ = (C.G * 3 == NGEMV);
               const bool heavy = spread_ ? (C.wave < 3) : (gw < NGEMV);
               if (heavy) break;
               const int li = spread_ ? C.bid * 5 + (C.wave - 3) : gw - NGEMV;
               it = T1 + (q - R1) * nlight + li; if (it >= TOT) break; }
        int r = it;
        if (r < 2 * I_IN) { const int l = r / I_IN, q = r % I_IN, kb = q / (INC / 32), nb = q % (INC / 32);
            const int n0 = 32 * nb; int row0 = n0, rs = 1;
            if (n0 < OFF_AV) { const int hh = n0 / HD, d0 = n0 % HD; row0 = hh * HD + (d0 < 64 ? 2 * d0 : 2 * (d0 - 64) + 1); rs = 2; }
            transpose_item(C_w_in + (size_t)l * D * INC, INC, C_WIN + (size_t)l * INC * D, D, row0, 64 * kb, n0, scr, lane, rs); continue; }
        r -= 2 * I_IN;
        if (r < 2 * I_OUT) { const int l = r / I_OUT, q = r % I_OUT, kb = q / (D / 32), nb = q % (D / 32);
            transpose_item(C_w_out + (size_t)l * D * D, D, C_WOUT + (size_t)l * D * D, D, 32 * nb, 64 * kb, 32 * nb, scr, lane); continue; }
        r -= 2 * I_OUT;
        if (r < 2 * 64 * I_EXP) { const int up = r / (64 * I_EXP), rr = r % (64 * I_EXP); const int le = rr / I_EXP, q = rr % I_EXP, kb = q / 16, nb = q % 16, f0 = 32 * nb;
            transpose_item((up ? C_w_up : C_w_gate) + (size_t)le * D * FF, FF, C_WGU + (size_t)le * 1024 * D, D, (f0 / 128) * 256 + up * 128 + (f0 % 128), 64 * kb, f0, scr, lane); continue; }
        r -= 2 * 64 * I_EXP;
        { const int le = r / I_EXP, q = r % I_EXP, kb = q / (D / 32), nb = q % (D / 32);
          transpose_item(C_w_down + (size_t)le * FF * D, D, C_WD + (size_t)le * D * FF, FF, 32 * nb, 64 * kb, 32 * nb, scr, lane); }
    }
}

__device__ __forceinline__ void ph_modulate0(const Ctx& C) {
    wg_wait_ge(C_CTLW + CW_GEMV, (unsigned)C.G);
    const int gt = C.bid * NTHREADS + C.tid, NT = C.G * NTHREADS;
    const int gw = C.bid * NWAVES + C.wave, NGW = C.G * NWAVES, lane = C.lane;
    for (int idx = gt; idx < DEPTH * 2 * 6 * D; idx += NT) {
        const int n = idx % (6 * D), l = idx / (2 * 6 * D);
        float a = C_b_mod[l * 6 * D + n];
#pragma unroll
        for (int kc = 0; kc < NKC; ++kc) a += C_MODP[(size_t)kc * (DEPTH * 2 * 6 * D) + idx];
        C_MOD[idx] = a;
    }
    LAS float* ms = (LAS float*)C.lds;
#pragma unroll 4
    for (int i = C.tid; i < 2 * 2 * D; i += NTHREADS) {
        const int kind = i / (2 * D), n = i % (2 * D);
        const int idx = (0 * 2 + kind) * 6 * D + n;
        float a = C_b_mod[n];
#pragma unroll
        for (int kc = 0; kc < NKC; ++kc) a += C_MODP[(size_t)kc * (DEPTH * 2 * 6 * D) + idx];
        ms[i] = a;
    }
    __syncthreads();
    float4 nxv[8];
    if (gw < NTOK) { const float* xp = xin_row(C, 0, gw);
#pragma unroll
        for (int j = 0; j < 8; ++j) nxv[j] = *(const float4*)(xp + 4 * lane + 256 * j); }
    for (int r = gw; r < NTOK; r += NGW) {
        const int kind = r < SEQ ? 0 : 1;
        const LAS float* sh = ms + kind * 2 * D; const LAS float* sc = sh + D;
        float4 cxv[8];
#pragma unroll
        for (int j = 0; j < 8; ++j) cxv[j] = nxv[j];
        if (r + NGW < NTOK) { const float* xp = xin_row(C, 0, r + NGW);
#pragma unroll
            for (int j = 0; j < 8; ++j) nxv[j] = *(const float4*)(xp + 4 * lane + 256 * j); }
#pragma unroll
        for (int j = 0; j < 8; ++j) {
            const int d0 = 4 * lane + 256 * j;
            const float4 xv = cxv[j];
            float4 hv; hv.x = xv.x * (1.f + sc[d0]) + sh[d0]; hv.y = xv.y * (1.f + sc[d0 + 1]) + sh[d0 + 1]; hv.z = xv.z * (1.f + sc[d0 + 2]) + sh[d0 + 2]; hv.w = xv.w * (1.f + sc[d0 + 3]) + sh[d0 + 3];
            st4(&C_H[(size_t)r * D + d0], hv);
        }
    }
}

namespace att {
using bf16x8 = __attribute__((ext_vector_type(8))) short;
using s16x4  = __attribute__((ext_vector_type(4))) short;
using f32x16 = __attribute__((ext_vector_type(16))) float;
using u32x4  = __attribute__((ext_vector_type(4))) unsigned;
constexpr int NW = 8, QBLK = 32, KVBLK = 64;
constexpr float SCALE = QSCALE, THR = 8.f;
constexpr int SHM_V = KVBLK * HD * 2, SHM_K = KVBLK * HD * 2;
constexpr int Q_OFF = 2 * SHM_V + 2 * SHM_K  , WS_OFF = 131072 + 1024, BIAS_OFF = WS_OFF + NW * 64 * 4, QSLOT_OFF = BIAS_OFF + (64 + 15 * 32 + 64) * 4, ATT_LDS = QSLOT_OFF + 16;
#define KSWZ(row, colB) ((row) * 256 + ((colB) ^ (((row) & 7) << 4)))
#define SBAR() __builtin_amdgcn_sched_barrier(0)
__device__ __forceinline__ int crow(int r, int hi) { return (r & 3) + 8 * (r >> 2) + 4 * hi; }
__device__ __forceinline__ unsigned cvtpk(float lo, float hi) { unsigned r; asm volatile("v_cvt_pk_bf16_f32 %0, %1, %2" : "=v"(r) : "v"(lo), "v"(hi)); return r; }

__device__ __forceinline__ void partialSM(f32x16& p0, f32x16& p1, float& m_reg, float& mn, float& alpha) {
  constexpr float Cc = SCALE * 1.4426950408889634f;
  float pmax = p0[0]; for (int r = 1; r < 16; ++r) pmax = fmaxf(pmax, p0[r]); for (int r = 0; r < 16; ++r) pmax = fmaxf(pmax, p1[r]);
  { auto rr = __builtin_amdgcn_permlane32_swap(__float_as_uint(pmax), __float_as_uint(pmax), false, false);
    pmax = fmaxf(__uint_as_float(rr[0]), __uint_as_float(rr[1])); }
  if (__builtin_expect(__all(pmax - m_reg <= THR / SCALE), 1)) { mn = m_reg; alpha = 1.f; }
  else { mn = fmaxf(m_reg, pmax); alpha = __builtin_amdgcn_exp2f((m_reg - mn) * Cc); m_reg = mn; }
  float mnC = -mn * Cc;
  for (int r = 0; r < 16; ++r) p0[r] = fmaf(p0[r], Cc, mnC); for (int r = 0; r < 16; ++r) p1[r] = fmaf(p1[r], Cc, mnC);
  for (int r = 0; r < 16; ++r) p0[r] = __builtin_amdgcn_exp2f(p0[r]);
}
__device__ __forceinline__ void finishSM(f32x16& p0, f32x16& p1, float alpha, float& l_reg, bf16x8& pa0, bf16x8& pa1, bf16x8& pa2, bf16x8& pa3) {
  for (int r = 0; r < 16; ++r) p1[r] = __builtin_amdgcn_exp2f(p1[r]);
  float ps = 0; for (int r = 0; r < 16; ++r) ps += p0[r]; for (int r = 0; r < 16; ++r) ps += p1[r];
  { auto rr = __builtin_amdgcn_permlane32_swap(__float_as_uint(ps), __float_as_uint(ps), false, false);
    ps = __uint_as_float(rr[0]) + __uint_as_float(rr[1]); }
  l_reg = l_reg * alpha + ps;
#define PK4(P, BASE, OUT) do { unsigned a0 = cvtpk(P[BASE + 0], P[BASE + 1]), a1 = cvtpk(P[BASE + 2], P[BASE + 3]);   \
    unsigned b0 = cvtpk(P[BASE + 4], P[BASE + 5]), b1 = cvtpk(P[BASE + 6], P[BASE + 7]);                              \
    auto r0 = __builtin_amdgcn_permlane32_swap(a0, b0, false, false); auto r1 = __builtin_amdgcn_permlane32_swap(a1, b1, false, false); \
    u32x4 w = {r0[0], r1[0], r0[1], r1[1]}; OUT = *reinterpret_cast<bf16x8*>(&w); } while (0)
  PK4(p0, 0, pa0); PK4(p0, 8, pa1); PK4(p1, 0, pa2); PK4(p1, 8, pa3);
#undef PK4
}
__device__ __forceinline__ void qkt(f32x16& p0, f32x16& p1, const LAS char* Ks, const LAS char* Qs, int r32, int hi) {
#pragma unroll
  for (int d0 = 0; d0 < 8; ++d0) { int cb = (d0 * 16 + hi * 8) * 2;
    bf16x8 b0 = *reinterpret_cast<const LAS bf16x8*>(Ks + KSWZ(r32, cb));
    bf16x8 b1 = *reinterpret_cast<const LAS bf16x8*>(Ks + KSWZ(32 + r32, cb));
    bf16x8 q = *reinterpret_cast<const LAS bf16x8*>(Qs + KSWZ(r32, cb));
    p0 = __builtin_amdgcn_mfma_f32_32x32x16_bf16(b0, q, p0, 0, 0, 0);
    p1 = __builtin_amdgcn_mfma_f32_32x32x16_bf16(b1, q, p1, 0, 0, 0); }
}
__device__ __forceinline__ int v_st(int k, int c) { const int kk = (k & ~0xC) | ((k & 4) << 1) | ((k & 8) >> 1); return ((kk >> 3) * 4 + (c >> 5)) * 512 + ((kk & 7) * 32 + (c & 31)) * 2; }
__device__ __forceinline__ int v_rd_base(int lane) { return ((lane & 3) << 3) | (((lane >> 2) & 3) << 6) | (((lane >> 4) & 1) << 5) | (((lane >> 5) & 1) << 8); }
constexpr int v_rd_off(int d0, int ks, int half) { return d0 * 512 + ks * 4096 + half * 2048; }
template <int OFF> __device__ __forceinline__ s16x4 tr_read(int vb) {
  s16x4 r; asm volatile("ds_read_b64_tr_b16 %0, %1 offset:%2" : "=&v"(r) : "v"(vb), "i"(OFF) : "memory"); return r;
}
template <int D0> __device__ __forceinline__ void pv_one(f32x16& od, int vb, bf16x8 pa0, bf16x8 pa1, bf16x8 pa2, bf16x8 pa3) {
  const s16x4 l0 = tr_read<v_rd_off(D0, 0, 0)>(vb), h0 = tr_read<v_rd_off(D0, 0, 1)>(vb), l1 = tr_read<v_rd_off(D0, 1, 0)>(vb), h1 = tr_read<v_rd_off(D0, 1, 1)>(vb);
  const s16x4 l2 = tr_read<v_rd_off(D0, 2, 0)>(vb), h2 = tr_read<v_rd_off(D0, 2, 1)>(vb), l3 = tr_read<v_rd_off(D0, 3, 0)>(vb), h3 = tr_read<v_rd_off(D0, 3, 1)>(vb);
  asm volatile("s_waitcnt lgkmcnt(0)" ::: "memory"); SBAR();
#define PK(L, H) (bf16x8){L[0], L[1], L[2], L[3], H[0], H[1], H[2], H[3]}
  od = __builtin_amdgcn_mfma_f32_32x32x16_bf16(pa0, PK(l0, h0), od, 0, 0, 0);
  od = __builtin_amdgcn_mfma_f32_32x32x16_bf16(pa1, PK(l1, h1), od, 0, 0, 0);
  od = __builtin_amdgcn_mfma_f32_32x32x16_bf16(pa2, PK(l2, h2), od, 0, 0, 0);
  od = __builtin_amdgcn_mfma_f32_32x32x16_bf16(pa3, PK(l3, h3), od, 0, 0, 0);
#undef PK
}
__device__ __forceinline__ void pv_d0(f32x16* o, int vb, bf16x8 pa0, bf16x8 pa1, bf16x8 pa2, bf16x8 pa3) {
  pv_one<0>(o[0], vb, pa0, pa1, pa2, pa3); pv_one<1>(o[1], vb, pa0, pa1, pa2, pa3); pv_one<2>(o[2], vb, pa0, pa1, pa2, pa3); pv_one<3>(o[3], vb, pa0, pa1, pa2, pa3);
}

template <int kind>
__device__ __forceinline__ void attn_unit(const bf16_t* __restrict__ P, bf16_t* __restrict__ MIX, const float* __restrict__ rpb_l, const float* __restrict__ sink_l,
                                          const int u, const int h, LAS char* lds, const int tid, unsigned* qctr, LAS int* qslot) {
  const int wid = __builtin_amdgcn_readfirstlane(tid >> 6), lane = tid & 63, r32 = lane & 31, hi = lane >> 5;
  LAS char* V_lds = lds; LAS char* K_lds = lds + 2 * SHM_V;
  LAS float* ws = (LAS float*)(lds + WS_OFF) + wid * 64; LAS float* li_l = ws; LAS float* al_l = ws + 32;
  LAS float* rpbs = (LAS float*)(lds + BIAS_OFF) + 64;
  constexpr bool isA = (kind == 0 || kind == 2), lat = kind < 2;
  const int qrow0 = lat ? 256 * u : SEQ;
  const int qcol = isA ? h * HD : OFF_BQ + h * HD;
  const int kcol = isA ? OFF_AK + (h / 3) * HD : OFF_BK + h * HD;
  const int vcol = isA ? OFF_AV + (h / 3) * HD : OFF_BV + h * HD;
  const int ocol = (isA ? 0 : 768) + h * HD;
  constexpr int NT = (kind == 0) ? 12 : (kind == 1) ? 16 : 4;
  int Rs = 4 * u - 4; Rs = Rs < 0 ? 0 : (Rs > 117 ? 117 : Rs);
  __syncthreads();
  if (kind == 1) for (int i = tid; i < 64 + 15 * 32 + 64; i += 512) { const int t = i - 64; rpbs[t] = (t >= 0 && t < 15 * 32 && (t & 31) < 31) ? rpb_l[h * 465 + (t >> 5) * 31 + (t & 31)] * (1.0f / SCALE) : 0.f; }
  float m_reg = -1e30f, l_reg = 0; f32x16 o[4] = {};
  LAS char* Qs = lds + Q_OFF + wid * 8192;
  { const bf16_t* Qw = P + (size_t)(qrow0 + wid * QBLK + r32) * INC + qcol + hi * 8;
#pragma unroll
    for (int d0 = 0; d0 < 8; ++d0) *reinterpret_cast<LAS bf16x8*>(Qs + KSWZ(r32, (d0 * 16 + hi * 8) * 2)) = *reinterpret_cast<const bf16x8*>(Qw + d0 * 16); }
  const int sr = tid >> 4, sc = (tid & 15) * 8, vst0 = v_st(sr, sc), vst1 = v_st(32 + sr, sc);
  const int vb0 = (int)(size_t)V_lds + v_rd_base(lane);
  const unsigned voffk = (unsigned)(sr * INC + sc + kcol) * 2u, voffk2 = voffk + 32u * INC * 2u, voffv = (unsigned)(sr * INC + sc + vcol) * 2u, voffv2 = voffv + 32u * INC * 2u;
  struct { bf16x8 vs0, vs1, ks0, ks1; } sr_[2];
#define KROW(j) (((j) < 4) ? (SEQ + 64 * (j)) : (kind == 0 ? ({ int t_ = 256 * u - 128 + 64 * ((j) - 4); t_ < 0 ? 0 : (t_ > SEQ - 64 ? SEQ - 64 : t_); }) : ({ int jj_ = (j) - 4; jj_ = jj_ > 10 ? 10 : jj_; (Rs + jj_) * 64; })))
#define SLOAD(i, j) do { const char* kb_ = (const char*)P + (size_t)KROW(j) * (INC * 2);                                             \
    sr_[i].vs0 = *reinterpret_cast<const bf16x8*>(kb_ + voffv); sr_[i].vs1 = *reinterpret_cast<const bf16x8*>(kb_ + voffv2); \
    sr_[i].ks0 = *reinterpret_cast<const bf16x8*>(kb_ + voffk); sr_[i].ks1 = *reinterpret_cast<const bf16x8*>(kb_ + voffk2); } while (0)
#define SWRITE(b, i) do { *(LAS bf16x8*)(V_lds + (b) * SHM_V + vst0) = sr_[i].vs0;          \
    *(LAS bf16x8*)(V_lds + (b) * SHM_V + vst1) = sr_[i].vs1; int kc_ = sc * 2;               \
    *(LAS bf16x8*)(K_lds + (b) * SHM_K + KSWZ(sr, kc_)) = sr_[i].ks0;                       \
    *(LAS bf16x8*)(K_lds + (b) * SHM_K + KSWZ(32 + sr, kc_)) = sr_[i].ks1; } while (0)
#define SWAIT() asm volatile("s_waitcnt vmcnt(4)" ::: "memory")
#define RESC(a) do { if (__any((a) < 1.f)) { if (hi == 0) al_l[r32] = (a); asm volatile("s_waitcnt lgkmcnt(0)" ::: "memory"); \
    for (int d = 0; d < 4; ++d) for (int r = 0; r < 16; ++r) o[d][r] *= al_l[crow(r, hi)]; } } while (0)
#define MASK(p0, p1, j) do { const int j_ = (j);                                                                                          \
    if (lat && j_ >= 4) {                                                                                                                 \
      if (kind == 0) {                                                                                                                    \
        const int t0_ = 256 * u - 128 + 64 * (j_ - 4), qw_ = 256 * u + 32 * wid;                                                          \
        const int dt_ = t0_ - qw_;                                    \
        if (t0_ >= 0 && t0_ < SEQ && dt_ >= -97 && dt_ <= 65) { _Pragma("unroll") for (int r = 0; r < 16; ++r) { p0[r] = 0.f; p1[r] = 0.f; } }     \
        else {                                                                                                                            \
        const float tp_ = (t0_ < 0 || t0_ >= SEQ) ? -1e30f : 0.f;                                     \
        const float dl_ = (float)(t0_ - (qw_ + r32) + 4 * hi);                                                                            \
        _Pragma("unroll") for (int r = 0; r < 16; ++r) { const float k0_ = dl_ + (float)((r & 3) + 8 * (r >> 2)), k1_ = k0_ + 32.f;       \
          p0[r] = fmaf(fminf(0.f, 128.5f - fabsf(k0_)), 1e30f, tp_); p1[r] = fmaf(fminf(0.f, 128.5f - fabsf(k1_)), 1e30f, tp_); } }       \
      } else {                                                                                                                            \
        const int kr_ = Rs + (j_ - 4), qrw_ = 4 * u + (wid >> 1); int r0_ = qrw_ - 4; r0_ = r0_ < 0 ? 0 : (r0_ > 120 ? 120 : r0_);        \
        const float tp_ = (j_ >= 15 || kr_ < r0_ || kr_ >= r0_ + 8) ? -1e30f : 0.f;           \
        int dr_ = kr_ - qrw_ + 7; dr_ = dr_ < 0 ? 0 : (dr_ > 14 ? 14 : dr_);                                                              \
        const int qc_ = (wid & 1) * 32 + r32;                                                                                             \
        const LAS float* br_ = rpbs + dr_ * 32 + (15 - qc_ + 4 * hi);                                                                     \
        _Pragma("unroll") for (int r = 0; r < 16; ++r) { const int kk_ = (r & 3) + 8 * (r >> 2);                                           \
          p0[r] = cm0[r] + (br_[kk_] + tp_); p1[r] = cm1[r] + (br_[kk_ + 32] + tp_); }                                                     \
      } }                                                                                                                                 \
    else { _Pragma("unroll") for (int r = 0; r < 16; ++r) { p0[r] = 0.f; p1[r] = 0.f; } } } while (0)
  float cm0[16], cm1[16];
  if (kind == 1) { const int qc_ = (wid & 1) * 32 + r32; int c0_ = qc_ - 8; c0_ = c0_ < 0 ? 0 : (c0_ > 48 ? 48 : c0_);
    const float xb_ = (float)(4 * hi - c0_) - 7.5f;
#pragma unroll
    for (int r = 0; r < 16; ++r) { const float x0_ = xb_ + (float)((r & 3) + 8 * (r >> 2)), x1_ = x0_ + 32.f;
      cm0[r] = fminf(0.f, 7.75f - fabsf(x0_)) * 1e30f; cm1[r] = fminf(0.f, 7.75f - fabsf(x1_)) * 1e30f; } }
  f32x16 pA0, pA1; float mnA, alA; bf16x8 pa0, pa1, pa2, pa3;
  SLOAD(0, 0); asm volatile("s_waitcnt vmcnt(0)" ::: "memory"); SWRITE(0, 0); __syncthreads();
  int jlo = 4, jhi = NT - 1;
  if (kind == 0) { const int qw_ = 32 * wid;
    jlo = 4 + (qw_ + 0) / 64; jhi = 4 + (qw_ + 31 + 256) / 64;
    const int first_ok = (256 * u - 128 < 0) ? 4 + 2 : 4, last_ok = (256 * u + 384 > SEQ) ? 4 + 5 : 4 + 7;
    jlo = jlo < first_ok ? first_ok : jlo; jhi = jhi > last_ok ? last_ok : jhi; }
  if (kind == 1) { const int qrw_ = 4 * u + (wid >> 1); int r0_ = qrw_ - 4; r0_ = r0_ < 0 ? 0 : (r0_ > 120 ? 120 : r0_); jlo = 4 + (r0_ - Rs); jhi = jlo + 7; }
#define TILE(J, B) do { if ((J) < 4 || ((J) >= jlo && (J) <= jhi)) {                                                    \
      MASK(pA0, pA1, (J));                                                                                              \
      SBAR(); qkt(pA0, pA1, K_lds + (B) * SHM_K, Qs, r32, hi);                                                          \
      partialSM(pA0, pA1, m_reg, mnA, alA);                                                                             \
      RESC(alA);                                                                                                        \
      finishSM(pA0, pA1, alA, l_reg, pa0, pa1, pa2, pa3); SBAR();                                                       \
      pv_d0(o, vb0 + (B) * SHM_V, pa0, pa1, pa2, pa3); } } while (0)
  SLOAD(1, 1);
  for (int j = 0; j < NT; j += 2) {
    if (j + 2 < NT) SLOAD(0, j + 2);
    TILE(j, 0);
    SWAIT(); SWRITE(1, 1);
    __syncthreads();
    if (j + 3 < NT) SLOAD(1, j + 3);
    TILE(j + 1, 1);
    if (j + 2 < NT) { SWAIT(); SWRITE(0, 0); }
    __syncthreads();
  }
#undef TILE
  int nq_ = 0; if (tid == 0) nq_ = (int)atomicAdd(qctr, 1u);
  if (isA) l_reg += __builtin_amdgcn_exp2f(sink_l[h] * 1.4426950408889634f - m_reg * (SCALE * 1.4426950408889634f));
  if (hi == 0) li_l[r32] = l_reg; asm volatile("s_waitcnt lgkmcnt(0)" ::: "memory");
  float rli[16];
#pragma unroll
  for (int r = 0; r < 16; ++r) rli[r] = __builtin_amdgcn_rcpf(li_l[crow(r, hi)]);
  __syncthreads();
  LAS char* ost = lds + wid * 8192;
#pragma unroll
  for (int r = 0; r < 16; ++r) { const int orow = crow(r, hi);
#pragma unroll
    for (int d0 = 0; d0 < 4; ++d0) *(LAS bf16_t*)(ost + orow * 256 + (d0 * 32 + r32) * 2) = f2bf(o[d0][r] * rli[r]); }
  asm volatile("s_waitcnt lgkmcnt(0)" ::: "memory");
  bf16_t* Ow = MIX + (size_t)(qrow0 + wid * QBLK) * D + ocol;
#pragma unroll
  for (int i = 0; i < 8; ++i) { const int c = lane + 64 * i, row = c >> 4, c16 = c & 15;
    const u32x4 v = *(const LAS u32x4*)(ost + c * 16);
    *reinterpret_cast<u32x4*>(Ow + (size_t)row * D + c16 * 8) = v; }
  if (tid == 0) *qslot = nq_;
#undef KROW
#undef SLOAD
#undef SWRITE
#undef SWAIT
#undef RESC
#undef MASK
}
#undef KSWZ
#undef SBAR
}

__device__ __forceinline__ float gelu_fast(float v) { const float z = 0.7978845608028654f * (v + 0.044715f * v * v * v); return v / (1.f + __expf(-2.f * z)); }
__device__ __forceinline__ void sgu_item(const Ctx& C, int l, int ch, int g, unsigned* qctr, LAS int* qslot) {
    typedef short bf16x8v __attribute__((ext_vector_type(8)));
    typedef float f32x4v __attribute__((ext_vector_type(4)));
    constexpr int PITCH = 272;
    LAS char* vnT = (LAS char*)C.lds;
    const int lane = C.lane, wave = C.wave;
    const int row0 = ch * 128;
    const int m16 = lane & 15, kg = lane >> 4;
    __syncthreads();
    unsigned short va[16], vb[16];
#pragma unroll
    for (int i = 0; i < 16; ++i) { const AT* vp = C_P + (size_t)(row0 + wave + 8 * i) * INC + OFF_C + CW + g * 128; va[i] = vp[lane]; vb[i] = vp[64 + lane]; }
    const float g0 = C_sgu_g[l * CW + g * 128 + lane], g1 = C_sgu_g[l * CW + g * 128 + 64 + lane];
    const float b0 = C_sgu_bn[l * CW + g * 128 + lane], b1 = C_sgu_bn[l * CW + g * 128 + 64 + lane];
    bf16x8v af[4];
    { const float* wp = C_sgu_w + ((size_t)(l * 4 + g) * 128 + 16 * wave + m16) * 128 + 8 * kg;
#pragma unroll
      for (int ks = 0; ks < 4; ++ks) { const float4 w0 = *(const float4*)(wp + 32 * ks), w1 = *(const float4*)(wp + 32 * ks + 4);
          uint4 pk; pk.x = pg8::cvt_pk_bf16(w0.x, w0.y); pk.y = pg8::cvt_pk_bf16(w0.z, w0.w); pk.z = pg8::cvt_pk_bf16(w1.x, w1.y); pk.w = pg8::cvt_pk_bf16(w1.z, w1.w);
          af[ks] = *reinterpret_cast<bf16x8v*>(&pk); } }
    const int pr = 16 * wave + m16;
    uint2 uu[8];
    { const AT* up = C_P + (size_t)(row0 + pr) * INC + OFF_C + g * 128 + 4 * kg;
#pragma unroll
      for (int nt = 0; nt < 8; ++nt) uu[nt] = *(const uint2*)(up + 16 * nt); }
    const float bs = C_sgu_b[(l * 4 + g) * 128 + pr];
#pragma unroll
    for (int i = 0; i < 16; ++i) {
        const int q = wave + 8 * i;
        const float a = gelu_fast(bf2f(va[i])), b = gelu_fast(bf2f(vb[i]));
        const float mu = wave_sum(a + b) * (1.f / 128.f);
        const float da = a - mu, db = b - mu;
        const float var = wave_sum(da * da + db * db) * (1.f / 128.f);
        const float rstd = 1.0f / sqrtf(var + LN_EPS);
        *(LAS bf16_t*)(vnT + lane * PITCH + q * 2) = f2bf(da * rstd * g0 + b0);
        *(LAS bf16_t*)(vnT + (64 + lane) * PITCH + q * 2) = f2bf(db * rstd * g1 + b1);
    }
    __syncthreads();
    int nq_ = 0; if (C.tid == 0) nq_ = (int)atomicAdd(qctr, 1u);
    f32x4v acc[8];
#pragma unroll
    for (int nt = 0; nt < 8; ++nt) acc[nt] = (f32x4v){0.f, 0.f, 0.f, 0.f};
#pragma unroll
    for (int nt = 0; nt < 8; ++nt)
#pragma unroll
        for (int ks = 0; ks < 4; ++ks) {
            const bf16x8v bfr = *(const LAS bf16x8v*)(vnT + (nt * 16 + m16) * PITCH + (32 * ks + 8 * kg) * 2);
            acc[nt] = __builtin_amdgcn_mfma_f32_16x16x32_bf16(bfr, af[ks], acc[nt], 0, 0, 0);
        }
    AT* op = C_MIX + (size_t)(row0 + pr) * D + 1536 + g * 128 + 4 * kg;
#pragma unroll
    for (int nt = 0; nt < 8; ++nt) {
        const float u0 = __uint_as_float(uu[nt].x << 16), u1 = __uint_as_float(uu[nt].x & 0xffff0000u), u2 = __uint_as_float(uu[nt].y << 16), u3 = __uint_as_float(uu[nt].y & 0xffff0000u);
        float4 o; o.x = gelu_fast(u0) * (acc[nt][0] + bs); o.y = gelu_fast(u1) * (acc[nt][1] + bs); o.z = gelu_fast(u2) * (acc[nt][2] + bs); o.w = gelu_fast(u3) * (acc[nt][3] + bs);
        st4(op + 16 * nt, o);
    }
    if (C.tid == 0) *qslot = nq_;
}

constexpr int CW_MTC = 32768;
constexpr int CW_Q = 16384 + 256;
constexpr int CW_CTXDONE = 16384 + 384;
constexpr int CW_INP = 16384 + 512;
__device__ __forceinline__ void ph_mixers(const Ctx& C, int l) {
    const bool last = (l == DEPTH - 1);
    bool attn_ok = false, sgu_ok = false, sguc_ok = false, attnc_ok = false;
    const int nC = last ? 0 : 12, nCS = last ? 0 : 8, nB = 192, nA = 192, nG = last ? 0 : 8, nS = 256;
    const int total = nC + nCS + nB + nA + nG + nS;
    LAS int* qs = (LAS int*)(C.lds + att::QSLOT_OFF);
    unsigned* ctr = uni(C_CTLW + CW_Q + l);
    unsigned* ctxdone = uni(C_CTLW + CW_CTXDONE);
    const bf16_t* Pq = uni((const bf16_t*)C_P); bf16_t* Mq = uni((bf16_t*)C_MIX); const float* rpq = uni(C_rpb + l * 6 * 465); const float* skq = uni(C_sink + l * 6);
    bool claimed = false;
    int rfirst = -1, nstat = 0; const int nlead = nC + nCS + nG;
    if (C.G == 256) { const int vq = (C.bid % 8) * 32 + C.bid / 8, dedq = last ? 0 : 8, nheavy = ((NTOK / 256) * 18 - 512) + dedq;
        nstat = 256 - dedq - nheavy; if (vq >= nheavy && vq < 256 - dedq) rfirst = nlead + (vq - nheavy); }
    nstat = __builtin_amdgcn_readfirstlane(nstat);
    if (rfirst >= 0) { if (C.tid == 0) *qs = rfirst - nstat - 0x1000000; claimed = true; }
    for (;;) {
        __syncthreads();
        if (!claimed && C.tid == 0) *qs = (int)atomicAdd(ctr, 1u);
        __syncthreads();
        int r = *qs;
        r = (r < 0) ? r + 0x1000000 + nstat : (r >= nlead ? r + nstat : r);
        if (r >= total) break;
        int kind = -1, u = 0, h = 0;
        if (r < nC) { kind = 2 + r / 6; h = r % 6; }
        else { r -= nC;
          if (r < nCS) { kind = 5; u = 64 + r / 4; h = r % 4; }
          else { r -= nCS;
            if (r < nG) { kind = 4; u = r; }
            else { r -= nG;
              if (r < nB) { kind = 1; u = r / 6; h = r % 6; }
              else { r -= nB;
                if (r < nA) { kind = 0; u = r / 6; h = r % 6; }
                else { r -= nA; kind = 5; u = r / 4; h = r % 4; } } } } }
        claimed = (kind != 4);
        if ((kind == 0 || kind == 1) && !attn_ok) { wg_wait_ge(C_CTLW + CW_INP + l * 128, (NTOK / 256) * 14); attn_ok = true; }
        if ((kind == 2 || kind == 3) && !attnc_ok) { wg_wait_ge(C_CTLW + CW_INP + 256 + l * 64 + 32, 14u); attnc_ok = true; }
        if (kind == 5 && u >= 64 && !sguc_ok) { wg_wait_ge(C_CTLW + CW_INP + 256 + l * 64, 4u); sguc_ok = true; }
        if (kind == 5 && u < 64 && !sgu_ok) { wg_wait_ge(C_CTLW + CW_INP + l * 128 + 64, (SEQ / 256) * 4); sgu_ok = true; }
        int t_ = threadIdx.x; asm volatile("" : "+v"(t_));
        if (kind == 1) att::attn_unit<1>(Pq, Mq, rpq, skq, u, h, (LAS char*)C.lds, t_, ctr, qs);
        else if (kind == 0) att::attn_unit<0>(Pq, Mq, rpq, skq, u, h, (LAS char*)C.lds, t_, ctr, qs);
        else if (kind == 2) att::attn_unit<2>(Pq, Mq, rpq, skq, u, h, (LAS char*)C.lds, t_, ctr, qs);
        else if (kind == 3) att::attn_unit<3>(Pq, Mq, rpq, skq, u, h, (LAS char*)C.lds, t_, ctr, qs);
        else if (kind == 5) { Ctx C2 = C; C2.tid = t_; C2.lane = t_ & 63; C2.wave = __builtin_amdgcn_readfirstlane(t_ >> 6); sgu_item(C2, l, u, h, ctr, qs); }
        else {
            if (t_ < 64) {
                unsigned sp = 0;
                while (__builtin_amdgcn_readfirstlane((int)__hip_atomic_load(ctxdone, __ATOMIC_RELAXED, __HIP_MEMORY_SCOPE_AGENT)) < nC + nCS) { __builtin_amdgcn_s_sleep(2); if (++sp > (1u << 22)) break; }
                __builtin_amdgcn_fence(__ATOMIC_ACQUIRE, "agent");
                asm volatile("s_waitcnt vmcnt(0)" ::: "memory");
            }
            __syncthreads();
            pg8::Unit uu; uu.pm = SEQ / 256; uu.pn = u; uu.A = (const char*)(C_MIX + (size_t)SEQ * D); uu.B = (const char*)(C_WOUT + (size_t)l * D * D + (size_t)u * 256 * D);
            pg8::OneUnit S{uu};
            pg8::EpiTln E{C.in, C.ws + C.z, l};
            pg8::gemm_phase<D>(C.lds, S, E);
        }
        if (kind == 2 || kind == 3 || (kind == 5 && u >= 64)) {
            asm volatile("s_waitcnt vmcnt(0)" ::: "memory");
            __syncthreads();
            if (threadIdx.x == 0) { __builtin_amdgcn_fence(__ATOMIC_RELEASE, "agent"); asm volatile("s_waitcnt vmcnt(0)" ::: "memory"); __hip_atomic_fetch_add(ctxdone, 1u, __ATOMIC_RELAXED, __HIP_MEMORY_SCOPE_AGENT); }
        }
    }
}

__device__ __forceinline__ void ph_ln1(const Ctx& C, int l) {
    typedef short bf16x8v __attribute__((ext_vector_type(8)));
    typedef float f32x4v __attribute__((ext_vector_type(4)));
    const bool last = (l == DEPTH - 1);
    const int nrows = last ? SEQ : NTOK;
    const int RPB = __builtin_amdgcn_readfirstlane((nrows + C.G - 1) / C.G);
    const int row_lo = __builtin_amdgcn_readfirstlane(C.bid * RPB), row_hi = __builtin_amdgcn_readfirstlane((row_lo + RPB < nrows) ? row_lo + RPB : nrows);
    const int lane = C.lane, wave = C.wave, tid = C.tid;
    LAS float* hbuf = (LAS float*)C.lds;
    LAS float* red = (LAS float*)C.lds;
    LAS int* hist = (LAS int*)(C.lds + 131072 + 1024);
    LAS int* rinfo = hist + 64;
    LAS int* rrank = rinfo + 256;
    const float* gam = C_ln1_g + l * D; const float* bet = C_ln1_b + l * D;
    if (tid < 32) hist[tid] = 0;
    LAS float* vecs = (LAS float*)(C.lds + 135168);
    { *(LAS f32x4v*)(vecs + 4 * tid) = *(const f32x4v*)(gam + 4 * tid); *(LAS f32x4v*)(vecs + D + 4 * tid) = *(const f32x4v*)(bet + 4 * tid);
      *(LAS f32x4v*)(vecs + 2 * D + 4 * tid) = *(const f32x4v*)(modp(C, l, 0, 4) + 4 * tid); }
    for (int sr = 0; row_lo + 16 * sr < row_hi; ++sr) {
        __syncthreads();
#pragma unroll
        for (int hsel = 0; hsel < 2; ++hsel) {
            const int slot = wave + 8 * hsel, r = row_lo + 16 * sr + slot;
            LAS float* hr = hbuf + slot * D;
            if (r < row_hi) {
                const int kind = r < SEQ ? 0 : 1;
                const bf16_t* tp = C_T + (size_t)r * D;
                const float* sc2 = modp(C, l, kind, 4); const float* sh2 = modp(C, l, kind, 3);
                float v[32]; float sm = 0.f;
                f32x4v shv[8];
#pragma unroll
                for (int j = 0; j < 8; ++j) { const float4 t4 = ld4(tp + 4 * lane + 256 * j); shv[j] = *(const f32x4v*)(sh2 + 4 * lane + 256 * j);
                    v[4 * j] = t4.x; v[4 * j + 1] = t4.y; v[4 * j + 2] = t4.z; v[4 * j + 3] = t4.w; sm += (t4.x + t4.y) + (t4.z + t4.w); }
                const float mu = wave_sum(sm) * (1.f / D);
                float q = 0.f;
#pragma unroll
                for (int k = 0; k < 32; ++k) { v[k] -= mu; q += v[k] * v[k]; }
                const float rstd = 1.0f / sqrtf(wave_sum(q) * (1.f / D) + LN_EPS);
                if (lane == 0) { C_STAT[2 * r] = mu; C_STAT[2 * r + 1] = rstd; }
#pragma unroll
                for (int j = 0; j < 8; ++j) {
                    const int d0 = 4 * lane + 256 * j;
                    const f32x4v g4v = *(const LAS f32x4v*)(vecs + d0), b4v = *(const LAS f32x4v*)(vecs + D + d0);
                    f32x4v sc4v = *(const LAS f32x4v*)(vecs + 2 * D + d0);
                    if (kind) sc4v = *(const f32x4v*)(sc2 + d0);
                    const float4 g4 = {g4v[0], g4v[1], g4v[2], g4v[3]}, b4 = {b4v[0], b4v[1], b4v[2], b4v[3]}, sc4 = {sc4v[0], sc4v[1], sc4v[2], sc4v[3]}, sh4 = {shv[j][0], shv[j][1], shv[j][2], shv[j][3]};
                    float4 x1, h2;
                    x1.x = v[4 * j + 0] * rstd * g4.x + b4.x; x1.y = v[4 * j + 1] * rstd * g4.y + b4.y; x1.z = v[4 * j + 2] * rstd * g4.z + b4.z; x1.w = v[4 * j + 3] * rstd * g4.w + b4.w;
                    h2.x = x1.x * (1.f + sc4.x) + sh4.x; h2.y = x1.y * (1.f + sc4.y) + sh4.y; h2.z = x1.z * (1.f + sc4.z) + sh4.z; h2.w = x1.w * (1.f + sc4.w) + sh4.w;
                    st4(&C_H2[(size_t)r * D + d0], h2);
                    *(LAS f32x4v*)(hr + d0) = (f32x4v){h2.x, h2.y, h2.z, h2.w};
                }
            } else {
#pragma unroll
                for (int j = 0; j < 8; ++j) *(LAS f32x4v*)(hr + 4 * lane + 256 * j) = (f32x4v){0.f, 0.f, 0.f, 0.f};
            }
        }
        __syncthreads();
        f32x4v acc0 = {0.f, 0.f, 0.f, 0.f}, acc1 = {0.f, 0.f, 0.f, 0.f};
        {
            const int m16 = lane & 15, kg = lane >> 4;
            const bf16_t* wt = C_WRT + (size_t)m16 * D + 256 * wave + 8 * kg;
            const LAS float* ar = hbuf + m16 * D + 256 * wave + 8 * kg;
#pragma unroll 4
            for (int ks = 0; ks < 8; ++ks) {
                const f32x4v a0 = *(const LAS f32x4v*)(ar + 32 * ks), a1 = *(const LAS f32x4v*)(ar + 32 * ks + 4);
                uint4 hi, lo;
                hi.x = pg8::cvt_pk_bf16(a0[0], a0[1]); hi.y = pg8::cvt_pk_bf16(a0[2], a0[3]); hi.z = pg8::cvt_pk_bf16(a1[0], a1[1]); hi.w = pg8::cvt_pk_bf16(a1[2], a1[3]);
                lo.x = pg8::cvt_pk_bf16(a0[0] - __uint_as_float(hi.x << 16), a0[1] - __uint_as_float(hi.x & 0xffff0000u));
                lo.y = pg8::cvt_pk_bf16(a0[2] - __uint_as_float(hi.y << 16), a0[3] - __uint_as_float(hi.y & 0xffff0000u));
                lo.z = pg8::cvt_pk_bf16(a1[0] - __uint_as_float(hi.z << 16), a1[1] - __uint_as_float(hi.z & 0xffff0000u));
                lo.w = pg8::cvt_pk_bf16(a1[2] - __uint_as_float(hi.w << 16), a1[3] - __uint_as_float(hi.w & 0xffff0000u));
                const bf16x8v Ah = *reinterpret_cast<bf16x8v*>(&hi), Al = *reinterpret_cast<bf16x8v*>(&lo);
                const bf16x8v B0h = *reinterpret_cast<const bf16x8v*>(wt + 32 * ks), B1h = *reinterpret_cast<const bf16x8v*>(wt + 16 * D + 32 * ks);
                const bf16x8v B0l = *reinterpret_cast<const bf16x8v*>(wt + NE * D + 32 * ks), B1l = *reinterpret_cast<const bf16x8v*>(wt + NE * D + 16 * D + 32 * ks);
                acc0 = __builtin_amdgcn_mfma_f32_16x16x32_bf16(Ah, B0h, acc0, 0, 0, 0); acc1 = __builtin_amdgcn_mfma_f32_16x16x32_bf16(Ah, B1h, acc1, 0, 0, 0);
                acc0 = __builtin_amdgcn_mfma_f32_16x16x32_bf16(Ah, B0l, acc0, 0, 0, 0); acc1 = __builtin_amdgcn_mfma_f32_16x16x32_bf16(Ah, B1l, acc1, 0, 0, 0);
                acc0 = __builtin_amdgcn_mfma_f32_16x16x32_bf16(Al, B0h, acc0, 0, 0, 0); acc1 = __builtin_amdgcn_mfma_f32_16x16x32_bf16(Al, B1h, acc1, 0, 0, 0);
            }
        }
        __syncthreads();
        {
            const int m16 = lane & 15, kg = lane >> 4;
#pragma unroll
            for (int reg = 0; reg < 4; ++reg) { red[(wave * 16 + 4 * kg + reg) * 32 + m16] = acc0[reg]; red[(wave * 16 + 4 * kg + reg) * 32 + 16 + m16] = acc1[reg]; }
        }
        __syncthreads();
        if (tid < 16 && row_lo + 16 * sr + tid < row_hi) {
            const int r = row_lo + 16 * sr + tid;
            float bestgs = -3.0e38f; int be0 = 0, be1 = 0; float bw0 = 0.f, bw1 = 0.f;
#pragma unroll 1
            for (int gq2 = 0; gq2 < 4; ++gq2) {
                float m1 = -3.0e38f, m2 = -3.0e38f, s1 = 0.f, s2 = 0.f; int i1 = 0, i2 = 0;
#pragma unroll 1
                for (int t = 0; t < 8; ++t) {
                    const int e = gq2 * 8 + t;
                    float lg = 0.f;
#pragma unroll
                    for (int w = 0; w < 8; ++w) lg += red[(w * 16 + tid) * 32 + e];
                    const float scv = 1.f / (1.f + expf(-lg)), bv = scv + C_router_bias[e];
                    if (bv > m1) { m2 = m1; i2 = i1; s2 = s1; m1 = bv; i1 = e; s1 = scv; }
                    else if (bv > m2) { m2 = bv; i2 = e; s2 = scv; }
                }
                const float gs = m1 + m2;
                if (gs > bestgs) { bestgs = gs; be0 = i1; be1 = i2; bw0 = s1; bw1 = s2; }
            }
            const float inv = 1.f / (bw0 + bw1);
            LAS int* ri = rinfo + (r - row_lo) * 4;
            ri[0] = be0; ri[1] = be1; ri[2] = __float_as_int(bw0 * inv); ri[3] = __float_as_int(bw1 * inv);
        }
    }
    const int nb = row_hi - row_lo;
    __syncthreads();
    int e_mine = 0;
    if (tid < 2 * nb) { e_mine = rinfo[(tid >> 1) * 4 + (tid & 1)]; rrank[tid] = (int)__hip_atomic_fetch_add((LAS unsigned*)(hist + e_mine), 1u, __ATOMIC_RELAXED, __HIP_MEMORY_SCOPE_WORKGROUP); }
    __syncthreads();
    if (tid < 32) { const int cnt = hist[tid]; hist[32 + tid] = cnt ? (int)atomicAdd(C_CTLW + CW_CNT + l * 32 + tid, (unsigned)cnt) : 0; }
    __syncthreads();
    if (tid < 2 * nb) {
        const int r = row_lo + (tid >> 1), k = tid & 1;
        const int pos = hist[32 + e_mine] + rrank[tid];
        C_POS[(size_t)r * 2 + k] = pos;
        C_ROUTE[(size_t)r * 4 + k] = e_mine;
        C_LIST[(size_t)e_mine * LCAP + pos] = r;
        C_SWL[(size_t)e_mine * LCAP + pos] = __int_as_float(rinfo[(tid >> 1) * 4 + 2 + k]);
    }
}

constexpr int TOFF_OFF = 131072;
__device__ __forceinline__ void compute_toff(const Ctx& C, int l) {
    LAS int* toff = (LAS int*)(C.lds + TOFF_OFF);
    __syncthreads();
    if (C.tid < 64) {
        const int e = C.tid & 31;
        const int c = C.tid < 32 ? (int)__hip_atomic_load(C_CTLW + CW_CNT + l * 32 + e, __ATOMIC_RELAXED, __HIP_MEMORY_SCOPE_AGENT) : 0;
        const int nt = (c + 255) >> 8; int inc = nt;
#pragma unroll
        for (int d = 1; d < 32; d <<= 1) { const int o = __shfl_up(inc, d); if ((C.tid & 63) >= d) inc += o; }
        if (C.tid < 32) { toff[e] = inc - nt; toff[40 + e] = c; if (e == 31) toff[NE] = inc; }
    }
    __syncthreads();
}
__device__ __forceinline__ void ph_dispatch(const Ctx& C, int l) {
    const bool last = (l == DEPTH - 1);
    const int nrows = last ? SEQ : NTOK;
    const int gw = C.bid * NWAVES + C.wave, NGW = C.G * NWAVES, lane = C.lane;
    compute_toff(C, l);
    const LAS int* toff = (const LAS int*)(C.lds + TOFF_OFF);
    for (int it = gw; it < nrows * 2; it += NGW) {
        const int r = it >> 1, k = it & 1;
        const int e = C_ROUTE[(size_t)r * 4 + k];
        const int slot = toff[e] * 256 + C_POS[it];
        if (lane == 0) { C_SLOT[it] = slot; C_SW[slot] = __int_as_float(C_ROUTE[(size_t)r * 4 + 2 + k]); }
        const uint4* src = (const uint4*)(C_H2 + (size_t)r * D); uint4* dst = (uint4*)(C_HS + (size_t)slot * D);
#pragma unroll
        for (int j = 0; j < 4; ++j) dst[lane + 64 * j] = src[lane + 64 * j];
    }
}

__device__ __forceinline__ void ph_ln2(const Ctx& C, int l) {
    const bool last = (l == DEPTH - 1);
    const int nrows = last ? SEQ : NTOK;
    const int gw = C.bid * NWAVES + C.wave, NGW = C.G * NWAVES, lane = C.lane;
    compute_toff(C, l);
    const LAS int* toff = (const LAS int*)(C.lds + TOFF_OFF);
    LAS float* vec0 = (LAS float*)C.lds;
    {
        const int ln = last ? l : l + 1;
#pragma unroll
        for (int k = 0; k < 2; ++k) {
            *(LAS pg8::f32x4*)(vec0 + (k * 5 + 0) * D + 4 * C.tid) = *(const pg8::f32x4*)(modp(C, l, k, 5) + 4 * C.tid);
            *(LAS pg8::f32x4*)(vec0 + (k * 5 + 1) * D + 4 * C.tid) = *(const pg8::f32x4*)(C_ln2_g + l * D + 4 * C.tid);
            *(LAS pg8::f32x4*)(vec0 + (k * 5 + 2) * D + 4 * C.tid) = *(const pg8::f32x4*)(C_ln2_b + l * D + 4 * C.tid);
            *(LAS pg8::f32x4*)(vec0 + (k * 5 + 3) * D + 4 * C.tid) = *(const pg8::f32x4*)(modp(C, ln, k, 1) + 4 * C.tid);
            *(LAS pg8::f32x4*)(vec0 + (k * 5 + 4) * D + 4 * C.tid) = *(const pg8::f32x4*)(modp(C, ln, k, 0) + 4 * C.tid);
        }
        *(LAS pg8::f32x4*)(vec0 + 10 * D + 4 * C.tid) = *(const pg8::f32x4*)(C_ln1_g + l * D + 4 * C.tid);
        *(LAS pg8::f32x4*)(vec0 + 11 * D + 4 * C.tid) = *(const pg8::f32x4*)(C_ln1_b + l * D + 4 * C.tid);
        __syncthreads();
    }
    uint2 nx[8], na[8], nb2[8]; float nmu = 0.f, nrs = 0.f;
    int s0 = 0, s1 = 0;
    int e0_ = 0, e1_ = 0, p0_ = 0, p1_ = 0;
#define LN2_SLOTS_ISSUE(rr) do { e0_ = 0; e1_ = 0; p0_ = 0; p1_ = 0; if ((rr) < nrows) { e0_ = C_ROUTE[(size_t)(rr) * 4]; e1_ = C_ROUTE[(size_t)(rr) * 4 + 1]; p0_ = C_POS[2 * (rr)]; p1_ = C_POS[2 * (rr) + 1]; } } while (0)
#define LN2_SLOTS_FIN() do { s0 = toff[e0_] * 256 + p0_; s1 = toff[e1_] * 256 + p1_; } while (0)
#define LN2_LOAD(rr) do { if ((rr) < nrows) { _Pragma("unroll") for (int j = 0; j < 8; ++j) { const int d0 = 4 * lane + 256 * j;                                   \
        nx[j] = *(const uint2*)(C_T + (size_t)(rr) * D + d0); na[j] = *(const uint2*)(C_Y + (size_t)s0 * D + d0); nb2[j] = *(const uint2*)(C_Y + (size_t)s1 * D + d0); } \
        nmu = C_STAT[2 * (rr)]; nrs = C_STAT[2 * (rr) + 1]; } } while (0)
    const int lane0 = C.lane;
    { const int lane = lane0; LN2_SLOTS_ISSUE(gw); LN2_SLOTS_FIN(); LN2_LOAD(gw); }
    LN2_SLOTS_ISSUE(gw + NGW); LN2_SLOTS_FIN();
    for (int r = gw; r < nrows; r += NGW) {
        int lane = lane0; asm volatile("" : "+v"(lane));
        const LAS float* vec = vec0 + (r < SEQ ? 0 : 5 * D);
        const float mu1 = nmu, rs1 = nrs;
        float v[32]; float s = 0.f;
#pragma unroll
        for (int j = 0; j < 8; ++j) { const int d0 = 4 * lane + 256 * j;
            float4 xq; xq.x = __uint_as_float(nx[j].x << 16); xq.y = __uint_as_float(nx[j].x & 0xffff0000u); xq.z = __uint_as_float(nx[j].y << 16); xq.w = __uint_as_float(nx[j].y & 0xffff0000u);
            { const pg8::f32x4 ga = *(const LAS pg8::f32x4*)(vec0 + 10 * D + d0), be = *(const LAS pg8::f32x4*)(vec0 + 11 * D + d0);
              xq.x = (xq.x - mu1) * rs1 * ga[0] + be[0]; xq.y = (xq.y - mu1) * rs1 * ga[1] + be[1]; xq.z = (xq.z - mu1) * rs1 * ga[2] + be[2]; xq.w = (xq.w - mu1) * rs1 * ga[3] + be[3]; }
            const pg8::f32x4 g4 = *(const LAS pg8::f32x4*)(vec + d0);
            const float y0 = __uint_as_float(na[j].x << 16) + __uint_as_float(nb2[j].x << 16), y1 = __uint_as_float(na[j].x & 0xffff0000u) + __uint_as_float(nb2[j].x & 0xffff0000u);
            const float y2 = __uint_as_float(na[j].y << 16) + __uint_as_float(nb2[j].y << 16), y3 = __uint_as_float(na[j].y & 0xffff0000u) + __uint_as_float(nb2[j].y & 0xffff0000u);
            v[4 * j + 0] = ALPHA * xq.x + g4[0] * y0; v[4 * j + 1] = ALPHA * xq.y + g4[1] * y1; v[4 * j + 2] = ALPHA * xq.z + g4[2] * y2; v[4 * j + 3] = ALPHA * xq.w + g4[3] * y3;
            s += (v[4 * j] + v[4 * j + 1]) + (v[4 * j + 2] + v[4 * j + 3]); }
        asm volatile("" ::: "memory");
        LN2_SLOTS_ISSUE(r + 2 * NGW); LN2_LOAD(r + NGW);
        const float mu = wave_sum(s) * (1.f / D);
        float q = 0.f;
#pragma unroll
        for (int i = 0; i < 32; ++i) { v[i] -= mu; q += v[i] * v[i]; }
        const float rstd = 1.0f / sqrtf(wave_sum(q) * (1.f / D) + LN_EPS);
        int rr = r; asm volatile("" : "+v"(rr) :: "memory");
#pragma unroll
        for (int j = 0; j < 8; ++j) { const int d0 = 4 * lane + 256 * j;
            const pg8::f32x4 g4 = *(const LAS pg8::f32x4*)(vec + D + d0), b4 = *(const LAS pg8::f32x4*)(vec + 2 * D + d0);
            float4 xo;
            xo.x = v[4 * j + 0] * rstd * g4[0] + b4[0]; xo.y = v[4 * j + 1] * rstd * g4[1] + b4[1]; xo.z = v[4 * j + 2] * rstd * g4[2] + b4[2]; xo.w = v[4 * j + 3] * rstd * g4[3] + b4[3];
            if (last) *(float4*)(C.out + C.z + (size_t)rr * D + d0) = xo;
            else {
                st4((bf16_t*)C_XB + (size_t)rr * D + d0, xo);
                const pg8::f32x4 sc4 = *(const LAS pg8::f32x4*)(vec + 3 * D + d0), sh4 = *(const LAS pg8::f32x4*)(vec + 4 * D + d0);
                float4 hn; hn.x = xo.x * (1.f + sc4[0]) + sh4[0]; hn.y = xo.y * (1.f + sc4[1]) + sh4[1]; hn.z = xo.z * (1.f + sc4[2]) + sh4[2]; hn.w = xo.w * (1.f + sc4[3]) + sh4[3];
                st4(&C_H[(size_t)rr * D + d0], hn);
            }
        }
        LN2_SLOTS_FIN();
    }
}

#undef LN2_SLOTS_ISSUE
#undef LN2_SLOTS_FIN
#undef LN2_LOAD
__device__ __forceinline__ Ctx fresh(const Ctx& C0) { Ctx C = C0; size_t z = 0; int t = threadIdx.x; int g_ = gridDim.x, b_ = blockIdx.x; asm volatile("" : "+s"(z), "+v"(t), "+s"(g_), "+s"(b_)); C.G = g_; C.bid = b_; C.z = z; C.tid = t; C.lane = t & 63; C.wave = __builtin_amdgcn_readfirstlane(t >> 6); return C; }
constexpr int PH_PER_LAYER = 6;
constexpr int N_PHASES = 2 + PH_PER_LAYER * DEPTH;
__global__ void __launch_bounds__(NTHREADS, 2) fwd_kernel(Args args) {
    extern __shared__ __attribute__((aligned(16))) unsigned char lds_raw[];
    Ctx C0;
    C0.lds = (LAS unsigned char*)lds_raw;
    C0.tid = threadIdx.x; C0.lane = C0.tid & 63; C0.wave = __builtin_amdgcn_readfirstlane(C0.tid >> 6); C0.G = gridDim.x; C0.bid = blockIdx.x;
    C0.in = args.in; C0.out = args.out; C0.ws = args.ws; C0.z = 0;
    unsigned char* ws = args.ws;

    volatile LAS unsigned* bst = (volatile LAS unsigned*)(C0.lds + LDS_BYTES - 16);
    if (C0.tid < 4) bst[C0.tid] = 0u;
    __syncthreads();
    const int lo = args.ph_lo, hi = args.ph_hi;
    XcdBarrier bar; bar.bar = (unsigned*)(ws + WS_CTL) + CW_BAR; bar.x = 0; bar.st = bst;
    if (hi - lo > 1) bar = xcd_barrier_post((unsigned*)(ws + WS_CTL) + CW_BAR, bst);
#define IN(k) (lo <= (k) && (k) < hi)
#define SEAM(k) do { if (IN(k) && IN((k) + 1)) xcd_barrier(bar); } while (0)

    if (IN(0)) { const Ctx C = fresh(C0); ph_prologue(C); }
    if (IN(1)) { const Ctx C = fresh(C0); ph_modulate0(C); } SEAM(1);
#pragma unroll 1
    for (int l = 0; l < DEPTH; ++l) {
        const int pb = 2 + PH_PER_LAYER * l;
        const bool last = (l == DEPTH - 1);
        if (IN(pb + 0)) {
            const Ctx C = fresh(C0);
            const int vid = (C.G % 8 == 0) ? (C.bid % 8) * (C.G / 8) + C.bid / 8 : C.bid;
            pg8::InprojSched S{C.G, vid, (const char*)C_H, (const char*)(C_WIN + (size_t)l * INC * D), C_CTLW + CW_INP + l * 128, C_CTLW + CW_INP + 256 + l * 64, (l == DEPTH - 1 || C.G != 256) ? 0 : 8};
            pg8::EpiP E{C_P, C_ROPE};
            pg8::gemm_phase<D>(C.lds, S, E);
        }
        if (IN(pb + 1)) { const Ctx C = fresh(C0); ph_mixers(C, l); } SEAM(pb + 1);
        if (IN(pb + 2)) {
            const Ctx C = fresh(C0);
            pg8::DenseSched<D / 256, D> S{SEQ / 256, C.G, C.bid, (const char*)C_MIX, (const char*)(C_WOUT + (size_t)l * D * D)};
            pg8::EpiTln E{C.in, C.ws + C.z, l};
            pg8::gemm_phase<D>(C.lds, S, E);
        }
        SEAM(pb + 3);
        if (IN(pb + 4)) {
            const Ctx C = fresh(C0);
            compute_toff(C, l);
            const int vid = (C.G % 8 == 0) ? (C.bid % 8) * (C.G / 8) + C.bid / 8 : C.bid;
            unsigned* mtc = C_CTLW + CW_MTC + l * (128 * 64);
            { pg8::MoeSched1 S{(const LAS int*)(C.lds + TOFF_OFF), C.G, vid, (const char*)C_H2, (const char*)(C_WGU + (size_t)l * NE * 1024 * D), mtc, C_LIST, C_SWL};
              pg8::EpiMoe1 E{C_HID};
              pg8::gemm_phase<D, pg8::EpiMoe1, pg8::MoeSched1, true, true, true, true>(C.lds, S, E); }
            { pg8::MoeSched2 S{(const LAS int*)(C.lds + TOFF_OFF), C.G, vid, (const char*)C_HID, (const char*)(C_WD + (size_t)l * NE * D * FF), mtc};
              pg8::EpiBf16 E{C_Y, D};
              pg8::gemm_phase<FF, pg8::EpiBf16, pg8::MoeSched2, true, false, false, true>(C.lds, S, E); }
        }
        SEAM(pb + 4);
        if (IN(pb + 5)) { const Ctx C = fresh(C0); ph_ln2(C, l); }
        if (!last) SEAM(pb + 5);
    }
#undef IN
#undef SEAM
}

#ifndef MK_N_LAUNCHES
#define MK_N_LAUNCHES 1
#endif
extern "C" void kernel_launch(void* const* d_in, const int* in_sizes, int n_in, void* d_out, int out_size, void* d_ws, size_t ws_size, hipStream_t stream) {
    static int grid = 0;
    if (grid == 0) {
        if (n_in != 23 || out_size != SEQ * D || ws_size < WS_END) {
            fprintf(stderr, "kernel_launch: unexpected shapes: n_in %d out %d ws %zu (need %zu)\n", n_in, out_size, ws_size, (size_t)WS_END); grid = -1; return; }
        int dev = 0, cus = 0;
        if (hipGetDevice(&dev) != hipSuccess || hipDeviceGetAttribute(&cus, hipDeviceAttributeMultiprocessorCount, dev) != hipSuccess) { grid = -1; return; }
        if (hipFuncSetAttribute((const void*)fwd_kernel, hipFuncAttributeMaxDynamicSharedMemorySize, LDS_BYTES) != hipSuccess) { fprintf(stderr, "kernel_launch: hipFuncSetAttribute failed\n"); grid = -1; return; }
        int per_cu = 0;
        if (hipOccupancyMaxActiveBlocksPerMultiprocessor(&per_cu, (const void*)fwd_kernel, NTHREADS, LDS_BYTES) != hipSuccess || per_cu < 1) fprintf(stderr, "kernel_launch: occupancy query says %d\n", per_cu);
        (void)hipGetLastError();
        grid = cus;
    }
    if (grid < 0) return;
    hipMemsetAsync((char*)d_ws + WS_CTL, 0, CTL_BYTES, stream);
    Args a{};
    for (int i = 0; i < 23; ++i) a.in[i] = (const float*)d_in[i];
    a.out = (float*)d_out; a.ws = (unsigned char*)d_ws;
    if (MK_N_LAUNCHES == 1) {
        a.ph_lo = 0; a.ph_hi = N_PHASES;
        hipLaunchKernelGGL(fwd_kernel, dim3(grid), dim3(NTHREADS), LDS_BYTES, stream, a);
    } else {
        for (int p = 0; p < N_PHASES; ++p) {
            a.ph_lo = p; a.ph_hi = p + 1;
            hipLaunchKernelGGL(fwd_kernel, dim3(grid), dim3(NTHREADS), LDS_BYTES, stream, a);
        }
    }
    const hipError_t le = hipPeekAtLastError();
    if (le != hipSuccess) fprintf(stderr, "kernel_launch: launch failed: %s\n", hipGetErrorName(le));
}
```

```cpp
#include <hip/hip_runtime.h>
#include <cstdio>
#include <cstdint>

#define LAS __attribute__((address_space(3)))
typedef unsigned short bf16_t;

constexpr int D = 2048, SEQ = 8192, CTXL = 256, NTOK = SEQ + CTXL;
constexpr int DEPTH = 2, GRID_W = 64, HD = 128;
constexpr int INC = 4608;
constexpr int OFF_AK = 768, OFF_AV = 1024, OFF_BQ = 1280, OFF_BK = 2048, OFF_BV = 2816, OFF_C = 3584;
constexpr int NE = 32, FF = 512, CW = 512;
constexpr float LN_EPS = 1e-5f;
constexpr float ALPHA = 1.4142135623730951f;
constexpr float QSCALE = 0.08838834764831845f;
constexpr int NTHREADS = 512, NWAVES = 8;

typedef bf16_t AT;
__device__ __forceinline__ float ldv(const float* p) { return *p; }
__device__ __forceinline__ void stv(float* p, float v) { *p = v; }
__device__ __forceinline__ float bf2f(bf16_t b) { return __uint_as_float(((unsigned)b) << 16); }
__device__ __forceinline__ bf16_t f2bf(float f) { unsigned u = __float_as_uint(f); return (bf16_t)((u + 0x7fffu + ((u >> 16) & 1u)) >> 16); }
__device__ __forceinline__ float ldv(const bf16_t* p) { return bf2f(*p); }
__device__ __forceinline__ void stv(bf16_t* p, float v) { *p = f2bf(v); }

__device__ __forceinline__ float4 ld4(const float* p) { return *(const float4*)p; }
__device__ __forceinline__ void st4(float* p, float4 v) { *(float4*)p = v; }
__device__ __forceinline__ float4 ld4(const bf16_t* p) { const uint2 u = *(const uint2*)p; float4 r; r.x = __uint_as_float(u.x << 16); r.y = __uint_as_float(u.x & 0xffff0000u); r.z = __uint_as_float(u.y << 16); r.w = __uint_as_float(u.y & 0xffff0000u); return r; }
__device__ __forceinline__ void st4(bf16_t* p, float4 v) { uint2 u; u.x = (unsigned)f2bf(v.x) | ((unsigned)f2bf(v.y) << 16); u.y = (unsigned)f2bf(v.z) | ((unsigned)f2bf(v.w) << 16); *(uint2*)p = u; }

constexpr size_t MiB = 1u << 20;
constexpr size_t WS_CTL = 0, CTL_BYTES = 1 * MiB;
constexpr int CW_BAR = 4096, CW_CNT = 16384, CW_CUR = 16384 + 128;
constexpr size_t WS_MOD = 1 * MiB;
constexpr size_t WS_ROPE = 2 * MiB;
constexpr size_t WS_ROUTE = 3 * MiB;
constexpr size_t WS_SLOT = 3 * MiB + 512 * 1024;
constexpr size_t WS_SW = 4 * MiB;
constexpr size_t WS_WRT = 4 * MiB + 512 * 1024;
constexpr size_t WS_MODP = 5 * MiB;
constexpr int MAXSLOT = 25088;
constexpr size_t WS_WIN = 8 * MiB;
constexpr size_t WS_WOUT = 44 * MiB;
constexpr size_t WS_WGU = 64 * MiB;
constexpr size_t WS_WD = 320 * MiB;
constexpr size_t WS_H = 448 * MiB;
constexpr size_t WS_P = 482 * MiB;
constexpr size_t WS_MIX = 558 * MiB;
constexpr size_t WS_T = 592 * MiB;
constexpr size_t WS_X1 = 660 * MiB;
constexpr size_t WS_XB = 728 * MiB;
constexpr size_t WS_H2 = 796 * MiB;
constexpr size_t WS_HS = 830 * MiB;
constexpr size_t WS_HID = 930 * MiB;
constexpr size_t WS_Y = 956 * MiB;
constexpr size_t WS_END = 1056 * MiB;

constexpr size_t WS_XW = WS_X1 + 4 * MiB;
constexpr int CW_OUT = 65536;
constexpr int LDS_BYTES = 163840;

#define XB_TMO      128
#define XB_XCNT(j)  (256  + 64 * (j))
#define XB_XSUB(j)  (1280 + 64 * (j))
#define XB_XGEN(j)  (2304 + 64 * (j))
#define XB_TOP      3328
#define XB_TOPGEN   3392
#define XCD_BAR_WORDS 3456
#define XB_SPIN_CAP (1u << 18)
__device__ __forceinline__ unsigned xb_ld(unsigned* p)              { return __hip_atomic_load(p, __ATOMIC_RELAXED, __HIP_MEMORY_SCOPE_AGENT); }
__device__ __forceinline__ unsigned xb_add(unsigned* p, unsigned v) { return __hip_atomic_fetch_add(p, v, __ATOMIC_RELAXED, __HIP_MEMORY_SCOPE_AGENT); }
__device__ __forceinline__ unsigned xb_xcc_id() { return (unsigned)__builtin_amdgcn_s_getreg((3 << 11) | 20) & 0xFu; }
#define XB_SPIN(cond, bar) do { unsigned _sp = 0; while (cond) { __builtin_amdgcn_s_sleep(1); \
    if ((++_sp & 255u) == 0u) { if (xb_ld(&(bar)[XB_TMO])) break; if (_sp > XB_SPIN_CAP) { atomicAdd(&(bar)[XB_TMO], 1u); break; } } } } while (0)
struct XcdBarrier { unsigned* bar; unsigned x; volatile LAS unsigned* st; };
__device__ __forceinline__ XcdBarrier xcd_barrier_post(unsigned* bar, volatile LAS unsigned* st) {
    XcdBarrier b; b.bar = bar; b.x = xb_xcc_id(); b.st = st;
    if (threadIdx.x == 0) (void)xb_add(&bar[XB_XCNT(b.x)], 1u);
    return b;
}
__device__ __forceinline__ void xcd_barrier_complete(unsigned* bar, unsigned x, unsigned& nloc, unsigned& nx) {
    const unsigned G = gridDim.x * gridDim.y * gridDim.z;
    unsigned sum, cnt, mine, sp = 0u;
    for (;;) {
        sum = 0u; cnt = 0u; mine = 0u;
#pragma unroll
        for (unsigned j = 0; j < 16; ++j) { const unsigned c = xb_ld(&bar[XB_XCNT(j)]); sum += c; cnt += (c > 0u) ? 1u : 0u; mine = (j == x) ? c : mine; }
        if (sum == G) break;
        __builtin_amdgcn_s_sleep(1);
        if ((++sp & 255u) == 0u) { if (xb_ld(&bar[XB_TMO])) break; if (sp > XB_SPIN_CAP) { atomicAdd(&bar[XB_TMO], 1u); break; } }
    }
    nloc = mine > 0u ? mine : 1u; nx = cnt > 0u ? cnt : 1u;
}
__device__ __noinline__ void xcd_barrier(const XcdBarrier b) {
    asm volatile("s_waitcnt vmcnt(0)" ::: "memory");
    __syncthreads();
    if (threadIdx.x == 0) {
        unsigned* bar = b.bar;
        __builtin_amdgcn_s_waitcnt(0);
        unsigned nloc = b.st[0], nx = b.st[1];
        if (nloc == 0u) { xcd_barrier_complete(bar, b.x, nloc, nx); b.st[0] = nloc; b.st[1] = nx; }
        const unsigned old = xb_add(&bar[XB_XSUB(b.x)], 1u);
        const unsigned gen = old / nloc;
        if (old + 1u == (gen + 1u) * nloc) {
            __builtin_amdgcn_fence(__ATOMIC_RELEASE, "agent");
            asm volatile("s_waitcnt vmcnt(0)" ::: "memory");
            const unsigned og = xb_add(&bar[XB_TOP], 1u);
            const unsigned tg = og / nx;
            if (og + 1u == (tg + 1u) * nx) xb_add(&bar[XB_TOPGEN], 1u);
            else XB_SPIN(xb_ld(&bar[XB_TOPGEN]) == tg, bar);
            __builtin_amdgcn_fence(__ATOMIC_ACQUIRE, "agent");
            xb_add(&bar[XB_XGEN(b.x)], 1u);
            asm volatile("s_waitcnt vmcnt(0)" ::: "memory");
        } else {
            XB_SPIN(xb_ld(&bar[XB_XGEN(b.x)]) == gen, bar);
            __builtin_amdgcn_fence(__ATOMIC_ACQUIRE, "agent");
            asm volatile("s_waitcnt vmcnt(0)" ::: "memory");
        }
    }
    __syncthreads();
}

struct Args {
    const float* in[23];
    float* out;
    unsigned char* ws;
    int ph_lo, ph_hi;
};

struct Ctx {
    LAS unsigned char* lds;
    int tid, lane, wave, G, bid;
    const float* const* in;
    float* out;
    unsigned char* ws;
    size_t z;
};
#define CIN(k) (C.in[k] + C.z)
#define C_x CIN(0)
#define C_c CIN(1)
#define C_ctx CIN(2)
#define C_c_ctx CIN(3)
#define C_w_mod CIN(4)
#define C_b_mod CIN(5)
#define C_w_in CIN(6)
#define C_sink CIN(7)
#define C_rpb CIN(8)
#define C_sgu_g CIN(9)
#define C_sgu_bn CIN(10)
#define C_sgu_w CIN(11)
#define C_sgu_b CIN(12)
#define C_w_out CIN(13)
#define C_ln1_g CIN(14)
#define C_ln1_b CIN(15)
#define C_w_router CIN(16)
#define C_router_bias CIN(17)
#define C_w_gate CIN(18)
#define C_w_up CIN(19)
#define C_w_down CIN(20)
#define C_ln2_g CIN(21)
#define C_ln2_b CIN(22)
#define C_MOD ((float*)(C.ws + C.z + WS_MOD))
#define C_ROPE ((float*)(C.ws + C.z + WS_ROPE))
#define C_ROUTE ((int*)(C.ws + C.z + WS_ROUTE))
#define C_H ((AT*)(C.ws + C.z + WS_H))
#define C_P ((AT*)(C.ws + C.z + WS_P))
#define C_MIX ((AT*)(C.ws + C.z + WS_MIX))
#define C_T ((bf16_t*)(C.ws + C.z + WS_T))
#define C_X1 ((float*)(C.ws + C.z + WS_X1))
#define C_STAT ((float*)(C.ws + C.z + WS_X1))
#define C_XB ((float*)(C.ws + C.z + WS_XB))
#define C_H2 ((AT*)(C.ws + C.z + WS_H2))
#define C_HID ((AT*)(C.ws + C.z + WS_HID))
#define C_Y ((AT*)(C.ws + C.z + WS_Y))
#define C_HS ((AT*)(C.ws + C.z + WS_HS))
#define C_WRT ((bf16_t*)(C.ws + C.z + WS_WRT))
constexpr int LCAP = NTOK;
#define C_LIST ((int*)(C.ws + C.z + WS_HS))
#define C_SWL ((float*)(C.ws + C.z + WS_HS + 2 * MiB))
#define C_SLOT ((int*)(C.ws + C.z + WS_SLOT))
#define C_SW ((float*)(C.ws + C.z + WS_SW))
#define C_MODP ((float*)(C.ws + C.z + WS_MODP))
#define C_CTLW ((unsigned*)(C.ws + C.z + WS_CTL))
constexpr int WS_POS_OFF = 3 * 1024 * 1024 + 768 * 1024;
#define C_POS ((int*)(C.ws + C.z + WS_POS_OFF))
#define C_WIN ((bf16_t*)(C.ws + C.z + WS_WIN))
#define C_WOUT ((bf16_t*)(C.ws + C.z + WS_WOUT))
#define C_WGU ((bf16_t*)(C.ws + C.z + WS_WGU))
#define C_WD ((bf16_t*)(C.ws + C.z + WS_WD))

__device__ __forceinline__ float silu_f(float v) { return v / (1.f + expf(-v)); }
__device__ __forceinline__ float gelu_tanh_f(float v) { return 0.5f * v * (1.f + tanhf(0.7978845608028654f * (v + 0.044715f * v * v * v))); }
__device__ __forceinline__ float wave_sum(float v) {
#pragma unroll
    for (int o = 1; o < 64; o <<= 1) v += __shfl_xor(v, o);
    return v;
}
__device__ __forceinline__ float wave_max(float v) {
#pragma unroll
    for (int o = 1; o < 64; o <<= 1) v = fmaxf(v, __shfl_xor(v, o));
    return v;
}
__device__ __forceinline__ const float* modp(const Ctx& C, int l, int kind, int j) { return C_MOD + ((size_t)(l * 2 + kind) * 6 + j) * D; }
__device__ __forceinline__ const float* xin_row(const Ctx& C, int l, int r) {
    if (l == 0) return r < SEQ ? C_x + (size_t)r * D : C_ctx + (size_t)(r - SEQ) * D;
    return C_XB + (size_t)r * D;
}

namespace pg8 {
#define PG8_LAS __attribute__((address_space(3)))
typedef short bf16x8 __attribute__((ext_vector_type(8)));
typedef float f32x4 __attribute__((ext_vector_type(4)));
typedef unsigned u32x4 __attribute__((ext_vector_type(4)));
constexpr int BM = 256, BK = 64, HALF = 128, HTB = HALF * BK * 2, STAGE_BYTES = 8 * HTB, NXCD = 8, WGM = 8;
__host__ __device__ __forceinline__ int lds_byte(int r, int c) { const int st = (r >> 4) * 2 + (c >> 5), rr = r & 15, cc = c & 31, ob = rr * 64 + cc * 2; return st * 1024 + (ob ^ (((ob >> 9) & 1) << 5)); }
__host__ __device__ __forceinline__ void stage_rc(int b, int& R, int& C) { const int st = b / 1024, sb = b % 1024, swz = sb ^ (((sb >> 9) & 1) << 5); R = (st >> 1) * 16 + swz / 64; C = (st & 1) * 32 + (swz % 64) / 2; }
__host__ __device__ __forceinline__ int perm32(int rho) { const int n = rho >> 4, i = rho & 15; return 8 * (i >> 2) + 4 * n + (i & 3); }
__device__ __forceinline__ unsigned cvt_pk_bf16(float lo, float hi) { unsigned r; asm volatile("v_cvt_pk_bf16_f32 %0, %1, %2" : "=v"(r) : "v"(lo), "v"(hi)); return r; }

__device__ __forceinline__ void store16_wt(void* p, u32x4 v) { asm volatile("global_store_dwordx4 %0, %1, off sc1\n\ts_nop 1" :: "v"(p), "v"(v) : "memory"); }
struct Unit { int pm, pn; const char* A; const char* B; const int* rows; const float* sw; int nvalid; };

template <int NN  , int KD>
struct DenseSched {
    int nM, G, c; const char* A; const char* Bt;
    __device__ __forceinline__ bool next(int i, Unit& u) const {
        const int nwg = nM * NN;
        const int L = i * G + c; if (L >= nwg) return false;
        int wgid = L; { const int q = nwg / NXCD, r = nwg % NXCD, xcd = wgid % NXCD, off = wgid / NXCD; wgid = (xcd < r ? xcd * (q + 1) : r * (q + 1) + (xcd - r) * q) + off; }
        const int nig = WGM * NN, gid = wgid / nig, fm = gid * WGM, gsz = (nM - fm) < WGM ? (nM - fm) : WGM;
        u.pm = fm + ((wgid % nig) % gsz); u.pn = (wgid % nig) / gsz;
        u.A = A + (size_t)u.pm * (BM * KD * 2); u.B = Bt + (size_t)u.pn * (BM * KD * 2); return true;
    }
    __device__ __forceinline__ void a_ready(const Unit&) const {}
    __device__ __forceinline__ void done(const Unit&) const {}
};
struct InprojSched {
    int G, v; const char* A; const char* Bt; unsigned* cnt; unsigned* cnt3; int ded;
    __device__ __forceinline__ bool next(int i, Unit& u) const {
        constexpr int N1 = (NTOK / 256) * 14, N2 = (NTOK / 256) * 4;
        int j;
        if (i == 0) j = v;
        else if (i == 1) { if (v >= G - ded) return false; j = G + v; }
        else j = i * G - ded + v;
        if (j >= N1 + N2) return false;
        if (j < 14) { u.pm = 32; u.pn = j; }
        else if (j < 18) { u.pm = 32; u.pn = j; }
        else if (j < 18 + 8 * 56) { const int k = j - 18, g = k / 56, r = k % 56; u.pm = 4 * g + (r & 3); u.pn = r >> 2; }
        else { const int jj = j - 18 - 8 * 56; const int g = jj >> 5, r = jj & 31; u.pm = 8 * g + (r & 7); u.pn = 14 + (r >> 3); }
        u.A = A + (size_t)u.pm * (BM * D * 2); u.B = Bt + (size_t)u.pn * (BM * D * 2); return true;
    }
    __device__ __forceinline__ void a_ready(const Unit&) const {}
    __device__ __forceinline__ void done(const Unit& u) const {
        asm volatile("s_waitcnt vmcnt(0)" ::: "memory");
        __builtin_amdgcn_s_barrier();
        if (threadIdx.x == 0) {
            const bool ctxt = (u.pm == SEQ / BM);
            __hip_atomic_fetch_add(u.pn < 14 ? cnt : (ctxt ? cnt3 : cnt + 64), 1u, __ATOMIC_RELAXED, __HIP_MEMORY_SCOPE_AGENT);
            if (ctxt && u.pn < 14) __hip_atomic_fetch_add(cnt3 + 32, 1u, __ATOMIC_RELAXED, __HIP_MEMORY_SCOPE_AGENT);
        }
    }
};
struct OneUnit { Unit u0; __device__ __forceinline__ bool next(int i, Unit& u) const { if (i != 0) return false; u = u0; return true; }
    __device__ __forceinline__ void a_ready(const Unit&) const {}
    __device__ __forceinline__ void done(const Unit&) const {} };
__device__ __forceinline__ int moe_expert_of(const PG8_LAS int* toff, int mt) { int e = 0; for (int q = 1; q < 32; ++q) e += (toff[q] <= mt) ? 1 : 0; return e; }
struct MoeSched1 {
    const PG8_LAS int* toff; int G, v; const char* A; const char* B; unsigned* mtc; const int* list; const float* swl;
    __device__ __forceinline__ bool next(int i, Unit& u) const {
        const int MT = toff[32];
        const int L = i * G + v; if (L >= MT * 4) return false;
        const int mt = L >> 2, pn = L & 3, e = moe_expert_of(toff, mt), p0 = 256 * (mt - toff[e]);
        u.pm = mt; u.pn = pn; u.A = A; u.B = B + (size_t)(e * 1024 + pn * 256) * (D * 2);
        u.rows = list + (size_t)e * NTOK + p0; u.sw = swl + (size_t)e * NTOK + p0; const int left = toff[40 + e] - p0; u.nvalid = left < 256 ? left : 256; return true;
    }
    __device__ __forceinline__ void a_ready(const Unit&) const {}
    __device__ __forceinline__ void done(const Unit& u) const {
        asm volatile("s_waitcnt vmcnt(0)" ::: "memory");
        __builtin_amdgcn_s_barrier();
        if (threadIdx.x == 0) __hip_atomic_fetch_add(mtc + 64 * u.pm, 1u, __ATOMIC_RELAXED, __HIP_MEMORY_SCOPE_AGENT);
    }
};
struct MoeSched2 {
    const PG8_LAS int* toff; int G, v; const char* A; const char* B; unsigned* mtc;
    __device__ __forceinline__ bool next(int i, Unit& u) const {
        const int MT = toff[32], N1 = MT * 4, N2 = MT * 8;
        const int r1 = N1 % G, nl = G - r1;
        const bool light = v >= r1;
        int j;
        if (light && i < 3) j = i * nl + (v - r1);
        else { const int ii = light ? i - 3 : i; j = 3 * nl + ii * G + (light ? v - r1 : nl + v); }
        if (j >= N2) return false;
        const int mt = j >> 3, pn = j & 7, e = moe_expert_of(toff, mt);
        u.pm = mt; u.pn = pn; u.A = A + (size_t)mt * (256 * FF * 2); u.B = B + (size_t)(e * D + pn * 256) * (FF * 2);
        const int left = toff[40 + e] - 256 * (mt - toff[e]); u.nvalid = left < 256 ? left : 256; return true;
    }
    __device__ __forceinline__ void a_ready(const Unit& u) const {
        if (threadIdx.x < 64) {
            unsigned sp = 0;
            while ((unsigned)__builtin_amdgcn_readfirstlane((int)__hip_atomic_load(mtc + 64 * u.pm, __ATOMIC_RELAXED, __HIP_MEMORY_SCOPE_AGENT)) < 4u) { __builtin_amdgcn_s_sleep(2); if (++sp > (1u << 22)) break; }
            __builtin_amdgcn_fence(__ATOMIC_ACQUIRE, "agent");
            asm volatile("s_waitcnt vmcnt(0)" ::: "memory");
        }
        asm volatile("" ::: "memory"); __builtin_amdgcn_s_barrier(); asm volatile("" ::: "memory");
    }
    __device__ __forceinline__ void done(const Unit&) const {}
};

struct EpiBf16 {
    static constexpr bool PERM = true, FUSED = false;
    bf16_t* O; int ldc;
    __device__ __forceinline__ void operator()(const f32x4 (&acc)[2][2][4][2], const Unit& u, int wr, int wc, int fr, int fq) const {
        const int row0 = u.pm * BM + wr * 64 + fr, col0 = u.pn * BM + wc * 32 + 8 * fq;
#pragma unroll
        for (int ai = 0; ai < 2; ++ai)
#pragma unroll
            for (int m = 0; m < 4; ++m) { bf16_t* rowp = O + (size_t)(row0 + ai * HALF + m * 16) * ldc + col0;
#pragma unroll
                for (int bj = 0; bj < 2; ++bj) { const f32x4 v0 = acc[ai][bj][m][0], v1 = acc[ai][bj][m][1];
                    u32x4 w; w.x = cvt_pk_bf16(v0[0], v0[1]); w.y = cvt_pk_bf16(v0[2], v0[3]); w.z = cvt_pk_bf16(v1[0], v1[1]); w.w = cvt_pk_bf16(v1[2], v1[3]);
                    *(u32x4*)(rowp + bj * HALF) = w; } }
    }
};
struct EpiP {
    static constexpr bool PERM = true, FUSED = false;
    bf16_t* O; const float* rope;
    __device__ __forceinline__ void operator()(const f32x4 (&acc)[2][2][4][2], const Unit& u, int wr, int wc, int fr, int fq) const {
        const int row0 = u.pm * BM + wr * 64 + fr, col0 = u.pn * BM + wc * 32 + 8 * fq;
        const bool rot = (u.pn < 4) && (u.pm < SEQ / BM);
#pragma unroll
        for (int ai = 0; ai < 2; ++ai)
#pragma unroll
            for (int m = 0; m < 4; ++m) { const int row = row0 + ai * HALF + m * 16; bf16_t* rowp = O + (size_t)row * INC + col0;
#pragma unroll
                for (int bj = 0; bj < 2; ++bj) { f32x4 v0 = acc[ai][bj][m][0], v1 = acc[ai][bj][m][1];
                    if (rot) {
                        const int i0 = ((col0 + bj * HALF) & 127) >> 1;
                        const int comp = (i0 < 32) ? (row >> 6) : (row & 63);
                        const f32x4 cs = *(const f32x4*)(rope + comp * 32 + (i0 & 31)), sn = *(const f32x4*)(rope + 4096 + comp * 32 + (i0 & 31));
                        const f32x4 a = v0, b = v1;
                        v0[0] = a[0] * cs[0] - a[1] * sn[0]; v0[1] = a[1] * cs[0] + a[0] * sn[0];
                        v0[2] = a[2] * cs[1] - a[3] * sn[1]; v0[3] = a[3] * cs[1] + a[2] * sn[1];
                        v1[0] = b[0] * cs[2] - b[1] * sn[2]; v1[1] = b[1] * cs[2] + b[0] * sn[2];
                        v1[2] = b[2] * cs[3] - b[3] * sn[3]; v1[3] = b[3] * cs[3] + b[2] * sn[3];
                    }
                    u32x4 w; w.x = cvt_pk_bf16(v0[0], v0[1]); w.y = cvt_pk_bf16(v0[2], v0[3]); w.z = cvt_pk_bf16(v1[0], v1[1]); w.w = cvt_pk_bf16(v1[2], v1[3]);
                    store16_wt(rowp + bj * HALF, w); } }
    }
};
struct EpiTres {
    static constexpr bool PERM = true, FUSED = false;
    bf16_t* T; const float* xl; const float* xc; const float* gl; const float* gc;
    __device__ __forceinline__ void operator()(const f32x4 (&acc)[2][2][4][2], const Unit& u, int wr, int wc, int fr, int fq) const {
        const int row0 = u.pm * BM + wr * 64 + fr, col0 = u.pn * BM + wc * 32 + 8 * fq;
        const bool isctx = (u.pm == SEQ / BM);
        const float* xb = isctx ? xc - (size_t)SEQ * D : xl; const float* gb = isctx ? gc : gl;
        f32x4 gv[2][2];
#pragma unroll
        for (int bj = 0; bj < 2; ++bj)
#pragma unroll
            for (int n = 0; n < 2; ++n) gv[bj][n] = *(const f32x4*)(gb + col0 + bj * HALF + n * 4);
#pragma unroll
        for (int ai = 0; ai < 2; ++ai)
#pragma unroll
            for (int m = 0; m < 4; ++m) { const size_t off = (size_t)(row0 + ai * HALF + m * 16) * D + col0;
#pragma unroll
                for (int bj = 0; bj < 2; ++bj) { const f32x4 x0 = *(const f32x4*)(xb + off + bj * HALF), x1 = *(const f32x4*)(xb + off + bj * HALF + 4);
                    const f32x4 v0 = x0 * ALPHA + gv[bj][0] * acc[ai][bj][m][0], v1 = x1 * ALPHA + gv[bj][1] * acc[ai][bj][m][1];
                    u32x4 w; w.x = cvt_pk_bf16(v0[0], v0[1]); w.y = cvt_pk_bf16(v0[2], v0[3]); w.z = cvt_pk_bf16(v1[0], v1[1]); w.w = cvt_pk_bf16(v1[2], v1[3]);
                    *(u32x4*)(T + off + bj * HALF) = w; }
                if (m == 3) asm volatile("" ::: "memory"); }
    }
};
struct EpiMoe1 {
    static constexpr bool PERM = true, FUSED = false;
    bf16_t* HID;
    __device__ __forceinline__ void operator()(const f32x4 (&acc)[2][2][4][2], const Unit& u, int wr, int wc, int fr, int fq) const {
        const int row0 = u.pm * BM + wr * 64 + fr, col0 = u.pn * HALF + wc * 32 + 8 * fq;
#pragma unroll
        for (int ai = 0; ai < 2; ++ai)
#pragma unroll
            for (int m = 0; m < 4; ++m) { const int row = row0 + ai * HALF + m * 16; const int rl = row - u.pm * BM; const float w = (rl < u.nvalid) ? u.sw[rl] : 0.f;
                float h[8];
#pragma unroll
                for (int n = 0; n < 2; ++n)
#pragma unroll
                    for (int j = 0; j < 4; ++j) { const float g = acc[ai][0][m][n][j], up = acc[ai][1][m][n][j]; h[4 * n + j] = g / (1.f + __expf(-g)) * up * w; }
                u32x4 o; o.x = cvt_pk_bf16(h[0], h[1]); o.y = cvt_pk_bf16(h[2], h[3]); o.z = cvt_pk_bf16(h[4], h[5]); o.w = cvt_pk_bf16(h[6], h[7]);
                store16_wt(HID + (size_t)row * FF + col0, o); }
    }
};

__device__ __forceinline__ void store4_wt(void* p, unsigned v) { asm volatile("global_store_dword %0, %1, off sc1" :: "v"(p), "v"(v) : "memory"); }
struct EpiTln {
    static constexpr bool PERM = true, FUSED = true;
    const float* const* in; unsigned char* ws; int l;
    __device__ __forceinline__ void fused(f32x4 (&acc)[2][2][4][2], const Unit& u, int wr, int wc, int fr_, int fq_, PG8_LAS unsigned char* lds, int wid, int lane_) const {
        typedef float f32x2v __attribute__((ext_vector_type(2)));
        int lane = lane_; asm volatile("" : "+v"(lane));
        const int fr = lane & 15, fq = lane >> 4;
        const int tid = wid * 64 + lane;
        const bool isctx = (u.pm == SEQ / BM);
        bf16_t* T = (bf16_t*)(ws + WS_T); bf16_t* H2 = (bf16_t*)(ws + WS_H2);
        const float* xl = l == 0 ? in[0] : (const float*)(ws + WS_XB); const float* xc = l == 0 ? in[2] : (const float*)(ws + WS_XB) + (size_t)SEQ * D;
        const float* mod = (const float*)(ws + WS_MOD) + (size_t)(l * 2) * 6 * D;
        const float* g1 = in[14] + l * D; const float* b1 = in[15] + l * D; const float* wrf = in[16]; const bf16_t* wrt = (const bf16_t*)(ws + WS_WRT); const float* rbias = in[17];
        unsigned char* xw = ws + WS_XW + (size_t)l * (16 * MiB);
        unsigned* cnt = (unsigned*)(ws + WS_CTL) + CW_OUT + l * (64 * 64); float* stat = (float*)(ws + WS_X1); unsigned* ecnt = (unsigned*)(ws + WS_CTL) + CW_CNT + l * 32;
        int* pos = (int*)(ws + WS_POS_OFF); int* route = (int*)(ws + WS_ROUTE); int* list = (int*)(ws + WS_HS); float* swl = (float*)(ws + WS_HS + 2 * MiB);
        const float* xb = isctx ? xc - (size_t)SEQ * D : xl; const float* md = mod + (isctx ? 6 * D : 0);
        const int col0 = u.pn * BM + wc * 32 + 8 * fq;
        constexpr int RP = 36;
        PG8_LAS float* RED = (PG8_LAS float*)lds;
        PG8_LAS f32x2v* P = (PG8_LAS f32x2v*)(lds + 73728);
        PG8_LAS f32x2v* S = (PG8_LAS f32x2v*)(lds + 81920);
        PG8_LAS float* SCO = (PG8_LAS float*)(lds + 83968);
        PG8_LAS float* CB = (PG8_LAS float*)(lds + 92416);
        PG8_LAS float* GB = (PG8_LAS float*)(lds + 96768);
        PG8_LAS int* hist = (PG8_LAS int*)(lds + 98816);
        PG8_LAS int* rinfo = hist + 64;
        PG8_LAS int* rrank = rinfo + 128;
        if (tid < 256) { const int c = u.pn * BM + tid; const float sc = md[4 * D + c]; GB[tid] = g1[c] * (1.f + sc); GB[256 + tid] = b1[c] * (1.f + sc) + md[3 * D + c]; }
        if (tid < 32) hist[tid] = 0;
        u32x4 wq[2][4][2];
        {
            f32x4 gv[2][2];
#pragma unroll
            for (int bj = 0; bj < 2; ++bj)
#pragma unroll
                for (int n = 0; n < 2; ++n) gv[bj][n] = *(const f32x4*)(md + 2 * D + col0 + bj * HALF + n * 4);
#pragma unroll
            for (int ai = 0; ai < 2; ++ai)
#pragma unroll
                for (int m = 0; m < 4; ++m) { const int rl = ai * HALF + wr * 64 + m * 16 + fr; const size_t off = (size_t)(u.pm * BM + rl) * D + col0;
                    float tv[16];
#pragma unroll
                    for (int bj = 0; bj < 2; ++bj) { f32x4 x0, x1;
                        if (l == 0) { x0 = *(const f32x4*)(xb + off + bj * HALF); x1 = *(const f32x4*)(xb + off + bj * HALF + 4); }
                        else { const u32x4 xr = *(const u32x4*)((const bf16_t*)(ws + WS_XB) + off + bj * HALF);
                            x0 = (f32x4){__uint_as_float(xr.x << 16), __uint_as_float(xr.x & 0xffff0000u), __uint_as_float(xr.y << 16), __uint_as_float(xr.y & 0xffff0000u)};
                            x1 = (f32x4){__uint_as_float(xr.z << 16), __uint_as_float(xr.z & 0xffff0000u), __uint_as_float(xr.w << 16), __uint_as_float(xr.w & 0xffff0000u)}; }
                        const f32x4 v0 = x0 * ALPHA + gv[bj][0] * acc[ai][bj][m][0], v1 = x1 * ALPHA + gv[bj][1] * acc[ai][bj][m][1];
                        u32x4 w; w.x = cvt_pk_bf16(v0[0], v0[1]); w.y = cvt_pk_bf16(v0[2], v0[3]); w.z = cvt_pk_bf16(v1[0], v1[1]); w.w = cvt_pk_bf16(v1[2], v1[3]);
                        *(u32x4*)(T + off + bj * HALF) = w; wq[ai][m][bj] = w;
#pragma unroll
                        for (int j = 0; j < 4; ++j) { tv[8 * bj + 2 * j] = __uint_as_float(w[j] << 16); tv[8 * bj + 2 * j + 1] = __uint_as_float(w[j] & 0xffff0000u); } }
                    float s = 0.f;
#pragma unroll
                    for (int j = 0; j < 16; j += 4) s += (tv[j] + tv[j + 1]) + (tv[j + 2] + tv[j + 3]);
                    s += __shfl_xor(s, 16); s += __shfl_xor(s, 32);
                    const float mw = s * (1.0f / 64.0f); float q = 0.f;
#pragma unroll
                    for (int j = 0; j < 16; ++j) { const float d = tv[j] - mw; q += d * d; }
                    q += __shfl_xor(q, 16); q += __shfl_xor(q, 32);
                    if (fq == 0) P[rl * 4 + wc] = (f32x2v){mw, q};
                    if (m == 3) asm volatile("" ::: "memory"); }
        }
        asm volatile("s_waitcnt lgkmcnt(0)" ::: "memory"); __builtin_amdgcn_s_barrier(); asm volatile("" ::: "memory");
        u32x4 wh[2][2], wl[2][2];
#pragma unroll
        for (int bj = 0; bj < 2; ++bj)
#pragma unroll
            for (int nt = 0; nt < 2; ++nt) { const bf16_t* p = wrt + (size_t)(fr + 16 * nt) * D + col0 + bj * HALF; wh[bj][nt] = *(const u32x4*)p; wl[bj][nt] = *(const u32x4*)(p + (size_t)NE * D); }
        { const int e = tid & 31, part = tid >> 5; float cs = 0.f, bw = 0.f; const float* wp = wrf + (size_t)(u.pn * BM + part * 16) * NE + e;
          float wv[16];
#pragma unroll
          for (int c = 0; c < 16; ++c) wv[c] = wp[c * NE];
#pragma unroll
          for (int c = 0; c < 16; ++c) { cs += GB[part * 16 + c] * wv[c]; bw += GB[256 + part * 16 + c] * wv[c]; }
          CB[part * 64 + e] = cs; CB[part * 64 + 32 + e] = bw; }
        {
            bf16x8 Bh[2][2], Bl[2][2];
#pragma unroll
            for (int bj = 0; bj < 2; ++bj) {
                const f32x4 ga = *(const PG8_LAS f32x4*)(GB + bj * HALF + wc * 32 + 8 * fq), gb = *(const PG8_LAS f32x4*)(GB + bj * HALF + wc * 32 + 8 * fq + 4);
                const float gq[8] = {ga[0], ga[1], ga[2], ga[3], gb[0], gb[1], gb[2], gb[3]};
#pragma unroll
                for (int nt = 0; nt < 2; ++nt) {
                    const u32x4 h = wh[bj][nt], lo = wl[bj][nt]; float w[8];
#pragma unroll
                    for (int j = 0; j < 4; ++j) { w[2 * j] = (__uint_as_float(h[j] << 16) + __uint_as_float(lo[j] << 16)) * gq[2 * j]; w[2 * j + 1] = (__uint_as_float(h[j] & 0xffff0000u) + __uint_as_float(lo[j] & 0xffff0000u)) * gq[2 * j + 1]; }
                    u32x4 hh, ll;
#pragma unroll
                    for (int j = 0; j < 4; ++j) { hh[j] = cvt_pk_bf16(w[2 * j], w[2 * j + 1]); ll[j] = cvt_pk_bf16(w[2 * j] - __uint_as_float(hh[j] << 16), w[2 * j + 1] - __uint_as_float(hh[j] & 0xffff0000u)); }
                    Bh[bj][nt] = *reinterpret_cast<bf16x8*>(&hh); Bl[bj][nt] = *reinterpret_cast<bf16x8*>(&ll);
                }
            }
            f32x4 dd[2][4][2];
#pragma unroll
            for (int ai = 0; ai < 2; ++ai)
#pragma unroll
                for (int m = 0; m < 4; ++m)
#pragma unroll
                    for (int nt = 0; nt < 2; ++nt) { f32x4 d = {0.f, 0.f, 0.f, 0.f};
#pragma unroll
                        for (int bj = 0; bj < 2; ++bj) { const bf16x8 a = *reinterpret_cast<const bf16x8*>(&wq[ai][m][bj]);
                            d = __builtin_amdgcn_mfma_f32_16x16x32_bf16(a, Bh[bj][nt], d, 0, 0, 0); d = __builtin_amdgcn_mfma_f32_16x16x32_bf16(a, Bl[bj][nt], d, 0, 0, 0); }
                        dd[ai][m][nt] = d; }
            PG8_LAS float* rb = RED + (wc & 1) * (256 * RP) + (wr * 64 + 4 * fq) * RP + fr;
            if (wc < 2) {
#pragma unroll
                for (int ai = 0; ai < 2; ++ai)
#pragma unroll
                    for (int m = 0; m < 4; ++m)
#pragma unroll
                        for (int nt = 0; nt < 2; ++nt)
#pragma unroll
                            for (int reg = 0; reg < 4; ++reg) rb[(ai * HALF + m * 16 + reg) * RP + 16 * nt] = dd[ai][m][nt][reg];
            }
            asm volatile("s_waitcnt lgkmcnt(0)" ::: "memory"); __builtin_amdgcn_s_barrier(); asm volatile("" ::: "memory");
            if (wc >= 2) {
#pragma unroll
                for (int ai = 0; ai < 2; ++ai)
#pragma unroll
                    for (int m = 0; m < 4; ++m)
#pragma unroll
                        for (int nt = 0; nt < 2; ++nt)
#pragma unroll
                            for (int reg = 0; reg < 4; ++reg) rb[(ai * HALF + m * 16 + reg) * RP + 16 * nt] += dd[ai][m][nt][reg];
            }
        }
        const int row = wid * 32 + (lane & 31);
        if (lane < 32) {
            const f32x2v a = P[row * 4 + 0], b = P[row * 4 + 1], c = P[row * 4 + 2], d = P[row * 4 + 3];
            const float mt = (a.x + b.x + c.x + d.x) * 0.25f;
            const float da = a.x - mt, db = b.x - mt, dc = c.x - mt, dd2 = d.x - mt;
            const float m2 = (a.y + b.y) + (c.y + d.y) + 64.0f * ((da * da + db * db) + (dc * dc + dd2 * dd2));
            unsigned long long* slot = (unsigned long long*)xw + ((size_t)(u.pm * BM + row) * 8 + u.pn);
            __hip_atomic_store(slot, ((unsigned long long)__float_as_uint(m2) << 32) | __float_as_uint(mt), __ATOMIC_RELAXED, __HIP_MEMORY_SCOPE_AGENT);
        }
        asm volatile("s_waitcnt lgkmcnt(0)" ::: "memory"); __builtin_amdgcn_s_barrier(); asm volatile("" ::: "memory");
        {
            float* xl_ = (float*)(xw + 2 * MiB);
#pragma unroll
            for (int i = 0; i < 4; ++i) { const int p = tid + 512 * i, rw = p >> 3, eg = p & 7;
                const f32x4 v = *(const PG8_LAS f32x4*)(RED + rw * RP + 4 * eg) + *(const PG8_LAS f32x4*)(RED + 256 * RP + rw * RP + 4 * eg);
                u32x4 o = {__float_as_uint(v[0]), __float_as_uint(v[1]), __float_as_uint(v[2]), __float_as_uint(v[3])};
                store16_wt(xl_ + ((size_t)(u.pm * BM + rw) * 8 + u.pn) * 32 + 4 * eg, o); }
        }
        if (tid < 64) { float a = 0.f;
#pragma unroll
            for (int p = 0; p < 16; ++p) a += CB[p * 64 + tid];
            store4_wt((float*)(xw + 1 * MiB) + (size_t)(u.pm * 8 + u.pn) * 64 + tid, __float_as_uint(a)); }
        asm volatile("s_waitcnt vmcnt(0)" ::: "memory");
        if (lane == 0) __hip_atomic_fetch_add(cnt + 64 * u.pm, 1u, __ATOMIC_RELAXED, __HIP_MEMORY_SCOPE_AGENT);
        if (wid == 0) {
            unsigned sp = 0;
            while ((unsigned)__builtin_amdgcn_readfirstlane((int)__hip_atomic_load(cnt + 64 * u.pm, __ATOMIC_RELAXED, __HIP_MEMORY_SCOPE_AGENT)) < 64u) { __builtin_amdgcn_s_sleep(2); if (++sp > (1u << 22)) break; }
            __builtin_amdgcn_fence(__ATOMIC_ACQUIRE, "agent");
        }
        asm volatile("s_waitcnt vmcnt(0) lgkmcnt(0)" ::: "memory"); __builtin_amdgcn_s_barrier(); asm volatile("" ::: "memory");
        if (lane < 32) {
            const unsigned long long* slot = (const unsigned long long*)xw + (size_t)(u.pm * BM + row) * 8; float mt[8], m2[8]; float ms = 0.f;
#pragma unroll
            for (int t = 0; t < 8; ++t) { const unsigned long long w = __hip_atomic_load(slot + t, __ATOMIC_RELAXED, __HIP_MEMORY_SCOPE_AGENT); mt[t] = __uint_as_float((unsigned)w); m2[t] = __uint_as_float((unsigned)(w >> 32)); ms += mt[t]; }
            const float mean = ms * 0.125f; float q = 0.f;
#pragma unroll
            for (int t = 0; t < 8; ++t) { const float dm = mt[t] - mean; q += m2[t] + 256.0f * dm * dm; }
            S[row] = (f32x2v){mean, 1.0f / sqrtf(q * (1.0f / D) + LN_EPS)};
        }
        if (tid >= 64 && tid < 128) { const int i = tid - 64; float a = 0.f; const float* xcp = (const float*)(xw + 1 * MiB) + (size_t)(u.pm * 8) * 64 + i;
#pragma unroll
            for (int p = 0; p < 8; ++p) a += xcp[p * 64];
            CB[1024 + i] = a; }
        const int grow0 = u.pm * BM + 32 * u.pn;
        float raw0 = 0.f, raw1 = 0.f;
        { const int j = tid >> 4, e2 = tid & 15; const float* xl_ = (const float*)(xw + 2 * MiB) + (size_t)(grow0 + j) * 8 * 32 + e2;
#pragma unroll
          for (int p = 0; p < 8; ++p) { raw0 += xl_[p * 32]; raw1 += xl_[p * 32 + 16]; } }
        asm volatile("s_waitcnt lgkmcnt(0)" ::: "memory"); __builtin_amdgcn_s_barrier(); asm volatile("" ::: "memory");
        { const int j = tid >> 4, e2 = tid & 15; const f32x2v sr = S[32 * u.pn + j];
          const float lg0 = sr.y * (raw0 - sr.x * CB[1024 + e2]) + CB[1024 + 32 + e2], lg1 = sr.y * (raw1 - sr.x * CB[1024 + 16 + e2]) + CB[1024 + 48 + e2];
          const float s0 = 1.f / (1.f + expf(-lg0)), s1 = 1.f / (1.f + expf(-lg1));
          SCO[j * 33 + e2] = s0; SCO[32 * 33 + j * 33 + e2] = s0 + rbias[e2];
          SCO[j * 33 + 16 + e2] = s1; SCO[32 * 33 + j * 33 + 16 + e2] = s1 + rbias[16 + e2]; }
        {
            f32x4 gq[2][2], bq[2][2];
#pragma unroll
            for (int bj = 0; bj < 2; ++bj)
#pragma unroll
                for (int n = 0; n < 2; ++n) { const int cl = bj * HALF + wc * 32 + 8 * fq + 4 * n; gq[bj][n] = *(const PG8_LAS f32x4*)(GB + cl); bq[bj][n] = *(const PG8_LAS f32x4*)(GB + 256 + cl); }
#pragma unroll
            for (int ai = 0; ai < 2; ++ai)
#pragma unroll
                for (int m = 0; m < 4; ++m) { const int rl = ai * HALF + wr * 64 + m * 16 + fr; const f32x2v sr = S[rl]; const size_t off = (size_t)(u.pm * BM + rl) * D + col0;
#pragma unroll
                    for (int bj = 0; bj < 2; ++bj) { u32x4 t = wq[ai][m][bj]; asm volatile("" : "+v"(t));
                        const f32x4 t0 = {__uint_as_float(t.x << 16), __uint_as_float(t.x & 0xffff0000u), __uint_as_float(t.y << 16), __uint_as_float(t.y & 0xffff0000u)};
                        const f32x4 t1 = {__uint_as_float(t.z << 16), __uint_as_float(t.z & 0xffff0000u), __uint_as_float(t.w << 16), __uint_as_float(t.w & 0xffff0000u)};
                        const f32x4 v0 = (t0 - sr.x) * sr.y * gq[bj][0] + bq[bj][0], v1 = (t1 - sr.x) * sr.y * gq[bj][1] + bq[bj][1];
                        u32x4 w; w.x = cvt_pk_bf16(v0[0], v0[1]); w.y = cvt_pk_bf16(v0[2], v0[3]); w.z = cvt_pk_bf16(v1[0], v1[1]); w.w = cvt_pk_bf16(v1[2], v1[3]);
                        *(u32x4*)(H2 + off + bj * HALF) = w; } }
        }
        asm volatile("s_waitcnt lgkmcnt(0)" ::: "memory"); __builtin_amdgcn_s_barrier(); asm volatile("" ::: "memory");
        if (tid < 32) {
            const int j = tid; const f32x2v sr = S[32 * u.pn + j];
            stat[2 * (size_t)(grow0 + j)] = sr.x; stat[2 * (size_t)(grow0 + j) + 1] = sr.y;
            float bestgs = -3.0e38f; int be0 = 0, be1 = 0; float bw0 = 0.f, bw1 = 0.f;
#pragma unroll 1
            for (int gq2 = 0; gq2 < 4; ++gq2) {
                float m1 = -3.0e38f, m2 = -3.0e38f, s1 = 0.f, s2 = 0.f; int i1 = 0, i2 = 0;
#pragma unroll
                for (int t = 0; t < 8; ++t) {
                    const int e = gq2 * 8 + t;
                    const float scv = SCO[j * 33 + e], bv = SCO[32 * 33 + j * 33 + e];
                    if (bv > m1) { m2 = m1; i2 = i1; s2 = s1; m1 = bv; i1 = e; s1 = scv; }
                    else if (bv > m2) { m2 = bv; i2 = e; s2 = scv; }
                }
                const float gs = m1 + m2;
                if (gs > bestgs) { bestgs = gs; be0 = i1; be1 = i2; bw0 = s1; bw1 = s2; }
            }
            const float inv = 1.f / (bw0 + bw1);
            PG8_LAS int* ri = rinfo + j * 4;
            ri[0] = be0; ri[1] = be1; ri[2] = __float_as_int(bw0 * inv); ri[3] = __float_as_int(bw1 * inv);
        }
        asm volatile("s_waitcnt lgkmcnt(0)" ::: "memory"); __builtin_amdgcn_s_barrier(); asm volatile("" ::: "memory");
        int e_mine = 0;
        if (tid < 64) { e_mine = rinfo[(tid >> 1) * 4 + (tid & 1)]; rrank[tid] = (int)__hip_atomic_fetch_add((PG8_LAS unsigned*)(hist + e_mine), 1u, __ATOMIC_RELAXED, __HIP_MEMORY_SCOPE_WORKGROUP); }
        asm volatile("s_waitcnt lgkmcnt(0)" ::: "memory"); __builtin_amdgcn_s_barrier(); asm volatile("" ::: "memory");
        if (tid < 32) { const int c = hist[tid]; hist[32 + tid] = c ? (int)atomicAdd(ecnt + tid, (unsigned)c) : 0; }
        asm volatile("s_waitcnt vmcnt(0) lgkmcnt(0)" ::: "memory"); __builtin_amdgcn_s_barrier(); asm volatile("" ::: "memory");
        if (tid < 64) {
            const int r = grow0 + (tid >> 1), k = tid & 1;
            const int ps = hist[32 + e_mine] + rrank[tid];
            pos[(size_t)r * 2 + k] = ps;
            route[(size_t)r * 4 + k] = e_mine;
            list[(size_t)e_mine * LCAP + ps] = r;
            swl[(size_t)e_mine * LCAP + ps] = __int_as_float(rinfo[(tid >> 1) * 4 + 2 + k]);
        }
    }
};

template <int K, class Epi, class Sched, bool ALIGN_EPI = true, bool SP2 = true, bool GATHER = false, bool SKIPH = false  >
__device__ __forceinline__ void gemm_phase(PG8_LAS unsigned char* lds, const Sched& S, const Epi& E) {
    int tid_ = threadIdx.x; asm volatile("" : "+v"(tid_));
    const int tid = tid_, wid = __builtin_amdgcn_readfirstlane(tid >> 6), lane = tid & 63, wr = wid >> 2, wc = wid & 3, fr = lane & 15, fq = lane >> 4;
    constexpr int nt = K / BK;
    unsigned voffA[2], voffB[2];
#pragma unroll
    for (int i = 0; i < 2; ++i) { int R, C; stage_rc(tid * 16 + i * 8192, R, C); const int Rb = Epi::PERM ? ((R & ~31) + perm32(R & 31)) : R;
        voffA[i] = (unsigned)(R * K + C) * 2u; voffB[i] = (unsigned)(Rb * K + C) * 2u; }
    const size_t kstep = (size_t)(BK * 2);
    const size_t hstep = (size_t)HALF * K * 2;
    const unsigned ldsw = (unsigned)wid * 1024u;
    const int aoff = lds_byte(wr * 64 + fr, fq * 8), boff = lds_byte(wc * 32 + fr, fq * 8);
#define PG8_SA(b, h) (((b) * 2 + (h)) * HTB)
#define PG8_SB(b, h) ((4 + (b) * 2 + (h)) * HTB)
#define PG8_STAGE(bufoff, gbase, voff) do { _Pragma("unroll") for (int _i = 0; _i < 2; ++_i) \
        __builtin_amdgcn_global_load_lds((const unsigned*)((const char*)(gbase) + (voff)[_i]), (PG8_LAS unsigned*)(lds + (bufoff) + ldsw + _i * 8192), 16, 0, 0); } while (0)
    unsigned gA[2][2];
    PG8_LAS unsigned* gnl = (PG8_LAS unsigned*)(lds + 147456) + tid * 4;
#define PG8_MKG(u_, g_) do { _Pragma("unroll") for (int h_ = 0; h_ < 2; ++h_) _Pragma("unroll") for (int i_ = 0; i_ < 2; ++i_) { int R_, C_; stage_rc(tid * 16 + i_ * 8192, R_, C_); \
        const int rr_ = R_ + HALF * h_; const int idx_ = (rr_ < (u_).nvalid) ? (u_).rows[rr_] : 0; g_[h_][i_] = (unsigned)(idx_ * K + C_) * 2u; } } while (0)
#define PG8_STAGEA(bufoff, base, h, G_) do { if constexpr (GATHER) { PG8_STAGE(bufoff, base, G_[h]); } else { PG8_STAGE(bufoff, (base) + (h) * hstep, voffA); } } while (0)
#define PG8_LDA(dst, b, h) do { _Pragma("unroll") for (int m = 0; m < 4; ++m) _Pragma("unroll") for (int k = 0; k < 2; ++k) dst[m][k] = *(const PG8_LAS bf16x8*)(lds + PG8_SA(b, h) + aoff + m * 2048 + k * 1024); } while (0)
#define PG8_LDB(dst, b, h) do { _Pragma("unroll") for (int n = 0; n < 2; ++n) _Pragma("unroll") for (int k = 0; k < 2; ++k) dst[n][k] = *(const PG8_LAS bf16x8*)(lds + PG8_SB(b, h) + boff + n * 2048 + k * 1024); } while (0)
#define PG8_MMA(ai, bj, At, Bt) do { __builtin_amdgcn_s_setprio(1); _Pragma("unroll") for (int m = 0; m < 4; ++m) _Pragma("unroll") for (int n = 0; n < 2; ++n) _Pragma("unroll") for (int k = 0; k < 2; ++k) \
        acc[ai][bj][m][n] = __builtin_amdgcn_mfma_f32_16x16x32_bf16(Bt[n][k], At[m][k], acc[ai][bj][m][n], 0, 0, 0); __builtin_amdgcn_s_setprio(0); } while (0)
#define PG8_WAIT_V(n) asm volatile("s_waitcnt vmcnt(" #n ")" ::: "memory")
#define PG8_WAIT_L(n) asm volatile("s_waitcnt lgkmcnt(" #n ")" ::: "memory")
#define PG8_BAR __builtin_amdgcn_s_barrier()
#define PG8_SCHED __builtin_amdgcn_sched_barrier(0)
    Unit cur, nxt; int ui = 0;
    if (!S.next(0, cur)) return;
    f32x4 acc[2][2][4][2];
#pragma unroll
    for (int a = 0; a < 2; ++a)
#pragma unroll
        for (int b = 0; b < 2; ++b)
#pragma unroll
            for (int m = 0; m < 4; ++m)
#pragma unroll
                for (int n = 0; n < 2; ++n) acc[a][b][m][n] = (f32x4){0.f, 0.f, 0.f, 0.f};
    bf16x8 At[4][2], B0[2][2], B1[2][2];
    const char* cA = cur.A; const char* cB = cur.B;
    S.a_ready(cur);
    if constexpr (GATHER) PG8_MKG(cur, gA);
    if constexpr (SP2) {
        PG8_STAGE(PG8_SB(0, 0), cB, voffB); PG8_STAGE(PG8_SB(0, 1), cB + hstep, voffB); PG8_STAGEA(PG8_SA(0, 0), cA, 0, gA); PG8_STAGEA(PG8_SA(0, 1), cA, 1, gA);
        if (wr == 1) PG8_BAR;
        PG8_WAIT_V(2); PG8_BAR;
        PG8_STAGE(PG8_SB(1, 0), cB + kstep, voffB); PG8_STAGEA(PG8_SA(1, 0), cA + kstep, 0, gA); PG8_STAGE(PG8_SB(1, 1), cB + hstep + kstep, voffB);
        PG8_WAIT_V(6); PG8_BAR;
    } else {
        PG8_STAGE(PG8_SB(0, 0), cB, voffB); PG8_STAGEA(PG8_SA(0, 0), cA, 0, gA); PG8_STAGE(PG8_SB(0, 1), cB + hstep, voffB); PG8_STAGEA(PG8_SA(0, 1), cA, 1, gA);
        if (wr == 1) PG8_BAR;
        PG8_WAIT_V(4); PG8_BAR;
        PG8_STAGE(PG8_SB(1, 0), cB + kstep, voffB); PG8_STAGEA(PG8_SA(1, 0), cA + kstep, 0, gA); PG8_STAGE(PG8_SB(1, 1), cB + hstep + kstep, voffB);
        PG8_WAIT_V(6); PG8_BAR;
    }
    for (;;) {
        const bool has_next = S.next(ui + 1, nxt);
        const char* nA = has_next ? nxt.A : cA; const char* nB = has_next ? nxt.B : cB;
        if constexpr (GATHER) { unsigned gT[2][2];
            if (has_next) PG8_MKG(nxt, gT); else { _Pragma("unroll") for (int h_ = 0; h_ < 2; ++h_) _Pragma("unroll") for (int i_ = 0; i_ < 2; ++i_) gT[h_][i_] = gA[h_][i_]; }
            gnl[0] = gT[0][0]; gnl[1] = gT[0][1]; gnl[2] = gT[1][0]; gnl[3] = gT[1][1]; }
        for (int t = 0; t < nt; t += 2) {
            const bool last = (t == nt - 2);
            if (last && has_next) S.a_ready(nxt);
            const char* a1 = cA + (size_t)(t + 1) * kstep;
            const char* a2 = last ? nA : cA + (size_t)(t + 2) * kstep; const char* b2 = last ? nB : cB + (size_t)(t + 2) * kstep;
            const char* a3 = a2 + kstep; const char* b3 = b2 + kstep;
            if constexpr (SP2) {
            PG8_LDB(B0, 0, 0); PG8_LDB(B1, 0, 1); PG8_SCHED; PG8_LDA(At, 0, 0); PG8_STAGEA(PG8_SA(1, 1), a1, 1, gA);
            if constexpr (GATHER) { if (last) { gA[0][0] = gnl[0]; gA[0][1] = gnl[1]; gA[1][0] = gnl[2]; gA[1][1] = gnl[3]; } }
            PG8_WAIT_V(8); PG8_WAIT_L(0); PG8_BAR; PG8_MMA(0, 0, At, B0); PG8_MMA(0, 1, At, B1); PG8_BAR; PG8_SCHED;
            PG8_LDA(At, 0, 1); PG8_STAGE(PG8_SB(0, 0), b2, voffB); PG8_STAGE(PG8_SB(0, 1), b2 + hstep, voffB); PG8_STAGEA(PG8_SA(0, 0), a2, 0, gA);
            PG8_WAIT_V(8); PG8_WAIT_L(0); PG8_BAR; if (!(SKIPH && cur.nvalid <= HALF)) { PG8_MMA(1, 0, At, B0); PG8_MMA(1, 1, At, B1); } PG8_BAR; PG8_SCHED;
            PG8_LDB(B0, 1, 0); PG8_LDB(B1, 1, 1); PG8_SCHED; PG8_LDA(At, 1, 0); PG8_STAGEA(PG8_SA(0, 1), a2, 1, gA);
            PG8_WAIT_V(8); PG8_WAIT_L(0); PG8_BAR; PG8_MMA(0, 0, At, B0); PG8_MMA(0, 1, At, B1); PG8_BAR; PG8_SCHED;
            PG8_LDA(At, 1, 1); PG8_STAGE(PG8_SB(1, 0), b3, voffB); PG8_STAGE(PG8_SB(1, 1), b3 + hstep, voffB); PG8_STAGEA(PG8_SA(1, 0), a3, 0, gA);
            PG8_WAIT_V(8); PG8_WAIT_L(0); PG8_BAR; if (!(SKIPH && cur.nvalid <= HALF)) { PG8_MMA(1, 0, At, B0); PG8_MMA(1, 1, At, B1); } PG8_BAR; PG8_SCHED;
            } else {
            PG8_LDB(B0, 0, 0); PG8_SCHED; PG8_LDA(At, 0, 0); PG8_STAGEA(PG8_SA(1, 1), a1, 1, gA);
            if constexpr (GATHER) { if (last) { gA[0][0] = gnl[0]; gA[0][1] = gnl[1]; gA[1][0] = gnl[2]; gA[1][1] = gnl[3]; } }
            PG8_WAIT_L(8); PG8_BAR; PG8_WAIT_L(0); PG8_MMA(0, 0, At, B0); PG8_BAR; PG8_SCHED;
            PG8_LDB(B1, 0, 1); PG8_STAGE(PG8_SB(0, 0), b2, voffB);
            PG8_BAR; PG8_WAIT_L(0); PG8_MMA(0, 1, At, B1); PG8_BAR;
            PG8_LDA(At, 0, 1); PG8_STAGEA(PG8_SA(0, 0), a2, 0, gA);
            PG8_BAR; PG8_WAIT_L(0); if (!(SKIPH && cur.nvalid <= HALF)) PG8_MMA(1, 0, At, B0); PG8_BAR; PG8_SCHED;
            PG8_STAGE(PG8_SB(0, 1), b2 + hstep, voffB);
            PG8_WAIT_V(6); PG8_BAR; if (!(SKIPH && cur.nvalid <= HALF)) PG8_MMA(1, 1, At, B1); PG8_BAR;
            PG8_LDB(B0, 1, 0); PG8_SCHED; PG8_LDA(At, 1, 0); PG8_STAGEA(PG8_SA(0, 1), a2, 1, gA);
            PG8_WAIT_L(8); PG8_BAR; PG8_WAIT_L(0); PG8_MMA(0, 0, At, B0); PG8_BAR; PG8_SCHED;
            PG8_LDB(B1, 1, 1); PG8_STAGE(PG8_SB(1, 0), b3, voffB);
            PG8_BAR; PG8_WAIT_L(0); PG8_MMA(0, 1, At, B1); PG8_BAR;
            PG8_LDA(At, 1, 1); PG8_STAGEA(PG8_SA(1, 0), a3, 0, gA);
            PG8_BAR; PG8_WAIT_L(0); if (!(SKIPH && cur.nvalid <= HALF)) PG8_MMA(1, 0, At, B0); PG8_BAR; PG8_SCHED;
            PG8_STAGE(PG8_SB(1, 1), b3 + hstep, voffB);
            PG8_WAIT_V(6); PG8_BAR; if (!(SKIPH && cur.nvalid <= HALF)) PG8_MMA(1, 1, At, B1); PG8_BAR;
            }
        }
        if constexpr (ALIGN_EPI) { if (wr == 0) PG8_BAR; }
        if constexpr (Epi::FUSED) { PG8_WAIT_V(0); PG8_BAR; E.fused(acc, cur, wr, wc, fr, fq, lds, wid, lane); } else E(acc, cur, wr, wc, fr, fq);
        S.done(cur);
        if (!has_next) break;
#pragma unroll
        for (int a = 0; a < 2; ++a)
#pragma unroll
            for (int b = 0; b < 2; ++b)
#pragma unroll
                for (int m = 0; m < 4; ++m)
#pragma unroll
                    for (int n = 0; n < 2; ++n) acc[a][b][m][n] = (f32x4){0.f, 0.f, 0.f, 0.f};
        cur = nxt; cA = nA; cB = nB; ++ui;
        if constexpr (ALIGN_EPI) { if (wr == 1) PG8_BAR; }
    }
    PG8_WAIT_V(0);
    if constexpr (!ALIGN_EPI) { if (wr == 0) PG8_BAR; }
    PG8_BAR;
#undef PG8_SA
#undef PG8_SB
#undef PG8_STAGE
#undef PG8_STAGEA
#undef PG8_MKG
#undef PG8_LDA
#undef PG8_LDB
#undef PG8_MMA
#undef PG8_WAIT_V
#undef PG8_WAIT_L
#undef PG8_BAR
#undef PG8_SCHED
}
}

constexpr int CW_GEMV = 16384 + 448;
__device__ __forceinline__ void wg_wait_ge(unsigned* w, unsigned need) {
    if (threadIdx.x < 64) {
        unsigned sp = 0;
        while ((unsigned)__builtin_amdgcn_readfirstlane((int)__hip_atomic_load(w, __ATOMIC_RELAXED, __HIP_MEMORY_SCOPE_AGENT)) < need) { __builtin_amdgcn_s_sleep(2); if (++sp > (1u << 22)) break; }
        __builtin_amdgcn_fence(__ATOMIC_ACQUIRE, "agent");
        asm volatile("s_waitcnt vmcnt(0)" ::: "memory");
    }
    __syncthreads();
}
__device__ __forceinline__ void transpose_item(const float* W, int N, bf16_t* WT, int K, int wt_row0, int k0, int n0, LAS float* scr, int lane, int rstride = 1) {
#pragma unroll
    for (int i = 0; i < 32; ++i) { const int kk = 2 * i + (lane >> 5); scr[kk * 33 + (lane & 31)] = __builtin_nontemporal_load(W + (size_t)(k0 + kk) * N + n0 + (lane & 31)); }
    asm volatile("s_waitcnt lgkmcnt(0)" ::: "memory");
    const int c = lane & 7;
#pragma unroll
    for (int j = 0; j < 4; ++j) { const int n = (lane >> 3) + 8 * j; const LAS float* sp = scr + (8 * c) * 33 + n;
        uint4 o; o.x = pg8::cvt_pk_bf16(sp[0 * 33], sp[1 * 33]); o.y = pg8::cvt_pk_bf16(sp[2 * 33], sp[3 * 33]); o.z = pg8::cvt_pk_bf16(sp[4 * 33], sp[5 * 33]); o.w = pg8::cvt_pk_bf16(sp[6 * 33], sp[7 * 33]);
        pg8::store16_wt(WT + (size_t)(wt_row0 + n * rstride) * K + k0 + 8 * c, (pg8::u32x4){o.x, o.y, o.z, o.w}); }
    asm volatile("s_waitcnt lgkmcnt(0)" ::: "memory");
}
constexpr int I_IN = (D / 64) * (INC / 32), I_OUT = (D / 64) * (D / 32), I_EXP = 512, NKC = 8;
__device__ __forceinline__ void ph_prologue(const Ctx& C) {
    const int gt = C.bid * NTHREADS + C.tid, NT = C.G * NTHREADS;
    const int gw = C.bid * NWAVES + C.wave, NGW = C.G * NWAVES, lane = C.lane;
    for (int idx = C.bid * 16 + C.tid; C.tid < 16 && idx < 128 * 32; idx += C.G * 16) {
        const int pos = idx / 32, j = idx % 32;
        const double inv = pow(10000.0, -(double)j / 32.0);
        const double ang = (double)pos * inv;
        C_ROPE[idx] = (float)cos(ang);
        C_ROPE[128 * 32 + idx] = (float)sin(ang);
    }
    for (int idx = gt; idx < NE * D; idx += NT) {
        const int e = idx / D, d = idx % D;
        const float w = C_w_router[(size_t)d * NE + e];
        const bf16_t hi = f2bf(w); const bf16_t lo = f2bf(w - bf2f(hi));
        C_WRT[idx] = hi; C_WRT[NE * D + idx] = lo;
    }
    {
        LAS float* sl = (LAS float*)C.lds;
        for (int k = C.tid; k < D; k += NTHREADS) { sl[k] = silu_f(C_c[k]); sl[D + k] = silu_f(C_c_ctx[k]); }
        __syncthreads();
        const bool spread = (C.G * 3 == DEPTH * 48 * NKC);
        for (int u = spread ? (C.wave < 3 ? C.wave * C.G + C.bid : DEPTH * 48 * NKC) : gw; u < DEPTH * 48 * NKC; u += NGW) {
            const int l = u / (48 * NKC), rem = u % (48 * NKC), sb = rem / NKC, kc = rem % NKC;
            const float* w = C_w_mod + (size_t)l * D * 6 * D + (size_t)(kc * (D / NKC)) * 6 * D + sb * 256 + lane * 4;
            float4 a0 = {0.f, 0.f, 0.f, 0.f}, a1 = {0.f, 0.f, 0.f, 0.f};
#pragma unroll 16
            for (int k = 0; k < D / NKC; ++k) {
                const pg8::f32x4 wv4 = __builtin_nontemporal_load((const pg8::f32x4*)(w + (size_t)k * 6 * D)); const float4 wv = {wv4[0], wv4[1], wv4[2], wv4[3]};
                const float c0 = sl[kc * (D / NKC) + k], c1 = sl[D + kc * (D / NKC) + k];
                a0.x += c0 * wv.x; a0.y += c0 * wv.y; a0.z += c0 * wv.z; a0.w += c0 * wv.w;
                a1.x += c1 * wv.x; a1.y += c1 * wv.y; a1.z += c1 * wv.z; a1.w += c1 * wv.w;
            }
            *(float4*)(C_MODP + ((size_t)(kc * 2 + l) * 2 + 0) * 6 * D + sb * 256 + lane * 4) = a0;
            *(float4*)(C_MODP + ((size_t)(kc * 2 + l) * 2 + 1) * 6 * D + sb * 256 + lane * 4) = a1;
        }
        asm volatile("s_waitcnt vmcnt(0)" ::: "memory");
        __syncthreads();
        if (C.tid == 0) { __builtin_amdgcn_fence(__ATOMIC_RELEASE, "agent"); asm volatile("s_waitcnt vmcnt(0)" ::: "memory"); __hip_atomic_fetch_add(C_CTLW + CW_GEMV, 1u, __ATOMIC_RELAXED, __HIP_MEMORY_SCOPE_AGENT); }
    }
    LAS float* scr = (LAS float*)(C.lds + C.wave * 16384);
    constexpr int TOT = 2 * I_IN + 2 * I_OUT + 3 * 64 * I_EXP;
    constexpr int NGEMV = DEPTH * 48 * NKC;
    const int nlight = NGW - NGEMV;
    const int R1 = (nlight > 0 && NGW == 2048) ? 28 : (TOT + NGW - 1) / NGW;
    const int T1 = R1 * NGW < TOT ? R1 * NGW : TOT;
    for (int q = 0;; ++q) {
        int it;
        if (q < R1) { it = q * NGW + gw; if (it >= T1) { if (T1 == TOT) break; continue; } }
        else { const bool spread_ = (C.G * 3 == NGEMV);
               const bool heavy = spread_ ? (C.wave < 3) : (gw < NGEMV);
               if (heavy) break;
               const int li = spread_ ? C.bid * 5 + (C.wave - 3) : gw - NGEMV;
               it = T1 + (q - R1) * nlight + li; if (it >= TOT) break; }
        int r = it;
        if (r < 2 * I_IN) { const int l = r / I_IN, q = r % I_IN, kb = q / (INC / 32), nb = q % (INC / 32);
            const int n0 = 32 * nb; int row0 = n0, rs = 1;
            if (n0 < OFF_AV) { const int hh = n0 / HD, d0 = n0 % HD; row0 = hh * HD + (d0 < 64 ? 2 * d0 : 2 * (d0 - 64) + 1); rs = 2; }
            transpose_item(C_w_in + (size_t)l * D * INC, INC, C_WIN + (size_t)l * INC * D, D, row0, 64 * kb, n0, scr, lane, rs); continue; }
        r -= 2 * I_IN;
        if (r < 2 * I_OUT) { const int l = r / I_OUT, q = r % I_OUT, kb = q / (D / 32), nb = q % (D / 32);
            transpose_item(C_w_out + (size_t)l * D * D, D, C_WOUT + (size_t)l * D * D, D, 32 * nb, 64 * kb, 32 * nb, scr, lane); continue; }
        r -= 2 * I_OUT;
        if (r < 2 * 64 * I_EXP) { const int up = r / (64 * I_EXP), rr = r % (64 * I_EXP); const int le = rr / I_EXP, q = rr % I_EXP, kb = q / 16, nb = q % 16, f0 = 32 * nb;
            transpose_item((up ? C_w_up : C_w_gate) + (size_t)le * D * FF, FF, C_WGU + (size_t)le * 1024 * D, D, (f0 / 128) * 256 + up * 128 + (f0 % 128), 64 * kb, f0, scr, lane); continue; }
        r -= 2 * 64 * I_EXP;
        { const int le = r / I_EXP, q = r % I_EXP, kb = q / (D / 32), nb = q % (D / 32);
          transpose_item(C_w_down + (size_t)le * FF * D, D, C_WD + (size_t)le * D * FF, FF, 32 * nb, 64 * kb, 32 * nb, scr, lane); }
    }
}

__device__ __forceinline__ void ph_modulate0(const Ctx& C) {
    wg_wait_ge(C_CTLW + CW_GEMV, (unsigned)C.G);
    const int gt = C.bid * NTHREADS + C.tid, NT = C.G * NTHREADS;
    const int gw = C.bid * NWAVES + C.wave, NGW = C.G * NWAVES, lane = C.lane;
    for (int idx = gt; idx < DEPTH * 2 * 6 * D; idx += NT) {
        const int n = idx % (6 * D), l = idx / (2 * 6 * D);
        float a = C_b_mod[l * 6 * D + n];
#pragma unroll
        for (int kc = 0; kc < NKC; ++kc) a += C_MODP[(size_t)kc * (DEPTH * 2 * 6 * D) + idx];
        C_MOD[idx] = a;
    }
    LAS float* ms = (LAS float*)C.lds;
#pragma unroll 4
    for (int i = C.tid; i < 2 * 2 * D; i += NTHREADS) {
        const int kind = i / (2 * D), n = i % (2 * D);
        const int idx = (0 * 2 + kind) * 6 * D + n;
        float a = C_b_mod[n];
#pragma unroll
        for (int kc = 0; kc < NKC; ++kc) a += C_MODP[(size_t)kc * (DEPTH * 2 * 6 * D) + idx];
        ms[i] = a;
    }
    __syncthreads();
    float4 nxv[8];
    if (gw < NTOK) { const float* xp = xin_row(C, 0, gw);
#pragma unroll
        for (int j = 0; j < 8; ++j) nxv[j] = *(const float4*)(xp + 4 * lane + 256 * j); }
    for (int r = gw; r < NTOK; r += NGW) {
        const int kind = r < SEQ ? 0 : 1;
        const LAS float* sh = ms + kind * 2 * D; const LAS float* sc = sh + D;
        float4 cxv[8];
#pragma unroll
        for (int j = 0; j < 8; ++j) cxv[j] = nxv[j];
        if (r + NGW < NTOK) { const float* xp = xin_row(C, 0, r + NGW);
#pragma unroll
            for (int j = 0; j < 8; ++j) nxv[j] = *(const float4*)(xp + 4 * lane + 256 * j); }
#pragma unroll
        for (int j = 0; j < 8; ++j) {
            const int d0 = 4 * lane + 256 * j;
            const float4 xv = cxv[j];
            float4 hv; hv.x = xv.x * (1.f + sc[d0]) + sh[d0]; hv.y = xv.y * (1.f + sc[d0 + 1]) + sh[d0 + 1]; hv.z = xv.z * (1.f + sc[d0 + 2]) + sh[d0 + 2]; hv.w = xv.w * (1.f + sc[d0 + 3]) + sh[d0 + 3];
            st4(&C_H[(size_t)r * D + d0], hv);
        }
    }
}

namespace att {
using bf16x8 = __attribute__((ext_vector_type(8))) short;
using s16x4  = __attribute__((ext_vector_type(4))) short;
using f32x16 = __attribute__((ext_vector_type(16))) float;
using u32x4  = __attribute__((ext_vector_type(4))) unsigned;
constexpr int NW = 8, QBLK = 32, KVBLK = 64;
constexpr float SCALE = QSCALE, THR = 8.f;
constexpr int SHM_V = KVBLK * HD * 2, SHM_K = KVBLK * HD * 2;
constexpr int Q_OFF = 2 * SHM_V + 2 * SHM_K  , WS_OFF = 131072 + 1024, BIAS_OFF = WS_OFF + NW * 64 * 4, QSLOT_OFF = BIAS_OFF + (64 + 15 * 32 + 64) * 4, ATT_LDS = QSLOT_OFF + 16;
#define KSWZ(row, colB) ((row) * 256 + ((colB) ^ (((row) & 7) << 4)))
#define SBAR() __builtin_amdgcn_sched_barrier(0)
__device__ __forceinline__ int crow(int r, int hi) { return (r & 3) + 8 * (r >> 2) + 4 * hi; }
__device__ __forceinline__ unsigned cvtpk(float lo, float hi) { unsigned r; asm volatile("v_cvt_pk_bf16_f32 %0, %1, %2" : "=v"(r) : "v"(lo), "v"(hi)); return r; }

__device__ __forceinline__ void partialSM(f32x16& p0, f32x16& p1, float& m_reg, float& mn, float& alpha) {
  constexpr float Cc = SCALE * 1.4426950408889634f;
  float pmax = p0[0]; for (int r = 1; r < 16; ++r) pmax = fmaxf(pmax, p0[r]); for (int r = 0; r < 16; ++r) pmax = fmaxf(pmax, p1[r]);
  { auto rr = __builtin_amdgcn_permlane32_swap(__float_as_uint(pmax), __float_as_uint(pmax), false, false);
    pmax = fmaxf(__uint_as_float(rr[0]), __uint_as_float(rr[1])); }
  if (__builtin_expect(__all(pmax - m_reg <= THR / SCALE), 1)) { mn = m_reg; alpha = 1.f; }
  else { mn = fmaxf(m_reg, pmax); alpha = __builtin_amdgcn_exp2f((m_reg - mn) * Cc); m_reg = mn; }
  float mnC = -mn * Cc;
  for (int r = 0; r < 16; ++r) p0[r] = fmaf(p0[r], Cc, mnC); for (int r = 0; r < 16; ++r) p1[r] = fmaf(p1[r], Cc, mnC);
  for (int r = 0; r < 16; ++r) p0[r] = __builtin_amdgcn_exp2f(p0[r]);
}
__device__ __forceinline__ void finishSM(f32x16& p0, f32x16& p1, float alpha, float& l_reg, bf16x8& pa0, bf16x8& pa1, bf16x8& pa2, bf16x8& pa3) {
  for (int r = 0; r < 16; ++r) p1[r] = __builtin_amdgcn_exp2f(p1[r]);
  float ps = 0; for (int r = 0; r < 16; ++r) ps += p0[r]; for (int r = 0; r < 16; ++r) ps += p1[r];
  { auto rr = __builtin_amdgcn_permlane32_swap(__float_as_uint(ps), __float_as_uint(ps), false, false);
    ps = __uint_as_float(rr[0]) + __uint_as_float(rr[1]); }
  l_reg = l_reg * alpha + ps;
#define PK4(P, BASE, OUT) do { unsigned a0 = cvtpk(P[BASE + 0], P[BASE + 1]), a1 = cvtpk(P[BASE + 2], P[BASE + 3]);   \
    unsigned b0 = cvtpk(P[BASE + 4], P[BASE + 5]), b1 = cvtpk(P[BASE + 6], P[BASE + 7]);                              \
    auto r0 = __builtin_amdgcn_permlane32_swap(a0, b0, false, false); auto r1 = __builtin_amdgcn_permlane32_swap(a1, b1, false, false); \
    u32x4 w = {r0[0], r1[0], r0[1], r1[1]}; OUT = *reinterpret_cast<bf16x8*>(&w); } while (0)
  PK4(p0, 0, pa0); PK4(p0, 8, pa1); PK4(p1, 0, pa2); PK4(p1, 8, pa3);
#undef PK4
}
__device__ __forceinline__ void qkt(f32x16& p0, f32x16& p1, const LAS char* Ks, const LAS char* Qs, int r32, int hi) {
#pragma unroll
  for (int d0 = 0; d0 < 8; ++d0) { int cb = (d0 * 16 + hi * 8) * 2;
    bf16x8 b0 = *reinterpret_cast<const LAS bf16x8*>(Ks + KSWZ(r32, cb));
    bf16x8 b1 = *reinterpret_cast<const LAS bf16x8*>(Ks + KSWZ(32 + r32, cb));
    bf16x8 q = *reinterpret_cast<const LAS bf16x8*>(Qs + KSWZ(r32, cb));
    p0 = __builtin_amdgcn_mfma_f32_32x32x16_bf16(b0, q, p0, 0, 0, 0);
    p1 = __builtin_amdgcn_mfma_f32_32x32x16_bf16(b1, q, p1, 0, 0, 0); }
}
__device__ __forceinline__ int v_st(int k, int c) { const int kk = (k & ~0xC) | ((k & 4) << 1) | ((k & 8) >> 1); return ((kk >> 3) * 4 + (c >> 5)) * 512 + ((kk & 7) * 32 + (c & 31)) * 2; }
__device__ __forceinline__ int v_rd_base(int lane) { return ((lane & 3) << 3) | (((lane >> 2) & 3) << 6) | (((lane >> 4) & 1) << 5) | (((lane >> 5) & 1) << 8); }
constexpr int v_rd_off(int d0, int ks, int half) { return d0 * 512 + ks * 4096 + half * 2048; }
template <int OFF> __device__ __forceinline__ s16x4 tr_read(int vb) {
  s16x4 r; asm volatile("ds_read_b64_tr_b16 %0, %1 offset:%2" : "=&v"(r) : "v"(vb), "i"(OFF) : "memory"); return r;
}
template <int D0> __device__ __forceinline__ void pv_one(f32x16& od, int vb, bf16x8 pa0, bf16x8 pa1, bf16x8 pa2, bf16x8 pa3) {
  const s16x4 l0 = tr_read<v_rd_off(D0, 0, 0)>(vb), h0 = tr_read<v_rd_off(D0, 0, 1)>(vb), l1 = tr_read<v_rd_off(D0, 1, 0)>(vb), h1 = tr_read<v_rd_off(D0, 1, 1)>(vb);
  const s16x4 l2 = tr_read<v_rd_off(D0, 2, 0)>(vb), h2 = tr_read<v_rd_off(D0, 2, 1)>(vb), l3 = tr_read<v_rd_off(D0, 3, 0)>(vb), h3 = tr_read<v_rd_off(D0, 3, 1)>(vb);
  asm volatile("s_waitcnt lgkmcnt(0)" ::: "memory"); SBAR();
#define PK(L, H) (bf16x8){L[0], L[1], L[2], L[3], H[0], H[1], H[2], H[3]}
  od = __builtin_amdgcn_mfma_f32_32x32x16_bf16(pa0, PK(l0, h0), od, 0, 0, 0);
  od = __builtin_amdgcn_mfma_f32_32x32x16_bf16(pa1, PK(l1, h1), od, 0, 0, 0);
  od = __builtin_amdgcn_mfma_f32_32x32x16_bf16(pa2, PK(l2, h2), od, 0, 0, 0);
  od = __builtin_amdgcn_mfma_f32_32x32x16_bf16(pa3, PK(l3, h3), od, 0, 0, 0);
#undef PK
}
__device__ __forceinline__ void pv_d0(f32x16* o, int vb, bf16x8 pa0, bf16x8 pa1, bf16x8 pa2, bf16x8 pa3) {
  pv_one<0>(o[0], vb, pa0, pa1, pa2, pa3); pv_one<1>(o[1], vb, pa0, pa1, pa2, pa3); pv_one<2>(o[2], vb, pa0, pa1, pa2, pa3); pv_one<3>(o[3], vb, pa0, pa1, pa2, pa3);
}

template <int kind>
__device__ __forceinline__ void attn_unit(const bf16_t* __restrict__ P, bf16_t* __restrict__ MIX, const float* __restrict__ rpb_l, const float* __restrict__ sink_l,
                                          const int u, const int h, LAS char* lds, const int tid, unsigned* qctr, LAS int* qslot) {
  const int wid = __builtin_amdgcn_readfirstlane(tid >> 6), lane = tid & 63, r32 = lane & 31, hi = lane >> 5;
  LAS char* V_lds = lds; LAS char* K_lds = lds + 2 * SHM_V;
  LAS float* ws = (LAS float*)(lds + WS_OFF) + wid * 64; LAS float* li_l = ws; LAS float* al_l = ws + 32;
  LAS float* rpbs = (LAS float*)(lds + BIAS_OFF) + 64;
  constexpr bool isA = (kind == 0 || kind == 2), lat = kind < 2;
  const int qrow0 = lat ? 256 * u : SEQ;
  const int qcol = isA ? h * HD : OFF_BQ + h * HD;
  const int kcol = isA ? OFF_AK + (h / 3) * HD : OFF_BK + h * HD;
  const int vcol = isA ? OFF_AV + (h / 3) * HD : OFF_BV + h * HD;
  const int ocol = (isA ? 0 : 768) + h * HD;
  constexpr int NT = (kind == 0) ? 12 : (kind == 1) ? 16 : 4;
  int Rs = 4 * u - 4; Rs = Rs < 0 ? 0 : (Rs > 117 ? 117 : Rs);
  __syncthreads();
  if (kind == 1) for (int i = tid; i < 64 + 15 * 32 + 64; i += 512) { const int t = i - 64; rpbs[t] = (t >= 0 && t < 15 * 32 && (t & 31) < 31) ? rpb_l[h * 465 + (t >> 5) * 31 + (t & 31)] * (1.0f / SCALE) : 0.f; }
  float m_reg = -1e30f, l_reg = 0; f32x16 o[4] = {};
  LAS char* Qs = lds + Q_OFF + wid * 8192;
  { const bf16_t* Qw = P + (size_t)(qrow0 + wid * QBLK + r32) * INC + qcol + hi * 8;
#pragma unroll
    for (int d0 = 0; d0 < 8; ++d0) *reinterpret_cast<LAS bf16x8*>(Qs + KSWZ(r32, (d0 * 16 + hi * 8) * 2)) = *reinterpret_cast<const bf16x8*>(Qw + d0 * 16); }
  const int sr = tid >> 4, sc = (tid & 15) * 8, vst0 = v_st(sr, sc), vst1 = v_st(32 + sr, sc);
  const int vb0 = (int)(size_t)V_lds + v_rd_base(lane);
  const unsigned voffk = (unsigned)(sr * INC + sc + kcol) * 2u, voffk2 = voffk + 32u * INC * 2u, voffv = (unsigned)(sr * INC + sc + vcol) * 2u, voffv2 = voffv + 32u * INC * 2u;
  struct { bf16x8 vs0, vs1, ks0, ks1; } sr_[2];
#define KROW(j) (((j) < 4) ? (SEQ + 64 * (j)) : (kind == 0 ? ({ int t_ = 256 * u - 128 + 64 * ((j) - 4); t_ < 0 ? 0 : (t_ > SEQ - 64 ? SEQ - 64 : t_); }) : ({ int jj_ = (j) - 4; jj_ = jj_ > 10 ? 10 : jj_; (Rs + jj_) * 64; })))
#define SLOAD(i, j) do { const char* kb_ = (const char*)P + (size_t)KROW(j) * (INC * 2);                                             \
    sr_[i].vs0 = *reinterpret_cast<const bf16x8*>(kb_ + voffv); sr_[i].vs1 = *reinterpret_cast<const bf16x8*>(kb_ + voffv2); \
    sr_[i].ks0 = *reinterpret_cast<const bf16x8*>(kb_ + voffk); sr_[i].ks1 = *reinterpret_cast<const bf16x8*>(kb_ + voffk2); } while (0)
#define SWRITE(b, i) do { *(LAS bf16x8*)(V_lds + (b) * SHM_V + vst0) = sr_[i].vs0;          \
    *(LAS bf16x8*)(V_lds + (b) * SHM_V + vst1) = sr_[i].vs1; int kc_ = sc * 2;               \
    *(LAS bf16x8*)(K_lds + (b) * SHM_K + KSWZ(sr, kc_)) = sr_[i].ks0;                       \
    *(LAS bf16x8*)(K_lds + (b) * SHM_K + KSWZ(32 + sr, kc_)) = sr_[i].ks1; } while (0)
#define SWAIT() asm volatile("s_waitcnt vmcnt(4)" ::: "memory")
#define RESC(a) do { if (__any((a) < 1.f)) { if (hi == 0) al_l[r32] = (a); asm volatile("s_waitcnt lgkmcnt(0)" ::: "memory"); \
    for (int d = 0; d < 4; ++d) for (int r = 0; r < 16; ++r) o[d][r] *= al_l[crow(r, hi)]; } } while (0)
#define MASK(p0, p1, j) do { const int j_ = (j);                                                                                          \
    if (lat && j_ >= 4) {                                                                                                                 \
      if (kind == 0) {                                                                                                                    \
        const int t0_ = 256 * u - 128 + 64 * (j_ - 4), qw_ = 256 * u + 32 * wid;                                                          \
        const int dt_ = t0_ - qw_;                                    \
        if (t0_ >= 0 && t0_ < SEQ && dt_ >= -97 && dt_ <= 65) { _Pragma("unroll") for (int r = 0; r < 16; ++r) { p0[r] = 0.f; p1[r] = 0.f; } }     \
        else {                                                                                                                            \
        const float tp_ = (t0_ < 0 || t0_ >= SEQ) ? -1e30f : 0.f;                                     \
        const float dl_ = (float)(t0_ - (qw_ + r32) + 4 * hi);                                                                            \
        _Pragma("unroll") for (int r = 0; r < 16; ++r) { const float k0_ = dl_ + (float)((r & 3) + 8 * (r >> 2)), k1_ = k0_ + 32.f;       \
          p0[r] = fmaf(fminf(0.f, 128.5f - fabsf(k0_)), 1e30f, tp_); p1[r] = fmaf(fminf(0.f, 128.5f - fabsf(k1_)), 1e30f, tp_); } }       \
      } else {                                                                                                                            \
        const int kr_ = Rs + (j_ - 4), qrw_ = 4 * u + (wid >> 1); int r0_ = qrw_ - 4; r0_ = r0_ < 0 ? 0 : (r0_ > 120 ? 120 : r0_);        \
        const float tp_ = (j_ >= 15 || kr_ < r0_ || kr_ >= r0_ + 8) ? -1e30f : 0.f;           \
        int dr_ = kr_ - qrw_ + 7; dr_ = dr_ < 0 ? 0 : (dr_ > 14 ? 14 : dr_);                                                              \
        const int qc_ = (wid & 1) * 32 + r32;                                                                                             \
        const LAS float* br_ = rpbs + dr_ * 32 + (15 - qc_ + 4 * hi);                                                                     \
        _Pragma("unroll") for (int r = 0; r < 16; ++r) { const int kk_ = (r & 3) + 8 * (r >> 2);                                           \
          p0[r] = cm0[r] + (br_[kk_] + tp_); p1[r] = cm1[r] + (br_[kk_ + 32] + tp_); }                                                     \
      } }                                                                                                                                 \
    else { _Pragma("unroll") for (int r = 0; r < 16; ++r) { p0[r] = 0.f; p1[r] = 0.f; } } } while (0)
  float cm0[16], cm1[16];
  if (kind == 1) { const int qc_ = (wid & 1) * 32 + r32; int c0_ = qc_ - 8; c0_ = c0_ < 0 ? 0 : (c0_ > 48 ? 48 : c0_);
    const float xb_ = (float)(4 * hi - c0_) - 7.5f;
#pragma unroll
    for (int r = 0; r < 16; ++r) { const float x0_ = xb_ + (float)((r & 3) + 8 * (r >> 2)), x1_ = x0_ + 32.f;
      cm0[r] = fminf(0.f, 7.75f - fabsf(x0_)) * 1e30f; cm1[r] = fminf(0.f, 7.75f - fabsf(x1_)) * 1e30f; } }
  f32x16 pA0, pA1; float mnA, alA; bf16x8 pa0, pa1, pa2, pa3;
  SLOAD(0, 0); asm volatile("s_waitcnt vmcnt(0)" ::: "memory"); SWRITE(0, 0); __syncthreads();
  int jlo = 4, jhi = NT - 1;
  if (kind == 0) { const int qw_ = 32 * wid;
    jlo = 4 + (qw_ + 0) / 64; jhi = 4 + (qw_ + 31 + 256) / 64;
    const int first_ok = (256 * u - 128 < 0) ? 4 + 2 : 4, last_ok = (256 * u + 384 > SEQ) ? 4 + 5 : 4 + 7;
    jlo = jlo < first_ok ? first_ok : jlo; jhi = jhi > last_ok ? last_ok : jhi; }
  if (kind == 1) { const int qrw_ = 4 * u + (wid >> 1); int r0_ = qrw_ - 4; r0_ = r0_ < 0 ? 0 : (r0_ > 120 ? 120 : r0_); jlo = 4 + (r0_ - Rs); jhi = jlo + 7; }
#define TILE(J, B) do { if ((J) < 4 || ((J) >= jlo && (J) <= jhi)) {                                                    \
      MASK(pA0, pA1, (J));                                                                                              \
      SBAR(); qkt(pA0, pA1, K_lds + (B) * SHM_K, Qs, r32, hi);                                                          \
      partialSM(pA0, pA1, m_reg, mnA, alA);                                                                             \
      RESC(alA);                                                                                                        \
      finishSM(pA0, pA1, alA, l_reg, pa0, pa1, pa2, pa3); SBAR();                                                       \
      pv_d0(o, vb0 + (B) * SHM_V, pa0, pa1, pa2, pa3); } } while (0)
  SLOAD(1, 1);
  for (int j = 0; j < NT; j += 2) {
    if (j + 2 < NT) SLOAD(0, j + 2);
    TILE(j, 0);
    SWAIT(); SWRITE(1, 1);
    __syncthreads();
    if (j + 3 < NT) SLOAD(1, j + 3);
    TILE(j + 1, 1);
    if (j + 2 < NT) { SWAIT(); SWRITE(0, 0); }
    __syncthreads();
  }
#undef TILE
  int nq_ = 0; if (tid == 0) nq_ = (int)atomicAdd(qctr, 1u);
  if (isA) l_reg += __builtin_amdgcn_exp2f(sink_l[h] * 1.4426950408889634f - m_reg * (SCALE * 1.4426950408889634f));
  if (hi == 0) li_l[r32] = l_reg; asm volatile("s_waitcnt lgkmcnt(0)" ::: "memory");
  float rli[16];
#pragma unroll
  for (int r = 0; r < 16; ++r) rli[r] = __builtin_amdgcn_rcpf(li_l[crow(r, hi)]);
  __syncthreads();
  LAS char* ost = lds + wid * 8192;
#pragma unroll
  for (int r = 0; r < 16; ++r) { const int orow = crow(r, hi);
#pragma unroll
    for (int d0 = 0; d0 < 4; ++d0) *(LAS bf16_t*)(ost + orow * 256 + (d0 * 32 + r32) * 2) = f2bf(o[d0][r] * rli[r]); }
  asm volatile("s_waitcnt lgkmcnt(0)" ::: "memory");
  bf16_t* Ow = MIX + (size_t)(qrow0 + wid * QBLK) * D + ocol;
#pragma unroll
  for (int i = 0; i < 8; ++i) { const int c = lane + 64 * i, row = c >> 4, c16 = c & 15;
    const u32x4 v = *(const LAS u32x4*)(ost + c * 16);
    *reinterpret_cast<u32x4*>(Ow + (size_t)row * D + c16 * 8) = v; }
  if (tid == 0) *qslot = nq_;
#undef KROW
#undef SLOAD
#undef SWRITE
#undef SWAIT
#undef RESC
#undef MASK
}
#undef KSWZ
#undef SBAR
}

__device__ __forceinline__ float gelu_fast(float v) { const float z = 0.7978845608028654f * (v + 0.044715f * v * v * v); return v / (1.f + __expf(-2.f * z)); }
__device__ __forceinline__ void sgu_item(const Ctx& C, int l, int ch, int g, unsigned* qctr, LAS int* qslot) {
    typedef short bf16x8v __attribute__((ext_vector_type(8)));
    typedef float f32x4v __attribute__((ext_vector_type(4)));
    constexpr int PITCH = 272;
    LAS char* vnT = (LAS char*)C.lds;
    const int lane = C.lane, wave = C.wave;
    const int row0 = ch * 128;
    const int m16 = lane & 15, kg = lane >> 4;
    __syncthreads();
    unsigned short va[16], vb[16];
#pragma unroll
    for (int i = 0; i < 16; ++i) { const AT* vp = C_P + (size_t)(row0 + wave + 8 * i) * INC + OFF_C + CW + g * 128; va[i] = vp[lane]; vb[i] = vp[64 + lane]; }
    const float g0 = C_sgu_g[l * CW + g * 128 + lane], g1 = C_sgu_g[l * CW + g * 128 + 64 + lane];
    const float b0 = C_sgu_bn[l * CW + g * 128 + lane], b1 = C_sgu_bn[l * CW + g * 128 + 64 + lane];
    bf16x8v af[4];
    { const float* wp = C_sgu_w + ((size_t)(l * 4 + g) * 128 + 16 * wave + m16) * 128 + 8 * kg;
#pragma unroll
      for (int ks = 0; ks < 4; ++ks) { const float4 w0 = *(const float4*)(wp + 32 * ks), w1 = *(const float4*)(wp + 32 * ks + 4);
          uint4 pk; pk.x = pg8::cvt_pk_bf16(w0.x, w0.y); pk.y = pg8::cvt_pk_bf16(w0.z, w0.w); pk.z = pg8::cvt_pk_bf16(w1.x, w1.y); pk.w = pg8::cvt_pk_bf16(w1.z, w1.w);
          af[ks] = *reinterpret_cast<bf16x8v*>(&pk); } }
    const int pr = 16 * wave + m16;
    uint2 uu[8];
    { const AT* up = C_P + (size_t)(row0 + pr) * INC + OFF_C + g * 128 + 4 * kg;
#pragma unroll
      for (int nt = 0; nt < 8; ++nt) uu[nt] = *(const uint2*)(up + 16 * nt); }
    const float bs = C_sgu_b[(l * 4 + g) * 128 + pr];
#pragma unroll
    for (int i = 0; i < 16; ++i) {
        const int q = wave + 8 * i;
        const float a = gelu_fast(bf2f(va[i])), b = gelu_fast(bf2f(vb[i]));
        const float mu = wave_sum(a + b) * (1.f / 128.f);
        const float da = a - mu, db = b - mu;
        const float var = wave_sum(da * da + db * db) * (1.f / 128.f);
        const float rstd = 1.0f / sqrtf(var + LN_EPS);
        *(LAS bf16_t*)(vnT + lane * PITCH + q * 2) = f2bf(da * rstd * g0 + b0);
        *(LAS bf16_t*)(vnT + (64 + lane) * PITCH + q * 2) = f2bf(db * rstd * g1 + b1);
    }
    __syncthreads();
    int nq_ = 0; if (C.tid == 0) nq_ = (int)atomicAdd(qctr, 1u);
    f32x4v acc[8];
#pragma unroll
    for (int nt = 0; nt < 8; ++nt) acc[nt] = (f32x4v){0.f, 0.f, 0.f, 0.f};
#pragma unroll
    for (int nt = 0; nt < 8; ++nt)
#pragma unroll
        for (int ks = 0; ks < 4; ++ks) {
            const bf16x8v bfr = *(const LAS bf16x8v*)(vnT + (nt * 16 + m16) * PITCH + (32 * ks + 8 * kg) * 2);
            acc[nt] = __builtin_amdgcn_mfma_f32_16x16x32_bf16(bfr, af[ks], acc[nt], 0, 0, 0);
        }
    AT* op = C_MIX + (size_t)(row0 + pr) * D + 1536 + g * 128 + 4 * kg;
#pragma unroll
    for (int nt = 0; nt < 8; ++nt) {
        const float u0 = __uint_as_float(uu[nt].x << 16), u1 = __uint_as_float(uu[nt].x & 0xffff0000u), u2 = __uint_as_float(uu[nt].y << 16), u3 = __uint_as_float(uu[nt].y & 0xffff0000u);
        float4 o; o.x = gelu_fast(u0) * (acc[nt][0] + bs); o.y = gelu_fast(u1) * (acc[nt][1] + bs); o.z = gelu_fast(u2) * (acc[nt][2] + bs); o.w = gelu_fast(u3) * (acc[nt][3] + bs);
        st4(op + 16 * nt, o);
    }
    if (C.tid == 0) *qslot = nq_;
}

constexpr int CW_MTC = 32768;
constexpr int CW_Q = 16384 + 256;
constexpr int CW_CTXDONE = 16384 + 384;
constexpr int CW_INP = 16384 + 512;
__device__ __forceinline__ void ph_mixers(const Ctx& C, int l) {
    const bool last = (l == DEPTH - 1);
    bool attn_ok = false, sgu_ok = false, sguc_ok = false, attnc_ok = false;
    const int nC = last ? 0 : 12, nCS = last ? 0 : 8, nB = 192, nA = 192, nG = last ? 0 : 8, nS = 256;
    const int total = nC + nCS + nB + nA + nG + nS;
    LAS int* qs = (LAS int*)(C.lds + att::QSLOT_OFF);
    unsigned* ctr = C_CTLW + CW_Q + l;
    unsigned* ctxdone = C_CTLW + CW_CTXDONE;
    bool claimed = false;
    for (;;) {
        __syncthreads();
        if (!claimed && C.tid == 0) *qs = (int)atomicAdd(ctr, 1u);
        __syncthreads();
        int r = *qs;
        if (r >= total) break;
        int kind = -1, u = 0, h = 0;
        if (r < nC) { kind = 2 + r / 6; h = r % 6; }
        else { r -= nC;
          if (r < nCS) { kind = 5; u = 64 + r / 4; h = r % 4; }
          else { r -= nCS;
            if (r < nG) { kind = 4; u = r; }
            else { r -= nG;
              if (r < nB) { kind = 1; u = r / 6; h = r % 6; }
              else { r -= nB;
                if (r < nA) { kind = 0; u = r / 6; h = r % 6; }
                else { r -= nA; kind = 5; u = r / 4; h = r % 4; } } } } }
        claimed = (kind != 4);
        if ((kind == 0 || kind == 1) && !attn_ok) { wg_wait_ge(C_CTLW + CW_INP + l * 128, (NTOK / 256) * 14); attn_ok = true; }
        if ((kind == 2 || kind == 3) && !attnc_ok) { wg_wait_ge(C_CTLW + CW_INP + 256 + l * 64 + 32, 14u); attnc_ok = true; }
        if (kind == 5 && u >= 64 && !sguc_ok) { wg_wait_ge(C_CTLW + CW_INP + 256 + l * 64, 4u); sguc_ok = true; }
        if (kind == 5 && u < 64 && !sgu_ok) { wg_wait_ge(C_CTLW + CW_INP + l * 128 + 64, (SEQ / 256) * 4); sgu_ok = true; }
        int t_ = threadIdx.x; asm volatile("" : "+v"(t_));
        if (kind == 1) att::attn_unit<1>(C_P, C_MIX, C_rpb + l * 6 * 465, C_sink + l * 6, u, h, (LAS char*)C.lds, t_, ctr, qs);
        else if (kind == 0) att::attn_unit<0>(C_P, C_MIX, C_rpb + l * 6 * 465, C_sink + l * 6, u, h, (LAS char*)C.lds, t_, ctr, qs);
        else if (kind == 2) att::attn_unit<2>(C_P, C_MIX, C_rpb + l * 6 * 465, C_sink + l * 6, u, h, (LAS char*)C.lds, t_, ctr, qs);
        else if (kind == 3) att::attn_unit<3>(C_P, C_MIX, C_rpb + l * 6 * 465, C_sink + l * 6, u, h, (LAS char*)C.lds, t_, ctr, qs);
        else if (kind == 5) { Ctx C2 = C; C2.tid = t_; C2.lane = t_ & 63; C2.wave = __builtin_amdgcn_readfirstlane(t_ >> 6); sgu_item(C2, l, u, h, ctr, qs); }
        else {
            if (t_ < 64) {
                unsigned sp = 0;
                while (__builtin_amdgcn_readfirstlane((int)__hip_atomic_load(ctxdone, __ATOMIC_RELAXED, __HIP_MEMORY_SCOPE_AGENT)) < nC + nCS) { __builtin_amdgcn_s_sleep(2); if (++sp > (1u << 22)) break; }
                __builtin_amdgcn_fence(__ATOMIC_ACQUIRE, "agent");
                asm volatile("s_waitcnt vmcnt(0)" ::: "memory");
            }
            __syncthreads();
            pg8::Unit uu; uu.pm = SEQ / 256; uu.pn = u; uu.A = (const char*)(C_MIX + (size_t)SEQ * D); uu.B = (const char*)(C_WOUT + (size_t)l * D * D + (size_t)u * 256 * D);
            pg8::OneUnit S{uu};
            pg8::EpiTln E{C.in, C.ws + C.z, l};
            pg8::gemm_phase<D>(C.lds, S, E);
        }
        if (kind == 2 || kind == 3 || (kind == 5 && u >= 64)) {
            asm volatile("s_waitcnt vmcnt(0)" ::: "memory");
            __syncthreads();
            if (threadIdx.x == 0) { __builtin_amdgcn_fence(__ATOMIC_RELEASE, "agent"); asm volatile("s_waitcnt vmcnt(0)" ::: "memory"); __hip_atomic_fetch_add(ctxdone, 1u, __ATOMIC_RELAXED, __HIP_MEMORY_SCOPE_AGENT); }
        }
    }
}

__device__ __forceinline__ void ph_ln1(const Ctx& C, int l) {
    typedef short bf16x8v __attribute__((ext_vector_type(8)));
    typedef float f32x4v __attribute__((ext_vector_type(4)));
    const bool last = (l == DEPTH - 1);
    const int nrows = last ? SEQ : NTOK;
    const int RPB = __builtin_amdgcn_readfirstlane((nrows + C.G - 1) / C.G);
    const int row_lo = __builtin_amdgcn_readfirstlane(C.bid * RPB), row_hi = __builtin_amdgcn_readfirstlane((row_lo + RPB < nrows) ? row_lo + RPB : nrows);
    const int lane = C.lane, wave = C.wave, tid = C.tid;
    LAS float* hbuf = (LAS float*)C.lds;
    LAS float* red = (LAS float*)C.lds;
    LAS int* hist = (LAS int*)(C.lds + 131072 + 1024);
    LAS int* rinfo = hist + 64;
    LAS int* rrank = rinfo + 256;
    const float* gam = C_ln1_g + l * D; const float* bet = C_ln1_b + l * D;
    if (tid < 32) hist[tid] = 0;
    LAS float* vecs = (LAS float*)(C.lds + 135168);
    { *(LAS f32x4v*)(vecs + 4 * tid) = *(const f32x4v*)(gam + 4 * tid); *(LAS f32x4v*)(vecs + D + 4 * tid) = *(const f32x4v*)(bet + 4 * tid);
      *(LAS f32x4v*)(vecs + 2 * D + 4 * tid) = *(const f32x4v*)(modp(C, l, 0, 4) + 4 * tid); }
    for (int sr = 0; row_lo + 16 * sr < row_hi; ++sr) {
        __syncthreads();
#pragma unroll
        for (int hsel = 0; hsel < 2; ++hsel) {
            const int slot = wave + 8 * hsel, r = row_lo + 16 * sr + slot;
            LAS float* hr = hbuf + slot * D;
            if (r < row_hi) {
                const int kind = r < SEQ ? 0 : 1;
                const bf16_t* tp = C_T + (size_t)r * D;
                const float* sc2 = modp(C, l, kind, 4); const float* sh2 = modp(C, l, kind, 3);
                float v[32]; float sm = 0.f;
                f32x4v shv[8];
#pragma unroll
                for (int j = 0; j < 8; ++j) { const float4 t4 = ld4(tp + 4 * lane + 256 * j); shv[j] = *(const f32x4v*)(sh2 + 4 * lane + 256 * j);
                    v[4 * j] = t4.x; v[4 * j + 1] = t4.y; v[4 * j + 2] = t4.z; v[4 * j + 3] = t4.w; sm += (t4.x + t4.y) + (t4.z + t4.w); }
                const float mu = wave_sum(sm) * (1.f / D);
                float q = 0.f;
#pragma unroll
                for (int k = 0; k < 32; ++k) { v[k] -= mu; q += v[k] * v[k]; }
                const float rstd = 1.0f / sqrtf(wave_sum(q) * (1.f / D) + LN_EPS);
                if (lane == 0) { C_STAT[2 * r] = mu; C_STAT[2 * r + 1] = rstd; }
#pragma unroll
                for (int j = 0; j < 8; ++j) {
                    const int d0 = 4 * lane + 256 * j;
                    const f32x4v g4v = *(const LAS f32x4v*)(vecs + d0), b4v = *(const LAS f32x4v*)(vecs + D + d0);
                    f32x4v sc4v = *(const LAS f32x4v*)(vecs + 2 * D + d0);
                    if (kind) sc4v = *(const f32x4v*)(sc2 + d0);
                    const float4 g4 = {g4v[0], g4v[1], g4v[2], g4v[3]}, b4 = {b4v[0], b4v[1], b4v[2], b4v[3]}, sc4 = {sc4v[0], sc4v[1], sc4v[2], sc4v[3]}, sh4 = {shv[j][0], shv[j][1], shv[j][2], shv[j][3]};
                    float4 x1, h2;
                    x1.x = v[4 * j + 0] * rstd * g4.x + b4.x; x1.y = v[4 * j + 1] * rstd * g4.y + b4.y; x1.z = v[4 * j + 2] * rstd * g4.z + b4.z; x1.w = v[4 * j + 3] * rstd * g4.w + b4.w;
                    h2.x = x1.x * (1.f + sc4.x) + sh4.x; h2.y = x1.y * (1.f + sc4.y) + sh4.y; h2.z = x1.z * (1.f + sc4.z) + sh4.z; h2.w = x1.w * (1.f + sc4.w) + sh4.w;
                    st4(&C_H2[(size_t)r * D + d0], h2);
                    *(LAS f32x4v*)(hr + d0) = (f32x4v){h2.x, h2.y, h2.z, h2.w};
                }
            } else {
#pragma unroll
                for (int j = 0; j < 8; ++j) *(LAS f32x4v*)(hr + 4 * lane + 256 * j) = (f32x4v){0.f, 0.f, 0.f, 0.f};
            }
        }
        __syncthreads();
        f32x4v acc0 = {0.f, 0.f, 0.f, 0.f}, acc1 = {0.f, 0.f, 0.f, 0.f};
        {
            const int m16 = lane & 15, kg = lane >> 4;
            const bf16_t* wt = C_WRT + (size_t)m16 * D + 256 * wave + 8 * kg;
            const LAS float* ar = hbuf + m16 * D + 256 * wave + 8 * kg;
#pragma unroll 4
            for (int ks = 0; ks < 8; ++ks) {
                const f32x4v a0 = *(const LAS f32x4v*)(ar + 32 * ks), a1 = *(const LAS f32x4v*)(ar + 32 * ks + 4);
                uint4 hi, lo;
                hi.x = pg8::cvt_pk_bf16(a0[0], a0[1]); hi.y = pg8::cvt_pk_bf16(a0[2], a0[3]); hi.z = pg8::cvt_pk_bf16(a1[0], a1[1]); hi.w = pg8::cvt_pk_bf16(a1[2], a1[3]);
                lo.x = pg8::cvt_pk_bf16(a0[0] - __uint_as_float(hi.x << 16), a0[1] - __uint_as_float(hi.x & 0xffff0000u));
                lo.y = pg8::cvt_pk_bf16(a0[2] - __uint_as_float(hi.y << 16), a0[3] - __uint_as_float(hi.y & 0xffff0000u));
                lo.z = pg8::cvt_pk_bf16(a1[0] - __uint_as_float(hi.z << 16), a1[1] - __uint_as_float(hi.z & 0xffff0000u));
                lo.w = pg8::cvt_pk_bf16(a1[2] - __uint_as_float(hi.w << 16), a1[3] - __uint_as_float(hi.w & 0xffff0000u));
                const bf16x8v Ah = *reinterpret_cast<bf16x8v*>(&hi), Al = *reinterpret_cast<bf16x8v*>(&lo);
                const bf16x8v B0h = *reinterpret_cast<const bf16x8v*>(wt + 32 * ks), B1h = *reinterpret_cast<const bf16x8v*>(wt + 16 * D + 32 * ks);
                const bf16x8v B0l = *reinterpret_cast<const bf16x8v*>(wt + NE * D + 32 * ks), B1l = *reinterpret_cast<const bf16x8v*>(wt + NE * D + 16 * D + 32 * ks);
                acc0 = __builtin_amdgcn_mfma_f32_16x16x32_bf16(Ah, B0h, acc0, 0, 0, 0); acc1 = __builtin_amdgcn_mfma_f32_16x16x32_bf16(Ah, B1h, acc1, 0, 0, 0);
                acc0 = __builtin_amdgcn_mfma_f32_16x16x32_bf16(Ah, B0l, acc0, 0, 0, 0); acc1 = __builtin_amdgcn_mfma_f32_16x16x32_bf16(Ah, B1l, acc1, 0, 0, 0);
                acc0 = __builtin_amdgcn_mfma_f32_16x16x32_bf16(Al, B0h, acc0, 0, 0, 0); acc1 = __builtin_amdgcn_mfma_f32_16x16x32_bf16(Al, B1h, acc1, 0, 0, 0);
            }
        }
        __syncthreads();
        {
            const int m16 = lane & 15, kg = lane >> 4;
#pragma unroll
            for (int reg = 0; reg < 4; ++reg) { red[(wave * 16 + 4 * kg + reg) * 32 + m16] = acc0[reg]; red[(wave * 16 + 4 * kg + reg) * 32 + 16 + m16] = acc1[reg]; }
        }
        __syncthreads();
        if (tid < 16 && row_lo + 16 * sr + tid < row_hi) {
            const int r = row_lo + 16 * sr + tid;
            float bestgs = -3.0e38f; int be0 = 0, be1 = 0; float bw0 = 0.f, bw1 = 0.f;
#pragma unroll 1
            for (int gq2 = 0; gq2 < 4; ++gq2) {
                float m1 = -3.0e38f, m2 = -3.0e38f, s1 = 0.f, s2 = 0.f; int i1 = 0, i2 = 0;
#pragma unroll 1
                for (int t = 0; t < 8; ++t) {
                    const int e = gq2 * 8 + t;
                    float lg = 0.f;
#pragma unroll
                    for (int w = 0; w < 8; ++w) lg += red[(w * 16 + tid) * 32 + e];
                    const float scv = 1.f / (1.f + expf(-lg)), bv = scv + C_router_bias[e];
                    if (bv > m1) { m2 = m1; i2 = i1; s2 = s1; m1 = bv; i1 = e; s1 = scv; }
                    else if (bv > m2) { m2 = bv; i2 = e; s2 = scv; }
                }
                const float gs = m1 + m2;
                if (gs > bestgs) { bestgs = gs; be0 = i1; be1 = i2; bw0 = s1; bw1 = s2; }
            }
            const float inv = 1.f / (bw0 + bw1);
            LAS int* ri = rinfo + (r - row_lo) * 4;
            ri[0] = be0; ri[1] = be1; ri[2] = __float_as_int(bw0 * inv); ri[3] = __float_as_int(bw1 * inv);
        }
    }
    const int nb = row_hi - row_lo;
    __syncthreads();
    int e_mine = 0;
    if (tid < 2 * nb) { e_mine = rinfo[(tid >> 1) * 4 + (tid & 1)]; rrank[tid] = (int)__hip_atomic_fetch_add((LAS unsigned*)(hist + e_mine), 1u, __ATOMIC_RELAXED, __HIP_MEMORY_SCOPE_WORKGROUP); }
    __syncthreads();
    if (tid < 32) { const int cnt = hist[tid]; hist[32 + tid] = cnt ? (int)atomicAdd(C_CTLW + CW_CNT + l * 32 + tid, (unsigned)cnt) : 0; }
    __syncthreads();
    if (tid < 2 * nb) {
        const int r = row_lo + (tid >> 1), k = tid & 1;
        const int pos = hist[32 + e_mine] + rrank[tid];
        C_POS[(size_t)r * 2 + k] = pos;
        C_ROUTE[(size_t)r * 4 + k] = e_mine;
        C_LIST[(size_t)e_mine * LCAP + pos] = r;
        C_SWL[(size_t)e_mine * LCAP + pos] = __int_as_float(rinfo[(tid >> 1) * 4 + 2 + k]);
    }
}

constexpr int TOFF_OFF = 131072;
__device__ __forceinline__ void compute_toff(const Ctx& C, int l) {
    LAS int* toff = (LAS int*)(C.lds + TOFF_OFF);
    __syncthreads();
    if (C.tid < 64) {
        const int e = C.tid & 31;
        const int c = C.tid < 32 ? (int)__hip_atomic_load(C_CTLW + CW_CNT + l * 32 + e, __ATOMIC_RELAXED, __HIP_MEMORY_SCOPE_AGENT) : 0;
        const int nt = (c + 255) >> 8; int inc = nt;
#pragma unroll
        for (int d = 1; d < 32; d <<= 1) { const int o = __shfl_up(inc, d); if ((C.tid & 63) >= d) inc += o; }
        if (C.tid < 32) { toff[e] = inc - nt; toff[40 + e] = c; if (e == 31) toff[NE] = inc; }
    }
    __syncthreads();
}
__device__ __forceinline__ void ph_dispatch(const Ctx& C, int l) {
    const bool last = (l == DEPTH - 1);
    const int nrows = last ? SEQ : NTOK;
    const int gw = C.bid * NWAVES + C.wave, NGW = C.G * NWAVES, lane = C.lane;
    compute_toff(C, l);
    const LAS int* toff = (const LAS int*)(C.lds + TOFF_OFF);
    for (int it = gw; it < nrows * 2; it += NGW) {
        const int r = it >> 1, k = it & 1;
        const int e = C_ROUTE[(size_t)r * 4 + k];
        const int slot = toff[e] * 256 + C_POS[it];
        if (lane == 0) { C_SLOT[it] = slot; C_SW[slot] = __int_as_float(C_ROUTE[(size_t)r * 4 + 2 + k]); }
        const uint4* src = (const uint4*)(C_H2 + (size_t)r * D); uint4* dst = (uint4*)(C_HS + (size_t)slot * D);
#pragma unroll
        for (int j = 0; j < 4; ++j) dst[lane + 64 * j] = src[lane + 64 * j];
    }
}

__device__ __forceinline__ void ph_ln2(const Ctx& C, int l) {
    const bool last = (l == DEPTH - 1);
    const int nrows = last ? SEQ : NTOK;
    const int gw = C.bid * NWAVES + C.wave, NGW = C.G * NWAVES, lane = C.lane;
    compute_toff(C, l);
    const LAS int* toff = (const LAS int*)(C.lds + TOFF_OFF);
    LAS float* vec0 = (LAS float*)C.lds;
    {
        const int ln = last ? l : l + 1;
#pragma unroll
        for (int k = 0; k < 2; ++k) {
            *(LAS pg8::f32x4*)(vec0 + (k * 5 + 0) * D + 4 * C.tid) = *(const pg8::f32x4*)(modp(C, l, k, 5) + 4 * C.tid);
            *(LAS pg8::f32x4*)(vec0 + (k * 5 + 1) * D + 4 * C.tid) = *(const pg8::f32x4*)(C_ln2_g + l * D + 4 * C.tid);
            *(LAS pg8::f32x4*)(vec0 + (k * 5 + 2) * D + 4 * C.tid) = *(const pg8::f32x4*)(C_ln2_b + l * D + 4 * C.tid);
            *(LAS pg8::f32x4*)(vec0 + (k * 5 + 3) * D + 4 * C.tid) = *(const pg8::f32x4*)(modp(C, ln, k, 1) + 4 * C.tid);
            *(LAS pg8::f32x4*)(vec0 + (k * 5 + 4) * D + 4 * C.tid) = *(const pg8::f32x4*)(modp(C, ln, k, 0) + 4 * C.tid);
        }
        *(LAS pg8::f32x4*)(vec0 + 10 * D + 4 * C.tid) = *(const pg8::f32x4*)(C_ln1_g + l * D + 4 * C.tid);
        *(LAS pg8::f32x4*)(vec0 + 11 * D + 4 * C.tid) = *(const pg8::f32x4*)(C_ln1_b + l * D + 4 * C.tid);
        __syncthreads();
    }
    uint2 nx[8], na[8], nb2[8]; float nmu = 0.f, nrs = 0.f;
    int s0 = 0, s1 = 0;
    int e0_ = 0, e1_ = 0, p0_ = 0, p1_ = 0;
#define LN2_SLOTS_ISSUE(rr) do { e0_ = 0; e1_ = 0; p0_ = 0; p1_ = 0; if ((rr) < nrows) { e0_ = C_ROUTE[(size_t)(rr) * 4]; e1_ = C_ROUTE[(size_t)(rr) * 4 + 1]; p0_ = C_POS[2 * (rr)]; p1_ = C_POS[2 * (rr) + 1]; } } while (0)
#define LN2_SLOTS_FIN() do { s0 = toff[e0_] * 256 + p0_; s1 = toff[e1_] * 256 + p1_; } while (0)
#define LN2_LOAD(rr) do { if ((rr) < nrows) { _Pragma("unroll") for (int j = 0; j < 8; ++j) { const int d0 = 4 * lane + 256 * j;                                   \
        nx[j] = *(const uint2*)(C_T + (size_t)(rr) * D + d0); na[j] = *(const uint2*)(C_Y + (size_t)s0 * D + d0); nb2[j] = *(const uint2*)(C_Y + (size_t)s1 * D + d0); } \
        nmu = C_STAT[2 * (rr)]; nrs = C_STAT[2 * (rr) + 1]; } } while (0)
    const int lane0 = C.lane;
    { const int lane = lane0; LN2_SLOTS_ISSUE(gw); LN2_SLOTS_FIN(); LN2_LOAD(gw); }
    LN2_SLOTS_ISSUE(gw + NGW); LN2_SLOTS_FIN();
    for (int r = gw; r < nrows; r += NGW) {
        int lane = lane0; asm volatile("" : "+v"(lane));
        const LAS float* vec = vec0 + (r < SEQ ? 0 : 5 * D);
        const float mu1 = nmu, rs1 = nrs;
        float v[32]; float s = 0.f;
#pragma unroll
        for (int j = 0; j < 8; ++j) { const int d0 = 4 * lane + 256 * j;
            float4 xq; xq.x = __uint_as_float(nx[j].x << 16); xq.y = __uint_as_float(nx[j].x & 0xffff0000u); xq.z = __uint_as_float(nx[j].y << 16); xq.w = __uint_as_float(nx[j].y & 0xffff0000u);
            { const pg8::f32x4 ga = *(const LAS pg8::f32x4*)(vec0 + 10 * D + d0), be = *(const LAS pg8::f32x4*)(vec0 + 11 * D + d0);
              xq.x = (xq.x - mu1) * rs1 * ga[0] + be[0]; xq.y = (xq.y - mu1) * rs1 * ga[1] + be[1]; xq.z = (xq.z - mu1) * rs1 * ga[2] + be[2]; xq.w = (xq.w - mu1) * rs1 * ga[3] + be[3]; }
            const pg8::f32x4 g4 = *(const LAS pg8::f32x4*)(vec + d0);
            const float y0 = __uint_as_float(na[j].x << 16) + __uint_as_float(nb2[j].x << 16), y1 = __uint_as_float(na[j].x & 0xffff0000u) + __uint_as_float(nb2[j].x & 0xffff0000u);
            const float y2 = __uint_as_float(na[j].y << 16) + __uint_as_float(nb2[j].y << 16), y3 = __uint_as_float(na[j].y & 0xffff0000u) + __uint_as_float(nb2[j].y & 0xffff0000u);
            v[4 * j + 0] = ALPHA * xq.x + g4[0] * y0; v[4 * j + 1] = ALPHA * xq.y + g4[1] * y1; v[4 * j + 2] = ALPHA * xq.z + g4[2] * y2; v[4 * j + 3] = ALPHA * xq.w + g4[3] * y3;
            s += (v[4 * j] + v[4 * j + 1]) + (v[4 * j + 2] + v[4 * j + 3]); }
        asm volatile("" ::: "memory");
        LN2_SLOTS_ISSUE(r + 2 * NGW); LN2_LOAD(r + NGW);
        const float mu = wave_sum(s) * (1.f / D);
        float q = 0.f;
#pragma unroll
        for (int i = 0; i < 32; ++i) { v[i] -= mu; q += v[i] * v[i]; }
        const float rstd = 1.0f / sqrtf(wave_sum(q) * (1.f / D) + LN_EPS);
        int rr = r; asm volatile("" : "+v"(rr) :: "memory");
#pragma unroll
        for (int j = 0; j < 8; ++j) { const int d0 = 4 * lane + 256 * j;
            const pg8::f32x4 g4 = *(const LAS pg8::f32x4*)(vec + D + d0), b4 = *(const LAS pg8::f32x4*)(vec + 2 * D + d0);
            float4 xo;
            xo.x = v[4 * j + 0] * rstd * g4[0] + b4[0]; xo.y = v[4 * j + 1] * rstd * g4[1] + b4[1]; xo.z = v[4 * j + 2] * rstd * g4[2] + b4[2]; xo.w = v[4 * j + 3] * rstd * g4[3] + b4[3];
            if (last) *(float4*)(C.out + C.z + (size_t)rr * D + d0) = xo;
            else {
                st4((bf16_t*)C_XB + (size_t)rr * D + d0, xo);
                const pg8::f32x4 sc4 = *(const LAS pg8::f32x4*)(vec + 3 * D + d0), sh4 = *(const LAS pg8::f32x4*)(vec + 4 * D + d0);
                float4 hn; hn.x = xo.x * (1.f + sc4[0]) + sh4[0]; hn.y = xo.y * (1.f + sc4[1]) + sh4[1]; hn.z = xo.z * (1.f + sc4[2]) + sh4[2]; hn.w = xo.w * (1.f + sc4[3]) + sh4[3];
                st4(&C_H[(size_t)rr * D + d0], hn);
            }
        }
        LN2_SLOTS_FIN();
    }
}

#undef LN2_SLOTS_ISSUE
#undef LN2_SLOTS_FIN
#undef LN2_LOAD
__device__ __forceinline__ Ctx fresh(const Ctx& C0) { Ctx C = C0; size_t z = 0; int t = threadIdx.x; int g_ = gridDim.x, b_ = blockIdx.x; asm volatile("" : "+s"(z), "+v"(t), "+s"(g_), "+s"(b_)); C.G = g_; C.bid = b_; C.z = z; C.tid = t; C.lane = t & 63; C.wave = __builtin_amdgcn_readfirstlane(t >> 6); return C; }
constexpr int PH_PER_LAYER = 6;
constexpr int N_PHASES = 2 + PH_PER_LAYER * DEPTH;
__global__ void __launch_bounds__(NTHREADS, 2) fwd_kernel(Args args) {
    extern __shared__ __attribute__((aligned(16))) unsigned char lds_raw[];
    Ctx C0;
    C0.lds = (LAS unsigned char*)lds_raw;
    C0.tid = threadIdx.x; C0.lane = C0.tid & 63; C0.wave = __builtin_amdgcn_readfirstlane(C0.tid >> 6); C0.G = gridDim.x; C0.bid = blockIdx.x;
    C0.in = args.in; C0.out = args.out; C0.ws = args.ws; C0.z = 0;
    unsigned char* ws = args.ws;

    volatile LAS unsigned* bst = (volatile LAS unsigned*)(C0.lds + LDS_BYTES - 16);
    if (C0.tid < 4) bst[C0.tid] = 0u;
    __syncthreads();
    const int lo = args.ph_lo, hi = args.ph_hi;
    XcdBarrier bar; bar.bar = (unsigned*)(ws + WS_CTL) + CW_BAR; bar.x = 0; bar.st = bst;
    if (hi - lo > 1) bar = xcd_barrier_post((unsigned*)(ws + WS_CTL) + CW_BAR, bst);
#define IN(k) (lo <= (k) && (k) < hi)
#define SEAM(k) do { if (IN(k) && IN((k) + 1)) xcd_barrier(bar); } while (0)

    if (IN(0)) { const Ctx C = fresh(C0); ph_prologue(C); }
    if (IN(1)) { const Ctx C = fresh(C0); ph_modulate0(C); } SEAM(1);
#pragma unroll 1
    for (int l = 0; l < DEPTH; ++l) {
        const int pb = 2 + PH_PER_LAYER * l;
        const bool last = (l == DEPTH - 1);
        if (IN(pb + 0)) {
            const Ctx C = fresh(C0);
            const int vid = (C.G % 8 == 0) ? (C.bid % 8) * (C.G / 8) + C.bid / 8 : C.bid;
            pg8::InprojSched S{C.G, vid, (const char*)C_H, (const char*)(C_WIN + (size_t)l * INC * D), C_CTLW + CW_INP + l * 128, C_CTLW + CW_INP + 256 + l * 64, (l == DEPTH - 1 || C.G != 256) ? 0 : 8};
            pg8::EpiP E{C_P, C_ROPE};
            pg8::gemm_phase<D>(C.lds, S, E);
        }
        if (IN(pb + 1)) { const Ctx C = fresh(C0); ph_mixers(C, l); } SEAM(pb + 1);
        if (IN(pb + 2)) {
            const Ctx C = fresh(C0);
            pg8::DenseSched<D / 256, D> S{SEQ / 256, C.G, C.bid, (const char*)C_MIX, (const char*)(C_WOUT + (size_t)l * D * D)};
            pg8::EpiTln E{C.in, C.ws + C.z, l};
            pg8::gemm_phase<D>(C.lds, S, E);
        }
        SEAM(pb + 3);
        if (IN(pb + 4)) {
            const Ctx C = fresh(C0);
            compute_toff(C, l);
            const int vid = (C.G % 8 == 0) ? (C.bid % 8) * (C.G / 8) + C.bid / 8 : C.bid;
            unsigned* mtc = C_CTLW + CW_MTC + l * (128 * 64);
            { pg8::MoeSched1 S{(const LAS int*)(C.lds + TOFF_OFF), C.G, vid, (const char*)C_H2, (const char*)(C_WGU + (size_t)l * NE * 1024 * D), mtc, C_LIST, C_SWL};
              pg8::EpiMoe1 E{C_HID};
              pg8::gemm_phase<D, pg8::EpiMoe1, pg8::MoeSched1, true, true, true, true>(C.lds, S, E); }
            { pg8::MoeSched2 S{(const LAS int*)(C.lds + TOFF_OFF), C.G, vid, (const char*)C_HID, (const char*)(C_WD + (size_t)l * NE * D * FF), mtc};
              pg8::EpiBf16 E{C_Y, D};
              pg8::gemm_phase<FF, pg8::EpiBf16, pg8::MoeSched2, true, false, false, true>(C.lds, S, E); }
        }
        SEAM(pb + 4);
        if (IN(pb + 5)) { const Ctx C = fresh(C0); ph_ln2(C, l); }
        if (!last) SEAM(pb + 5);
    }
#undef IN
#undef SEAM
}

#ifndef MK_N_LAUNCHES
#define MK_N_LAUNCHES 1
#endif
extern "C" void kernel_launch(void* const* d_in, const int* in_sizes, int n_in, void* d_out, int out_size, void* d_ws, size_t ws_size, hipStream_t stream) {
    static int grid = 0;
    if (grid == 0) {
        if (n_in != 23 || out_size != SEQ * D || ws_size < WS_END) {
            fprintf(stderr, "kernel_launch: unexpected shapes: n_in %d out %d ws %zu (need %zu)\n", n_in, out_size, ws_size, (size_t)WS_END); grid = -1; return; }
        int dev = 0, cus = 0;
        if (hipGetDevice(&dev) != hipSuccess || hipDeviceGetAttribute(&cus, hipDeviceAttributeMultiprocessorCount, dev) != hipSuccess) { grid = -1; return; }
        if (hipFuncSetAttribute((const void*)fwd_kernel, hipFuncAttributeMaxDynamicSharedMemorySize, LDS_BYTES) != hipSuccess) { fprintf(stderr, "kernel_launch: hipFuncSetAttribute failed\n"); grid = -1; return; }
        int per_cu = 0;
        if (hipOccupancyMaxActiveBlocksPerMultiprocessor(&per_cu, (const void*)fwd_kernel, NTHREADS, LDS_BYTES) != hipSuccess || per_cu < 1) fprintf(stderr, "kernel_launch: occupancy query says %d\n", per_cu);
        (void)hipGetLastError();
        grid = cus;
    }
    if (grid < 0) return;
    hipMemsetAsync((char*)d_ws + WS_CTL, 0, CTL_BYTES, stream);
    Args a{};
    for (int i = 0; i < 23; ++i) a.in[i] = (const float*)d_in[i];
    a.out = (float*)d_out; a.ws = (unsigned char*)d_ws;
    if (MK_N_LAUNCHES == 1) {
        a.ph_lo = 0; a.ph_hi = N_PHASES;
        hipLaunchKernelGGL(fwd_kernel, dim3(grid), dim3(NTHREADS), LDS_BYTES, stream, a);
    } else {
        for (int p = 0; p < N_PHASES; ++p) {
            a.ph_lo = p; a.ph_hi = p + 1;
            hipLaunchKernelGGL(fwd_kernel, dim3(grid), dim3(NTHREADS), LDS_BYTES, stream, a);
        }
    }
    const hipError_t le = hipPeekAtLastError();
    if (le != hipSuccess) fprintf(stderr, "kernel_launch: launch failed: %s\n", hipGetErrorName(le));
}
```
